# Optimizing an MI355X kernel written in HIP

```python
import jax, jax.numpy as jnp
from jax import lax
import numpy as np

D_MODEL = 1024
BATCH = 4
SEQ = 8192
DEPTH = 1

HEAD_DIM = 64
N_SB_HEADS = 8
N_SW_HEADS = 8
N_SW_KV_HEADS = 2
D_SB = N_SB_HEADS * HEAD_DIM
D_SW = N_SW_HEADS * HEAD_DIM
D_SW_KV = N_SW_KV_HEADS * HEAD_DIM
D_MIX = D_SB + D_SW
D_IN = 3 * D_SB + D_SW + 2 * D_SW_KV
IN_SPLITS = (D_SB, 2 * D_SB, 3 * D_SB, 3 * D_SB + D_SW, 3 * D_SB + D_SW + D_SW_KV)
Q_BLOCK = 128
WINDOW = 128
ROPE_THETA = 10000.0
N_GROUPS = 4
EXPERTS_PER_GROUP = 4
N_EXPERTS = N_GROUPS * EXPERTS_PER_GROUP
TOP_K = 2
D_EXPERT = 512
EXPERT_BLOCK = 128
EPS = 1e-6

kernel_name = "hymba_sb_swa_hmoe_adaln_block"


def rmsnorm(x, g):
    xf = x.astype(jnp.float32)
    y = xf * lax.rsqrt(jnp.mean(xf * xf, axis=-1, keepdims=True) + EPS)
    return (y * g.astype(jnp.float32)).astype(x.dtype)


def rope(x, positions):
    d = x.shape[-1]
    inv_freq = ROPE_THETA ** (-jnp.arange(0, d, 2, dtype=jnp.float32) / d)
    ang = positions.astype(jnp.float32)[..., None] * inv_freq
    cos = jnp.cos(ang)[:, :, None, :]
    sin = jnp.sin(ang)[:, :, None, :]
    xf = x.astype(jnp.float32)
    x1, x2 = xf[..., : d // 2], xf[..., d // 2:]
    return jnp.concatenate([x1 * cos - x2 * sin, x2 * cos + x1 * sin], axis=-1).astype(x.dtype)


def stick_breaking_attention(q, k, v):
    B, S, H, d = q.shape
    nblk = S // Q_BLOCK
    scale = d ** -0.5
    qb = q.reshape(B, nblk, Q_BLOCK, H, d).transpose(1, 0, 2, 3, 4)
    kf = k.astype(jnp.float32)
    vf = v.astype(jnp.float32)
    key_pos = jnp.arange(S)

    def one_block(args):
        i, qi = args
        z = jnp.einsum('bqhd,bkhd->bhqk', qi.astype(jnp.float32), kf) * scale
        q_pos = i * Q_BLOCK + jnp.arange(Q_BLOCK)
        causal = key_pos[None, :] < q_pos[:, None]
        log_beta = jax.nn.log_sigmoid(z)
        log_one_minus = jnp.where(causal, jax.nn.log_sigmoid(-z), 0.0)
        suffix = lax.cumsum(log_one_minus, axis=3, reverse=True) - log_one_minus
        weights = jnp.where(causal, jnp.exp(log_beta + suffix), 0.0)
        return jnp.einsum('bhqk,bkhd->bqhd', weights, vf)

    out = lax.map(one_block, (jnp.arange(nblk), qb))
    return out.transpose(1, 0, 2, 3, 4).reshape(B, S, H, d).astype(q.dtype)


def sliding_window_attention(q, k, v, sinks):
    B, S, Hq, d = q.shape
    Hkv = k.shape[2]
    rep = Hq // Hkv
    nblk = S // WINDOW
    scale = d ** -0.5
    qb = q.reshape(B, nblk, WINDOW, Hkv, rep, d)

    def with_prev(t):
        tb = t.reshape(B, nblk, WINDOW, Hkv, d)
        prev = jnp.pad(tb, ((0, 0), (1, 0), (0, 0), (0, 0), (0, 0)))[:, :-1]
        return jnp.concatenate([prev, tb], axis=2)

    kb = with_prev(k)
    vb = with_prev(v)
    s = jnp.einsum('bnqgrd,bnkgd->bngrqk', qb, kb,
                   preferred_element_type=jnp.float32) * scale
    qi = jnp.arange(WINDOW)[:, None]
    kk = jnp.arange(2 * WINDOW)[None, :]
    diff = WINDOW + qi - kk
    in_window = (diff >= 0) & (diff < WINDOW)
    blk = jnp.arange(nblk)[:, None, None]
    key_exists = blk * WINDOW + kk[None] - WINDOW >= 0
    mask = (in_window[None] & key_exists)[None, :, None, None]
    s = jnp.where(mask, s, -1e30)
    sink = sinks.astype(jnp.float32).reshape(1, 1, Hkv, rep, 1, 1)
    m = jnp.maximum(jnp.max(s, axis=-1, keepdims=True), sink)
    p = jnp.exp(s - m)
    denom = jnp.sum(p, axis=-1, keepdims=True) + jnp.exp(sink - m)
    p = (p / denom).astype(v.dtype)
    out = jnp.einsum('bngrqk,bnkgd->bnqgrd', p, vb)
    return out.reshape(B, S, Hq, d)


def hierarchical_moe(h, w_router_group, w_router_expert, w_gate, w_up, w_down):
    B, S, D = h.shape
    T = B * S
    xt = h.reshape(T, D)
    group_logits = jnp.einsum('td,dg->tg', xt, w_router_group, preferred_element_type=jnp.float32)
    group_probs = jax.nn.softmax(group_logits, axis=-1)
    g_sel = jnp.argmax(group_logits, axis=-1)
    g_prob = jnp.take_along_axis(group_probs, g_sel[:, None], axis=-1)
    expert_logits = jnp.einsum('td,de->te', xt, w_router_expert,
                               preferred_element_type=jnp.float32).reshape(T, N_GROUPS, EXPERTS_PER_GROUP)
    within = jnp.take_along_axis(expert_logits, g_sel[:, None, None], axis=1)[:, 0]
    top_logits, top_local = lax.top_k(within, TOP_K)
    top_w = jax.nn.softmax(top_logits, axis=-1) * g_prob
    expert_id = g_sel[:, None] * EXPERTS_PER_GROUP + top_local

    A = T * TOP_K
    flat_e = expert_id.reshape(A).astype(jnp.int32)
    flat_w = top_w.reshape(A)
    flat_tok = jnp.arange(A, dtype=jnp.int32) // TOP_K
    order = jnp.argsort(flat_e)
    sorted_e = flat_e[order]
    counts = jax.ops.segment_sum(jnp.ones_like(flat_e), flat_e, num_segments=N_EXPERTS)
    padded = (counts + EXPERT_BLOCK - 1) // EXPERT_BLOCK * EXPERT_BLOCK
    start = jnp.cumsum(counts) - counts
    pstart = jnp.cumsum(padded) - padded
    dest = pstart[sorted_e] + (jnp.arange(A, dtype=jnp.int32) - start[sorted_e])
    P = A + N_EXPERTS * EXPERT_BLOCK
    nb = P // EXPERT_BLOCK
    buf_tok = jnp.zeros((P,), jnp.int32).at[dest].set(flat_tok[order])
    buf_w = jnp.zeros((P,), jnp.float32).at[dest].set(flat_w[order])
    block_start = jnp.arange(nb, dtype=jnp.int32) * EXPERT_BLOCK
    block_e = jnp.minimum(jnp.searchsorted(pstart + padded, block_start, side='right'),
                          N_EXPERTS - 1).astype(jnp.int32)

    def expert_block(args):
        tok, e = args
        xb = xt[tok]
        hidden = jax.nn.silu(xb @ w_gate[e]) * (xb @ w_up[e])
        return hidden @ w_down[e]

    yb = lax.map(expert_block, (buf_tok.reshape(nb, EXPERT_BLOCK), block_e))
    y = jax.ops.segment_sum(yb.reshape(P, D) * buf_w[:, None].astype(yb.dtype), buf_tok,
                            num_segments=T)
    return y.reshape(B, S, D).astype(h.dtype)


def setup_inputs(seed: int = 0) -> dict:
    key = jax.random.key(seed)
    ks = jax.random.split(key, 20)

    def nrm(k, shape, s):
        return jax.random.normal(k, shape, jnp.float32) * s

    x = nrm(ks[0], (BATCH, SEQ, D_MODEL), 1.0)
    c = nrm(ks[1], (BATCH, D_MODEL), 1.0)
    offsets = jax.random.randint(ks[2], (BATCH, 1), 0, 4096, dtype=jnp.int32)
    positions = offsets + jnp.arange(SEQ, dtype=jnp.int32)[None, :]
    return {
        "x": x,
        "c": c,
        "positions": positions,
        "w_ada": nrm(ks[3], (DEPTH, D_MODEL, 6 * D_MODEL), D_MODEL ** -0.5),
        "b_ada": nrm(ks[4], (DEPTH, 6 * D_MODEL), 0.01),
        "norm_mix_g": 1.0 + nrm(ks[5], (DEPTH, D_MODEL), 0.02),
        "w_in": nrm(ks[6], (DEPTH, D_MODEL, D_IN), D_MODEL ** -0.5),
        "sinks": nrm(ks[7], (DEPTH, N_SW_HEADS), 1.0),
        "out_norm_sb_g": 1.0 + nrm(ks[8], (DEPTH, D_SB), 0.02),
        "out_norm_sw_g": 1.0 + nrm(ks[9], (DEPTH, D_SW), 0.02),
        "w_out": nrm(ks[10], (DEPTH, D_MIX, D_MODEL), D_MIX ** -0.5),
        "norm_ffn_g": 1.0 + nrm(ks[11], (DEPTH, D_MODEL), 0.02),
        "w_router_group": nrm(ks[12], (DEPTH, D_MODEL, N_GROUPS), D_MODEL ** -0.5),
        "w_router_expert": nrm(ks[13], (DEPTH, D_MODEL, N_EXPERTS), D_MODEL ** -0.5),
        "w_gate": nrm(ks[14], (DEPTH, N_EXPERTS, D_MODEL, D_EXPERT), D_MODEL ** -0.5),
        "w_up": nrm(ks[15], (DEPTH, N_EXPERTS, D_MODEL, D_EXPERT), D_MODEL ** -0.5),
        "w_down": nrm(ks[16], (DEPTH, N_EXPERTS, D_EXPERT, D_MODEL), D_EXPERT ** -0.5),
        "norm_final_g": 1.0 + nrm(ks[17], (D_MODEL,), 0.02),
    }


def reference(x, c, positions, w_ada, b_ada, norm_mix_g, w_in, sinks, out_norm_sb_g, out_norm_sw_g,
              w_out, norm_ffn_g, w_router_group, w_router_expert, w_gate, w_up, w_down, norm_final_g):
    B, S, D = x.shape
    for l in range(DEPTH):
        mod = jax.nn.silu(c) @ w_ada[l] + b_ada[l]
        shift1, scale1, gate1, shift2, scale2, gate2 = jnp.split(mod[:, None, :], 6, axis=-1)

        h = rmsnorm(x, norm_mix_g[l]) * (1.0 + scale1) + shift1
        proj = jnp.einsum('bsd,de->bse', h, w_in[l])
        q_sb, k_sb, v_sb, q_sw, k_sw, v_sw = jnp.split(proj, IN_SPLITS, axis=-1)
        o_sb = stick_breaking_attention(q_sb.reshape(B, S, N_SB_HEADS, HEAD_DIM),
                                        k_sb.reshape(B, S, N_SB_HEADS, HEAD_DIM),
                                        v_sb.reshape(B, S, N_SB_HEADS, HEAD_DIM))
        q_sw = rope(q_sw.reshape(B, S, N_SW_HEADS, HEAD_DIM), positions)
        k_sw = rope(k_sw.reshape(B, S, N_SW_KV_HEADS, HEAD_DIM), positions)
        o_sw = sliding_window_attention(q_sw, k_sw, v_sw.reshape(B, S, N_SW_KV_HEADS, HEAD_DIM), sinks[l])
        mixed = jnp.concatenate([rmsnorm(o_sb.reshape(B, S, D_SB), out_norm_sb_g[l]),
                                 rmsnorm(o_sw.reshape(B, S, D_SW), out_norm_sw_g[l])], axis=-1)
        x = x + gate1 * jnp.einsum('bse,ed->bsd', mixed, w_out[l])

        h2 = rmsnorm(x, norm_ffn_g[l]) * (1.0 + scale2) + shift2
        x = x + gate2 * hierarchical_moe(h2, w_router_group[l], w_router_expert[l],
                                         w_gate[l], w_up[l], w_down[l])
    return rmsnorm(x, norm_final_g)
```

```cpp
#include <hip/hip_runtime.h>
#include <hip/hip_cooperative_groups.h>
#include <cstdio>
#include <cstdint>
#include <cmath>
namespace cg = cooperative_groups;

#define LAS __attribute__((address_space(3)))
#define DI __device__ __forceinline__
typedef unsigned short bf16_t;
typedef short bf16x8 __attribute__((ext_vector_type(8)));
typedef float f32x4 __attribute__((ext_vector_type(4)));
typedef float f32x2 __attribute__((ext_vector_type(2)));
typedef unsigned u32x4 __attribute__((ext_vector_type(4)));
typedef unsigned u32x2 __attribute__((ext_vector_type(2)));
typedef __bf16 bf16x2_t __attribute__((ext_vector_type(2)));

constexpr int NB = 4, SEQ = 8192, DM = 1024, T = NB * SEQ;
constexpr int DIN = 2304, DSB = 512, DSW = 512, DKV = 128;
constexpr int NEXP = 16, DEXP = 512, NBUCKET = 24, WINDOW = 128;
constexpr int MAXTILES = T / 256 + NBUCKET, TPAD = MAXTILES * 256;
constexpr float EPS = 1e-6f, LOG2E = 1.4426950408889634f, QSCALE = 0.125f * LOG2E;
constexpr float SB_EXIT = -150.0f;
constexpr int NTHREADS = 512, NWAVES = 8;

constexpr size_t MiB = 1u << 20;
constexpr size_t WS_CTL = 0, CTL_BYTES = 1 * MiB;
constexpr size_t WS_MOD = 1 * MiB;
constexpr size_t WS_COS = 2 * MiB, WS_SIN = 6 * MiB;
constexpr size_t WS_WIN = 10 * MiB;
constexpr size_t WS_WOUT = 15 * MiB;
constexpr size_t WS_WGU = 17 * MiB;
constexpr size_t WS_WD = 49 * MiB;
constexpr size_t WS_LIST = 65 * MiB;
constexpr size_t WS_WTS = 68 * MiB;
constexpr size_t WS_H = 80 * MiB;
constexpr size_t WS_QSB = 144 * MiB, WS_KSB = 176 * MiB, WS_VSB = 208 * MiB, WS_QSW = 240 * MiB;
constexpr size_t WS_KSW = 272 * MiB, WS_VSW = 280 * MiB;
constexpr size_t WS_MIX = 288 * MiB;
constexpr size_t WS_HID = 352 * MiB;
constexpr size_t WS_END = 428 * MiB;
static_assert(WS_KSB - WS_QSB == WS_VSB - WS_KSB, "q/k/v_sb buffers equally spaced");
static_assert(WS_HID + (size_t)TPAD * 1024 * 2 <= WS_END, "ws map");
constexpr int CW_CNT = 64;

constexpr int LDS_BYTES = 147456;

struct Args {
    const float* x; const float* c; const int* pos; const float* w_ada; const float* b_ada; const float* g_mix; const float* w_in; const float* sinks;
    const float* g_sb; const float* g_sw; const float* w_out; const float* g_ffn; const float* w_rg; const float* w_re; const float* w_gate; const float* w_up;
    const float* w_down; const float* g_fin; float* out; unsigned char* ws;
};

__constant__ float INV_FREQ[32] = {1.000000000e+00f, 7.498942018e-01f, 5.623413324e-01f, 4.216965139e-01f, 3.162277639e-01f, 2.371373773e-01f, 1.778279394e-01f, 1.333521456e-01f, 1.000000015e-01f, 7.498942316e-02f, 5.623413250e-02f, 4.216964915e-02f, 3.162277490e-02f, 2.371373773e-02f, 1.778279431e-02f, 1.333521400e-02f, 9.999999776e-03f, 7.498942316e-03f, 5.623413250e-03f, 4.216964822e-03f, 3.162277630e-03f, 2.371373819e-03f, 1.778279431e-03f, 1.333521446e-03f, 1.000000047e-03f, 7.498941850e-04f, 5.623413017e-04f, 4.216965172e-04f, 3.162277571e-04f, 2.371373703e-04f, 1.778279402e-04f, 1.333521504e-04f};

DI unsigned f2bf(float f) { unsigned u = __builtin_bit_cast(unsigned, f); return (u + 0x7fffu + ((u >> 16) & 1u)) >> 16; }
DI unsigned pk2(float lo, float hi) { f32x2 v = {lo, hi}; bf16x2_t b = __builtin_convertvector(v, bf16x2_t); return __builtin_bit_cast(unsigned, b); }
DI float bf2f(unsigned short b) { return __builtin_bit_cast(float, (unsigned)b << 16); }
DI float bflo(unsigned w) { return __builtin_bit_cast(float, w << 16); }
DI float bfhi(unsigned w) { return __builtin_bit_cast(float, w & 0xffff0000u); }
DI float wave_sum(float v) {
#pragma unroll
    for (int o = 1; o < 64; o <<= 1) v += __shfl_xor(v, o);
    return v;
}
#define LDS_WAIT() asm volatile("s_waitcnt lgkmcnt(0)" ::: "memory")

DI void tr_item(const float* W, int N, int k0, int n0, bf16_t* WT, int drow0, int Kd, const float* kscale, LAS float* scr, int lane) {
#pragma unroll 8
    for (int i = 0; i < 32; ++i) { const int kk = 2 * i + (lane >> 5); float v = W[(size_t)(k0 + kk) * N + n0 + (lane & 31)]; if (kscale) v *= kscale[k0 + kk]; scr[kk * 33 + (lane & 31)] = v; }
    LDS_WAIT();
    const int c = lane & 7;
#pragma unroll
    for (int j = 0; j < 4; ++j) { const int n = (lane >> 3) + 8 * j; const LAS float* s = scr + (8 * c) * 33 + n;
        u32x4 o; o.x = pk2(s[0 * 33], s[1 * 33]); o.y = pk2(s[2 * 33], s[3 * 33]); o.z = pk2(s[4 * 33], s[5 * 33]); o.w = pk2(s[6 * 33], s[7 * 33]);
        *(u32x4*)(WT + (size_t)(drow0 + n) * Kd + k0 + 8 * c) = o; }
    LDS_WAIT();
}
DI int win_drow(int n0) {
    if (n0 < 1536) return n0;
    if (n0 < 2048) { const int c = n0 - 1536, head = c >> 6, half = (c >> 5) & 1; return 1536 + (head >> 2) * 256 + half * 128 + (head & 3) * 32; }
    if (n0 < 2176) { const int c = n0 - 2048, head = c >> 6, half = (c >> 5) & 1; return 2048 + half * 128 + head * 32; }
    const int c = n0 - 2176; return 2048 + (c >> 6) * 128 + 64 + (c & 63);
}
DI void p0_prologue(const Args& a, LAS unsigned char* lds, int tid, int lane, int wave) {
    unsigned char* ws = a.ws;
    {
        float* mod = (float*)(ws + WS_MOD); LAS float* red = (LAS float*)lds;
        for (int cb = blockIdx.x; cb < 6144 / 32; cb += gridDim.x) {
            const int cj = tid & 31, kg = tid >> 5, col = cb * 32 + cj;
            float acc0 = 0.f, acc1 = 0.f, acc2 = 0.f, acc3 = 0.f;
            for (int kk = 0; kk < 64; ++kk) { const int k = kg * 64 + kk; const float w = a.w_ada[(size_t)k * 6144 + col];
                float c0 = a.c[k], c1 = a.c[1024 + k], c2 = a.c[2048 + k], c3 = a.c[3072 + k];
                c0 = c0 / (1.f + expf(-c0)); c1 = c1 / (1.f + expf(-c1)); c2 = c2 / (1.f + expf(-c2)); c3 = c3 / (1.f + expf(-c3));
                acc0 += c0 * w; acc1 += c1 * w; acc2 += c2 * w; acc3 += c3 * w; }
            red[(kg * 4 + 0) * 32 + cj] = acc0; red[(kg * 4 + 1) * 32 + cj] = acc1; red[(kg * 4 + 2) * 32 + cj] = acc2; red[(kg * 4 + 3) * 32 + cj] = acc3;
            __syncthreads();
            if (tid < 128) { const int b = tid >> 5, c2 = tid & 31; float s = 0.f; for (int g = 0; g < 16; ++g) s += red[(g * 4 + b) * 32 + c2]; mod[b * 6144 + cb * 32 + c2] = s + a.b_ada[cb * 32 + c2]; }
            __syncthreads();
        }
    }
    {
        float* cosT = (float*)(ws + WS_COS); float* sinT = (float*)(ws + WS_SIN);
        for (int idx = blockIdx.x * NTHREADS + tid; idx < T * 32; idx += gridDim.x * NTHREADS) {
            const int t = idx >> 5, i = idx & 31; const float ang = (float)a.pos[t] * INV_FREQ[i];
            const double ad = (double)ang, kq = rint(ad * 0.63661977236758134308);
            double y = fma(-kq, 1.5707963267948966192, ad); y = fma(-kq, 6.123233995736766036e-17, y);
            const int q = (int)((long long)kq & 3); const double y2 = y * y;
            const double sn = y * (1.0 + y2 * (-1.0 / 6 + y2 * (1.0 / 120 + y2 * (-1.0 / 5040 + y2 * (1.0 / 362880 + y2 * (-1.0 / 39916800))))));
            const double cs = 1.0 + y2 * (-0.5 + y2 * (1.0 / 24 + y2 * (-1.0 / 720 + y2 * (1.0 / 40320 + y2 * (-1.0 / 3628800 + y2 * (1.0 / 479001600))))));
            double co, si; if (q == 0) { co = cs; si = sn; } else if (q == 1) { co = -sn; si = cs; } else if (q == 2) { co = -cs; si = -sn; } else { co = sn; si = -cs; }
            cosT[idx] = (float)co; sinT[idx] = (float)si;
        }
    }
    {
        LAS float* scr = (LAS float*)(lds + 8192 + wave * 8704);
        const int gw = blockIdx.x * NWAVES + wave, NGW = gridDim.x * NWAVES;
        constexpr int I_IN = 16 * 72, I_OUT = 16 * 32, I_G = 16 * 16 * 16, I_D = 16 * 8 * 32, NITEMS = I_IN + I_OUT + 2 * I_G + I_D;
        for (int it = gw; it < NITEMS; it += NGW) {
            int r = it;
            if (r < I_IN) { const int kb = r / 72, nb = r % 72; tr_item(a.w_in, DIN, kb * 64, nb * 32, (bf16_t*)(ws + WS_WIN), win_drow(nb * 32), 1024, nullptr, scr, lane); continue; } r -= I_IN;
            if (r < I_OUT) { const int kb = r / 32, nb = r % 32; const float* ks = (kb < 8) ? a.g_sb : (a.g_sw - 512); tr_item(a.w_out, 1024, kb * 64, nb * 32, (bf16_t*)(ws + WS_WOUT), nb * 32, 1024, ks, scr, lane); continue; } r -= I_OUT;
            if (r < 2 * I_G) { const int up = r >= I_G; if (up) r -= I_G; const int e = r / 256, q = r % 256, kb = q / 16, nb = q % 16, c0 = nb * 32;
                tr_item((up ? a.w_up : a.w_gate) + (size_t)e * 1024 * 512, 512, kb * 64, c0, (bf16_t*)(ws + WS_WGU) + (size_t)e * 1024 * 1024, (c0 >> 7) * 256 + up * 128 + (c0 & 127), 1024, nullptr, scr, lane); continue; } r -= 2 * I_G;
            { const int e = r / 256, q = r % 256, kb = q / 32, nb = q % 32; tr_item(a.w_down + (size_t)e * 512 * 1024, 1024, kb * 64, nb * 32, (bf16_t*)(ws + WS_WD) + (size_t)e * 1024 * 512, nb * 32, 512, nullptr, scr, lane); }
        }
    }
}

DI void p1_norm(const Args& a, int lane, int wave) {
    const float* mod = (const float*)(a.ws + WS_MOD); bf16_t* H = (bf16_t*)(a.ws + WS_H);
    const int gw = blockIdx.x * NWAVES + wave, NGW = gridDim.x * NWAVES;
    for (int ch = gw; ch < T / 16; ch += NGW) {
        const int row0 = ch * 16, b = row0 / SEQ;
        f32x4 ca[4], cb[4];
#pragma unroll
        for (int j = 0; j < 4; ++j) { const int col = 4 * lane + 256 * j; const f32x4 g = *(const f32x4*)(a.g_mix + col), sc = *(const f32x4*)(mod + b * 6144 + 1024 + col); ca[j] = g * (sc + 1.0f); cb[j] = *(const f32x4*)(mod + b * 6144 + col); }
        for (int r = 0; r < 16; ++r) {
            const float* xr = a.x + (size_t)(row0 + r) * DM; f32x4 v[4]; float s = 0.f;
#pragma unroll
            for (int j = 0; j < 4; ++j) { v[j] = *(const f32x4*)(xr + 4 * lane + 256 * j); s += (v[j].x * v[j].x + v[j].y * v[j].y) + (v[j].z * v[j].z + v[j].w * v[j].w); }
            const float rs = 1.0f / sqrtf(wave_sum(s) * (1.0f / DM) + EPS);
            bf16_t* hr = H + (size_t)(row0 + r) * DM;
#pragma unroll
            for (int j = 0; j < 4; ++j) { const f32x4 o = v[j] * rs * ca[j] + cb[j]; u32x2 w; w.x = pk2(o.x, o.y); w.y = pk2(o.z, o.w); *(u32x2*)(hr + 4 * lane + 256 * j) = w; }
        }
    }
}
DI void p8_final(const Args& a, int lane, int wave) {
    const int gw = blockIdx.x * NWAVES + wave, NGW = gridDim.x * NWAVES;
    f32x4 g[4];
#pragma unroll
    for (int j = 0; j < 4; ++j) g[j] = *(const f32x4*)(a.g_fin + 4 * lane + 256 * j);
    for (int row = gw; row < T; row += NGW) {
        float* xr = a.out + (size_t)row * DM; f32x4 v[4]; float s = 0.f;
#pragma unroll
        for (int j = 0; j < 4; ++j) { v[j] = *(const f32x4*)(xr + 4 * lane + 256 * j); s += (v[j].x * v[j].x + v[j].y * v[j].y) + (v[j].z * v[j].z + v[j].w * v[j].w); }
        const float rs = 1.0f / sqrtf(wave_sum(s) * (1.0f / DM) + EPS);
#pragma unroll
        for (int j = 0; j < 4; ++j) *(f32x4*)(xr + 4 * lane + 256 * j) = v[j] * rs * g[j];
    }
}
DI void p5_router(const Args& a, int lane, int wave) {
    const float* mod = (const float*)(a.ws + WS_MOD); bf16_t* H = (bf16_t*)(a.ws + WS_H);
    unsigned* cnt = (unsigned*)(a.ws + WS_CTL) + CW_CNT; int* list = (int*)(a.ws + WS_LIST); f32x2* wts = (f32x2*)(a.ws + WS_WTS);
    const int gw = blockIdx.x * NWAVES + wave, NGW = gridDim.x * NWAVES;
    for (int ch = gw; ch < T / 16; ch += NGW) {
        const int row0 = ch * 16, b = row0 / SEQ;
        f32x4 ca[4], cb[4];
#pragma unroll
        for (int j = 0; j < 4; ++j) { const int col = 4 * lane + 256 * j; const f32x4 g = *(const f32x4*)(a.g_ffn + col), sc = *(const f32x4*)(mod + b * 6144 + 4096 + col); ca[j] = g * (sc + 1.0f); cb[j] = *(const f32x4*)(mod + b * 6144 + 3072 + col); }
        for (int r = 0; r < 16; ++r) {
            const int row = row0 + r; const float* xr = a.out + (size_t)row * DM; f32x4 v[4]; float s = 0.f;
#pragma unroll
            for (int j = 0; j < 4; ++j) { v[j] = *(const f32x4*)(xr + 4 * lane + 256 * j); s += (v[j].x * v[j].x + v[j].y * v[j].y) + (v[j].z * v[j].z + v[j].w * v[j].w); }
            const float rs = 1.0f / sqrtf(wave_sum(s) * (1.0f / DM) + EPS);
            bf16_t* hr = H + (size_t)row * DM;
            float lg[20];
#pragma unroll
            for (int i = 0; i < 20; ++i) lg[i] = 0.f;
#pragma unroll
            for (int j = 0; j < 4; ++j) { const f32x4 o = v[j] * rs * ca[j] + cb[j]; u32x2 w; w.x = pk2(o.x, o.y); w.y = pk2(o.z, o.w); *(u32x2*)(hr + 4 * lane + 256 * j) = w;
#pragma unroll
                for (int e = 0; e < 4; ++e) { const int k = 4 * lane + 256 * j + e; const float hv = o[e];
                    const f32x4 wg = *(const f32x4*)(a.w_rg + k * 4);
                    lg[0] += hv * wg.x; lg[1] += hv * wg.y; lg[2] += hv * wg.z; lg[3] += hv * wg.w;
#pragma unroll
                    for (int q = 0; q < 4; ++q) { const f32x4 we = *(const f32x4*)(a.w_re + k * 16 + 4 * q); lg[4 + 4 * q] += hv * we.x; lg[5 + 4 * q] += hv * we.y; lg[6 + 4 * q] += hv * we.z; lg[7 + 4 * q] += hv * we.w; } } }
#pragma unroll
            for (int i = 0; i < 20; ++i) lg[i] = wave_sum(lg[i]);
            int g = 0; float gm = lg[0];
#pragma unroll
            for (int i = 1; i < 4; ++i) if (lg[i] > gm) { gm = lg[i]; g = i; }
            float gs = 0.f;
#pragma unroll
            for (int i = 0; i < 4; ++i) gs += expf(lg[i] - gm);
            const float gprob = 1.0f / gs;
            float el[4];
#pragma unroll
            for (int i = 0; i < 4; ++i) el[i] = g == 0 ? lg[4 + i] : g == 1 ? lg[8 + i] : g == 2 ? lg[12 + i] : lg[16 + i];
            int i0 = 0; float m0 = el[0];
#pragma unroll
            for (int i = 1; i < 4; ++i) if (el[i] > m0) { m0 = el[i]; i0 = i; }
            int i1 = -1; float m1 = 0.f;
#pragma unroll
            for (int i = 0; i < 4; ++i) if (i != i0 && (i1 < 0 || el[i] > m1)) { m1 = el[i]; i1 = i; }
            const float ex = expf(m1 - m0), w0 = 1.0f / (1.0f + ex), w1 = ex * w0;
            const int ea = i0 < i1 ? i0 : i1, eb = i0 < i1 ? i1 : i0; const float wa = (i0 < i1 ? w0 : w1) * gprob, wb = (i0 < i1 ? w1 : w0) * gprob;
            const int bucket = g * 6 + (ea * (7 - ea)) / 2 + (eb - ea - 1);
            if (lane == 0) { const unsigned p = atomicAdd(cnt + bucket, 1u); list[bucket * T + p] = row; wts[bucket * T + p] = (f32x2){wa, wb}; }
        }
    }
}

struct GUnit { const bf16_t* A; const int* aidx; int nvalid; const bf16_t* B0; const bf16_t* B1; int pm, pn, bucket, rt; };
template <class Sched, class Epi>
DI void gemm_direct(int K, int ldb, int ksplit, const Sched& S, const Epi& E, int lane, int wave) {
    const int wr = wave >> 2, wc = wave & 3, fr = lane & 15, fq = lane >> 4;
    GUnit u;
    for (int i = 0; S.next(i, u); ++i) {
        f32x4 acc[2][2][4][2];
#pragma unroll
        for (int x = 0; x < 2; ++x)
#pragma unroll
            for (int y = 0; y < 2; ++y)
#pragma unroll
                for (int m = 0; m < 4; ++m)
#pragma unroll
                    for (int n = 0; n < 2; ++n) acc[x][y][m][n] = (f32x4){0.f, 0.f, 0.f, 0.f};
        unsigned aoff[2][4], boff[2][2];
#pragma unroll
        for (int ai = 0; ai < 2; ++ai)
#pragma unroll
            for (int m = 0; m < 4; ++m) { const int r = 128 * ai + 64 * wr + 16 * m + fr; const int gr = u.aidx ? u.aidx[r < u.nvalid ? r : 0] : r; aoff[ai][m] = (unsigned)gr * (unsigned)K + fq * 8; }
#pragma unroll
        for (int bj = 0; bj < 2; ++bj)
#pragma unroll
            for (int n = 0; n < 2; ++n) { const int c = 128 * bj + 32 * wc + 8 * (fr >> 2) + 4 * n + (fr & 3); boff[bj][n] = (unsigned)c * (unsigned)ldb + fq * 8; }
        for (int k0 = 0; k0 < K; k0 += 32) {
            const bf16_t* Bp = k0 < ksplit ? u.B0 + k0 : u.B1 + (k0 - ksplit);
            bf16x8 af[2][4], bfr[2][2];
#pragma unroll
            for (int ai = 0; ai < 2; ++ai)
#pragma unroll
                for (int m = 0; m < 4; ++m) af[ai][m] = *(const bf16x8*)(u.A + aoff[ai][m] + k0);
#pragma unroll
            for (int bj = 0; bj < 2; ++bj)
#pragma unroll
                for (int n = 0; n < 2; ++n) bfr[bj][n] = *(const bf16x8*)(Bp + boff[bj][n]);
#pragma unroll
            for (int ai = 0; ai < 2; ++ai)
#pragma unroll
                for (int bj = 0; bj < 2; ++bj)
#pragma unroll
                    for (int m = 0; m < 4; ++m)
#pragma unroll
                        for (int n = 0; n < 2; ++n) acc[ai][bj][m][n] = __builtin_amdgcn_mfma_f32_16x16x32_bf16(bfr[bj][n], af[ai][m], acc[ai][bj][m][n], 0, 0, 0);
        }
        E(acc, u, wr, wc, fr, fq);
    }
}
struct DenseSched {
    const bf16_t* A; const bf16_t* Bt; int K, nM, nN;
    DI bool next(int i, GUnit& u) const { const int L = i * (int)gridDim.x + (int)blockIdx.x; if (L >= nM * nN) return false; u.pm = L / nN; u.pn = L % nN;
        u.A = A + (size_t)u.pm * 256 * K; u.aidx = nullptr; u.nvalid = 256; u.B0 = Bt + (size_t)u.pn * 256 * K; u.B1 = u.B0; u.bucket = 0; u.rt = 0; return true; }
};
struct MoeSched {
    const LAS int* tstart; const unsigned* cnt; const int* list; const bf16_t* A; const bf16_t* W; int NT; bool up;
    DI bool next(int i, GUnit& u) const {
        const int L = i * (int)gridDim.x + (int)blockIdx.x; const int ntile = tstart[NBUCKET]; if (L >= ntile * NT) return false;
        const int ti = L / NT, pn = L % NT; int b = 0;
        for (int q = 1; q < NBUCKET; ++q) if (tstart[q] <= ti) b = q;
        const int rt = ti - tstart[b]; const int g = b / 6, p = b % 6; const int ea = 4 * g + (p < 3 ? 0 : (p < 5 ? 1 : 2)), eb = 4 * g + (p < 3 ? p + 1 : (p < 5 ? p - 1 : 3));
        u.pm = ti; u.pn = pn; u.bucket = b; u.rt = rt; const int nv = (int)cnt[b] - rt * 256; u.nvalid = nv < 256 ? nv : 256;
        if (up) { u.A = A; u.aidx = list + (size_t)b * T + rt * 256; const int e = pn < 4 ? ea : eb; u.B0 = W + (size_t)e * 1024 * 1024 + (size_t)(pn & 3) * 256 * 1024; u.B1 = u.B0; }
        else { u.A = A + (size_t)ti * 256 * 1024; u.aidx = nullptr; u.B0 = W + (size_t)ea * 1024 * 512 + (size_t)pn * 256 * 512; u.B1 = W + (size_t)eb * 1024 * 512 + (size_t)pn * 256 * 512; }
        return true;
    }
};

DI u32x4 pack8(const f32x4 v0, const f32x4 v1) { u32x4 w; w.x = pk2(v0[0], v0[1]); w.y = pk2(v0[2], v0[3]); w.z = pk2(v1[0], v1[1]); w.w = pk2(v1[2], v1[3]); return w; }
struct EpiProj {
    bf16_t *qsb, *ksb, *vsb, *qsw, *ksw, *vsw; const float *cosT, *sinT;
    DI void operator()(const f32x4 (&acc)[2][2][4][2], const GUnit& u, int wr, int wc, int fr, int fq) const {
        const int pn = u.pn, rowb = u.pm * 256 + wr * 64 + fr;
        if (pn < 6) {
            bf16_t* base = qsb + (size_t)(pn >> 1) * ((WS_KSB - WS_QSB) / 2); const float sc = pn < 2 ? QSCALE : 1.0f; const int colt = (pn & 1) * 256 + wc * 32 + 8 * fq;
#pragma unroll
            for (int ai = 0; ai < 2; ++ai)
#pragma unroll
                for (int m = 0; m < 4; ++m) { const size_t row = rowb + ai * 128 + m * 16;
#pragma unroll
                    for (int bj = 0; bj < 2; ++bj) *(u32x4*)(base + row * 512 + colt + bj * 128) = pack8(acc[ai][bj][m][0] * sc, acc[ai][bj][m][1] * sc); }
        } else if (pn < 8 || wc < 2) {
            const bool isq = pn < 8; bf16_t* base = isq ? qsw : ksw; const int pitch = isq ? 512 : 128; const int head = isq ? (pn - 6) * 4 + wc : wc; const float sc = isq ? QSCALE : 1.0f;
#pragma unroll
            for (int ai = 0; ai < 2; ++ai)
#pragma unroll
                for (int m = 0; m < 4; ++m) { const size_t row = rowb + ai * 128 + m * 16;
                    const f32x4 c0 = *(const f32x4*)(cosT + row * 32 + 8 * fq), c1 = *(const f32x4*)(cosT + row * 32 + 8 * fq + 4);
                    const f32x4 s0 = *(const f32x4*)(sinT + row * 32 + 8 * fq), s1 = *(const f32x4*)(sinT + row * 32 + 8 * fq + 4);
                    const f32x4 x10 = acc[ai][0][m][0], x11 = acc[ai][0][m][1], x20 = acc[ai][1][m][0], x21 = acc[ai][1][m][1];
                    const f32x4 o10 = (x10 * c0 - x20 * s0) * sc, o11 = (x11 * c1 - x21 * s1) * sc, o20 = (x20 * c0 + x10 * s0) * sc, o21 = (x21 * c1 + x11 * s1) * sc;
                    *(u32x4*)(base + row * pitch + head * 64 + 8 * fq) = pack8(o10, o11); *(u32x4*)(base + row * pitch + head * 64 + 32 + 8 * fq) = pack8(o20, o21); }
        } else {
#pragma unroll
            for (int ai = 0; ai < 2; ++ai)
#pragma unroll
                for (int m = 0; m < 4; ++m) { const size_t row = rowb + ai * 128 + m * 16;
#pragma unroll
                    for (int bj = 0; bj < 2; ++bj) *(u32x4*)(vsw + row * 128 + bj * 64 + (wc * 32 - 64) + 8 * fq) = pack8(acc[ai][bj][m][0], acc[ai][bj][m][1]); }
        }
    }
};
struct EpiWout {
    const float* x; const float* mod; float* out;
    DI void operator()(const f32x4 (&acc)[2][2][4][2], const GUnit& u, int wr, int wc, int fr, int fq) const {
        const int rowb = u.pm * 256 + wr * 64 + fr, colb = u.pn * 256 + wc * 32 + 8 * fq; const int b = (u.pm * 256) / SEQ;
        f32x4 gt[2][2];
#pragma unroll
        for (int bj = 0; bj < 2; ++bj)
#pragma unroll
            for (int n = 0; n < 2; ++n) gt[bj][n] = *(const f32x4*)(mod + b * 6144 + 2048 + colb + bj * 128 + 4 * n);
#pragma unroll
        for (int ai = 0; ai < 2; ++ai)
#pragma unroll
            for (int m = 0; m < 4; ++m) { const size_t off = (size_t)(rowb + ai * 128 + m * 16) * DM + colb;
#pragma unroll
                for (int bj = 0; bj < 2; ++bj)
#pragma unroll
                    for (int n = 0; n < 2; ++n) { const f32x4 xv = *(const f32x4*)(x + off + bj * 128 + 4 * n); *(f32x4*)(out + off + bj * 128 + 4 * n) = xv + gt[bj][n] * acc[ai][bj][m][n]; } }
    }
};
DI f32x4 swiglu4(const f32x4 g, const f32x4 uu, float w) { f32x4 o;
#pragma unroll
    for (int j = 0; j < 4; ++j) o[j] = w * uu[j] * g[j] / (1.0f + __expf(-g[j]));
    return o; }
struct EpiUp {
    bf16_t* hid; const f32x2* wts;
    DI void operator()(const f32x4 (&acc)[2][2][4][2], const GUnit& u, int wr, int wc, int fr, int fq) const {
        const int hc = (u.pn >> 2) * 512 + (u.pn & 3) * 128 + wc * 32 + 8 * fq; const bool second = u.pn >= 4;
#pragma unroll
        for (int ai = 0; ai < 2; ++ai)
#pragma unroll
            for (int m = 0; m < 4; ++m) { const int r = ai * 128 + wr * 64 + m * 16 + fr; float w = 0.f;
                if (r < u.nvalid) { const f32x2 ww = wts[(size_t)u.bucket * T + u.rt * 256 + r]; w = second ? ww.y : ww.x; }
                *(u32x4*)(hid + (size_t)(u.pm * 256 + r) * 1024 + hc) = pack8(swiglu4(acc[ai][0][m][0], acc[ai][1][m][0], w), swiglu4(acc[ai][0][m][1], acc[ai][1][m][1], w)); }
    }
};
struct EpiDown {
    const int* list; const float* mod; float* out;
    DI void operator()(const f32x4 (&acc)[2][2][4][2], const GUnit& u, int wr, int wc, int fr, int fq) const {
        const int colb = u.pn * 256 + wc * 32 + 8 * fq;
#pragma unroll
        for (int ai = 0; ai < 2; ++ai)
#pragma unroll
            for (int m = 0; m < 4; ++m) { const int r = ai * 128 + wr * 64 + m * 16 + fr;
                if (r < u.nvalid) { const int tok = list[(size_t)u.bucket * T + u.rt * 256 + r]; const int b = tok / SEQ; const size_t off = (size_t)tok * DM + colb;
#pragma unroll
                    for (int bj = 0; bj < 2; ++bj)
#pragma unroll
                        for (int n = 0; n < 2; ++n) { const f32x4 gt = *(const f32x4*)(mod + b * 6144 + 5120 + colb + bj * 128 + 4 * n); const f32x4 xv = *(const f32x4*)(out + off + bj * 128 + 4 * n);
                            *(f32x4*)(out + off + bj * 128 + 4 * n) = xv + gt * acc[ai][bj][m][n]; } } }
    }
};

DI void load64(const bf16_t* p, float (&v)[64]) {
#pragma unroll
    for (int c = 0; c < 8; ++c) { const u32x4 w = *(const u32x4*)(p + 8 * c); v[8 * c] = bflo(w.x); v[8 * c + 1] = bfhi(w.x); v[8 * c + 2] = bflo(w.y); v[8 * c + 3] = bfhi(w.y); v[8 * c + 4] = bflo(w.z); v[8 * c + 5] = bfhi(w.z); v[8 * c + 6] = bflo(w.w); v[8 * c + 7] = bfhi(w.w); }
}
DI float dot64(const bf16_t* p, const float (&q)[64]) {
    float s0 = 0.f, s1 = 0.f;
#pragma unroll
    for (int c = 0; c < 8; ++c) { const u32x4 w = *(const u32x4*)(p + 8 * c); s0 += q[8 * c] * bflo(w.x); s1 += q[8 * c + 1] * bfhi(w.x); s0 += q[8 * c + 2] * bflo(w.y); s1 += q[8 * c + 3] * bfhi(w.y); s0 += q[8 * c + 4] * bflo(w.z); s1 += q[8 * c + 5] * bfhi(w.z); s0 += q[8 * c + 6] * bflo(w.w); s1 += q[8 * c + 7] * bfhi(w.w); }
    return s0 + s1;
}
DI void axpy64(const bf16_t* p, float a, float (&o)[64]) {
#pragma unroll
    for (int c = 0; c < 8; ++c) { const u32x4 w = *(const u32x4*)(p + 8 * c); o[8 * c] += a * bflo(w.x); o[8 * c + 1] += a * bfhi(w.x); o[8 * c + 2] += a * bflo(w.y); o[8 * c + 3] += a * bfhi(w.y); o[8 * c + 4] += a * bflo(w.z); o[8 * c + 5] += a * bfhi(w.z); o[8 * c + 6] += a * bflo(w.w); o[8 * c + 7] += a * bfhi(w.w); }
}
DI void store_normed(bf16_t* dst, float (&o)[64]) {
    float ss = 0.f;
#pragma unroll
    for (int d = 0; d < 64; ++d) ss += o[d] * o[d];
    ss += __shfl_xor(ss, 1); ss += __shfl_xor(ss, 2); ss += __shfl_xor(ss, 4);
    const float rs = 1.0f / sqrtf(ss * (1.0f / 512.0f) + EPS);
#pragma unroll
    for (int c = 0; c < 8; ++c) { u32x4 w; w.x = pk2(o[8 * c] * rs, o[8 * c + 1] * rs); w.y = pk2(o[8 * c + 2] * rs, o[8 * c + 3] * rs); w.z = pk2(o[8 * c + 4] * rs, o[8 * c + 5] * rs); w.w = pk2(o[8 * c + 6] * rs, o[8 * c + 7] * rs); *(u32x4*)(dst + 8 * c) = w; }
}
DI void p3_attention_naive(const Args& a, int tid) {
    const bf16_t* QSB = (const bf16_t*)(a.ws + WS_QSB); const bf16_t* KSB = (const bf16_t*)(a.ws + WS_KSB); const bf16_t* VSB = (const bf16_t*)(a.ws + WS_VSB);
    const bf16_t* QSW = (const bf16_t*)(a.ws + WS_QSW); const bf16_t* KSW = (const bf16_t*)(a.ws + WS_KSW); const bf16_t* VSW = (const bf16_t*)(a.ws + WS_VSW);
    bf16_t* MIX = (bf16_t*)(a.ws + WS_MIX);
    for (int ch = blockIdx.x; ch < 2 * (T * 8 / NTHREADS); ch += gridDim.x) {
        const bool sw = ch & 1; const int idx = (ch >> 1) * NTHREADS + tid, t = idx >> 3, head = idx & 7, b = t / SEQ, tl = t % SEQ;
        float q[64], o[64];
#pragma unroll
        for (int d = 0; d < 64; ++d) o[d] = 0.f;
        if (!sw) {
            load64(QSB + (size_t)t * 512 + head * 64, q);
            float R = 0.f;
            for (int s = tl - 1; s >= 0; --s) {
                const size_t kr = (size_t)(b * SEQ + s) * 512 + head * 64;
                const float z = dot64(KSB + kr, q);
                const float l = log2f(1.0f + exp2f(-fabsf(z))); const float L = fminf(-z, 0.f) - l;
                const float p = exp2f(z + L + R);
                axpy64(VSB + kr, p, o);
                R += L; if (R < SB_EXIT) break;
            }
            store_normed(MIX + (size_t)t * 1024 + head * 64, o);
        } else {
            load64(QSW + (size_t)t * 512 + head * 64, q);
            const int kvh = head >> 2; float m = a.sinks[head] * LOG2E, l = 1.0f;
            const int s0 = tl - (WINDOW - 1) < 0 ? 0 : tl - (WINDOW - 1);
            for (int s = s0; s <= tl; ++s) {
                const size_t kr = (size_t)(b * SEQ + s) * 128 + kvh * 64;
                const float sc = dot64(KSW + kr, q);
                if (sc > m) { const float f = exp2f(m - sc); l *= f;
#pragma unroll
                    for (int d = 0; d < 64; ++d) o[d] *= f;
                    m = sc; }
                const float p = exp2f(sc - m); l += p; axpy64(VSW + kr, p, o);
            }
            const float il = 1.0f / l;
#pragma unroll
            for (int d = 0; d < 64; ++d) o[d] *= il;
            store_normed(MIX + (size_t)t * 1024 + 512 + head * 64, o);
        }
    }
}

__global__ void __launch_bounds__(NTHREADS, 2) mk_fwd(Args a) {
    extern __shared__ __attribute__((aligned(16))) unsigned char lds_raw[];
    LAS unsigned char* lds = (LAS unsigned char*)lds_raw;
    cg::grid_group grid = cg::this_grid();
    const int tid = threadIdx.x, lane = tid & 63, wave = __builtin_amdgcn_readfirstlane(tid >> 6);
    unsigned char* ws = a.ws;
    const float* mod = (const float*)(ws + WS_MOD);

    p0_prologue(a, lds, tid, lane, wave);
    grid.sync();
    p1_norm(a, lane, wave);
    grid.sync();
    {
        DenseSched S{(const bf16_t*)(ws + WS_H), (const bf16_t*)(ws + WS_WIN), 1024, T / 256, DIN / 256};
        EpiProj E{(bf16_t*)(ws + WS_QSB), (bf16_t*)(ws + WS_KSB), (bf16_t*)(ws + WS_VSB), (bf16_t*)(ws + WS_QSW), (bf16_t*)(ws + WS_KSW), (bf16_t*)(ws + WS_VSW), (const float*)(ws + WS_COS), (const float*)(ws + WS_SIN)};
        gemm_direct(1024, 1024, 1024, S, E, lane, wave);
    }
    grid.sync();
    p3_attention_naive(a, tid);
    grid.sync();
    {
        DenseSched S{(const bf16_t*)(ws + WS_MIX), (const bf16_t*)(ws + WS_WOUT), 1024, T / 256, DM / 256};
        EpiWout E{a.x, mod, a.out};
        gemm_direct(1024, 1024, 1024, S, E, lane, wave);
    }
    grid.sync();
    p5_router(a, lane, wave);
    grid.sync();
    LAS int* tstart = (LAS int*)lds;
    const unsigned* cnt = (const unsigned*)(ws + WS_CTL) + CW_CNT;
    if (tid == 0) { int run = 0; for (int b = 0; b < NBUCKET; ++b) { tstart[b] = run; run += ((int)cnt[b] + 255) >> 8; } tstart[NBUCKET] = run; }
    __syncthreads();
    {
        MoeSched S{tstart, cnt, (const int*)(ws + WS_LIST), (const bf16_t*)(ws + WS_H), (const bf16_t*)(ws + WS_WGU), 8, true};
        EpiUp E{(bf16_t*)(ws + WS_HID), (const f32x2*)(ws + WS_WTS)};
        gemm_direct(1024, 1024, 1024, S, E, lane, wave);
    }
    grid.sync();
    {
        MoeSched S{tstart, cnt, (const int*)(ws + WS_LIST), (const bf16_t*)(ws + WS_HID), (const bf16_t*)(ws + WS_WD), 4, false};
        EpiDown E{(const int*)(ws + WS_LIST), mod, a.out};
        gemm_direct(1024, 512, 512, S, E, lane, wave);
    }
    grid.sync();
    p8_final(a, lane, wave);
}

extern "C" void kernel_launch(void* const* d_in, const int* in_sizes, int n_in, void* d_out, int out_size, void* d_ws, size_t ws_size, hipStream_t stream) {
    static int grid = 0;
    if (grid == 0) {
        if (n_in != 18 || in_sizes[0] != T * DM || out_size != T * DM || ws_size < WS_END) { fprintf(stderr, "kernel_launch: unexpected shapes (n_in %d, in0 %d, out %d, ws %zu); nothing launched\n", n_in, n_in > 0 ? in_sizes[0] : -1, out_size, ws_size); grid = -1; return; }
        int dev = 0, cus = 0, per_cu = 0;
        (void)hipGetDevice(&dev); (void)hipDeviceGetAttribute(&cus, hipDeviceAttributeMultiprocessorCount, dev);
        (void)hipFuncSetAttribute((const void*)mk_fwd, hipFuncAttributeMaxDynamicSharedMemorySize, LDS_BYTES);
        (void)hipOccupancyMaxActiveBlocksPerMultiprocessor(&per_cu, (const void*)mk_fwd, NTHREADS, LDS_BYTES);
        if (per_cu < 1) { fprintf(stderr, "kernel_launch: occupancy query says %d blocks per CU\n", per_cu); per_cu = 1; }
        grid = cus * per_cu;
        fprintf(stderr, "kernel_launch: %d CUs x %d = grid %d\n", cus, per_cu, grid);
    }
    if (grid < 0) return;
    (void)hipMemsetAsync((char*)d_ws + WS_CTL, 0, CTL_BYTES, stream);
    Args a{};
    a.x = (const float*)d_in[0]; a.c = (const float*)d_in[1]; a.pos = (const int*)d_in[2]; a.w_ada = (const float*)d_in[3]; a.b_ada = (const float*)d_in[4]; a.g_mix = (const float*)d_in[5];
    a.w_in = (const float*)d_in[6]; a.sinks = (const float*)d_in[7]; a.g_sb = (const float*)d_in[8]; a.g_sw = (const float*)d_in[9]; a.w_out = (const float*)d_in[10]; a.g_ffn = (const float*)d_in[11];
    a.w_rg = (const float*)d_in[12]; a.w_re = (const float*)d_in[13]; a.w_gate = (const float*)d_in[14]; a.w_up = (const float*)d_in[15]; a.w_down = (const float*)d_in[16]; a.g_fin = (const float*)d_in[17];
    a.out = (float*)d_out; a.ws = (unsigned char*)d_ws;
    void* args[] = {&a};
    hipError_t e = hipLaunchCooperativeKernel((const void*)mk_fwd, dim3(grid), dim3(NTHREADS), args, LDS_BYTES, stream);
    if (e != hipSuccess) fprintf(stderr, "kernel_launch: cooperative launch failed: %s (grid %d)\n", hipGetErrorString(e), grid);
}
```

```cpp
#include <hip/hip_runtime.h>
#include <hip/hip_cooperative_groups.h>
#include <cstdio>
#include <cstdint>
#include <cmath>
namespace cg = cooperative_groups;

#define LAS __attribute__((address_space(3)))
#define DI __device__ __forceinline__
typedef unsigned short bf16_t;
typedef short bf16x8 __attribute__((ext_vector_type(8)));
typedef float f32x4 __attribute__((ext_vector_type(4)));
typedef float f32x2 __attribute__((ext_vector_type(2)));
typedef unsigned u32x4 __attribute__((ext_vector_type(4)));
typedef unsigned u32x2 __attribute__((ext_vector_type(2)));
typedef __bf16 bf16x2_t __attribute__((ext_vector_type(2)));

constexpr int NB = 4, SEQ = 8192, DM = 1024, T = NB * SEQ;
constexpr int DIN = 2304, DSB = 512, DSW = 512, DKV = 128;
constexpr int NEXP = 16, DEXP = 512, NBUCKET = 24, WINDOW = 128;
constexpr int MAXTILES = T / 256 + NBUCKET, TPAD = MAXTILES * 256;
constexpr float EPS = 1e-6f, LOG2E = 1.4426950408889634f, QSCALE = 0.125f * LOG2E;
constexpr float SB_EXIT = -150.0f;
constexpr int NTHREADS = 512, NWAVES = 8;

constexpr size_t MiB = 1u << 20;
constexpr size_t WS_CTL = 0, CTL_BYTES = 1 * MiB;
constexpr size_t WS_MOD = 1 * MiB;
constexpr size_t WS_COS = 2 * MiB, WS_SIN = 6 * MiB;
constexpr size_t WS_WIN = 10 * MiB;
constexpr size_t WS_WOUT = 15 * MiB;
constexpr size_t WS_WGU = 17 * MiB;
constexpr size_t WS_WD = 49 * MiB;
constexpr size_t WS_LIST = 65 * MiB;
constexpr size_t WS_WTS = 68 * MiB;
constexpr size_t WS_H = 80 * MiB;
constexpr size_t WS_QSB = 144 * MiB, WS_KSB = 176 * MiB, WS_VSB = 208 * MiB, WS_QSW = 240 * MiB;
constexpr size_t WS_KSW = 272 * MiB, WS_VSW = 280 * MiB;
constexpr size_t WS_MIX = 288 * MiB;
constexpr size_t WS_HID = 352 * MiB;
constexpr size_t WS_END = 428 * MiB;
static_assert(WS_KSB - WS_QSB == WS_VSB - WS_KSB, "q/k/v_sb buffers equally spaced");
static_assert(WS_HID + (size_t)TPAD * 1024 * 2 <= WS_END, "ws map");
constexpr int CW_CNT = 64;

constexpr int LDS_BYTES = 147456;

struct Args {
    const float* x; const float* c; const int* pos; const float* w_ada; const float* b_ada; const float* g_mix; const float* w_in; const float* sinks;
    const float* g_sb; const float* g_sw; const float* w_out; const float* g_ffn; const float* w_rg; const float* w_re; const float* w_gate; const float* w_up;
    const float* w_down; const float* g_fin; float* out; unsigned char* ws;
};

__constant__ float INV_FREQ[32] = {1.000000000e+00f, 7.498942018e-01f, 5.623413324e-01f, 4.216965139e-01f, 3.162277639e-01f, 2.371373773e-01f, 1.778279394e-01f, 1.333521456e-01f, 1.000000015e-01f, 7.498942316e-02f, 5.623413250e-02f, 4.216964915e-02f, 3.162277490e-02f, 2.371373773e-02f, 1.778279431e-02f, 1.333521400e-02f, 9.999999776e-03f, 7.498942316e-03f, 5.623413250e-03f, 4.216964822e-03f, 3.162277630e-03f, 2.371373819e-03f, 1.778279431e-03f, 1.333521446e-03f, 1.000000047e-03f, 7.498941850e-04f, 5.623413017e-04f, 4.216965172e-04f, 3.162277571e-04f, 2.371373703e-04f, 1.778279402e-04f, 1.333521504e-04f};

DI unsigned f2bf(float f) { unsigned u = __builtin_bit_cast(unsigned, f); return (u + 0x7fffu + ((u >> 16) & 1u)) >> 16; }
DI unsigned pk2(float lo, float hi) { f32x2 v = {lo, hi}; bf16x2_t b = __builtin_convertvector(v, bf16x2_t); return __builtin_bit_cast(unsigned, b); }
DI float bf2f(unsigned short b) { return __builtin_bit_cast(float, (unsigned)b << 16); }
DI float bflo(unsigned w) { return __builtin_bit_cast(float, w << 16); }
DI float bfhi(unsigned w) { return __builtin_bit_cast(float, w & 0xffff0000u); }
DI float wave_sum(float v) {
#pragma unroll
    for (int o = 1; o < 64; o <<= 1) v += __shfl_xor(v, o);
    return v;
}
#define LDS_WAIT() asm volatile("s_waitcnt lgkmcnt(0)" ::: "memory")

DI void tr_item(const float* W, int N, int k0, int n0, bf16_t* WT, int drow0, int Kd, const float* kscale, LAS float* scr, int lane) {
#pragma unroll 8
    for (int i = 0; i < 32; ++i) { const int kk = 2 * i + (lane >> 5); float v = W[(size_t)(k0 + kk) * N + n0 + (lane & 31)]; if (kscale) v *= kscale[k0 + kk]; scr[kk * 33 + (lane & 31)] = v; }
    LDS_WAIT();
    const int c = lane & 7;
#pragma unroll
    for (int j = 0; j < 4; ++j) { const int n = (lane >> 3) + 8 * j; const LAS float* s = scr + (8 * c) * 33 + n;
        u32x4 o; o.x = pk2(s[0 * 33], s[1 * 33]); o.y = pk2(s[2 * 33], s[3 * 33]); o.z = pk2(s[4 * 33], s[5 * 33]); o.w = pk2(s[6 * 33], s[7 * 33]);
        *(u32x4*)(WT + (size_t)(drow0 + n) * Kd + k0 + 8 * c) = o; }
    LDS_WAIT();
}
DI int win_drow(int n0) {
    if (n0 < 1536) return n0;
    if (n0 < 2048) { const int c = n0 - 1536, head = c >> 6, half = (c >> 5) & 1; return 1536 + (head >> 2) * 256 + half * 128 + (head & 3) * 32; }
    if (n0 < 2176) { const int c = n0 - 2048, head = c >> 6, half = (c >> 5) & 1; return 2048 + half * 128 + head * 32; }
    const int c = n0 - 2176; return 2048 + (c >> 6) * 128 + 64 + (c & 63);
}
DI void p0_prologue(const Args& a, LAS unsigned char* lds, int tid, int lane, int wave) {
    unsigned char* ws = a.ws;
    {
        float* mod = (float*)(ws + WS_MOD); LAS float* red = (LAS float*)lds;
        for (int cb = blockIdx.x; cb < 6144 / 32; cb += gridDim.x) {
            const int cj = tid & 31, kg = tid >> 5, col = cb * 32 + cj;
            float acc0 = 0.f, acc1 = 0.f, acc2 = 0.f, acc3 = 0.f;
            for (int kk = 0; kk < 64; ++kk) { const int k = kg * 64 + kk; const float w = a.w_ada[(size_t)k * 6144 + col];
                float c0 = a.c[k], c1 = a.c[1024 + k], c2 = a.c[2048 + k], c3 = a.c[3072 + k];
                c0 = c0 / (1.f + expf(-c0)); c1 = c1 / (1.f + expf(-c1)); c2 = c2 / (1.f + expf(-c2)); c3 = c3 / (1.f + expf(-c3));
                acc0 += c0 * w; acc1 += c1 * w; acc2 += c2 * w; acc3 += c3 * w; }
            red[(kg * 4 + 0) * 32 + cj] = acc0; red[(kg * 4 + 1) * 32 + cj] = acc1; red[(kg * 4 + 2) * 32 + cj] = acc2; red[(kg * 4 + 3) * 32 + cj] = acc3;
            __syncthreads();
            if (tid < 128) { const int b = tid >> 5, c2 = tid & 31; float s = 0.f; for (int g = 0; g < 16; ++g) s += red[(g * 4 + b) * 32 + c2]; mod[b * 6144 + cb * 32 + c2] = s + a.b_ada[cb * 32 + c2]; }
            __syncthreads();
        }
    }
    {
        float* cosT = (float*)(ws + WS_COS); float* sinT = (float*)(ws + WS_SIN);
        for (int idx = blockIdx.x * NTHREADS + tid; idx < T * 32; idx += gridDim.x * NTHREADS) {
            const int t = idx >> 5, i = idx & 31; const float ang = (float)a.pos[t] * INV_FREQ[i];
            const double ad = (double)ang, kq = rint(ad * 0.63661977236758134308);
            double y = fma(-kq, 1.5707963267948966192, ad); y = fma(-kq, 6.123233995736766036e-17, y);
            const int q = (int)((long long)kq & 3); const double y2 = y * y;
            const double sn = y * (1.0 + y2 * (-1.0 / 6 + y2 * (1.0 / 120 + y2 * (-1.0 / 5040 + y2 * (1.0 / 362880 + y2 * (-1.0 / 39916800))))));
            const double cs = 1.0 + y2 * (-0.5 + y2 * (1.0 / 24 + y2 * (-1.0 / 720 + y2 * (1.0 / 40320 + y2 * (-1.0 / 3628800 + y2 * (1.0 / 479001600))))));
            double co, si; if (q == 0) { co = cs; si = sn; } else if (q == 1) { co = -sn; si = cs; } else if (q == 2) { co = -cs; si = -sn; } else { co = sn; si = -cs; }
            cosT[idx] = (float)co; sinT[idx] = (float)si;
        }
    }
    {
        LAS float* scr = (LAS float*)(lds + 8192 + wave * 8704);
        const int gw = blockIdx.x * NWAVES + wave, NGW = gridDim.x * NWAVES;
        constexpr int I_IN = 16 * 72, I_OUT = 16 * 32, I_G = 16 * 16 * 16, I_D = 16 * 8 * 32, NITEMS = I_IN + I_OUT + 2 * I_G + I_D;
        for (int it = gw; it < NITEMS; it += NGW) {
            int r = it;
            if (r < I_IN) { const int kb = r / 72, nb = r % 72; tr_item(a.w_in, DIN, kb * 64, nb * 32, (bf16_t*)(ws + WS_WIN), win_drow(nb * 32), 1024, nullptr, scr, lane); continue; } r -= I_IN;
            if (r < I_OUT) { const int kb = r / 32, nb = r % 32; const float* ks = (kb < 8) ? a.g_sb : (a.g_sw - 512); tr_item(a.w_out, 1024, kb * 64, nb * 32, (bf16_t*)(ws + WS_WOUT), nb * 32, 1024, ks, scr, lane); continue; } r -= I_OUT;
            if (r < 2 * I_G) { const int up = r >= I_G; if (up) r -= I_G; const int e = r / 256, q = r % 256, kb = q / 16, nb = q % 16, c0 = nb * 32;
                tr_item((up ? a.w_up : a.w_gate) + (size_t)e * 1024 * 512, 512, kb * 64, c0, (bf16_t*)(ws + WS_WGU) + (size_t)e * 1024 * 1024, (c0 >> 7) * 256 + up * 128 + (c0 & 127), 1024, nullptr, scr, lane); continue; } r -= 2 * I_G;
            { const int e = r / 256, q = r % 256, kb = q / 32, nb = q % 32; tr_item(a.w_down + (size_t)e * 512 * 1024, 1024, kb * 64, nb * 32, (bf16_t*)(ws + WS_WD) + (size_t)e * 1024 * 512, nb * 32, 512, nullptr, scr, lane); }
        }
    }
}

DI void p1_norm(const Args& a, int lane, int wave) {
    const float* mod = (const float*)(a.ws + WS_MOD); bf16_t* H = (bf16_t*)(a.ws + WS_H);
    const int gw = blockIdx.x * NWAVES + wave, NGW = gridDim.x * NWAVES;
    for (int ch = gw; ch < T / 16; ch += NGW) {
        const int row0 = ch * 16, b = row0 / SEQ;
        f32x4 ca[4], cb[4];
#pragma unroll
        for (int j = 0; j < 4; ++j) { const int col = 4 * lane + 256 * j; const f32x4 g = *(const f32x4*)(a.g_mix + col), sc = *(const f32x4*)(mod + b * 6144 + 1024 + col); ca[j] = g * (sc + 1.0f); cb[j] = *(const f32x4*)(mod + b * 6144 + col); }
        for (int r = 0; r < 16; ++r) {
            const float* xr = a.x + (size_t)(row0 + r) * DM; f32x4 v[4]; float s = 0.f;
#pragma unroll
            for (int j = 0; j < 4; ++j) { v[j] = *(const f32x4*)(xr + 4 * lane + 256 * j); s += (v[j].x * v[j].x + v[j].y * v[j].y) + (v[j].z * v[j].z + v[j].w * v[j].w); }
            const float rs = 1.0f / sqrtf(wave_sum(s) * (1.0f / DM) + EPS);
            bf16_t* hr = H + (size_t)(row0 + r) * DM;
#pragma unroll
            for (int j = 0; j < 4; ++j) { const f32x4 o = v[j] * rs * ca[j] + cb[j]; u32x2 w; w.x = pk2(o.x, o.y); w.y = pk2(o.z, o.w); *(u32x2*)(hr + 4 * lane + 256 * j) = w; }
        }
    }
}
DI void p8_final(const Args& a, int lane, int wave) {
    const int gw = blockIdx.x * NWAVES + wave, NGW = gridDim.x * NWAVES;
    f32x4 g[4];
#pragma unroll
    for (int j = 0; j < 4; ++j) g[j] = *(const f32x4*)(a.g_fin + 4 * lane + 256 * j);
    for (int row = gw; row < T; row += NGW) {
        float* xr = a.out + (size_t)row * DM; f32x4 v[4]; float s = 0.f;
#pragma unroll
        for (int j = 0; j < 4; ++j) { v[j] = *(const f32x4*)(xr + 4 * lane + 256 * j); s += (v[j].x * v[j].x + v[j].y * v[j].y) + (v[j].z * v[j].z + v[j].w * v[j].w); }
        const float rs = 1.0f / sqrtf(wave_sum(s) * (1.0f / DM) + EPS);
#pragma unroll
        for (int j = 0; j < 4; ++j) *(f32x4*)(xr + 4 * lane + 256 * j) = v[j] * rs * g[j];
    }
}
DI void p5_router(const Args& a, int lane, int wave) {
    const float* mod = (const float*)(a.ws + WS_MOD); bf16_t* H = (bf16_t*)(a.ws + WS_H);
    unsigned* cnt = (unsigned*)(a.ws + WS_CTL) + CW_CNT; int* list = (int*)(a.ws + WS_LIST); f32x2* wts = (f32x2*)(a.ws + WS_WTS);
    const int gw = blockIdx.x * NWAVES + wave, NGW = gridDim.x * NWAVES;
    for (int ch = gw; ch < T / 16; ch += NGW) {
        const int row0 = ch * 16, b = row0 / SEQ;
        f32x4 ca[4], cb[4];
#pragma unroll
        for (int j = 0; j < 4; ++j) { const int col = 4 * lane + 256 * j; const f32x4 g = *(const f32x4*)(a.g_ffn + col), sc = *(const f32x4*)(mod + b * 6144 + 4096 + col); ca[j] = g * (sc + 1.0f); cb[j] = *(const f32x4*)(mod + b * 6144 + 3072 + col); }
        for (int r = 0; r < 16; ++r) {
            const int row = row0 + r; const float* xr = a.out + (size_t)row * DM; f32x4 v[4]; float s = 0.f;
#pragma unroll
            for (int j = 0; j < 4; ++j) { v[j] = *(const f32x4*)(xr + 4 * lane + 256 * j); s += (v[j].x * v[j].x + v[j].y * v[j].y) + (v[j].z * v[j].z + v[j].w * v[j].w); }
            const float rs = 1.0f / sqrtf(wave_sum(s) * (1.0f / DM) + EPS);
            bf16_t* hr = H + (size_t)row * DM;
            float lg[20];
#pragma unroll
            for (int i = 0; i < 20; ++i) lg[i] = 0.f;
#pragma unroll
            for (int j = 0; j < 4; ++j) { const f32x4 o = v[j] * rs * ca[j] + cb[j]; u32x2 w; w.x = pk2(o.x, o.y); w.y = pk2(o.z, o.w); *(u32x2*)(hr + 4 * lane + 256 * j) = w;
#pragma unroll
                for (int e = 0; e < 4; ++e) { const int k = 4 * lane + 256 * j + e; const float hv = o[e];
                    const f32x4 wg = *(const f32x4*)(a.w_rg + k * 4);
                    lg[0] += hv * wg.x; lg[1] += hv * wg.y; lg[2] += hv * wg.z; lg[3] += hv * wg.w;
#pragma unroll
                    for (int q = 0; q < 4; ++q) { const f32x4 we = *(const f32x4*)(a.w_re + k * 16 + 4 * q); lg[4 + 4 * q] += hv * we.x; lg[5 + 4 * q] += hv * we.y; lg[6 + 4 * q] += hv * we.z; lg[7 + 4 * q] += hv * we.w; } } }
#pragma unroll
            for (int i = 0; i < 20; ++i) lg[i] = wave_sum(lg[i]);
            int g = 0; float gm = lg[0];
#pragma unroll
            for (int i = 1; i < 4; ++i) if (lg[i] > gm) { gm = lg[i]; g = i; }
            float gs = 0.f;
#pragma unroll
            for (int i = 0; i < 4; ++i) gs += expf(lg[i] - gm);
            const float gprob = 1.0f / gs;
            float el[4];
#pragma unroll
            for (int i = 0; i < 4; ++i) el[i] = g == 0 ? lg[4 + i] : g == 1 ? lg[8 + i] : g == 2 ? lg[12 + i] : lg[16 + i];
            int i0 = 0; float m0 = el[0];
#pragma unroll
            for (int i = 1; i < 4; ++i) if (el[i] > m0) { m0 = el[i]; i0 = i; }
            int i1 = -1; float m1 = 0.f;
#pragma unroll
            for (int i = 0; i < 4; ++i) if (i != i0 && (i1 < 0 || el[i] > m1)) { m1 = el[i]; i1 = i; }
            const float ex = expf(m1 - m0), w0 = 1.0f / (1.0f + ex), w1 = ex * w0;
            const int ea = i0 < i1 ? i0 : i1, eb = i0 < i1 ? i1 : i0; const float wa = (i0 < i1 ? w0 : w1) * gprob, wb = (i0 < i1 ? w1 : w0) * gprob;
            const int bucket = g * 6 + (ea * (7 - ea)) / 2 + (eb - ea - 1);
            if (lane == 0) { const unsigned p = atomicAdd(cnt + bucket, 1u); list[bucket * T + p] = row; wts[bucket * T + p] = (f32x2){wa, wb}; }
        }
    }
}

struct GUnit { const bf16_t* A; const int* aidx; int nvalid; const bf16_t* B0; const bf16_t* B1; int pm, pn, lbase; };
namespace pg8 {
constexpr int BM = 256, BK = 64, HALF = 128, HTB = HALF * BK * 2, STAGE_BYTES = 8 * HTB;
DI int lds_byte(int r, int c) { const int st = (r >> 4) * 2 + (c >> 5), rr = r & 15, cc = c & 31, ob = rr * 64 + cc * 2; return st * 1024 + (ob ^ (((ob >> 9) & 1) << 5)); }
DI void stage_rc(int b, int& R, int& C) { const int st = b / 1024, sb = b % 1024, swz = sb ^ (((sb >> 9) & 1) << 5); R = (st >> 1) * 16 + swz / 64; C = (st & 1) * 32 + (swz % 64) / 2; }
DI int perm32(int rho) { const int n = rho >> 4, i = rho & 15; return 8 * (i >> 2) + 4 * n + (i & 3); }
DI void a_offsets(const GUnit& u, int K, int tid_, unsigned (&vo)[2][2]) {
    asm volatile("" : "+v"(tid_));
#pragma unroll
    for (int i = 0; i < 2; ++i) { int R, C; stage_rc(tid_ * 16 + i * 8192, R, C);
#pragma unroll
        for (int h = 0; h < 2; ++h) { const int r = h * HALF + R; const int gr = u.aidx ? u.aidx[r < u.nvalid ? r : 0] : r; vo[h][i] = ((unsigned)gr * (unsigned)K + (unsigned)C) * 2u; } }
}
template <class Sched, class Epi, bool ALIGN_EPI, int K, int ldb, int nsplit>
DI void gemm_phase(LAS unsigned char* lds, const Sched& S, const Epi& E) {
    int tid = threadIdx.x; asm volatile("" : "+v"(tid));
    const int wid = __builtin_amdgcn_readfirstlane(tid >> 6), lane = tid & 63, wr = wid >> 2, wc = wid & 3, fr = lane & 15, fq = lane >> 4;
    const int nt = K / BK;
    unsigned voffB[2];
#pragma unroll
    for (int i = 0; i < 2; ++i) { int R, C; stage_rc(tid * 16 + i * 8192, R, C); const int Rb = (R & ~31) + perm32(R & 31); voffB[i] = ((unsigned)Rb * (unsigned)ldb + (unsigned)C) * 2u; }
    const size_t hB = (size_t)HALF * ldb * 2;
    const unsigned ldsw = (unsigned)wid * 1024u;
    const int aoff = lds_byte(wr * 64 + fr, fq * 8), boff = lds_byte(wc * 32 + fr, fq * 8);
#define PG8_SA(b, h) (((b) * 2 + (h)) * HTB)
#define PG8_SB(b, h) ((4 + (b) * 2 + (h)) * HTB)
#define PG8_STAGE(bufoff, gbase, voff) do { _Pragma("unroll") for (int _i = 0; _i < 2; ++_i) \
        __builtin_amdgcn_global_load_lds((const unsigned*)((const char*)(gbase) + (voff)[_i]), (LAS unsigned*)(lds + (bufoff) + ldsw + _i * 8192), 16, 0, 0); } while (0)
#define PG8_LDA(dst, b, h) do { _Pragma("unroll") for (int m = 0; m < 4; ++m) _Pragma("unroll") for (int k = 0; k < 2; ++k) dst[m][k] = *(const LAS bf16x8*)(lds + PG8_SA(b, h) + aoff + m * 2048 + k * 1024); } while (0)
#define PG8_LDB(dst, b, h) do { _Pragma("unroll") for (int n = 0; n < 2; ++n) _Pragma("unroll") for (int k = 0; k < 2; ++k) dst[n][k] = *(const LAS bf16x8*)(lds + PG8_SB(b, h) + boff + n * 2048 + k * 1024); } while (0)
#define PG8_MMA(ai, bj, At, Bt) do { __builtin_amdgcn_s_setprio(1); _Pragma("unroll") for (int m = 0; m < 4; ++m) _Pragma("unroll") for (int n = 0; n < 2; ++n) _Pragma("unroll") for (int k = 0; k < 2; ++k) \
        acc[ai][bj][m][n] = __builtin_amdgcn_mfma_f32_16x16x32_bf16(Bt[n][k], At[m][k], acc[ai][bj][m][n], 0, 0, 0); __builtin_amdgcn_s_setprio(0); } while (0)
#define PG8_WAIT_V(n) asm volatile("s_waitcnt vmcnt(" #n ")" ::: "memory")
#define PG8_WAIT_L(n) asm volatile("s_waitcnt lgkmcnt(" #n ")" ::: "memory")
#define PG8_BAR __builtin_amdgcn_s_barrier()
#define PG8_SCHED __builtin_amdgcn_sched_barrier(0)
#define PG8_AK(u, kt) ((const char*)(u).A + (size_t)(kt) * (BK * 2))
#define PG8_BK(u, kt) ((kt) < nsplit ? (const char*)(u).B0 + (size_t)(kt) * (BK * 2) : (const char*)(u).B1 + (size_t)((kt) - nsplit) * (BK * 2))
    GUnit cur, nxt; int ui = 0;
    if (!S.next(0, cur)) return;
    f32x4 acc[2][2][4][2];
#pragma unroll
    for (int a = 0; a < 2; ++a)
#pragma unroll
        for (int b = 0; b < 2; ++b)
#pragma unroll
            for (int m = 0; m < 4; ++m)
#pragma unroll
                for (int n = 0; n < 2; ++n) acc[a][b][m][n] = (f32x4){0.f, 0.f, 0.f, 0.f};
    bf16x8 At[4][2], B0[2][2], B1[2][2];
    unsigned voffA[2][2];
    a_offsets(cur, K, tid, voffA);
    {
        const char* a0 = PG8_AK(cur, 0); const char* b0 = PG8_BK(cur, 0); const char* a1 = PG8_AK(cur, 1); const char* b1 = PG8_BK(cur, 1);
        PG8_STAGE(PG8_SB(0, 0), b0, voffB); PG8_STAGE(PG8_SB(0, 1), b0 + hB, voffB); PG8_STAGE(PG8_SA(0, 0), a0, voffA[0]); PG8_STAGE(PG8_SA(0, 1), a0, voffA[1]);
        if (wr == 1) PG8_BAR;
        PG8_WAIT_V(2); PG8_BAR;
        PG8_STAGE(PG8_SB(1, 0), b1, voffB); PG8_STAGE(PG8_SA(1, 0), a1, voffA[0]); PG8_STAGE(PG8_SB(1, 1), b1 + hB, voffB);
        PG8_WAIT_V(6); PG8_BAR;
    }
    for (;;) {
        const bool has_next = S.next(ui + 1, nxt);
        if (!has_next) nxt = cur;
        for (int t = 0; t < nt; t += 2) {
            const bool last = (t == nt - 2);
            const char* a1 = PG8_AK(cur, t + 1);
            const char* a2 = last ? PG8_AK(nxt, 0) : PG8_AK(cur, t + 2); const char* b2 = last ? PG8_BK(nxt, 0) : PG8_BK(cur, t + 2);
            const char* a3 = last ? PG8_AK(nxt, 1) : PG8_AK(cur, t + 3); const char* b3 = last ? PG8_BK(nxt, 1) : PG8_BK(cur, t + 3);
            PG8_LDB(B0, 0, 0); PG8_LDB(B1, 0, 1); PG8_SCHED; PG8_LDA(At, 0, 0); PG8_STAGE(PG8_SA(1, 1), a1, voffA[1]);
            if (last) a_offsets(nxt, K, tid, voffA);
            PG8_WAIT_V(8); PG8_WAIT_L(0); PG8_BAR; PG8_MMA(0, 0, At, B0); PG8_MMA(0, 1, At, B1); PG8_BAR; PG8_SCHED;
            PG8_LDA(At, 0, 1); PG8_STAGE(PG8_SB(0, 0), b2, voffB); PG8_STAGE(PG8_SB(0, 1), b2 + hB, voffB); PG8_STAGE(PG8_SA(0, 0), a2, voffA[0]);
            PG8_WAIT_V(8); PG8_WAIT_L(0); PG8_BAR; PG8_MMA(1, 0, At, B0); PG8_MMA(1, 1, At, B1); PG8_BAR; PG8_SCHED;
            PG8_LDB(B0, 1, 0); PG8_LDB(B1, 1, 1); PG8_SCHED; PG8_LDA(At, 1, 0); PG8_STAGE(PG8_SA(0, 1), a2, voffA[1]);
            PG8_WAIT_V(8); PG8_WAIT_L(0); PG8_BAR; PG8_MMA(0, 0, At, B0); PG8_MMA(0, 1, At, B1); PG8_BAR; PG8_SCHED;
            PG8_LDA(At, 1, 1); PG8_STAGE(PG8_SB(1, 0), b3, voffB); PG8_STAGE(PG8_SB(1, 1), b3 + hB, voffB); PG8_STAGE(PG8_SA(1, 0), a3, voffA[0]);
            PG8_WAIT_V(8); PG8_WAIT_L(0); PG8_BAR; PG8_MMA(1, 0, At, B0); PG8_MMA(1, 1, At, B1); PG8_BAR; PG8_SCHED;
        }
        if constexpr (ALIGN_EPI) { if (wr == 0) PG8_BAR; }
        E(acc, cur, wr, wc, fr, fq);
        if (!has_next) break;
#pragma unroll
        for (int a = 0; a < 2; ++a)
#pragma unroll
            for (int b = 0; b < 2; ++b)
#pragma unroll
                for (int m = 0; m < 4; ++m)
#pragma unroll
                    for (int n = 0; n < 2; ++n) acc[a][b][m][n] = (f32x4){0.f, 0.f, 0.f, 0.f};
        cur = nxt; ++ui;
        if constexpr (ALIGN_EPI) { if (wr == 1) PG8_BAR; }
    }
    PG8_WAIT_V(0);
    if constexpr (!ALIGN_EPI) { if (wr == 0) PG8_BAR; }
    PG8_BAR;
#undef PG8_SA
#undef PG8_SB
#undef PG8_STAGE
#undef PG8_LDA
#undef PG8_LDB
#undef PG8_MMA
#undef PG8_WAIT_V
#undef PG8_WAIT_L
#undef PG8_BAR
#undef PG8_SCHED
#undef PG8_AK
#undef PG8_BK
}
}
struct DenseSched {
    const bf16_t* A; const bf16_t* Bt; int K, nM, nN;
    DI bool next(int i, GUnit& u) const {
        const int nwg = nM * nN; const long L = (long)i * (int)gridDim.x + (int)blockIdx.x; if (L >= nwg) return false;
        int wgid = (int)L; { const int q = nwg / 8, r = nwg % 8, xcd = wgid % 8, off = wgid / 8; wgid = (xcd < r ? xcd * (q + 1) : r * (q + 1) + (xcd - r) * q) + off; }
        const int nig = 8 * nN, gid = wgid / nig, fm = gid * 8, gsz = (nM - fm) < 8 ? (nM - fm) : 8;
        u.pm = fm + ((wgid % nig) % gsz); u.pn = (wgid % nig) / gsz;
        u.A = A + (size_t)u.pm * 256 * K; u.aidx = nullptr; u.nvalid = 256; u.B0 = Bt + (size_t)u.pn * 256 * K; u.B1 = u.B0; u.lbase = 0; return true; }
};
template <int NT, bool up> struct MoeSched {
    const LAS int* tstart; const unsigned* cnt; const int* list; const bf16_t* A; const bf16_t* W;
    DI bool next(int i, GUnit& u) const {
        const int ntile = __builtin_amdgcn_readfirstlane(tstart[NBUCKET]), nwg = ntile * NT; const int L0 = i * (int)gridDim.x + (int)blockIdx.x; if (L0 >= nwg) return false;
        int L = L0; { const int q = nwg / 8, r = nwg % 8, xcd = L0 % 8, off = L0 / 8; L = (xcd < r ? xcd * (q + 1) : r * (q + 1) + (xcd - r) * q) + off; }
        const int ti = L / NT, pn = L % NT; int b = 0;
        for (int q = 1; q < NBUCKET; ++q) if (__builtin_amdgcn_readfirstlane(tstart[q]) <= ti) b = q;
        const int rt = ti - __builtin_amdgcn_readfirstlane(tstart[b]); const int g = b / 6, p = b % 6; const int ea = 4 * g + (p < 3 ? 0 : (p < 5 ? 1 : 2)), eb = 4 * g + (p < 3 ? p + 1 : (p < 5 ? p - 1 : 3));
        u.pm = ti; u.pn = pn; u.lbase = b * T + rt * 256; const int nv = __builtin_amdgcn_readfirstlane((int)cnt[b]) - rt * 256; u.nvalid = nv < 256 ? nv : 256;
        if (up) { u.A = A; u.aidx = list + u.lbase; const int e = pn < 4 ? ea : eb; u.B0 = W + (size_t)e * 1024 * 1024 + (size_t)(pn & 3) * 256 * 1024; u.B1 = u.B0; }
        else { u.A = A + (size_t)ti * 256 * 1024; u.aidx = nullptr; u.B0 = W + (size_t)ea * 1024 * 512 + (size_t)pn * 256 * 512; u.B1 = W + (size_t)eb * 1024 * 512 + (size_t)pn * 256 * 512; }
        return true;
    }
};

DI u32x4 pack8(const f32x4 v0, const f32x4 v1) { u32x4 w; w.x = pk2(v0[0], v0[1]); w.y = pk2(v0[2], v0[3]); w.z = pk2(v1[0], v1[1]); w.w = pk2(v1[2], v1[3]); return w; }
struct EpiProj {
    bf16_t *qsb, *ksb, *vsb, *qsw, *ksw, *vsw; const float *cosT, *sinT;
    DI void operator()(const f32x4 (&acc)[2][2][4][2], const GUnit& u, int wr, int wc, int fr, int fq) const {
        const int pn = u.pn, rowb = u.pm * 256 + wr * 64 + fr;
        if (pn < 6) {
            bf16_t* base = qsb + (size_t)(pn >> 1) * ((WS_KSB - WS_QSB) / 2); const float sc = pn < 2 ? QSCALE : 1.0f; const int colt = (pn & 1) * 256 + wc * 32 + 8 * fq;
#pragma unroll
            for (int ai = 0; ai < 2; ++ai)
#pragma unroll
                for (int m = 0; m < 4; ++m) { const size_t row = rowb + ai * 128 + m * 16;
#pragma unroll
                    for (int bj = 0; bj < 2; ++bj) *(u32x4*)(base + row * 512 + colt + bj * 128) = pack8(acc[ai][bj][m][0] * sc, acc[ai][bj][m][1] * sc); }
        } else if (pn < 8 || wc < 2) {
            const bool isq = pn < 8; bf16_t* base = isq ? qsw : ksw; const int pitch = isq ? 512 : 128; const int head = isq ? (pn - 6) * 4 + wc : wc; const float sc = isq ? QSCALE : 1.0f;
#pragma unroll
            for (int ai = 0; ai < 2; ++ai)
#pragma unroll
                for (int m = 0; m < 4; ++m) { const size_t row = rowb + ai * 128 + m * 16;
                    const f32x4 c0 = *(const f32x4*)(cosT + row * 32 + 8 * fq), c1 = *(const f32x4*)(cosT + row * 32 + 8 * fq + 4);
                    const f32x4 s0 = *(const f32x4*)(sinT + row * 32 + 8 * fq), s1 = *(const f32x4*)(sinT + row * 32 + 8 * fq + 4);
                    const f32x4 x10 = acc[ai][0][m][0], x11 = acc[ai][0][m][1], x20 = acc[ai][1][m][0], x21 = acc[ai][1][m][1];
                    const f32x4 o10 = (x10 * c0 - x20 * s0) * sc, o11 = (x11 * c1 - x21 * s1) * sc, o20 = (x20 * c0 + x10 * s0) * sc, o21 = (x21 * c1 + x11 * s1) * sc;
                    *(u32x4*)(base + row * pitch + head * 64 + 8 * fq) = pack8(o10, o11); *(u32x4*)(base + row * pitch + head * 64 + 32 + 8 * fq) = pack8(o20, o21); }
        } else {
#pragma unroll
            for (int ai = 0; ai < 2; ++ai)
#pragma unroll
                for (int m = 0; m < 4; ++m) { const size_t row = rowb + ai * 128 + m * 16;
#pragma unroll
                    for (int bj = 0; bj < 2; ++bj) *(u32x4*)(vsw + row * 128 + bj * 64 + (wc * 32 - 64) + 8 * fq) = pack8(acc[ai][bj][m][0], acc[ai][bj][m][1]); }
        }
    }
};
struct EpiWout {
    const float* x; const float* mod; float* out;
    DI void operator()(const f32x4 (&acc)[2][2][4][2], const GUnit& u, int wr, int wc, int fr, int fq) const {
        const int rowb = u.pm * 256 + wr * 64 + fr, colb = u.pn * 256 + wc * 32 + 8 * fq; const int b = (u.pm * 256) / SEQ;
        f32x4 gt[2][2];
#pragma unroll
        for (int bj = 0; bj < 2; ++bj)
#pragma unroll
            for (int n = 0; n < 2; ++n) gt[bj][n] = *(const f32x4*)(mod + b * 6144 + 2048 + colb + bj * 128 + 4 * n);
#pragma unroll
        for (int ai = 0; ai < 2; ++ai)
#pragma unroll
            for (int m = 0; m < 4; ++m) { const size_t off = (size_t)(rowb + ai * 128 + m * 16) * DM + colb;
#pragma unroll
                for (int bj = 0; bj < 2; ++bj)
#pragma unroll
                    for (int n = 0; n < 2; ++n) { const f32x4 xv = *(const f32x4*)(x + off + bj * 128 + 4 * n); *(f32x4*)(out + off + bj * 128 + 4 * n) = xv + gt[bj][n] * acc[ai][bj][m][n]; } }
    }
};
DI f32x4 swiglu4(const f32x4 g, const f32x4 uu, float w) { f32x4 o;
#pragma unroll
    for (int j = 0; j < 4; ++j) o[j] = w * uu[j] * g[j] / (1.0f + __expf(-g[j]));
    return o; }
struct EpiUp {
    bf16_t* hid; const f32x2* wts;
    DI void operator()(const f32x4 (&acc)[2][2][4][2], const GUnit& u, int wr, int wc, int fr, int fq) const {
        const int hc = (u.pn >> 2) * 512 + (u.pn & 3) * 128 + wc * 32 + 8 * fq; const bool second = u.pn >= 4;
#pragma unroll
        for (int ai = 0; ai < 2; ++ai)
#pragma unroll
            for (int m = 0; m < 4; ++m) { const int r = ai * 128 + wr * 64 + m * 16 + fr; float w = 0.f;
                if (r < u.nvalid) { const f32x2 ww = wts[u.lbase + r]; w = second ? ww.y : ww.x; }
                *(u32x4*)(hid + (size_t)(u.pm * 256 + r) * 1024 + hc) = pack8(swiglu4(acc[ai][0][m][0], acc[ai][1][m][0], w), swiglu4(acc[ai][0][m][1], acc[ai][1][m][1], w)); }
    }
};
struct EpiDown {
    const int* list; const float* mod; float* out;
    DI void operator()(const f32x4 (&acc)[2][2][4][2], const GUnit& u, int wr, int wc, int fr, int fq) const {
        const int colb = u.pn * 256 + wc * 32 + 8 * fq; const int* lp = list + u.lbase;
#pragma unroll
        for (int ai = 0; ai < 2; ++ai)
#pragma unroll
            for (int m = 0; m < 4; ++m) { const int r = ai * 128 + wr * 64 + m * 16 + fr;
                if (r < u.nvalid) { const int tok = lp[r]; const float* gp = mod + (tok / SEQ) * 6144 + 5120 + colb; float* op = out + (size_t)tok * DM + colb;
#pragma unroll
                    for (int bj = 0; bj < 2; ++bj) { const f32x4 g0 = *(const f32x4*)(gp + bj * 128), g1 = *(const f32x4*)(gp + bj * 128 + 4); const f32x4 x0 = *(const f32x4*)(op + bj * 128), x1 = *(const f32x4*)(op + bj * 128 + 4);
                        *(f32x4*)(op + bj * 128) = x0 + g0 * acc[ai][bj][m][0]; *(f32x4*)(op + bj * 128 + 4) = x1 + g1 * acc[ai][bj][m][1]; } }
                asm volatile("" ::: "memory"); }
    }
};

DI void load64(const bf16_t* p, float (&v)[64]) {
#pragma unroll
    for (int c = 0; c < 8; ++c) { const u32x4 w = *(const u32x4*)(p + 8 * c); v[8 * c] = bflo(w.x); v[8 * c + 1] = bfhi(w.x); v[8 * c + 2] = bflo(w.y); v[8 * c + 3] = bfhi(w.y); v[8 * c + 4] = bflo(w.z); v[8 * c + 5] = bfhi(w.z); v[8 * c + 6] = bflo(w.w); v[8 * c + 7] = bfhi(w.w); }
}
DI float dot64(const bf16_t* p, const float (&q)[64]) {
    float s0 = 0.f, s1 = 0.f;
#pragma unroll
    for (int c = 0; c < 8; ++c) { const u32x4 w = *(const u32x4*)(p + 8 * c); s0 += q[8 * c] * bflo(w.x); s1 += q[8 * c + 1] * bfhi(w.x); s0 += q[8 * c + 2] * bflo(w.y); s1 += q[8 * c + 3] * bfhi(w.y); s0 += q[8 * c + 4] * bflo(w.z); s1 += q[8 * c + 5] * bfhi(w.z); s0 += q[8 * c + 6] * bflo(w.w); s1 += q[8 * c + 7] * bfhi(w.w); }
    return s0 + s1;
}
DI void axpy64(const bf16_t* p, float a, float (&o)[64]) {
#pragma unroll
    for (int c = 0; c < 8; ++c) { const u32x4 w = *(const u32x4*)(p + 8 * c); o[8 * c] += a * bflo(w.x); o[8 * c + 1] += a * bfhi(w.x); o[8 * c + 2] += a * bflo(w.y); o[8 * c + 3] += a * bfhi(w.y); o[8 * c + 4] += a * bflo(w.z); o[8 * c + 5] += a * bfhi(w.z); o[8 * c + 6] += a * bflo(w.w); o[8 * c + 7] += a * bfhi(w.w); }
}
DI void store_normed(bf16_t* dst, float (&o)[64]) {
    float ss = 0.f;
#pragma unroll
    for (int d = 0; d < 64; ++d) ss += o[d] * o[d];
    ss += __shfl_xor(ss, 1); ss += __shfl_xor(ss, 2); ss += __shfl_xor(ss, 4);
    const float rs = 1.0f / sqrtf(ss * (1.0f / 512.0f) + EPS);
#pragma unroll
    for (int c = 0; c < 8; ++c) { u32x4 w; w.x = pk2(o[8 * c] * rs, o[8 * c + 1] * rs); w.y = pk2(o[8 * c + 2] * rs, o[8 * c + 3] * rs); w.z = pk2(o[8 * c + 4] * rs, o[8 * c + 5] * rs); w.w = pk2(o[8 * c + 6] * rs, o[8 * c + 7] * rs); *(u32x4*)(dst + 8 * c) = w; }
}
DI void p3_attention_naive(const Args& a, int tid) {
    const bf16_t* QSB = (const bf16_t*)(a.ws + WS_QSB); const bf16_t* KSB = (const bf16_t*)(a.ws + WS_KSB); const bf16_t* VSB = (const bf16_t*)(a.ws + WS_VSB);
    const bf16_t* QSW = (const bf16_t*)(a.ws + WS_QSW); const bf16_t* KSW = (const bf16_t*)(a.ws + WS_KSW); const bf16_t* VSW = (const bf16_t*)(a.ws + WS_VSW);
    bf16_t* MIX = (bf16_t*)(a.ws + WS_MIX);
    for (int ch = blockIdx.x; ch < 2 * (T * 8 / NTHREADS); ch += gridDim.x) {
        const bool sw = ch & 1; const int idx = (ch >> 1) * NTHREADS + tid, t = idx >> 3, head = idx & 7, b = t / SEQ, tl = t % SEQ;
        float q[64], o[64];
#pragma unroll
        for (int d = 0; d < 64; ++d) o[d] = 0.f;
        if (!sw) {
            load64(QSB + (size_t)t * 512 + head * 64, q);
            float R = 0.f;
            for (int s = tl - 1; s >= 0; --s) {
                const size_t kr = (size_t)(b * SEQ + s) * 512 + head * 64;
                const float z = dot64(KSB + kr, q);
                const float l = log2f(1.0f + exp2f(-fabsf(z))); const float L = fminf(-z, 0.f) - l;
                const float p = exp2f(z + L + R);
                axpy64(VSB + kr, p, o);
                R += L; if (R < SB_EXIT) break;
            }
            store_normed(MIX + (size_t)t * 1024 + head * 64, o);
        } else {
            load64(QSW + (size_t)t * 512 + head * 64, q);
            const int kvh = head >> 2; float m = a.sinks[head] * LOG2E, l = 1.0f;
            const int s0 = tl - (WINDOW - 1) < 0 ? 0 : tl - (WINDOW - 1);
            for (int s = s0; s <= tl; ++s) {
                const size_t kr = (size_t)(b * SEQ + s) * 128 + kvh * 64;
                const float sc = dot64(KSW + kr, q);
                if (sc > m) { const float f = exp2f(m - sc); l *= f;
#pragma unroll
                    for (int d = 0; d < 64; ++d) o[d] *= f;
                    m = sc; }
                const float p = exp2f(sc - m); l += p; axpy64(VSW + kr, p, o);
            }
            const float il = 1.0f / l;
#pragma unroll
            for (int d = 0; d < 64; ++d) o[d] *= il;
            store_normed(MIX + (size_t)t * 1024 + 512 + head * 64, o);
        }
    }
}

__global__ void __launch_bounds__(NTHREADS, 2) mk_fwd(Args a) {
    extern __shared__ __attribute__((aligned(16))) unsigned char lds_raw[];
    LAS unsigned char* lds = (LAS unsigned char*)lds_raw;
    cg::grid_group grid = cg::this_grid();
    const int tid = threadIdx.x, lane = tid & 63, wave = __builtin_amdgcn_readfirstlane(tid >> 6);
    unsigned char* ws = a.ws;
    const float* mod = (const float*)(ws + WS_MOD);

    p0_prologue(a, lds, tid, lane, wave);
    grid.sync();
    p1_norm(a, lane, wave);
    grid.sync();
    {
        DenseSched S{(const bf16_t*)(ws + WS_H), (const bf16_t*)(ws + WS_WIN), 1024, T / 256, DIN / 256};
        EpiProj E{(bf16_t*)(ws + WS_QSB), (bf16_t*)(ws + WS_KSB), (bf16_t*)(ws + WS_VSB), (bf16_t*)(ws + WS_QSW), (bf16_t*)(ws + WS_KSW), (bf16_t*)(ws + WS_VSW), (const float*)(ws + WS_COS), (const float*)(ws + WS_SIN)};
        pg8::gemm_phase<DenseSched, EpiProj, true, 1024, 1024, 16>(lds, S, E);
    }
    grid.sync();
    p3_attention_naive(a, tid);
    grid.sync();
    {
        DenseSched S{(const bf16_t*)(ws + WS_MIX), (const bf16_t*)(ws + WS_WOUT), 1024, T / 256, DM / 256};
        EpiWout E{a.x, mod, a.out};
        pg8::gemm_phase<DenseSched, EpiWout, true, 1024, 1024, 16>(lds, S, E);
    }
    grid.sync();
    p5_router(a, lane, wave);
    grid.sync();
    LAS int* tstart = (LAS int*)(lds + pg8::STAGE_BYTES);
    const unsigned* cnt = (const unsigned*)(ws + WS_CTL) + CW_CNT;
    if (tid == 0) { int run = 0; for (int b = 0; b < NBUCKET; ++b) { tstart[b] = run; run += ((int)cnt[b] + 255) >> 8; } tstart[NBUCKET] = run; }
    __syncthreads();
    {
        MoeSched<8, true> S{tstart, cnt, (const int*)(ws + WS_LIST), (const bf16_t*)(ws + WS_H), (const bf16_t*)(ws + WS_WGU)};
        EpiUp E{(bf16_t*)(ws + WS_HID), (const f32x2*)(ws + WS_WTS)};
        pg8::gemm_phase<MoeSched<8, true>, EpiUp, true, 1024, 1024, 16>(lds, S, E);
    }
    grid.sync();
    {
        MoeSched<4, false> S{tstart, cnt, (const int*)(ws + WS_LIST), (const bf16_t*)(ws + WS_HID), (const bf16_t*)(ws + WS_WD)};
        EpiDown E{(const int*)(ws + WS_LIST), mod, a.out};
        pg8::gemm_phase<MoeSched<4, false>, EpiDown, true, 1024, 512, 8>(lds, S, E);
    }
    grid.sync();
    p8_final(a, lane, wave);
}

extern "C" void kernel_launch(void* const* d_in, const int* in_sizes, int n_in, void* d_out, int out_size, void* d_ws, size_t ws_size, hipStream_t stream) {
    static int grid = 0;
    if (grid == 0) {
        if (n_in != 18 || in_sizes[0] != T * DM || out_size != T * DM || ws_size < WS_END) { fprintf(stderr, "kernel_launch: unexpected shapes (n_in %d, in0 %d, out %d, ws %zu); nothing launched\n", n_in, n_in > 0 ? in_sizes[0] : -1, out_size, ws_size); grid = -1; return; }
        int dev = 0, cus = 0, per_cu = 0;
        (void)hipGetDevice(&dev); (void)hipDeviceGetAttribute(&cus, hipDeviceAttributeMultiprocessorCount, dev);
        (void)hipFuncSetAttribute((const void*)mk_fwd, hipFuncAttributeMaxDynamicSharedMemorySize, LDS_BYTES);
        (void)hipOccupancyMaxActiveBlocksPerMultiprocessor(&per_cu, (const void*)mk_fwd, NTHREADS, LDS_BYTES);
        if (per_cu < 1) { fprintf(stderr, "kernel_launch: occupancy query says %d blocks per CU\n", per_cu); per_cu = 1; }
        grid = cus * per_cu;
        fprintf(stderr, "kernel_launch: %d CUs x %d = grid %d\n", cus, per_cu, grid);
    }
    if (grid < 0) return;
    (void)hipMemsetAsync((char*)d_ws + WS_CTL, 0, CTL_BYTES, stream);
    Args a{};
    a.x = (const float*)d_in[0]; a.c = (const float*)d_in[1]; a.pos = (const int*)d_in[2]; a.w_ada = (const float*)d_in[3]; a.b_ada = (const float*)d_in[4]; a.g_mix = (const float*)d_in[5];
    a.w_in = (const float*)d_in[6]; a.sinks = (const float*)d_in[7]; a.g_sb = (const float*)d_in[8]; a.g_sw = (const float*)d_in[9]; a.w_out = (const float*)d_in[10]; a.g_ffn = (const float*)d_in[11];
    a.w_rg = (const float*)d_in[12]; a.w_re = (const float*)d_in[13]; a.w_gate = (const float*)d_in[14]; a.w_up = (const float*)d_in[15]; a.w_down = (const float*)d_in[16]; a.g_fin = (const float*)d_in[17];
    a.out = (float*)d_out; a.ws = (unsigned char*)d_ws;
    void* args[] = {&a};
    hipError_t e = hipLaunchCooperativeKernel((const void*)mk_fwd, dim3(grid), dim3(NTHREADS), args, LDS_BYTES, stream);
    if (e != hipSuccess) fprintf(stderr, "kernel_launch: cooperative launch failed: %s (grid %d)\n", hipGetErrorString(e), grid);
}
```

```cpp
#include <hip/hip_runtime.h>
#include <hip/hip_cooperative_groups.h>
#include <cstdio>
#include <cstdint>
#include <cmath>
namespace cg = cooperative_groups;

#define LAS __attribute__((address_space(3)))
#define DI __device__ __forceinline__
typedef unsigned short bf16_t;
typedef short bf16x8 __attribute__((ext_vector_type(8)));
typedef float f32x4 __attribute__((ext_vector_type(4)));
typedef float f32x2 __attribute__((ext_vector_type(2)));
typedef unsigned u32x4 __attribute__((ext_vector_type(4)));
typedef unsigned u32x2 __attribute__((ext_vector_type(2)));
typedef __bf16 bf16x2_t __attribute__((ext_vector_type(2)));

constexpr int NB = 4, SEQ = 8192, DM = 1024, T = NB * SEQ;
constexpr int DIN = 2304, DSB = 512, DSW = 512, DKV = 128;
constexpr int NEXP = 16, DEXP = 512, NBUCKET = 24, WINDOW = 128;
constexpr int MAXTILES = T / 256 + NBUCKET, TPAD = MAXTILES * 256;
constexpr float EPS = 1e-6f, LOG2E = 1.4426950408889634f, QSCALE = 0.125f * LOG2E;
constexpr float SB_EXIT = -150.0f;
constexpr int NTHREADS = 512, NWAVES = 8;

constexpr size_t MiB = 1u << 20;
constexpr size_t WS_CTL = 0, CTL_BYTES = 1 * MiB;
constexpr size_t WS_MOD = 1 * MiB;
constexpr size_t WS_COS = 2 * MiB, WS_SIN = 6 * MiB;
constexpr size_t WS_WIN = 10 * MiB;
constexpr size_t WS_WOUT = 15 * MiB;
constexpr size_t WS_WGU = 17 * MiB;
constexpr size_t WS_WD = 49 * MiB;
constexpr size_t WS_LIST = 65 * MiB;
constexpr size_t WS_WTS = 68 * MiB;
constexpr size_t WS_H = 80 * MiB;
constexpr size_t WS_QSB = 144 * MiB, WS_KSB = 176 * MiB, WS_VSB = 208 * MiB, WS_QSW = 240 * MiB;
constexpr size_t WS_KSW = 272 * MiB, WS_VSW = 280 * MiB;
constexpr size_t WS_MIX = 288 * MiB;
constexpr size_t WS_HID = 352 * MiB;
constexpr size_t WS_END = 428 * MiB;
static_assert(WS_KSB - WS_QSB == WS_VSB - WS_KSB, "q/k/v_sb buffers equally spaced");
static_assert(WS_HID + (size_t)TPAD * 1024 * 2 <= WS_END, "ws map");
constexpr int CW_CNT = 64, CW_ATTNQ = 128;

constexpr int LDS_BYTES = 147456;

struct Args {
    const float* x; const float* c; const int* pos; const float* w_ada; const float* b_ada; const float* g_mix; const float* w_in; const float* sinks;
    const float* g_sb; const float* g_sw; const float* w_out; const float* g_ffn; const float* w_rg; const float* w_re; const float* w_gate; const float* w_up;
    const float* w_down; const float* g_fin; float* out; unsigned char* ws;
};

__constant__ float INV_FREQ[32] = {1.000000000e+00f, 7.498942018e-01f, 5.623413324e-01f, 4.216965139e-01f, 3.162277639e-01f, 2.371373773e-01f, 1.778279394e-01f, 1.333521456e-01f, 1.000000015e-01f, 7.498942316e-02f, 5.623413250e-02f, 4.216964915e-02f, 3.162277490e-02f, 2.371373773e-02f, 1.778279431e-02f, 1.333521400e-02f, 9.999999776e-03f, 7.498942316e-03f, 5.623413250e-03f, 4.216964822e-03f, 3.162277630e-03f, 2.371373819e-03f, 1.778279431e-03f, 1.333521446e-03f, 1.000000047e-03f, 7.498941850e-04f, 5.623413017e-04f, 4.216965172e-04f, 3.162277571e-04f, 2.371373703e-04f, 1.778279402e-04f, 1.333521504e-04f};

DI unsigned f2bf(float f) { unsigned u = __builtin_bit_cast(unsigned, f); return (u + 0x7fffu + ((u >> 16) & 1u)) >> 16; }
DI unsigned pk2(float lo, float hi) { f32x2 v = {lo, hi}; bf16x2_t b = __builtin_convertvector(v, bf16x2_t); return __builtin_bit_cast(unsigned, b); }
DI float bf2f(unsigned short b) { return __builtin_bit_cast(float, (unsigned)b << 16); }
DI float bflo(unsigned w) { return __builtin_bit_cast(float, w << 16); }
DI float bfhi(unsigned w) { return __builtin_bit_cast(float, w & 0xffff0000u); }
DI float wave_sum(float v) {
#pragma unroll
    for (int o = 1; o < 64; o <<= 1) v += __shfl_xor(v, o);
    return v;
}
#define LDS_WAIT() asm volatile("s_waitcnt lgkmcnt(0)" ::: "memory")

DI void tr_item(const float* W, int N, int k0, int n0, bf16_t* WT, int drow0, int Kd, const float* kscale, LAS float* scr, int lane) {
#pragma unroll 8
    for (int i = 0; i < 32; ++i) { const int kk = 2 * i + (lane >> 5); float v = W[(size_t)(k0 + kk) * N + n0 + (lane & 31)]; if (kscale) v *= kscale[k0 + kk]; scr[kk * 33 + (lane & 31)] = v; }
    LDS_WAIT();
    const int c = lane & 7;
#pragma unroll
    for (int j = 0; j < 4; ++j) { const int n = (lane >> 3) + 8 * j; const LAS float* s = scr + (8 * c) * 33 + n;
        u32x4 o; o.x = pk2(s[0 * 33], s[1 * 33]); o.y = pk2(s[2 * 33], s[3 * 33]); o.z = pk2(s[4 * 33], s[5 * 33]); o.w = pk2(s[6 * 33], s[7 * 33]);
        *(u32x4*)(WT + (size_t)(drow0 + n) * Kd + k0 + 8 * c) = o; }
    LDS_WAIT();
}
DI int win_drow(int n0) {
    if (n0 < 1536) return n0;
    if (n0 < 2048) { const int c = n0 - 1536, head = c >> 6, half = (c >> 5) & 1; return 1536 + (head >> 2) * 256 + half * 128 + (head & 3) * 32; }
    if (n0 < 2176) { const int c = n0 - 2048, head = c >> 6, half = (c >> 5) & 1; return 2048 + half * 128 + head * 32; }
    const int c = n0 - 2176; return 2048 + (c >> 6) * 128 + 64 + (c & 63);
}
DI void p0_prologue(const Args& a, LAS unsigned char* lds, int tid, int lane, int wave) {
    unsigned char* ws = a.ws;
    {
        float* mod = (float*)(ws + WS_MOD); LAS float* red = (LAS float*)lds;
        for (int cb = blockIdx.x; cb < 6144 / 32; cb += gridDim.x) {
            const int cj = tid & 31, kg = tid >> 5, col = cb * 32 + cj;
            float acc0 = 0.f, acc1 = 0.f, acc2 = 0.f, acc3 = 0.f;
            for (int kk = 0; kk < 64; ++kk) { const int k = kg * 64 + kk; const float w = a.w_ada[(size_t)k * 6144 + col];
                float c0 = a.c[k], c1 = a.c[1024 + k], c2 = a.c[2048 + k], c3 = a.c[3072 + k];
                c0 = c0 / (1.f + expf(-c0)); c1 = c1 / (1.f + expf(-c1)); c2 = c2 / (1.f + expf(-c2)); c3 = c3 / (1.f + expf(-c3));
                acc0 += c0 * w; acc1 += c1 * w; acc2 += c2 * w; acc3 += c3 * w; }
            red[(kg * 4 + 0) * 32 + cj] = acc0; red[(kg * 4 + 1) * 32 + cj] = acc1; red[(kg * 4 + 2) * 32 + cj] = acc2; red[(kg * 4 + 3) * 32 + cj] = acc3;
            __syncthreads();
            if (tid < 128) { const int b = tid >> 5, c2 = tid & 31; float s = 0.f; for (int g = 0; g < 16; ++g) s += red[(g * 4 + b) * 32 + c2]; mod[b * 6144 + cb * 32 + c2] = s + a.b_ada[cb * 32 + c2]; }
            __syncthreads();
        }
    }
    {
        float* cosT = (float*)(ws + WS_COS); float* sinT = (float*)(ws + WS_SIN);
        for (int idx = blockIdx.x * NTHREADS + tid; idx < T * 32; idx += gridDim.x * NTHREADS) {
            const int t = idx >> 5, i = idx & 31; const float ang = (float)a.pos[t] * INV_FREQ[i];
            const double ad = (double)ang, kq = rint(ad * 0.63661977236758134308);
            double y = fma(-kq, 1.5707963267948966192, ad); y = fma(-kq, 6.123233995736766036e-17, y);
            const int q = (int)((long long)kq & 3); const double y2 = y * y;
            const double sn = y * (1.0 + y2 * (-1.0 / 6 + y2 * (1.0 / 120 + y2 * (-1.0 / 5040 + y2 * (1.0 / 362880 + y2 * (-1.0 / 39916800))))));
            const double cs = 1.0 + y2 * (-0.5 + y2 * (1.0 / 24 + y2 * (-1.0 / 720 + y2 * (1.0 / 40320 + y2 * (-1.0 / 3628800 + y2 * (1.0 / 479001600))))));
            double co, si; if (q == 0) { co = cs; si = sn; } else if (q == 1) { co = -sn; si = cs; } else if (q == 2) { co = -cs; si = -sn; } else { co = sn; si = -cs; }
            cosT[idx] = (float)co; sinT[idx] = (float)si;
        }
    }
    {
        LAS float* scr = (LAS float*)(lds + 8192 + wave * 8704);
        const int gw = blockIdx.x * NWAVES + wave, NGW = gridDim.x * NWAVES;
        constexpr int I_IN = 16 * 72, I_OUT = 16 * 32, I_G = 16 * 16 * 16, I_D = 16 * 8 * 32, NITEMS = I_IN + I_OUT + 2 * I_G + I_D;
        for (int it = gw; it < NITEMS; it += NGW) {
            int r = it;
            if (r < I_IN) { const int kb = r / 72, nb = r % 72; tr_item(a.w_in, DIN, kb * 64, nb * 32, (bf16_t*)(ws + WS_WIN), win_drow(nb * 32), 1024, nullptr, scr, lane); continue; } r -= I_IN;
            if (r < I_OUT) { const int kb = r / 32, nb = r % 32; const float* ks = (kb < 8) ? a.g_sb : (a.g_sw - 512); tr_item(a.w_out, 1024, kb * 64, nb * 32, (bf16_t*)(ws + WS_WOUT), nb * 32, 1024, ks, scr, lane); continue; } r -= I_OUT;
            if (r < 2 * I_G) { const int up = r >= I_G; if (up) r -= I_G; const int e = r / 256, q = r % 256, kb = q / 16, nb = q % 16, c0 = nb * 32;
                tr_item((up ? a.w_up : a.w_gate) + (size_t)e * 1024 * 512, 512, kb * 64, c0, (bf16_t*)(ws + WS_WGU) + (size_t)e * 1024 * 1024, (c0 >> 7) * 256 + up * 128 + (c0 & 127), 1024, nullptr, scr, lane); continue; } r -= 2 * I_G;
            { const int e = r / 256, q = r % 256, kb = q / 32, nb = q % 32; tr_item(a.w_down + (size_t)e * 512 * 1024, 1024, kb * 64, nb * 32, (bf16_t*)(ws + WS_WD) + (size_t)e * 1024 * 512, nb * 32, 512, nullptr, scr, lane); }
        }
    }
}

DI void p1_norm(const Args& a, int lane, int wave) {
    const float* mod = (const float*)(a.ws + WS_MOD); bf16_t* H = (bf16_t*)(a.ws + WS_H);
    const int gw = blockIdx.x * NWAVES + wave, NGW = gridDim.x * NWAVES;
    for (int ch = gw; ch < T / 16; ch += NGW) {
        const int row0 = ch * 16, b = row0 / SEQ;
        f32x4 ca[4], cb[4];
#pragma unroll
        for (int j = 0; j < 4; ++j) { const int col = 4 * lane + 256 * j; const f32x4 g = *(const f32x4*)(a.g_mix + col), sc = *(const f32x4*)(mod + b * 6144 + 1024 + col); ca[j] = g * (sc + 1.0f); cb[j] = *(const f32x4*)(mod + b * 6144 + col); }
        for (int r = 0; r < 16; ++r) {
            const float* xr = a.x + (size_t)(row0 + r) * DM; f32x4 v[4]; float s = 0.f;
#pragma unroll
            for (int j = 0; j < 4; ++j) { v[j] = *(const f32x4*)(xr + 4 * lane + 256 * j); s += (v[j].x * v[j].x + v[j].y * v[j].y) + (v[j].z * v[j].z + v[j].w * v[j].w); }
            const float rs = 1.0f / sqrtf(wave_sum(s) * (1.0f / DM) + EPS);
            bf16_t* hr = H + (size_t)(row0 + r) * DM;
#pragma unroll
            for (int j = 0; j < 4; ++j) { const f32x4 o = v[j] * rs * ca[j] + cb[j]; u32x2 w; w.x = pk2(o.x, o.y); w.y = pk2(o.z, o.w); *(u32x2*)(hr + 4 * lane + 256 * j) = w; }
        }
    }
}
DI void p8_final(const Args& a, int lane, int wave) {
    const int gw = blockIdx.x * NWAVES + wave, NGW = gridDim.x * NWAVES;
    f32x4 g[4];
#pragma unroll
    for (int j = 0; j < 4; ++j) g[j] = *(const f32x4*)(a.g_fin + 4 * lane + 256 * j);
    for (int row = gw; row < T; row += NGW) {
        float* xr = a.out + (size_t)row * DM; f32x4 v[4]; float s = 0.f;
#pragma unroll
        for (int j = 0; j < 4; ++j) { v[j] = *(const f32x4*)(xr + 4 * lane + 256 * j); s += (v[j].x * v[j].x + v[j].y * v[j].y) + (v[j].z * v[j].z + v[j].w * v[j].w); }
        const float rs = 1.0f / sqrtf(wave_sum(s) * (1.0f / DM) + EPS);
#pragma unroll
        for (int j = 0; j < 4; ++j) *(f32x4*)(xr + 4 * lane + 256 * j) = v[j] * rs * g[j];
    }
}
DI void p5_router(const Args& a, int lane, int wave) {
    const float* mod = (const float*)(a.ws + WS_MOD); bf16_t* H = (bf16_t*)(a.ws + WS_H);
    unsigned* cnt = (unsigned*)(a.ws + WS_CTL) + CW_CNT; int* list = (int*)(a.ws + WS_LIST); f32x2* wts = (f32x2*)(a.ws + WS_WTS);
    const int gw = blockIdx.x * NWAVES + wave, NGW = gridDim.x * NWAVES;
    for (int ch = gw; ch < T / 16; ch += NGW) {
        const int row0 = ch * 16, b = row0 / SEQ;
        f32x4 ca[4], cb[4];
#pragma unroll
        for (int j = 0; j < 4; ++j) { const int col = 4 * lane + 256 * j; const f32x4 g = *(const f32x4*)(a.g_ffn + col), sc = *(const f32x4*)(mod + b * 6144 + 4096 + col); ca[j] = g * (sc + 1.0f); cb[j] = *(const f32x4*)(mod + b * 6144 + 3072 + col); }
        for (int r = 0; r < 16; ++r) {
            const int row = row0 + r; const float* xr = a.out + (size_t)row * DM; f32x4 v[4]; float s = 0.f;
#pragma unroll
            for (int j = 0; j < 4; ++j) { v[j] = *(const f32x4*)(xr + 4 * lane + 256 * j); s += (v[j].x * v[j].x + v[j].y * v[j].y) + (v[j].z * v[j].z + v[j].w * v[j].w); }
            const float rs = 1.0f / sqrtf(wave_sum(s) * (1.0f / DM) + EPS);
            bf16_t* hr = H + (size_t)row * DM;
            float lg[20];
#pragma unroll
            for (int i = 0; i < 20; ++i) lg[i] = 0.f;
#pragma unroll
            for (int j = 0; j < 4; ++j) { const f32x4 o = v[j] * rs * ca[j] + cb[j]; u32x2 w; w.x = pk2(o.x, o.y); w.y = pk2(o.z, o.w); *(u32x2*)(hr + 4 * lane + 256 * j) = w;
#pragma unroll
                for (int e = 0; e < 4; ++e) { const int k = 4 * lane + 256 * j + e; const float hv = o[e];
                    const f32x4 wg = *(const f32x4*)(a.w_rg + k * 4);
                    lg[0] += hv * wg.x; lg[1] += hv * wg.y; lg[2] += hv * wg.z; lg[3] += hv * wg.w;
#pragma unroll
                    for (int q = 0; q < 4; ++q) { const f32x4 we = *(const f32x4*)(a.w_re + k * 16 + 4 * q); lg[4 + 4 * q] += hv * we.x; lg[5 + 4 * q] += hv * we.y; lg[6 + 4 * q] += hv * we.z; lg[7 + 4 * q] += hv * we.w; } } }
#pragma unroll
            for (int i = 0; i < 20; ++i) lg[i] = wave_sum(lg[i]);
            int g = 0; float gm = lg[0];
#pragma unroll
            for (int i = 1; i < 4; ++i) if (lg[i] > gm) { gm = lg[i]; g = i; }
            float gs = 0.f;
#pragma unroll
            for (int i = 0; i < 4; ++i) gs += expf(lg[i] - gm);
            const float gprob = 1.0f / gs;
            float el[4];
#pragma unroll
            for (int i = 0; i < 4; ++i) el[i] = g == 0 ? lg[4 + i] : g == 1 ? lg[8 + i] : g == 2 ? lg[12 + i] : lg[16 + i];
            int i0 = 0; float m0 = el[0];
#pragma unroll
            for (int i = 1; i < 4; ++i) if (el[i] > m0) { m0 = el[i]; i0 = i; }
            int i1 = -1; float m1 = 0.f;
#pragma unroll
            for (int i = 0; i < 4; ++i) if (i != i0 && (i1 < 0 || el[i] > m1)) { m1 = el[i]; i1 = i; }
            const float ex = expf(m1 - m0), w0 = 1.0f / (1.0f + ex), w1 = ex * w0;
            const int ea = i0 < i1 ? i0 : i1, eb = i0 < i1 ? i1 : i0; const float wa = (i0 < i1 ? w0 : w1) * gprob, wb = (i0 < i1 ? w1 : w0) * gprob;
            const int bucket = g * 6 + (ea * (7 - ea)) / 2 + (eb - ea - 1);
            if (lane == 0) { const unsigned p = atomicAdd(cnt + bucket, 1u); list[bucket * T + p] = row; wts[bucket * T + p] = (f32x2){wa, wb}; }
        }
    }
}

struct GUnit { const bf16_t* A; const int* aidx; int nvalid; const bf16_t* B0; const bf16_t* B1; int pm, pn, lbase; };
namespace pg8 {
constexpr int BM = 256, BK = 64, HALF = 128, HTB = HALF * BK * 2, STAGE_BYTES = 8 * HTB;
DI int lds_byte(int r, int c) { const int st = (r >> 4) * 2 + (c >> 5), rr = r & 15, cc = c & 31, ob = rr * 64 + cc * 2; return st * 1024 + (ob ^ (((ob >> 9) & 1) << 5)); }
DI void stage_rc(int b, int& R, int& C) { const int st = b / 1024, sb = b % 1024, swz = sb ^ (((sb >> 9) & 1) << 5); R = (st >> 1) * 16 + swz / 64; C = (st & 1) * 32 + (swz % 64) / 2; }
DI int perm32(int rho) { const int n = rho >> 4, i = rho & 15; return 8 * (i >> 2) + 4 * n + (i & 3); }
DI void a_offsets(const GUnit& u, int K, int tid_, unsigned (&vo)[2][2]) {
    asm volatile("" : "+v"(tid_));
#pragma unroll
    for (int i = 0; i < 2; ++i) { int R, C; stage_rc(tid_ * 16 + i * 8192, R, C);
#pragma unroll
        for (int h = 0; h < 2; ++h) { const int r = h * HALF + R; const int gr = u.aidx ? u.aidx[r < u.nvalid ? r : 0] : r; vo[h][i] = ((unsigned)gr * (unsigned)K + (unsigned)C) * 2u; } }
}
template <class Sched, class Epi, bool ALIGN_EPI, int K, int ldb, int nsplit>
DI void gemm_phase(LAS unsigned char* lds, const Sched& S, const Epi& E) {
    int tid = threadIdx.x; asm volatile("" : "+v"(tid));
    const int wid = __builtin_amdgcn_readfirstlane(tid >> 6), lane = tid & 63, wr = wid >> 2, wc = wid & 3, fr = lane & 15, fq = lane >> 4;
    const int nt = K / BK;
    unsigned voffB[2];
#pragma unroll
    for (int i = 0; i < 2; ++i) { int R, C; stage_rc(tid * 16 + i * 8192, R, C); const int Rb = (R & ~31) + perm32(R & 31); voffB[i] = ((unsigned)Rb * (unsigned)ldb + (unsigned)C) * 2u; }
    const size_t hB = (size_t)HALF * ldb * 2;
    const unsigned ldsw = (unsigned)wid * 1024u;
    const int aoff = lds_byte(wr * 64 + fr, fq * 8), boff = lds_byte(wc * 32 + fr, fq * 8);
#define PG8_SA(b, h) (((b) * 2 + (h)) * HTB)
#define PG8_SB(b, h) ((4 + (b) * 2 + (h)) * HTB)
#define PG8_STAGE(bufoff, gbase, voff) do { _Pragma("unroll") for (int _i = 0; _i < 2; ++_i) \
        __builtin_amdgcn_global_load_lds((const unsigned*)((const char*)(gbase) + (voff)[_i]), (LAS unsigned*)(lds + (bufoff) + ldsw + _i * 8192), 16, 0, 0); } while (0)
#define PG8_LDA(dst, b, h) do { _Pragma("unroll") for (int m = 0; m < 4; ++m) _Pragma("unroll") for (int k = 0; k < 2; ++k) dst[m][k] = *(const LAS bf16x8*)(lds + PG8_SA(b, h) + aoff + m * 2048 + k * 1024); } while (0)
#define PG8_LDB(dst, b, h) do { _Pragma("unroll") for (int n = 0; n < 2; ++n) _Pragma("unroll") for (int k = 0; k < 2; ++k) dst[n][k] = *(const LAS bf16x8*)(lds + PG8_SB(b, h) + boff + n * 2048 + k * 1024); } while (0)
#define PG8_MMA(ai, bj, At, Bt) do { __builtin_amdgcn_s_setprio(1); _Pragma("unroll") for (int m = 0; m < 4; ++m) _Pragma("unroll") for (int n = 0; n < 2; ++n) _Pragma("unroll") for (int k = 0; k < 2; ++k) \
        acc[ai][bj][m][n] = __builtin_amdgcn_mfma_f32_16x16x32_bf16(Bt[n][k], At[m][k], acc[ai][bj][m][n], 0, 0, 0); __builtin_amdgcn_s_setprio(0); } while (0)
#define PG8_WAIT_V(n) asm volatile("s_waitcnt vmcnt(" #n ")" ::: "memory")
#define PG8_WAIT_L(n) asm volatile("s_waitcnt lgkmcnt(" #n ")" ::: "memory")
#define PG8_BAR __builtin_amdgcn_s_barrier()
#define PG8_SCHED __builtin_amdgcn_sched_barrier(0)
#define PG8_AK(u, kt) ((const char*)(u).A + (size_t)(kt) * (BK * 2))
#define PG8_BK(u, kt) ((kt) < nsplit ? (const char*)(u).B0 + (size_t)(kt) * (BK * 2) : (const char*)(u).B1 + (size_t)((kt) - nsplit) * (BK * 2))
    GUnit cur, nxt; int ui = 0;
    if (!S.next(0, cur)) return;
    f32x4 acc[2][2][4][2];
#pragma unroll
    for (int a = 0; a < 2; ++a)
#pragma unroll
        for (int b = 0; b < 2; ++b)
#pragma unroll
            for (int m = 0; m < 4; ++m)
#pragma unroll
                for (int n = 0; n < 2; ++n) acc[a][b][m][n] = (f32x4){0.f, 0.f, 0.f, 0.f};
    bf16x8 At[4][2], B0[2][2], B1[2][2];
    unsigned voffA[2][2];
    a_offsets(cur, K, tid, voffA);
    {
        const char* a0 = PG8_AK(cur, 0); const char* b0 = PG8_BK(cur, 0); const char* a1 = PG8_AK(cur, 1); const char* b1 = PG8_BK(cur, 1);
        PG8_STAGE(PG8_SB(0, 0), b0, voffB); PG8_STAGE(PG8_SB(0, 1), b0 + hB, voffB); PG8_STAGE(PG8_SA(0, 0), a0, voffA[0]); PG8_STAGE(PG8_SA(0, 1), a0, voffA[1]);
        if (wr == 1) PG8_BAR;
        PG8_WAIT_V(2); PG8_BAR;
        PG8_STAGE(PG8_SB(1, 0), b1, voffB); PG8_STAGE(PG8_SA(1, 0), a1, voffA[0]); PG8_STAGE(PG8_SB(1, 1), b1 + hB, voffB);
        PG8_WAIT_V(6); PG8_BAR;
    }
    for (;;) {
        const bool has_next = S.next(ui + 1, nxt);
        if (!has_next) nxt = cur;
        for (int t = 0; t < nt; t += 2) {
            const bool last = (t == nt - 2);
            const char* a1 = PG8_AK(cur, t + 1);
            const char* a2 = last ? PG8_AK(nxt, 0) : PG8_AK(cur, t + 2); const char* b2 = last ? PG8_BK(nxt, 0) : PG8_BK(cur, t + 2);
            const char* a3 = last ? PG8_AK(nxt, 1) : PG8_AK(cur, t + 3); const char* b3 = last ? PG8_BK(nxt, 1) : PG8_BK(cur, t + 3);
            PG8_LDB(B0, 0, 0); PG8_LDB(B1, 0, 1); PG8_SCHED; PG8_LDA(At, 0, 0); PG8_STAGE(PG8_SA(1, 1), a1, voffA[1]);
            if (last) a_offsets(nxt, K, tid, voffA);
            PG8_WAIT_V(8); PG8_WAIT_L(0); PG8_BAR; PG8_MMA(0, 0, At, B0); PG8_MMA(0, 1, At, B1); PG8_BAR; PG8_SCHED;
            PG8_LDA(At, 0, 1); PG8_STAGE(PG8_SB(0, 0), b2, voffB); PG8_STAGE(PG8_SB(0, 1), b2 + hB, voffB); PG8_STAGE(PG8_SA(0, 0), a2, voffA[0]);
            PG8_WAIT_V(8); PG8_WAIT_L(0); PG8_BAR; PG8_MMA(1, 0, At, B0); PG8_MMA(1, 1, At, B1); PG8_BAR; PG8_SCHED;
            PG8_LDB(B0, 1, 0); PG8_LDB(B1, 1, 1); PG8_SCHED; PG8_LDA(At, 1, 0); PG8_STAGE(PG8_SA(0, 1), a2, voffA[1]);
            PG8_WAIT_V(8); PG8_WAIT_L(0); PG8_BAR; PG8_MMA(0, 0, At, B0); PG8_MMA(0, 1, At, B1); PG8_BAR; PG8_SCHED;
            PG8_LDA(At, 1, 1); PG8_STAGE(PG8_SB(1, 0), b3, voffB); PG8_STAGE(PG8_SB(1, 1), b3 + hB, voffB); PG8_STAGE(PG8_SA(1, 0), a3, voffA[0]);
            PG8_WAIT_V(8); PG8_WAIT_L(0); PG8_BAR; PG8_MMA(1, 0, At, B0); PG8_MMA(1, 1, At, B1); PG8_BAR; PG8_SCHED;
        }
        if constexpr (ALIGN_EPI) { if (wr == 0) PG8_BAR; }
        E(acc, cur, wr, wc, fr, fq);
        if (!has_next) break;
#pragma unroll
        for (int a = 0; a < 2; ++a)
#pragma unroll
            for (int b = 0; b < 2; ++b)
#pragma unroll
                for (int m = 0; m < 4; ++m)
#pragma unroll
                    for (int n = 0; n < 2; ++n) acc[a][b][m][n] = (f32x4){0.f, 0.f, 0.f, 0.f};
        cur = nxt; ++ui;
        if constexpr (ALIGN_EPI) { if (wr == 1) PG8_BAR; }
    }
    PG8_WAIT_V(0);
    if constexpr (!ALIGN_EPI) { if (wr == 0) PG8_BAR; }
    PG8_BAR;
#undef PG8_SA
#undef PG8_SB
#undef PG8_STAGE
#undef PG8_LDA
#undef PG8_LDB
#undef PG8_MMA
#undef PG8_WAIT_V
#undef PG8_WAIT_L
#undef PG8_BAR
#undef PG8_SCHED
#undef PG8_AK
#undef PG8_BK
}
}
struct DenseSched {
    const bf16_t* A; const bf16_t* Bt; int K, nM, nN;
    DI bool next(int i, GUnit& u) const {
        const int nwg = nM * nN; const long L = (long)i * (int)gridDim.x + (int)blockIdx.x; if (L >= nwg) return false;
        int wgid = (int)L; { const int q = nwg / 8, r = nwg % 8, xcd = wgid % 8, off = wgid / 8; wgid = (xcd < r ? xcd * (q + 1) : r * (q + 1) + (xcd - r) * q) + off; }
        const int nig = 8 * nN, gid = wgid / nig, fm = gid * 8, gsz = (nM - fm) < 8 ? (nM - fm) : 8;
        u.pm = fm + ((wgid % nig) % gsz); u.pn = (wgid % nig) / gsz;
        u.A = A + (size_t)u.pm * 256 * K; u.aidx = nullptr; u.nvalid = 256; u.B0 = Bt + (size_t)u.pn * 256 * K; u.B1 = u.B0; u.lbase = 0; return true; }
};
template <int NT, bool up> struct MoeSched {
    const LAS int* tstart; const unsigned* cnt; const int* list; const bf16_t* A; const bf16_t* W;
    DI bool next(int i, GUnit& u) const {
        const int ntile = __builtin_amdgcn_readfirstlane(tstart[NBUCKET]), nwg = ntile * NT; const int L0 = i * (int)gridDim.x + (int)blockIdx.x; if (L0 >= nwg) return false;
        int L = L0; { const int q = nwg / 8, r = nwg % 8, xcd = L0 % 8, off = L0 / 8; L = (xcd < r ? xcd * (q + 1) : r * (q + 1) + (xcd - r) * q) + off; }
        const int ti = L / NT, pn = L % NT; int b = 0;
        for (int q = 1; q < NBUCKET; ++q) if (__builtin_amdgcn_readfirstlane(tstart[q]) <= ti) b = q;
        const int rt = ti - __builtin_amdgcn_readfirstlane(tstart[b]); const int g = b / 6, p = b % 6; const int ea = 4 * g + (p < 3 ? 0 : (p < 5 ? 1 : 2)), eb = 4 * g + (p < 3 ? p + 1 : (p < 5 ? p - 1 : 3));
        u.pm = ti; u.pn = pn; u.lbase = b * T + rt * 256; const int nv = __builtin_amdgcn_readfirstlane((int)cnt[b]) - rt * 256; u.nvalid = nv < 256 ? nv : 256;
        if (up) { u.A = A; u.aidx = list + u.lbase; const int e = pn < 4 ? ea : eb; u.B0 = W + (size_t)e * 1024 * 1024 + (size_t)(pn & 3) * 256 * 1024; u.B1 = u.B0; }
        else { u.A = A + (size_t)ti * 256 * 1024; u.aidx = nullptr; u.B0 = W + (size_t)ea * 1024 * 512 + (size_t)pn * 256 * 512; u.B1 = W + (size_t)eb * 1024 * 512 + (size_t)pn * 256 * 512; }
        return true;
    }
};

DI u32x4 pack8(const f32x4 v0, const f32x4 v1) { u32x4 w; w.x = pk2(v0[0], v0[1]); w.y = pk2(v0[2], v0[3]); w.z = pk2(v1[0], v1[1]); w.w = pk2(v1[2], v1[3]); return w; }
struct EpiProj {
    bf16_t *qsb, *vtsb, *qsw, *ksw, *vtsw; const float *cosT, *sinT;
    DI void operator()(const f32x4 (&acc)[2][2][4][2], const GUnit& u, int wr, int wc, int fr, int fq) const {
        const int pn = u.pn, rowb = u.pm * 256 + wr * 64 + fr;
        if (pn < 4) {
            bf16_t* base = qsb + (size_t)(pn >> 1) * ((WS_KSB - WS_QSB) / 2); const float sc = pn < 2 ? QSCALE : 1.0f; const int colt = (pn & 1) * 256 + wc * 32 + 8 * fq;
#pragma unroll
            for (int ai = 0; ai < 2; ++ai)
#pragma unroll
                for (int m = 0; m < 4; ++m) { const size_t row = rowb + ai * 128 + m * 16;
#pragma unroll
                    for (int bj = 0; bj < 2; ++bj) *(u32x4*)(base + row * 512 + colt + bj * 128) = pack8(acc[ai][bj][m][0] * sc, acc[ai][bj][m][1] * sc); }
        } else if (pn < 6 || (pn == 8 && wc >= 2)) {
            bf16_t* base = pn < 6 ? vtsb + (size_t)((pn - 4) * 256 + wc * 32 + 8 * fq) * T : vtsw + (size_t)((wc * 32 - 64) + 8 * fq) * T; const size_t bjs = pn < 6 ? (size_t)128 * T : (size_t)64 * T;
#pragma unroll
            for (int ai = 0; ai < 2; ++ai)
#pragma unroll
                for (int m = 0; m < 4; ++m) { const size_t row = rowb + ai * 128 + m * 16;
#pragma unroll
                    for (int bj = 0; bj < 2; ++bj)
#pragma unroll
                        for (int n = 0; n < 2; ++n)
#pragma unroll
                            for (int j = 0; j < 4; ++j) base[bj * bjs + (size_t)(4 * n + j) * T + row] = (bf16_t)f2bf(acc[ai][bj][m][n][j]); }
        } else {
            const bool isq = pn < 8; bf16_t* base = isq ? qsw : ksw; const int pitch = isq ? 512 : 128; const int head = isq ? (pn - 6) * 4 + wc : wc; const float sc = isq ? QSCALE : 1.0f;
#pragma unroll
            for (int ai = 0; ai < 2; ++ai)
#pragma unroll
                for (int m = 0; m < 4; ++m) { const size_t row = rowb + ai * 128 + m * 16;
                    const f32x4 c0 = *(const f32x4*)(cosT + row * 32 + 8 * fq), c1 = *(const f32x4*)(cosT + row * 32 + 8 * fq + 4);
                    const f32x4 s0 = *(const f32x4*)(sinT + row * 32 + 8 * fq), s1 = *(const f32x4*)(sinT + row * 32 + 8 * fq + 4);
                    const f32x4 x10 = acc[ai][0][m][0], x11 = acc[ai][0][m][1], x20 = acc[ai][1][m][0], x21 = acc[ai][1][m][1];
                    const f32x4 o10 = (x10 * c0 - x20 * s0) * sc, o11 = (x11 * c1 - x21 * s1) * sc, o20 = (x20 * c0 + x10 * s0) * sc, o21 = (x21 * c1 + x11 * s1) * sc;
                    *(u32x4*)(base + row * pitch + head * 64 + 8 * fq) = pack8(o10, o11); *(u32x4*)(base + row * pitch + head * 64 + 32 + 8 * fq) = pack8(o20, o21); }
        }
    }
};
struct EpiWout {
    const float* x; const float* mod; float* out;
    DI void operator()(const f32x4 (&acc)[2][2][4][2], const GUnit& u, int wr, int wc, int fr, int fq) const {
        const int rowb = u.pm * 256 + wr * 64 + fr, colb = u.pn * 256 + wc * 32 + 8 * fq; const int b = (u.pm * 256) / SEQ;
        f32x4 gt[2][2];
#pragma unroll
        for (int bj = 0; bj < 2; ++bj)
#pragma unroll
            for (int n = 0; n < 2; ++n) gt[bj][n] = *(const f32x4*)(mod + b * 6144 + 2048 + colb + bj * 128 + 4 * n);
#pragma unroll
        for (int ai = 0; ai < 2; ++ai)
#pragma unroll
            for (int m = 0; m < 4; ++m) { const size_t off = (size_t)(rowb + ai * 128 + m * 16) * DM + colb;
#pragma unroll
                for (int bj = 0; bj < 2; ++bj)
#pragma unroll
                    for (int n = 0; n < 2; ++n) { const f32x4 xv = *(const f32x4*)(x + off + bj * 128 + 4 * n); *(f32x4*)(out + off + bj * 128 + 4 * n) = xv + gt[bj][n] * acc[ai][bj][m][n]; } }
    }
};
DI f32x4 swiglu4(const f32x4 g, const f32x4 uu, float w) { f32x4 o;
#pragma unroll
    for (int j = 0; j < 4; ++j) o[j] = w * uu[j] * g[j] / (1.0f + __expf(-g[j]));
    return o; }
struct EpiUp {
    bf16_t* hid; const f32x2* wts;
    DI void operator()(const f32x4 (&acc)[2][2][4][2], const GUnit& u, int wr, int wc, int fr, int fq) const {
        const int hc = (u.pn >> 2) * 512 + (u.pn & 3) * 128 + wc * 32 + 8 * fq; const bool second = u.pn >= 4;
#pragma unroll
        for (int ai = 0; ai < 2; ++ai)
#pragma unroll
            for (int m = 0; m < 4; ++m) { const int r = ai * 128 + wr * 64 + m * 16 + fr; float w = 0.f;
                if (r < u.nvalid) { const f32x2 ww = wts[u.lbase + r]; w = second ? ww.y : ww.x; }
                *(u32x4*)(hid + (size_t)(u.pm * 256 + r) * 1024 + hc) = pack8(swiglu4(acc[ai][0][m][0], acc[ai][1][m][0], w), swiglu4(acc[ai][0][m][1], acc[ai][1][m][1], w)); }
    }
};
struct EpiDown {
    const int* list; const float* mod; float* out;
    DI void operator()(const f32x4 (&acc)[2][2][4][2], const GUnit& u, int wr, int wc, int fr, int fq) const {
        const int colb = u.pn * 256 + wc * 32 + 8 * fq; const int* lp = list + u.lbase;
#pragma unroll
        for (int ai = 0; ai < 2; ++ai)
#pragma unroll
            for (int m = 0; m < 4; ++m) { const int r = ai * 128 + wr * 64 + m * 16 + fr;
                if (r < u.nvalid) { const int tok = lp[r]; const float* gp = mod + (tok / SEQ) * 6144 + 5120 + colb; float* op = out + (size_t)tok * DM + colb;
#pragma unroll
                    for (int bj = 0; bj < 2; ++bj) { const f32x4 g0 = *(const f32x4*)(gp + bj * 128), g1 = *(const f32x4*)(gp + bj * 128 + 4); const f32x4 x0 = *(const f32x4*)(op + bj * 128), x1 = *(const f32x4*)(op + bj * 128 + 4);
                        *(f32x4*)(op + bj * 128) = x0 + g0 * acc[ai][bj][m][0]; *(f32x4*)(op + bj * 128 + 4) = x1 + g1 * acc[ai][bj][m][1]; } }
                asm volatile("" ::: "memory"); }
    }
};

typedef float f32x16 __attribute__((ext_vector_type(16)));
#define MFMA32(a, b, c) __builtin_amdgcn_mfma_f32_32x32x16_bf16((a), (b), (c), 0, 0, 0)
DI int pi32(int r) { return (r & ~12) | ((r & 4) << 1) | ((r & 8) >> 1); }
DI int crow(int i, int h) { return (i & 3) + 8 * (i >> 2) + 4 * h; }
template <int S_> DI bf16x8 packacc(const f32x16& x) { u32x4 p; p.x = pk2(x[8 * S_], x[8 * S_ + 1]); p.y = pk2(x[8 * S_ + 2], x[8 * S_ + 3]); p.z = pk2(x[8 * S_ + 4], x[8 * S_ + 5]); p.w = pk2(x[8 * S_ + 6], x[8 * S_ + 7]); return __builtin_bit_cast(bf16x8, p); }
DI f32x16 zero16() { f32x16 z;
#pragma unroll
    for (int i = 0; i < 16; ++i) z[i] = 0.f;
    return z; }
DI void sb_unit(const bf16_t* Q, const bf16_t* K, const bf16_t* VT, int b, int t0, int hd, int lane, f32x16 (&o)[2]) {
    const int r = lane & 31, h = lane >> 5; const size_t gb = (size_t)b * SEQ;
    bf16x8 qf[4];
#pragma unroll
    for (int d0 = 0; d0 < 4; ++d0) qf[d0] = *(const bf16x8*)(Q + (gb + t0 + r) * 512 + hd * 64 + 16 * d0 + 8 * h);
    bf16x8 U0, U1, ones; const int kr = pi32(r);
#pragma unroll
    for (int j = 0; j < 8; ++j) { U0[j] = (8 * h + j > kr) ? (short)0x3F80 : (short)0; U1[j] = (16 + 8 * h + j > kr) ? (short)0x3F80 : (short)0; ones[j] = (short)0x3F80; }
    o[0] = zero16(); o[1] = zero16(); f32x16 C = zero16();
    const bf16_t* kp = K + (gb + pi32(r)) * 512 + hd * 64 + 8 * h;
    const bf16_t* vp = VT + (size_t)(hd * 64 + r) * T + gb + 8 * h;
    const int jd = t0 >> 5;
    for (int j = jd; j >= 0; --j) {
        bf16x8 kf[4], vf[2][2];
#pragma unroll
        for (int d0 = 0; d0 < 4; ++d0) kf[d0] = *(const bf16x8*)(kp + (size_t)j * 32 * 512 + 16 * d0);
#pragma unroll
        for (int dt = 0; dt < 2; ++dt)
#pragma unroll
            for (int sx = 0; sx < 2; ++sx) vf[dt][sx] = *(const bf16x8*)(vp + (size_t)dt * 32 * T + 32 * j + 16 * sx);
        f32x16 S = zero16();
#pragma unroll
        for (int d0 = 0; d0 < 4; ++d0) S = MFMA32(kf[d0], qf[d0], S);
        const bool diag = (j == jd);
        f32x16 L, lb;
#pragma unroll
        for (int i = 0; i < 16; ++i) { const float z = S[i]; const float e = __builtin_amdgcn_exp2f(-__builtin_fabsf(z)); const float l = __builtin_amdgcn_logf(1.0f + e);
            float Li = __builtin_fminf(-z, 0.f) - l; lb[i] = z + Li;
            if (diag && !(16 * (i >> 3) + 8 * h + (i & 7) < r)) Li = 0.f;
            L[i] = Li; }
        const bf16x8 Lf0 = packacc<0>(L), Lf1 = packacc<1>(L);
        f32x16 W = MFMA32(U0, Lf0, C); W = MFMA32(U1, Lf1, W);
        C = MFMA32(ones, Lf0, C); C = MFMA32(ones, Lf1, C);
        f32x16 P;
#pragma unroll
        for (int i = 0; i < 16; ++i) { float pv = __builtin_amdgcn_exp2f(lb[i] + W[i]); if (diag && !(16 * (i >> 3) + 8 * h + (i & 7) < r)) pv = 0.f; P[i] = pv; }
        const bf16x8 Pf0 = packacc<0>(P), Pf1 = packacc<1>(P);
#pragma unroll
        for (int dt = 0; dt < 2; ++dt) { o[dt] = MFMA32(Pf0, vf[dt][0], o[dt]); o[dt] = MFMA32(Pf1, vf[dt][1], o[dt]); }
        if (__all(C[0] < SB_EXIT)) break;
    }
}
DI void sw_unit(const bf16_t* Q, const bf16_t* K, const bf16_t* VT, float sink2, int b, int t0, int hq, int lane, f32x16 (&o)[2], float& lsum) {
    const int r = lane & 31, h = lane >> 5, kvh = hq >> 2, a = t0 >> 5; const size_t gb = (size_t)b * SEQ;
    bf16x8 qf[4];
#pragma unroll
    for (int d0 = 0; d0 < 4; ++d0) qf[d0] = *(const bf16x8*)(Q + (gb + t0 + r) * 512 + hq * 64 + 16 * d0 + 8 * h);
    const bf16_t* kp = K + (gb + pi32(r)) * 128 + kvh * 64 + 8 * h;
    const bf16_t* vp = VT + (size_t)(kvh * 64 + r) * T + gb + 8 * h;
    f32x16 S[5]; float m = sink2;
#pragma unroll
    for (int jj = 0; jj < 5; ++jj) { const int j = a - 4 + jj;
        if (j >= 0) { bf16x8 kf[4];
#pragma unroll
            for (int d0 = 0; d0 < 4; ++d0) kf[d0] = *(const bf16x8*)(kp + (size_t)j * 32 * 128 + 16 * d0);
            f32x16 s = zero16();
#pragma unroll
            for (int d0 = 0; d0 < 4; ++d0) s = MFMA32(kf[d0], qf[d0], s);
#pragma unroll
            for (int i = 0; i < 16; ++i) { const int ko = 16 * (i >> 3) + 8 * h + (i & 7); float v = s[i];
                if (jj == 4 && ko > r) v = -1e30f;
                if (jj == 0 && ko <= r) v = -1e30f;
                s[i] = v; m = __builtin_fmaxf(m, v); }
            S[jj] = s; }
        else {
#pragma unroll
            for (int i = 0; i < 16; ++i) S[jj][i] = -1e30f; } }
    m = __builtin_fmaxf(m, __shfl_xor(m, 32));
    o[0] = zero16(); o[1] = zero16(); float ls = 0.f;
#pragma unroll
    for (int jj = 0; jj < 5; ++jj) { const int j = a - 4 + jj;
        if (j >= 0) { bf16x8 vf[2][2];
#pragma unroll
            for (int dt = 0; dt < 2; ++dt)
#pragma unroll
                for (int sx = 0; sx < 2; ++sx) vf[dt][sx] = *(const bf16x8*)(vp + (size_t)dt * 32 * T + 32 * j + 16 * sx);
            f32x16 P;
#pragma unroll
            for (int i = 0; i < 16; ++i) { P[i] = __builtin_amdgcn_exp2f(S[jj][i] - m); ls += P[i]; }
            const bf16x8 Pf0 = packacc<0>(P), Pf1 = packacc<1>(P);
#pragma unroll
            for (int dt = 0; dt < 2; ++dt) { o[dt] = MFMA32(Pf0, vf[dt][0], o[dt]); o[dt] = MFMA32(Pf1, vf[dt][1], o[dt]); } } }
    ls += __shfl_xor(ls, 32);
    lsum = ls + __builtin_amdgcn_exp2f(sink2 - m);
}
constexpr int ATT_STG = 33 * 68;
constexpr int ATT_EX = NWAVES * ATT_STG * 4;
constexpr int NATT_TASKS = T / 32;
DI void p3_attention(const Args& a, LAS unsigned char* lds, int tid, int lane, int wave) {
    const bf16_t* QSB = (const bf16_t*)(a.ws + WS_QSB); const bf16_t* KSB = (const bf16_t*)(a.ws + WS_KSB); const bf16_t* VTSB = (const bf16_t*)(a.ws + WS_VSB);
    const bf16_t* QSW = (const bf16_t*)(a.ws + WS_QSW); const bf16_t* KSW = (const bf16_t*)(a.ws + WS_KSW); const bf16_t* VTSW = (const bf16_t*)(a.ws + WS_VSW);
    bf16_t* MIX = (bf16_t*)(a.ws + WS_MIX); unsigned* qctr = (unsigned*)(a.ws + WS_CTL) + CW_ATTNQ;
    LAS float* stg = (LAS float*)lds + wave * ATT_STG; LAS float* ex = (LAS float*)(lds + ATT_EX); LAS int* slot = (LAS int*)(lds + ATT_EX + 4096);
    const int r = lane & 31, h = lane >> 5, row = lane >> 1, hf = lane & 1;
    const float sink2 = a.sinks[wave] * LOG2E;
    int par = 0;
    for (;;) {
        __syncthreads();
        if (tid == 0) *slot = (int)atomicAdd(qctr, 1u);
        __syncthreads();
        const int task = __builtin_amdgcn_readfirstlane(*slot); if (task >= NATT_TASKS) break;
        const int b = task / (SEQ / 32), t0 = (task % (SEQ / 32)) * 32;
        f32x16 o[2]; float sbv[32], swv[32];
        sb_unit(QSB, KSB, VTSB, b, t0, wave, lane, o);
#pragma unroll
        for (int dt = 0; dt < 2; ++dt)
#pragma unroll
            for (int i = 0; i < 16; ++i) stg[crow(i, h) * 68 + 32 * dt + r] = o[dt][i];
        LDS_WAIT();
        float ss = 0.f;
#pragma unroll
        for (int k = 0; k < 8; ++k) { const f32x4 v = *(const LAS f32x4*)(stg + row * 68 + hf * 32 + 4 * k); sbv[4 * k] = v.x; sbv[4 * k + 1] = v.y; sbv[4 * k + 2] = v.z; sbv[4 * k + 3] = v.w; ss += (v.x * v.x + v.y * v.y) + (v.z * v.z + v.w * v.w); }
        ss += __shfl_xor(ss, 1);
        if (hf == 0) ex[par * 512 + row * 8 + wave] = ss;
        LDS_WAIT();
        float lsum;
        sw_unit(QSW, KSW, VTSW, sink2, b, t0, wave, lane, o, lsum);
#pragma unroll
        for (int dt = 0; dt < 2; ++dt)
#pragma unroll
            for (int i = 0; i < 16; ++i) stg[crow(i, h) * 68 + 32 * dt + r] = o[dt][i];
        if (h == 0) stg[32 * 68 + r] = lsum;
        LDS_WAIT();
        const float il = 1.0f / stg[32 * 68 + row]; float s2 = 0.f;
#pragma unroll
        for (int k = 0; k < 8; ++k) { const f32x4 v = *(const LAS f32x4*)(stg + row * 68 + hf * 32 + 4 * k) * il; swv[4 * k] = v.x; swv[4 * k + 1] = v.y; swv[4 * k + 2] = v.z; swv[4 * k + 3] = v.w; s2 += (v.x * v.x + v.y * v.y) + (v.z * v.z + v.w * v.w); }
        s2 += __shfl_xor(s2, 1);
        if (hf == 0) ex[par * 512 + 256 + row * 8 + wave] = s2;
        LDS_WAIT();
        __syncthreads();
        float tsb = 0.f, tsw = 0.f;
#pragma unroll
        for (int w = 0; w < 8; ++w) { tsb += ex[par * 512 + row * 8 + w]; tsw += ex[par * 512 + 256 + row * 8 + w]; }
        const float rsb = 1.0f / sqrtf(tsb * (1.0f / 512.0f) + EPS), rsw = 1.0f / sqrtf(tsw * (1.0f / 512.0f) + EPS);
        bf16_t* mrow = MIX + ((size_t)b * SEQ + t0 + row) * 1024 + wave * 64 + hf * 32;
#pragma unroll
        for (int k = 0; k < 4; ++k) { u32x4 w; w.x = pk2(sbv[8 * k] * rsb, sbv[8 * k + 1] * rsb); w.y = pk2(sbv[8 * k + 2] * rsb, sbv[8 * k + 3] * rsb); w.z = pk2(sbv[8 * k + 4] * rsb, sbv[8 * k + 5] * rsb); w.w = pk2(sbv[8 * k + 6] * rsb, sbv[8 * k + 7] * rsb); *(u32x4*)(mrow + 8 * k) = w; }
#pragma unroll
        for (int k = 0; k < 4; ++k) { u32x4 w; w.x = pk2(swv[8 * k] * rsw, swv[8 * k + 1] * rsw); w.y = pk2(swv[8 * k + 2] * rsw, swv[8 * k + 3] * rsw); w.z = pk2(swv[8 * k + 4] * rsw, swv[8 * k + 5] * rsw); w.w = pk2(swv[8 * k + 6] * rsw, swv[8 * k + 7] * rsw); *(u32x4*)(mrow + 512 + 8 * k) = w; }
        par ^= 1;
    }
}

__global__ void __launch_bounds__(NTHREADS, 2) mk_fwd(Args a) {
    extern __shared__ __attribute__((aligned(16))) unsigned char lds_raw[];
    LAS unsigned char* lds = (LAS unsigned char*)lds_raw;
    cg::grid_group grid = cg::this_grid();
    const int tid = threadIdx.x, lane = tid & 63, wave = __builtin_amdgcn_readfirstlane(tid >> 6);
    unsigned char* ws = a.ws;
    const float* mod = (const float*)(ws + WS_MOD);

    p0_prologue(a, lds, tid, lane, wave);
    grid.sync();
    p1_norm(a, lane, wave);
    grid.sync();
    {
        DenseSched S{(const bf16_t*)(ws + WS_H), (const bf16_t*)(ws + WS_WIN), 1024, T / 256, DIN / 256};
        EpiProj E{(bf16_t*)(ws + WS_QSB), (bf16_t*)(ws + WS_VSB), (bf16_t*)(ws + WS_QSW), (bf16_t*)(ws + WS_KSW), (bf16_t*)(ws + WS_VSW), (const float*)(ws + WS_COS), (const float*)(ws + WS_SIN)};
        pg8::gemm_phase<DenseSched, EpiProj, true, 1024, 1024, 16>(lds, S, E);
    }
    grid.sync();
    p3_attention(a, lds, tid, lane, wave);
    grid.sync();
    {
        DenseSched S{(const bf16_t*)(ws + WS_MIX), (const bf16_t*)(ws + WS_WOUT), 1024, T / 256, DM / 256};
        EpiWout E{a.x, mod, a.out};
        pg8::gemm_phase<DenseSched, EpiWout, true, 1024, 1024, 16>(lds, S, E);
    }
    grid.sync();
    p5_router(a, lane, wave);
    grid.sync();
    LAS int* tstart = (LAS int*)(lds + pg8::STAGE_BYTES);
    const unsigned* cnt = (const unsigned*)(ws + WS_CTL) + CW_CNT;
    if (tid == 0) { int run = 0; for (int b = 0; b < NBUCKET; ++b) { tstart[b] = run; run += ((int)cnt[b] + 255) >> 8; } tstart[NBUCKET] = run; }
    __syncthreads();
    {
        MoeSched<8, true> S{tstart, cnt, (const int*)(ws + WS_LIST), (const bf16_t*)(ws + WS_H), (const bf16_t*)(ws + WS_WGU)};
        EpiUp E{(bf16_t*)(ws + WS_HID), (const f32x2*)(ws + WS_WTS)};
        pg8::gemm_phase<MoeSched<8, true>, EpiUp, true, 1024, 1024, 16>(lds, S, E);
    }
    grid.sync();
    {
        MoeSched<4, false> S{tstart, cnt, (const int*)(ws + WS_LIST), (const bf16_t*)(ws + WS_HID), (const bf16_t*)(ws + WS_WD)};
        EpiDown E{(const int*)(ws + WS_LIST), mod, a.out};
        pg8::gemm_phase<MoeSched<4, false>, EpiDown, true, 1024, 512, 8>(lds, S, E);
    }
    grid.sync();
    p8_final(a, lane, wave);
}

extern "C" void kernel_launch(void* const* d_in, const int* in_sizes, int n_in, void* d_out, int out_size, void* d_ws, size_t ws_size, hipStream_t stream) {
    static int grid = 0;
    if (grid == 0) {
        if (n_in != 18 || in_sizes[0] != T * DM || out_size != T * DM || ws_size < WS_END) { fprintf(stderr, "kernel_launch: unexpected shapes (n_in %d, in0 %d, out %d, ws %zu); nothing launched\n", n_in, n_in > 0 ? in_sizes[0] : -1, out_size, ws_size); grid = -1; return; }
        int dev = 0, cus = 0, per_cu = 0;
        (void)hipGetDevice(&dev); (void)hipDeviceGetAttribute(&cus, hipDeviceAttributeMultiprocessorCount, dev);
        (void)hipFuncSetAttribute((const void*)mk_fwd, hipFuncAttributeMaxDynamicSharedMemorySize, LDS_BYTES);
        (void)hipOccupancyMaxActiveBlocksPerMultiprocessor(&per_cu, (const void*)mk_fwd, NTHREADS, LDS_BYTES);
        if (per_cu < 1) { fprintf(stderr, "kernel_launch: occupancy query says %d blocks per CU\n", per_cu); per_cu = 1; }
        grid = cus * per_cu;
        fprintf(stderr, "kernel_launch: %d CUs x %d = grid %d\n", cus, per_cu, grid);
    }
    if (grid < 0) return;
    (void)hipMemsetAsync((char*)d_ws + WS_CTL, 0, CTL_BYTES, stream);
    Args a{};
    a.x = (const float*)d_in[0]; a.c = (const float*)d_in[1]; a.pos = (const int*)d_in[2]; a.w_ada = (const float*)d_in[3]; a.b_ada = (const float*)d_in[4]; a.g_mix = (const float*)d_in[5];
    a.w_in = (const float*)d_in[6]; a.sinks = (const float*)d_in[7]; a.g_sb = (const float*)d_in[8]; a.g_sw = (const float*)d_in[9]; a.w_out = (const float*)d_in[10]; a.g_ffn = (const float*)d_in[11];
    a.w_rg = (const float*)d_in[12]; a.w_re = (const float*)d_in[13]; a.w_gate = (const float*)d_in[14]; a.w_up = (const float*)d_in[15]; a.w_down = (const float*)d_in[16]; a.g_fin = (const float*)d_in[17];
    a.out = (float*)d_out; a.ws = (unsigned char*)d_ws;
    void* args[] = {&a};
    hipError_t e = hipLaunchCooperativeKernel((const void*)mk_fwd, dim3(grid), dim3(NTHREADS), args, LDS_BYTES, stream);
    if (e != hipSuccess) fprintf(stderr, "kernel_launch: cooperative launch failed: %s (grid %d)\n", hipGetErrorString(e), grid);
}
```

```cpp
#include <hip/hip_runtime.h>
#include <hip/hip_cooperative_groups.h>
#include <cstdio>
#include <cstdint>
#include <cmath>
namespace cg = cooperative_groups;

#define LAS __attribute__((address_space(3)))
#define DI __device__ __forceinline__
typedef unsigned short bf16_t;
typedef short bf16x8 __attribute__((ext_vector_type(8)));
typedef float f32x4 __attribute__((ext_vector_type(4)));
typedef float f32x2 __attribute__((ext_vector_type(2)));
typedef unsigned u32x4 __attribute__((ext_vector_type(4)));
typedef unsigned u32x2 __attribute__((ext_vector_type(2)));
typedef __bf16 bf16x2_t __attribute__((ext_vector_type(2)));

constexpr int NB = 4, SEQ = 8192, DM = 1024, T = NB * SEQ;
constexpr int DIN = 2304, DSB = 512, DSW = 512, DKV = 128;
constexpr int NEXP = 16, DEXP = 512, NBUCKET = 24, WINDOW = 128;
constexpr int MAXTILES = T / 256 + NBUCKET, TPAD = MAXTILES * 256;
constexpr float EPS = 1e-6f, LOG2E = 1.4426950408889634f, QSCALE = 0.125f * LOG2E;
constexpr float SB_EXIT = -150.0f;
constexpr int NTHREADS = 512, NWAVES = 8;

constexpr size_t MiB = 1u << 20;
constexpr size_t WS_CTL = 0, CTL_BYTES = 1 * MiB;
constexpr size_t WS_MOD = 1 * MiB;
constexpr size_t WS_COS = 2 * MiB, WS_SIN = 6 * MiB;
constexpr size_t WS_WIN = 10 * MiB;
constexpr size_t WS_WOUT = 15 * MiB;
constexpr size_t WS_WGU = 17 * MiB;
constexpr size_t WS_WD = 49 * MiB;
constexpr size_t WS_LIST = 65 * MiB;
constexpr size_t WS_WTS = 68 * MiB;
constexpr size_t WS_H = 80 * MiB;
constexpr size_t WS_QSB = 144 * MiB, WS_KSB = 176 * MiB, WS_VSB = 208 * MiB, WS_QSW = 240 * MiB;
constexpr size_t WS_KSW = 272 * MiB, WS_VSW = 280 * MiB;
constexpr size_t WS_MIX = 288 * MiB;
constexpr size_t WS_HID = 352 * MiB;
constexpr size_t WS_END = 428 * MiB;
static_assert(WS_KSB - WS_QSB == WS_VSB - WS_KSB, "q/k/v_sb buffers equally spaced");
static_assert(WS_HID + (size_t)TPAD * 1024 * 2 <= WS_END, "ws map");
constexpr int CW_CNT = 64, CW_ATTNQ = 128, CW_BAR = 4096;
constexpr int LDS_MISC = 143360;

constexpr int LDS_BYTES = 147456;

struct Args {
    const float* x; const float* c; const int* pos; const float* w_ada; const float* b_ada; const float* g_mix; const float* w_in; const float* sinks;
    const float* g_sb; const float* g_sw; const float* w_out; const float* g_ffn; const float* w_rg; const float* w_re; const float* w_gate; const float* w_up;
    const float* w_down; const float* g_fin; float* out; unsigned char* ws;
};

__constant__ float INV_FREQ[32] = {1.000000000e+00f, 7.498942018e-01f, 5.623413324e-01f, 4.216965139e-01f, 3.162277639e-01f, 2.371373773e-01f, 1.778279394e-01f, 1.333521456e-01f, 1.000000015e-01f, 7.498942316e-02f, 5.623413250e-02f, 4.216964915e-02f, 3.162277490e-02f, 2.371373773e-02f, 1.778279431e-02f, 1.333521400e-02f, 9.999999776e-03f, 7.498942316e-03f, 5.623413250e-03f, 4.216964822e-03f, 3.162277630e-03f, 2.371373819e-03f, 1.778279431e-03f, 1.333521446e-03f, 1.000000047e-03f, 7.498941850e-04f, 5.623413017e-04f, 4.216965172e-04f, 3.162277571e-04f, 2.371373703e-04f, 1.778279402e-04f, 1.333521504e-04f};

DI unsigned f2bf(float f) { unsigned u = __builtin_bit_cast(unsigned, f); return (u + 0x7fffu + ((u >> 16) & 1u)) >> 16; }
DI unsigned pk2(float lo, float hi) { f32x2 v = {lo, hi}; bf16x2_t b = __builtin_convertvector(v, bf16x2_t); return __builtin_bit_cast(unsigned, b); }
DI float bf2f(unsigned short b) { return __builtin_bit_cast(float, (unsigned)b << 16); }
DI float bflo(unsigned w) { return __builtin_bit_cast(float, w << 16); }
DI float bfhi(unsigned w) { return __builtin_bit_cast(float, w & 0xffff0000u); }
DI float wave_sum(float v) {
#pragma unroll
    for (int o = 1; o < 64; o <<= 1) v += __shfl_xor(v, o);
    return v;
}
#define LDS_WAIT() asm volatile("s_waitcnt lgkmcnt(0)" ::: "memory")

DI void tr_item(const float* W, int N, int k0, int n0, bf16_t* WT, int drow0, int Kd, const float* kscale, LAS float* scr, int lane) {
#pragma unroll 8
    for (int i = 0; i < 32; ++i) { const int kk = 2 * i + (lane >> 5); float v = W[(size_t)(k0 + kk) * N + n0 + (lane & 31)]; if (kscale) v *= kscale[k0 + kk]; scr[kk * 33 + (lane & 31)] = v; }
    LDS_WAIT();
    const int c = lane & 7;
#pragma unroll
    for (int j = 0; j < 4; ++j) { const int n = (lane >> 3) + 8 * j; const LAS float* s = scr + (8 * c) * 33 + n;
        u32x4 o; o.x = pk2(s[0 * 33], s[1 * 33]); o.y = pk2(s[2 * 33], s[3 * 33]); o.z = pk2(s[4 * 33], s[5 * 33]); o.w = pk2(s[6 * 33], s[7 * 33]);
        *(u32x4*)(WT + (size_t)(drow0 + n) * Kd + k0 + 8 * c) = o; }
    LDS_WAIT();
}
DI int win_drow(int n0) {
    if (n0 < 1536) return n0;
    if (n0 < 2048) { const int c = n0 - 1536, head = c >> 6, half = (c >> 5) & 1; return 1536 + (head >> 2) * 256 + half * 128 + (head & 3) * 32; }
    if (n0 < 2176) { const int c = n0 - 2048, head = c >> 6, half = (c >> 5) & 1; return 2048 + half * 128 + head * 32; }
    const int c = n0 - 2176; return 2048 + (c >> 6) * 128 + 64 + (c & 63);
}
DI void p0_prologue(const Args& a, LAS unsigned char* lds, int tid, int lane, int wave) {
    unsigned char* ws = a.ws;
    {
        float* mod = (float*)(ws + WS_MOD); LAS float* red = (LAS float*)lds;
        for (int cb = blockIdx.x; cb < 6144 / 32; cb += gridDim.x) {
            const int cj = tid & 31, kg = tid >> 5, col = cb * 32 + cj;
            float acc0 = 0.f, acc1 = 0.f, acc2 = 0.f, acc3 = 0.f;
            for (int kk = 0; kk < 64; ++kk) { const int k = kg * 64 + kk; const float w = a.w_ada[(size_t)k * 6144 + col];
                float c0 = a.c[k], c1 = a.c[1024 + k], c2 = a.c[2048 + k], c3 = a.c[3072 + k];
                c0 = c0 / (1.f + expf(-c0)); c1 = c1 / (1.f + expf(-c1)); c2 = c2 / (1.f + expf(-c2)); c3 = c3 / (1.f + expf(-c3));
                acc0 += c0 * w; acc1 += c1 * w; acc2 += c2 * w; acc3 += c3 * w; }
            red[(kg * 4 + 0) * 32 + cj] = acc0; red[(kg * 4 + 1) * 32 + cj] = acc1; red[(kg * 4 + 2) * 32 + cj] = acc2; red[(kg * 4 + 3) * 32 + cj] = acc3;
            __syncthreads();
            if (tid < 128) { const int b = tid >> 5, c2 = tid & 31; float s = 0.f; for (int g = 0; g < 16; ++g) s += red[(g * 4 + b) * 32 + c2]; mod[b * 6144 + cb * 32 + c2] = s + a.b_ada[cb * 32 + c2]; }
            __syncthreads();
        }
    }
    {
        float* cosT = (float*)(ws + WS_COS); float* sinT = (float*)(ws + WS_SIN);
        for (int idx = blockIdx.x * NTHREADS + tid; idx < T * 32; idx += gridDim.x * NTHREADS) {
            const int t = idx >> 5, i = idx & 31; const float ang = (float)a.pos[t] * INV_FREQ[i];
            const double ad = (double)ang, kq = rint(ad * 0.63661977236758134308);
            double y = fma(-kq, 1.5707963267948966192, ad); y = fma(-kq, 6.123233995736766036e-17, y);
            const int q = (int)((long long)kq & 3); const double y2 = y * y;
            const double sn = y * (1.0 + y2 * (-1.0 / 6 + y2 * (1.0 / 120 + y2 * (-1.0 / 5040 + y2 * (1.0 / 362880 + y2 * (-1.0 / 39916800))))));
            const double cs = 1.0 + y2 * (-0.5 + y2 * (1.0 / 24 + y2 * (-1.0 / 720 + y2 * (1.0 / 40320 + y2 * (-1.0 / 3628800 + y2 * (1.0 / 479001600))))));
            double co, si; if (q == 0) { co = cs; si = sn; } else if (q == 1) { co = -sn; si = cs; } else if (q == 2) { co = -cs; si = -sn; } else { co = sn; si = -cs; }
            cosT[idx] = (float)co; sinT[idx] = (float)si;
        }
    }
    {
        LAS float* scr = (LAS float*)(lds + 8192 + wave * 8704);
        const int gw = blockIdx.x * NWAVES + wave, NGW = gridDim.x * NWAVES;
        constexpr int I_IN = 16 * 72, I_OUT = 16 * 32, I_G = 16 * 16 * 16, I_D = 16 * 8 * 32, NITEMS = I_IN + I_OUT + 2 * I_G + I_D;
        for (int it = gw; it < NITEMS; it += NGW) {
            int r = it;
            if (r < I_IN) { const int kb = r / 72, nb = r % 72; tr_item(a.w_in, DIN, kb * 64, nb * 32, (bf16_t*)(ws + WS_WIN), win_drow(nb * 32), 1024, nullptr, scr, lane); continue; } r -= I_IN;
            if (r < I_OUT) { const int kb = r / 32, nb = r % 32; const float* ks = (kb < 8) ? a.g_sb : (a.g_sw - 512); tr_item(a.w_out, 1024, kb * 64, nb * 32, (bf16_t*)(ws + WS_WOUT), nb * 32, 1024, ks, scr, lane); continue; } r -= I_OUT;
            if (r < 2 * I_G) { const int up = r >= I_G; if (up) r -= I_G; const int e = r / 256, q = r % 256, kb = q / 16, nb = q % 16, c0 = nb * 32;
                tr_item((up ? a.w_up : a.w_gate) + (size_t)e * 1024 * 512, 512, kb * 64, c0, (bf16_t*)(ws + WS_WGU) + (size_t)e * 1024 * 1024, (c0 >> 7) * 256 + up * 128 + (c0 & 127), 1024, nullptr, scr, lane); continue; } r -= 2 * I_G;
            { const int e = r / 256, q = r % 256, kb = q / 32, nb = q % 32; tr_item(a.w_down + (size_t)e * 512 * 1024, 1024, kb * 64, nb * 32, (bf16_t*)(ws + WS_WD) + (size_t)e * 1024 * 512, nb * 32, 512, nullptr, scr, lane); }
        }
    }
}

DI void p1_norm(const Args& a, int lane, int wave) {
    const float* mod = (const float*)(a.ws + WS_MOD); bf16_t* H = (bf16_t*)(a.ws + WS_H);
    const int gw = blockIdx.x * NWAVES + wave, NGW = gridDim.x * NWAVES;
    for (int ch = gw; ch < T / 16; ch += NGW) {
        const int row0 = ch * 16, b = row0 / SEQ;
        f32x4 ca[4], cb[4];
#pragma unroll
        for (int j = 0; j < 4; ++j) { const int col = 4 * lane + 256 * j; const f32x4 g = *(const f32x4*)(a.g_mix + col), sc = *(const f32x4*)(mod + b * 6144 + 1024 + col); ca[j] = g * (sc + 1.0f); cb[j] = *(const f32x4*)(mod + b * 6144 + col); }
        for (int r = 0; r < 16; ++r) {
            const float* xr = a.x + (size_t)(row0 + r) * DM; f32x4 v[4]; float s = 0.f;
#pragma unroll
            for (int j = 0; j < 4; ++j) { v[j] = *(const f32x4*)(xr + 4 * lane + 256 * j); s += (v[j].x * v[j].x + v[j].y * v[j].y) + (v[j].z * v[j].z + v[j].w * v[j].w); }
            const float rs = 1.0f / sqrtf(wave_sum(s) * (1.0f / DM) + EPS);
            bf16_t* hr = H + (size_t)(row0 + r) * DM;
#pragma unroll
            for (int j = 0; j < 4; ++j) { const f32x4 o = v[j] * rs * ca[j] + cb[j]; u32x2 w; w.x = pk2(o.x, o.y); w.y = pk2(o.z, o.w); *(u32x2*)(hr + 4 * lane + 256 * j) = w; }
        }
    }
}
DI void p8_final(const Args& a, int lane, int wave) {
    const int gw = blockIdx.x * NWAVES + wave, NGW = gridDim.x * NWAVES;
    f32x4 g[4];
#pragma unroll
    for (int j = 0; j < 4; ++j) g[j] = *(const f32x4*)(a.g_fin + 4 * lane + 256 * j);
    for (int row = gw; row < T; row += NGW) {
        float* xr = a.out + (size_t)row * DM; f32x4 v[4]; float s = 0.f;
#pragma unroll
        for (int j = 0; j < 4; ++j) { v[j] = *(const f32x4*)(xr + 4 * lane + 256 * j); s += (v[j].x * v[j].x + v[j].y * v[j].y) + (v[j].z * v[j].z + v[j].w * v[j].w); }
        const float rs = 1.0f / sqrtf(wave_sum(s) * (1.0f / DM) + EPS);
#pragma unroll
        for (int j = 0; j < 4; ++j) *(f32x4*)(xr + 4 * lane + 256 * j) = v[j] * rs * g[j];
    }
}
DI void p5_router(const Args& a, int lane, int wave) {
    const float* mod = (const float*)(a.ws + WS_MOD); bf16_t* H = (bf16_t*)(a.ws + WS_H);
    unsigned* cnt = (unsigned*)(a.ws + WS_CTL) + CW_CNT; int* list = (int*)(a.ws + WS_LIST); f32x2* wts = (f32x2*)(a.ws + WS_WTS);
    const int gw = blockIdx.x * NWAVES + wave, NGW = gridDim.x * NWAVES;
    for (int ch = gw; ch < T / 16; ch += NGW) {
        const int row0 = ch * 16, b = row0 / SEQ;
        f32x4 ca[4], cb[4];
#pragma unroll
        for (int j = 0; j < 4; ++j) { const int col = 4 * lane + 256 * j; const f32x4 g = *(const f32x4*)(a.g_ffn + col), sc = *(const f32x4*)(mod + b * 6144 + 4096 + col); ca[j] = g * (sc + 1.0f); cb[j] = *(const f32x4*)(mod + b * 6144 + 3072 + col); }
        for (int r = 0; r < 16; ++r) {
            const int row = row0 + r; const float* xr = a.out + (size_t)row * DM; f32x4 v[4]; float s = 0.f;
#pragma unroll
            for (int j = 0; j < 4; ++j) { v[j] = *(const f32x4*)(xr + 4 * lane + 256 * j); s += (v[j].x * v[j].x + v[j].y * v[j].y) + (v[j].z * v[j].z + v[j].w * v[j].w); }
            const float rs = 1.0f / sqrtf(wave_sum(s) * (1.0f / DM) + EPS);
            bf16_t* hr = H + (size_t)row * DM;
            float lg[20];
#pragma unroll
            for (int i = 0; i < 20; ++i) lg[i] = 0.f;
#pragma unroll
            for (int j = 0; j < 4; ++j) { const f32x4 o = v[j] * rs * ca[j] + cb[j]; u32x2 w; w.x = pk2(o.x, o.y); w.y = pk2(o.z, o.w); *(u32x2*)(hr + 4 * lane + 256 * j) = w;
#pragma unroll
                for (int e = 0; e < 4; ++e) { const int k = 4 * lane + 256 * j + e; const float hv = o[e];
                    const f32x4 wg = *(const f32x4*)(a.w_rg + k * 4);
                    lg[0] += hv * wg.x; lg[1] += hv * wg.y; lg[2] += hv * wg.z; lg[3] += hv * wg.w;
#pragma unroll
                    for (int q = 0; q < 4; ++q) { const f32x4 we = *(const f32x4*)(a.w_re + k * 16 + 4 * q); lg[4 + 4 * q] += hv * we.x; lg[5 + 4 * q] += hv * we.y; lg[6 + 4 * q] += hv * we.z; lg[7 + 4 * q] += hv * we.w; } } }
#pragma unroll
            for (int i = 0; i < 20; ++i) lg[i] = wave_sum(lg[i]);
            int g = 0; float gm = lg[0];
#pragma unroll
            for (int i = 1; i < 4; ++i) if (lg[i] > gm) { gm = lg[i]; g = i; }
            float gs = 0.f;
#pragma unroll
            for (int i = 0; i < 4; ++i) gs += expf(lg[i] - gm);
            const float gprob = 1.0f / gs;
            float el[4];
#pragma unroll
            for (int i = 0; i < 4; ++i) el[i] = g == 0 ? lg[4 + i] : g == 1 ? lg[8 + i] : g == 2 ? lg[12 + i] : lg[16 + i];
            int i0 = 0; float m0 = el[0];
#pragma unroll
            for (int i = 1; i < 4; ++i) if (el[i] > m0) { m0 = el[i]; i0 = i; }
            int i1 = -1; float m1 = 0.f;
#pragma unroll
            for (int i = 0; i < 4; ++i) if (i != i0 && (i1 < 0 || el[i] > m1)) { m1 = el[i]; i1 = i; }
            const float ex = expf(m1 - m0), w0 = 1.0f / (1.0f + ex), w1 = ex * w0;
            const int ea = i0 < i1 ? i0 : i1, eb = i0 < i1 ? i1 : i0; const float wa = (i0 < i1 ? w0 : w1) * gprob, wb = (i0 < i1 ? w1 : w0) * gprob;
            const int bucket = g * 6 + (ea * (7 - ea)) / 2 + (eb - ea - 1);
            if (lane == 0) { const unsigned p = atomicAdd(cnt + bucket, 1u); list[bucket * T + p] = row; wts[bucket * T + p] = (f32x2){wa, wb}; }
        }
    }
}

struct GUnit { const bf16_t* A; const int* aidx; int nvalid; const bf16_t* B0; const bf16_t* B1; int pm, pn, lbase; };
namespace pg8 {
constexpr int BM = 256, BK = 64, HALF = 128, HTB = HALF * BK * 2, STAGE_BYTES = 8 * HTB;
DI int lds_byte(int r, int c) { const int st = (r >> 4) * 2 + (c >> 5), rr = r & 15, cc = c & 31, ob = rr * 64 + cc * 2; return st * 1024 + (ob ^ (((ob >> 9) & 1) << 5)); }
DI void stage_rc(int b, int& R, int& C) { const int st = b / 1024, sb = b % 1024, swz = sb ^ (((sb >> 9) & 1) << 5); R = (st >> 1) * 16 + swz / 64; C = (st & 1) * 32 + (swz % 64) / 2; }
DI int perm32(int rho) { const int n = rho >> 4, i = rho & 15; return 8 * (i >> 2) + 4 * n + (i & 3); }
DI void a_offsets(const GUnit& u, int K, int tid_, unsigned (&vo)[2][2]) {
    asm volatile("" : "+v"(tid_));
#pragma unroll
    for (int i = 0; i < 2; ++i) { int R, C; stage_rc(tid_ * 16 + i * 8192, R, C);
#pragma unroll
        for (int h = 0; h < 2; ++h) { const int r = h * HALF + R; const int gr = u.aidx ? u.aidx[r < u.nvalid ? r : 0] : r; vo[h][i] = ((unsigned)gr * (unsigned)K + (unsigned)C) * 2u; } }
}
template <class Sched, class Epi, bool ALIGN_EPI, int K, int ldb, int nsplit>
DI void gemm_phase(LAS unsigned char* lds, const Sched& S, const Epi& E) {
    int tid = threadIdx.x; asm volatile("" : "+v"(tid));
    const int wid = __builtin_amdgcn_readfirstlane(tid >> 6), lane = tid & 63, wr = wid >> 2, wc = wid & 3, fr = lane & 15, fq = lane >> 4;
    const int nt = K / BK;
    unsigned voffB[2];
#pragma unroll
    for (int i = 0; i < 2; ++i) { int R, C; stage_rc(tid * 16 + i * 8192, R, C); const int Rb = (R & ~31) + perm32(R & 31); voffB[i] = ((unsigned)Rb * (unsigned)ldb + (unsigned)C) * 2u; }
    const size_t hB = (size_t)HALF * ldb * 2;
    const unsigned ldsw = (unsigned)wid * 1024u;
    const int aoff = lds_byte(wr * 64 + fr, fq * 8), boff = lds_byte(wc * 32 + fr, fq * 8);
#define PG8_SA(b, h) (((b) * 2 + (h)) * HTB)
#define PG8_SB(b, h) ((4 + (b) * 2 + (h)) * HTB)
#define PG8_STAGE(bufoff, gbase, voff) do { _Pragma("unroll") for (int _i = 0; _i < 2; ++_i) \
        __builtin_amdgcn_global_load_lds((const unsigned*)((const char*)(gbase) + (voff)[_i]), (LAS unsigned*)(lds + (bufoff) + ldsw + _i * 8192), 16, 0, 0); } while (0)
#define PG8_LDA(dst, b, h) do { _Pragma("unroll") for (int m = 0; m < 4; ++m) _Pragma("unroll") for (int k = 0; k < 2; ++k) dst[m][k] = *(const LAS bf16x8*)(lds + PG8_SA(b, h) + aoff + m * 2048 + k * 1024); } while (0)
#define PG8_LDB(dst, b, h) do { _Pragma("unroll") for (int n = 0; n < 2; ++n) _Pragma("unroll") for (int k = 0; k < 2; ++k) dst[n][k] = *(const LAS bf16x8*)(lds + PG8_SB(b, h) + boff + n * 2048 + k * 1024); } while (0)
#define PG8_MMA(ai, bj, At, Bt) do { __builtin_amdgcn_s_setprio(1); _Pragma("unroll") for (int m = 0; m < 4; ++m) _Pragma("unroll") for (int n = 0; n < 2; ++n) _Pragma("unroll") for (int k = 0; k < 2; ++k) \
        acc[ai][bj][m][n] = __builtin_amdgcn_mfma_f32_16x16x32_bf16(Bt[n][k], At[m][k], acc[ai][bj][m][n], 0, 0, 0); __builtin_amdgcn_s_setprio(0); } while (0)
#define PG8_WAIT_V(n) asm volatile("s_waitcnt vmcnt(" #n ")" ::: "memory")
#define PG8_WAIT_L(n) asm volatile("s_waitcnt lgkmcnt(" #n ")" ::: "memory")
#define PG8_BAR __builtin_amdgcn_s_barrier()
#define PG8_SCHED __builtin_amdgcn_sched_barrier(0)
#define PG8_AK(u, kt) ((const char*)(u).A + (size_t)(kt) * (BK * 2))
#define PG8_BK(u, kt) ((kt) < nsplit ? (const char*)(u).B0 + (size_t)(kt) * (BK * 2) : (const char*)(u).B1 + (size_t)((kt) - nsplit) * (BK * 2))
    GUnit cur, nxt; int ui = 0;
    if (!S.next(0, cur)) return;
    f32x4 acc[2][2][4][2];
#pragma unroll
    for (int a = 0; a < 2; ++a)
#pragma unroll
        for (int b = 0; b < 2; ++b)
#pragma unroll
            for (int m = 0; m < 4; ++m)
#pragma unroll
                for (int n = 0; n < 2; ++n) acc[a][b][m][n] = (f32x4){0.f, 0.f, 0.f, 0.f};
    bf16x8 At[4][2], B0[2][2], B1[2][2];
    unsigned voffA[2][2];
    a_offsets(cur, K, tid, voffA);
    {
        const char* a0 = PG8_AK(cur, 0); const char* b0 = PG8_BK(cur, 0); const char* a1 = PG8_AK(cur, 1); const char* b1 = PG8_BK(cur, 1);
        PG8_STAGE(PG8_SB(0, 0), b0, voffB); PG8_STAGE(PG8_SB(0, 1), b0 + hB, voffB); PG8_STAGE(PG8_SA(0, 0), a0, voffA[0]); PG8_STAGE(PG8_SA(0, 1), a0, voffA[1]);
        if (wr == 1) PG8_BAR;
        PG8_WAIT_V(2); PG8_BAR;
        PG8_STAGE(PG8_SB(1, 0), b1, voffB); PG8_STAGE(PG8_SA(1, 0), a1, voffA[0]); PG8_STAGE(PG8_SB(1, 1), b1 + hB, voffB);
        PG8_WAIT_V(6); PG8_BAR;
    }
    for (;;) {
        const bool has_next = S.next(ui + 1, nxt);
        if (!has_next) nxt = cur;
        for (int t = 0; t < nt; t += 2) {
            const bool last = (t == nt - 2);
            const char* a1 = PG8_AK(cur, t + 1);
            const char* a2 = last ? PG8_AK(nxt, 0) : PG8_AK(cur, t + 2); const char* b2 = last ? PG8_BK(nxt, 0) : PG8_BK(cur, t + 2);
            const char* a3 = last ? PG8_AK(nxt, 1) : PG8_AK(cur, t + 3); const char* b3 = last ? PG8_BK(nxt, 1) : PG8_BK(cur, t + 3);
            PG8_LDB(B0, 0, 0); PG8_LDB(B1, 0, 1); PG8_SCHED; PG8_LDA(At, 0, 0); PG8_STAGE(PG8_SA(1, 1), a1, voffA[1]);
            if (last) a_offsets(nxt, K, tid, voffA);
            PG8_WAIT_V(8); PG8_WAIT_L(0); PG8_BAR; PG8_MMA(0, 0, At, B0); PG8_MMA(0, 1, At, B1); PG8_BAR; PG8_SCHED;
            PG8_LDA(At, 0, 1); PG8_STAGE(PG8_SB(0, 0), b2, voffB); PG8_STAGE(PG8_SB(0, 1), b2 + hB, voffB); PG8_STAGE(PG8_SA(0, 0), a2, voffA[0]);
            PG8_WAIT_V(8); PG8_WAIT_L(0); PG8_BAR; PG8_MMA(1, 0, At, B0); PG8_MMA(1, 1, At, B1); PG8_BAR; PG8_SCHED;
            PG8_LDB(B0, 1, 0); PG8_LDB(B1, 1, 1); PG8_SCHED; PG8_LDA(At, 1, 0); PG8_STAGE(PG8_SA(0, 1), a2, voffA[1]);
            PG8_WAIT_V(8); PG8_WAIT_L(0); PG8_BAR; PG8_MMA(0, 0, At, B0); PG8_MMA(0, 1, At, B1); PG8_BAR; PG8_SCHED;
            PG8_LDA(At, 1, 1); PG8_STAGE(PG8_SB(1, 0), b3, voffB); PG8_STAGE(PG8_SB(1, 1), b3 + hB, voffB); PG8_STAGE(PG8_SA(1, 0), a3, voffA[0]);
            PG8_WAIT_V(8); PG8_WAIT_L(0); PG8_BAR; PG8_MMA(1, 0, At, B0); PG8_MMA(1, 1, At, B1); PG8_BAR; PG8_SCHED;
        }
        if constexpr (ALIGN_EPI) { if (wr == 0) PG8_BAR; }
        E(acc, cur, wr, wc, fr, fq);
        if (!has_next) break;
#pragma unroll
        for (int a = 0; a < 2; ++a)
#pragma unroll
            for (int b = 0; b < 2; ++b)
#pragma unroll
                for (int m = 0; m < 4; ++m)
#pragma unroll
                    for (int n = 0; n < 2; ++n) acc[a][b][m][n] = (f32x4){0.f, 0.f, 0.f, 0.f};
        cur = nxt; ++ui;
        if constexpr (ALIGN_EPI) { if (wr == 1) PG8_BAR; }
    }
    PG8_WAIT_V(0);
    if constexpr (!ALIGN_EPI) { if (wr == 0) PG8_BAR; }
    PG8_BAR;
#undef PG8_SA
#undef PG8_SB
#undef PG8_STAGE
#undef PG8_LDA
#undef PG8_LDB
#undef PG8_MMA
#undef PG8_WAIT_V
#undef PG8_WAIT_L
#undef PG8_BAR
#undef PG8_SCHED
#undef PG8_AK
#undef PG8_BK
}
}
struct DenseSched {
    const bf16_t* A; const bf16_t* Bt; int K, nM, nN;
    DI bool next(int i, GUnit& u) const {
        const int nwg = nM * nN; const long L = (long)i * (int)gridDim.x + (int)blockIdx.x; if (L >= nwg) return false;
        int wgid = (int)L; { const int q = nwg / 8, r = nwg % 8, xcd = wgid % 8, off = wgid / 8; wgid = (xcd < r ? xcd * (q + 1) : r * (q + 1) + (xcd - r) * q) + off; }
        const int nig = 8 * nN, gid = wgid / nig, fm = gid * 8, gsz = (nM - fm) < 8 ? (nM - fm) : 8;
        u.pm = fm + ((wgid % nig) % gsz); u.pn = (wgid % nig) / gsz;
        u.A = A + (size_t)u.pm * 256 * K; u.aidx = nullptr; u.nvalid = 256; u.B0 = Bt + (size_t)u.pn * 256 * K; u.B1 = u.B0; u.lbase = 0; return true; }
};
template <int NT, bool up> struct MoeSched {
    const LAS int* tstart; const unsigned* cnt; const int* list; const bf16_t* A; const bf16_t* W;
    DI bool next(int i, GUnit& u) const {
        const int ntile = __builtin_amdgcn_readfirstlane(tstart[NBUCKET]), nwg = ntile * NT; const int L0 = i * (int)gridDim.x + (int)blockIdx.x; if (L0 >= nwg) return false;
        int L = L0; { const int q = nwg / 8, r = nwg % 8, xcd = L0 % 8, off = L0 / 8; L = (xcd < r ? xcd * (q + 1) : r * (q + 1) + (xcd - r) * q) + off; }
        const int ti = L / NT, pn = L % NT; int b = 0;
        for (int q = 1; q < NBUCKET; ++q) if (__builtin_amdgcn_readfirstlane(tstart[q]) <= ti) b = q;
        const int rt = ti - __builtin_amdgcn_readfirstlane(tstart[b]); const int g = b / 6, p = b % 6; const int ea = 4 * g + (p < 3 ? 0 : (p < 5 ? 1 : 2)), eb = 4 * g + (p < 3 ? p + 1 : (p < 5 ? p - 1 : 3));
        u.pm = ti; u.pn = pn; u.lbase = b * T + rt * 256; const int nv = __builtin_amdgcn_readfirstlane((int)cnt[b]) - rt * 256; u.nvalid = nv < 256 ? nv : 256;
        if (up) { u.A = A; u.aidx = list + u.lbase; const int e = pn < 4 ? ea : eb; u.B0 = W + (size_t)e * 1024 * 1024 + (size_t)(pn & 3) * 256 * 1024; u.B1 = u.B0; }
        else { u.A = A + (size_t)ti * 256 * 1024; u.aidx = nullptr; u.B0 = W + (size_t)ea * 1024 * 512 + (size_t)pn * 256 * 512; u.B1 = W + (size_t)eb * 1024 * 512 + (size_t)pn * 256 * 512; }
        return true;
    }
};

DI u32x4 pack8(const f32x4 v0, const f32x4 v1) { u32x4 w; w.x = pk2(v0[0], v0[1]); w.y = pk2(v0[2], v0[3]); w.z = pk2(v1[0], v1[1]); w.w = pk2(v1[2], v1[3]); return w; }
struct EpiProj {
    bf16_t *qsb, *vtsb, *qsw, *ksw, *vtsw; const float *cosT, *sinT;
    DI void operator()(const f32x4 (&acc)[2][2][4][2], const GUnit& u, int wr, int wc, int fr, int fq) const {
        const int pn = u.pn, rowb = u.pm * 256 + wr * 64 + fr;
        if (pn < 4) {
            bf16_t* base = qsb + (size_t)(pn >> 1) * ((WS_KSB - WS_QSB) / 2); const float sc = pn < 2 ? QSCALE : 1.0f; const int colt = (pn & 1) * 256 + wc * 32 + 8 * fq;
#pragma unroll
            for (int ai = 0; ai < 2; ++ai)
#pragma unroll
                for (int m = 0; m < 4; ++m) { const size_t row = rowb + ai * 128 + m * 16;
#pragma unroll
                    for (int bj = 0; bj < 2; ++bj) *(u32x4*)(base + row * 512 + colt + bj * 128) = pack8(acc[ai][bj][m][0] * sc, acc[ai][bj][m][1] * sc); }
        } else if (pn < 6 || (pn == 8 && wc >= 2)) {
            bf16_t* base = pn < 6 ? vtsb + (size_t)((pn - 4) * 256 + wc * 32 + 8 * fq) * T : vtsw + (size_t)((wc * 32 - 64) + 8 * fq) * T; const size_t bjs = pn < 6 ? (size_t)128 * T : (size_t)64 * T;
#pragma unroll
            for (int ai = 0; ai < 2; ++ai)
#pragma unroll
                for (int m = 0; m < 4; ++m) { const size_t row = rowb + ai * 128 + m * 16;
#pragma unroll
                    for (int bj = 0; bj < 2; ++bj)
#pragma unroll
                        for (int n = 0; n < 2; ++n)
#pragma unroll
                            for (int j = 0; j < 4; ++j) base[bj * bjs + (size_t)(4 * n + j) * T + row] = (bf16_t)f2bf(acc[ai][bj][m][n][j]); }
        } else {
            const bool isq = pn < 8; bf16_t* base = isq ? qsw : ksw; const int pitch = isq ? 512 : 128; const int head = isq ? (pn - 6) * 4 + wc : wc; const float sc = isq ? QSCALE : 1.0f;
#pragma unroll
            for (int ai = 0; ai < 2; ++ai)
#pragma unroll
                for (int m = 0; m < 4; ++m) { const size_t row = rowb + ai * 128 + m * 16;
                    const f32x4 c0 = *(const f32x4*)(cosT + row * 32 + 8 * fq), c1 = *(const f32x4*)(cosT + row * 32 + 8 * fq + 4);
                    const f32x4 s0 = *(const f32x4*)(sinT + row * 32 + 8 * fq), s1 = *(const f32x4*)(sinT + row * 32 + 8 * fq + 4);
                    const f32x4 x10 = acc[ai][0][m][0], x11 = acc[ai][0][m][1], x20 = acc[ai][1][m][0], x21 = acc[ai][1][m][1];
                    const f32x4 o10 = (x10 * c0 - x20 * s0) * sc, o11 = (x11 * c1 - x21 * s1) * sc, o20 = (x20 * c0 + x10 * s0) * sc, o21 = (x21 * c1 + x11 * s1) * sc;
                    *(u32x4*)(base + row * pitch + head * 64 + 8 * fq) = pack8(o10, o11); *(u32x4*)(base + row * pitch + head * 64 + 32 + 8 * fq) = pack8(o20, o21); }
        }
    }
};
struct EpiWout {
    const float* x; const float* mod; float* out;
    DI void operator()(const f32x4 (&acc)[2][2][4][2], const GUnit& u, int wr, int wc, int fr, int fq) const {
        const int rowb = u.pm * 256 + wr * 64 + fr, colb = u.pn * 256 + wc * 32 + 8 * fq; const int b = (u.pm * 256) / SEQ;
        f32x4 gt[2][2];
#pragma unroll
        for (int bj = 0; bj < 2; ++bj)
#pragma unroll
            for (int n = 0; n < 2; ++n) gt[bj][n] = *(const f32x4*)(mod + b * 6144 + 2048 + colb + bj * 128 + 4 * n);
#pragma unroll
        for (int ai = 0; ai < 2; ++ai)
#pragma unroll
            for (int m = 0; m < 4; ++m) { const size_t off = (size_t)(rowb + ai * 128 + m * 16) * DM + colb;
#pragma unroll
                for (int bj = 0; bj < 2; ++bj)
#pragma unroll
                    for (int n = 0; n < 2; ++n) { const f32x4 xv = *(const f32x4*)(x + off + bj * 128 + 4 * n); *(f32x4*)(out + off + bj * 128 + 4 * n) = xv + gt[bj][n] * acc[ai][bj][m][n]; } }
    }
};
DI f32x4 swiglu4(const f32x4 g, const f32x4 uu, float w) { f32x4 o;
#pragma unroll
    for (int j = 0; j < 4; ++j) o[j] = w * uu[j] * g[j] / (1.0f + __expf(-g[j]));
    return o; }
struct EpiUp {
    bf16_t* hid; const f32x2* wts;
    DI void operator()(const f32x4 (&acc)[2][2][4][2], const GUnit& u, int wr, int wc, int fr, int fq) const {
        const int hc = (u.pn >> 2) * 512 + (u.pn & 3) * 128 + wc * 32 + 8 * fq; const bool second = u.pn >= 4;
#pragma unroll
        for (int ai = 0; ai < 2; ++ai)
#pragma unroll
            for (int m = 0; m < 4; ++m) { const int r = ai * 128 + wr * 64 + m * 16 + fr; float w = 0.f;
                if (r < u.nvalid) { const f32x2 ww = wts[u.lbase + r]; w = second ? ww.y : ww.x; }
                *(u32x4*)(hid + (size_t)(u.pm * 256 + r) * 1024 + hc) = pack8(swiglu4(acc[ai][0][m][0], acc[ai][1][m][0], w), swiglu4(acc[ai][0][m][1], acc[ai][1][m][1], w)); }
    }
};
struct EpiDown {
    const int* list; const float* mod; float* out;
    DI void operator()(const f32x4 (&acc)[2][2][4][2], const GUnit& u, int wr, int wc, int fr, int fq) const {
        const int colb = u.pn * 256 + wc * 32 + 8 * fq; const int* lp = list + u.lbase;
#pragma unroll
        for (int ai = 0; ai < 2; ++ai)
#pragma unroll
            for (int m = 0; m < 4; ++m) { const int r = ai * 128 + wr * 64 + m * 16 + fr;
                if (r < u.nvalid) { const int tok = lp[r]; const float* gp = mod + (tok / SEQ) * 6144 + 5120 + colb; float* op = out + (size_t)tok * DM + colb;
#pragma unroll
                    for (int bj = 0; bj < 2; ++bj) { const f32x4 g0 = *(const f32x4*)(gp + bj * 128), g1 = *(const f32x4*)(gp + bj * 128 + 4); const f32x4 x0 = *(const f32x4*)(op + bj * 128), x1 = *(const f32x4*)(op + bj * 128 + 4);
                        *(f32x4*)(op + bj * 128) = x0 + g0 * acc[ai][bj][m][0]; *(f32x4*)(op + bj * 128 + 4) = x1 + g1 * acc[ai][bj][m][1]; } }
                asm volatile("" ::: "memory"); }
    }
};

typedef float f32x16 __attribute__((ext_vector_type(16)));
#define MFMA32(a, b, c) __builtin_amdgcn_mfma_f32_32x32x16_bf16((a), (b), (c), 0, 0, 0)
DI int pi32(int r) { return (r & ~12) | ((r & 4) << 1) | ((r & 8) >> 1); }
DI int crow(int i, int h) { return (i & 3) + 8 * (i >> 2) + 4 * h; }
template <int S_> DI bf16x8 packacc(const f32x16& x) { u32x4 p; p.x = pk2(x[8 * S_], x[8 * S_ + 1]); p.y = pk2(x[8 * S_ + 2], x[8 * S_ + 3]); p.z = pk2(x[8 * S_ + 4], x[8 * S_ + 5]); p.w = pk2(x[8 * S_ + 6], x[8 * S_ + 7]); return __builtin_bit_cast(bf16x8, p); }
DI f32x16 zero16() { f32x16 z;
#pragma unroll
    for (int i = 0; i < 16; ++i) z[i] = 0.f;
    return z; }
DI void sb_unit(const bf16_t* Q, const bf16_t* K, const bf16_t* VT, int b, int t0, int hd, int lane, f32x16 (&o)[2]) {
    const int r = lane & 31, h = lane >> 5; const size_t gb = (size_t)b * SEQ;
    bf16x8 qf[4];
#pragma unroll
    for (int d0 = 0; d0 < 4; ++d0) qf[d0] = *(const bf16x8*)(Q + (gb + t0 + r) * 512 + hd * 64 + 16 * d0 + 8 * h);
    bf16x8 U0, U1, ones; const int kr = pi32(r);
#pragma unroll
    for (int j = 0; j < 8; ++j) { U0[j] = (8 * h + j > kr) ? (short)0x3F80 : (short)0; U1[j] = (16 + 8 * h + j > kr) ? (short)0x3F80 : (short)0; ones[j] = (short)0x3F80; }
    o[0] = zero16(); o[1] = zero16(); f32x16 C = zero16();
    const bf16_t* kp = K + (gb + pi32(r)) * 512 + hd * 64 + 8 * h;
    const bf16_t* vp = VT + (size_t)(hd * 64 + r) * T + gb + 8 * h;
    const int jd = t0 >> 5;
    for (int j = jd; j >= 0; --j) {
        bf16x8 kf[4], vf[2][2];
#pragma unroll
        for (int d0 = 0; d0 < 4; ++d0) kf[d0] = *(const bf16x8*)(kp + (size_t)j * 32 * 512 + 16 * d0);
#pragma unroll
        for (int dt = 0; dt < 2; ++dt)
#pragma unroll
            for (int sx = 0; sx < 2; ++sx) vf[dt][sx] = *(const bf16x8*)(vp + (size_t)dt * 32 * T + 32 * j + 16 * sx);
        f32x16 S = zero16();
#pragma unroll
        for (int d0 = 0; d0 < 4; ++d0) S = MFMA32(kf[d0], qf[d0], S);
        const bool diag = (j == jd);
        f32x16 L, lb;
#pragma unroll
        for (int i = 0; i < 16; ++i) { const float z = S[i]; const float e = __builtin_amdgcn_exp2f(-__builtin_fabsf(z)); const float l = __builtin_amdgcn_logf(1.0f + e);
            float Li = __builtin_fminf(-z, 0.f) - l; lb[i] = z + Li;
            if (diag && !(16 * (i >> 3) + 8 * h + (i & 7) < r)) Li = 0.f;
            L[i] = Li; }
        const bf16x8 Lf0 = packacc<0>(L), Lf1 = packacc<1>(L);
        f32x16 W = MFMA32(U0, Lf0, C); W = MFMA32(U1, Lf1, W);
        C = MFMA32(ones, Lf0, C); C = MFMA32(ones, Lf1, C);
        f32x16 P;
#pragma unroll
        for (int i = 0; i < 16; ++i) { float pv = __builtin_amdgcn_exp2f(lb[i] + W[i]); if (diag && !(16 * (i >> 3) + 8 * h + (i & 7) < r)) pv = 0.f; P[i] = pv; }
        const bf16x8 Pf0 = packacc<0>(P), Pf1 = packacc<1>(P);
#pragma unroll
        for (int dt = 0; dt < 2; ++dt) { o[dt] = MFMA32(Pf0, vf[dt][0], o[dt]); o[dt] = MFMA32(Pf1, vf[dt][1], o[dt]); }
        if (__all(C[0] < SB_EXIT)) break;
    }
}
DI void sw_unit(const bf16_t* Q, const bf16_t* K, const bf16_t* VT, float sink2, int b, int t0, int hq, int lane, f32x16 (&o)[2], float& lsum) {
    const int r = lane & 31, h = lane >> 5, kvh = hq >> 2, a = t0 >> 5; const size_t gb = (size_t)b * SEQ;
    bf16x8 qf[4];
#pragma unroll
    for (int d0 = 0; d0 < 4; ++d0) qf[d0] = *(const bf16x8*)(Q + (gb + t0 + r) * 512 + hq * 64 + 16 * d0 + 8 * h);
    const bf16_t* kp = K + (gb + pi32(r)) * 128 + kvh * 64 + 8 * h;
    const bf16_t* vp = VT + (size_t)(kvh * 64 + r) * T + gb + 8 * h;
    f32x16 S[5]; float m = sink2;
#pragma unroll
    for (int jj = 0; jj < 5; ++jj) { const int j = a - 4 + jj;
        if (j >= 0) { bf16x8 kf[4];
#pragma unroll
            for (int d0 = 0; d0 < 4; ++d0) kf[d0] = *(const bf16x8*)(kp + (size_t)j * 32 * 128 + 16 * d0);
            f32x16 s = zero16();
#pragma unroll
            for (int d0 = 0; d0 < 4; ++d0) s = MFMA32(kf[d0], qf[d0], s);
#pragma unroll
            for (int i = 0; i < 16; ++i) { const int ko = 16 * (i >> 3) + 8 * h + (i & 7); float v = s[i];
                if (jj == 4 && ko > r) v = -1e30f;
                if (jj == 0 && ko <= r) v = -1e30f;
                s[i] = v; m = __builtin_fmaxf(m, v); }
            S[jj] = s; }
        else {
#pragma unroll
            for (int i = 0; i < 16; ++i) S[jj][i] = -1e30f; } }
    m = __builtin_fmaxf(m, __shfl_xor(m, 32));
    o[0] = zero16(); o[1] = zero16(); float ls = 0.f;
#pragma unroll
    for (int jj = 0; jj < 5; ++jj) { const int j = a - 4 + jj;
        if (j >= 0) { bf16x8 vf[2][2];
#pragma unroll
            for (int dt = 0; dt < 2; ++dt)
#pragma unroll
                for (int sx = 0; sx < 2; ++sx) vf[dt][sx] = *(const bf16x8*)(vp + (size_t)dt * 32 * T + 32 * j + 16 * sx);
            f32x16 P;
#pragma unroll
            for (int i = 0; i < 16; ++i) { P[i] = __builtin_amdgcn_exp2f(S[jj][i] - m); ls += P[i]; }
            const bf16x8 Pf0 = packacc<0>(P), Pf1 = packacc<1>(P);
#pragma unroll
            for (int dt = 0; dt < 2; ++dt) { o[dt] = MFMA32(Pf0, vf[dt][0], o[dt]); o[dt] = MFMA32(Pf1, vf[dt][1], o[dt]); } } }
    ls += __shfl_xor(ls, 32);
    lsum = ls + __builtin_amdgcn_exp2f(sink2 - m);
}
constexpr int ATT_STG = 33 * 68;
constexpr int ATT_EX = NWAVES * ATT_STG * 4;
constexpr int NATT_TASKS = T / 32;
DI void p3_attention(const Args& a, LAS unsigned char* lds, int tid, int lane, int wave) {
    const bf16_t* QSB = (const bf16_t*)(a.ws + WS_QSB); const bf16_t* KSB = (const bf16_t*)(a.ws + WS_KSB); const bf16_t* VTSB = (const bf16_t*)(a.ws + WS_VSB);
    const bf16_t* QSW = (const bf16_t*)(a.ws + WS_QSW); const bf16_t* KSW = (const bf16_t*)(a.ws + WS_KSW); const bf16_t* VTSW = (const bf16_t*)(a.ws + WS_VSW);
    bf16_t* MIX = (bf16_t*)(a.ws + WS_MIX); unsigned* qctr = (unsigned*)(a.ws + WS_CTL) + CW_ATTNQ;
    LAS float* stg = (LAS float*)lds + wave * ATT_STG; LAS float* ex = (LAS float*)(lds + ATT_EX); LAS int* slot = (LAS int*)(lds + ATT_EX + 4096);
    const int r = lane & 31, h = lane >> 5, row = lane >> 1, hf = lane & 1;
    const float sink2 = a.sinks[wave] * LOG2E;
    int par = 0;
    for (;;) {
        __syncthreads();
        if (tid == 0) *slot = (int)atomicAdd(qctr, 1u);
        __syncthreads();
        const int task = __builtin_amdgcn_readfirstlane(*slot); if (task >= NATT_TASKS) break;
        const int b = task / (SEQ / 32), t0 = (task % (SEQ / 32)) * 32;
        f32x16 o[2]; float sbv[32], swv[32];
        sb_unit(QSB, KSB, VTSB, b, t0, wave, lane, o);
#pragma unroll
        for (int dt = 0; dt < 2; ++dt)
#pragma unroll
            for (int i = 0; i < 16; ++i) stg[crow(i, h) * 68 + 32 * dt + r] = o[dt][i];
        LDS_WAIT();
        float ss = 0.f;
#pragma unroll
        for (int k = 0; k < 8; ++k) { const f32x4 v = *(const LAS f32x4*)(stg + row * 68 + hf * 32 + 4 * k); sbv[4 * k] = v.x; sbv[4 * k + 1] = v.y; sbv[4 * k + 2] = v.z; sbv[4 * k + 3] = v.w; ss += (v.x * v.x + v.y * v.y) + (v.z * v.z + v.w * v.w); }
        ss += __shfl_xor(ss, 1);
        if (hf == 0) ex[par * 512 + row * 8 + wave] = ss;
        LDS_WAIT();
        float lsum;
        sw_unit(QSW, KSW, VTSW, sink2, b, t0, wave, lane, o, lsum);
#pragma unroll
        for (int dt = 0; dt < 2; ++dt)
#pragma unroll
            for (int i = 0; i < 16; ++i) stg[crow(i, h) * 68 + 32 * dt + r] = o[dt][i];
        if (h == 0) stg[32 * 68 + r] = lsum;
        LDS_WAIT();
        const float il = 1.0f / stg[32 * 68 + row]; float s2 = 0.f;
#pragma unroll
        for (int k = 0; k < 8; ++k) { const f32x4 v = *(const LAS f32x4*)(stg + row * 68 + hf * 32 + 4 * k) * il; swv[4 * k] = v.x; swv[4 * k + 1] = v.y; swv[4 * k + 2] = v.z; swv[4 * k + 3] = v.w; s2 += (v.x * v.x + v.y * v.y) + (v.z * v.z + v.w * v.w); }
        s2 += __shfl_xor(s2, 1);
        if (hf == 0) ex[par * 512 + 256 + row * 8 + wave] = s2;
        LDS_WAIT();
        __syncthreads();
        float tsb = 0.f, tsw = 0.f;
#pragma unroll
        for (int w = 0; w < 8; ++w) { tsb += ex[par * 512 + row * 8 + w]; tsw += ex[par * 512 + 256 + row * 8 + w]; }
        const float rsb = 1.0f / sqrtf(tsb * (1.0f / 512.0f) + EPS), rsw = 1.0f / sqrtf(tsw * (1.0f / 512.0f) + EPS);
        bf16_t* mrow = MIX + ((size_t)b * SEQ + t0 + row) * 1024 + wave * 64 + hf * 32;
#pragma unroll
        for (int k = 0; k < 4; ++k) { u32x4 w; w.x = pk2(sbv[8 * k] * rsb, sbv[8 * k + 1] * rsb); w.y = pk2(sbv[8 * k + 2] * rsb, sbv[8 * k + 3] * rsb); w.z = pk2(sbv[8 * k + 4] * rsb, sbv[8 * k + 5] * rsb); w.w = pk2(sbv[8 * k + 6] * rsb, sbv[8 * k + 7] * rsb); *(u32x4*)(mrow + 8 * k) = w; }
#pragma unroll
        for (int k = 0; k < 4; ++k) { u32x4 w; w.x = pk2(swv[8 * k] * rsw, swv[8 * k + 1] * rsw); w.y = pk2(swv[8 * k + 2] * rsw, swv[8 * k + 3] * rsw); w.z = pk2(swv[8 * k + 4] * rsw, swv[8 * k + 5] * rsw); w.w = pk2(swv[8 * k + 6] * rsw, swv[8 * k + 7] * rsw); *(u32x4*)(mrow + 512 + 8 * k) = w; }
        par ^= 1;
    }
}

#define XB_TMO      128
#define XB_XCNT(j)  (256  + 64 * (j))
#define XB_XSUB(j)  (1280 + 64 * (j))
#define XB_XGEN(j)  (2304 + 64 * (j))
#define XB_TOP      3328
#define XB_TOPGEN   3392
#define XCD_BAR_WORDS 3456
#define XB_SPIN_CAP (1u << 18)
DI unsigned xb_ld(unsigned* p)              { return __hip_atomic_load(p, __ATOMIC_RELAXED, __HIP_MEMORY_SCOPE_AGENT); }
DI unsigned xb_add(unsigned* p, unsigned v) { return __hip_atomic_fetch_add(p, v, __ATOMIC_RELAXED, __HIP_MEMORY_SCOPE_AGENT); }
DI unsigned xb_xcc_id() { return (unsigned)__builtin_amdgcn_s_getreg((3 << 11) | 20) & 0xFu; }
#define XB_SPIN(cond, bar) do { unsigned _sp = 0; while (cond) { __builtin_amdgcn_s_sleep(1); \
    if ((++_sp & 255u) == 0u) { if (xb_ld(&(bar)[XB_TMO])) break; if (_sp > XB_SPIN_CAP) { atomicAdd(&(bar)[XB_TMO], 1u); break; } } } } while (0)
struct XcdBarrier { unsigned* bar; unsigned x; volatile LAS unsigned* st; };
DI XcdBarrier xcd_barrier_post(unsigned* bar, volatile LAS unsigned* st) {
    XcdBarrier b; b.bar = bar; b.x = xb_xcc_id(); b.st = st;
    if (threadIdx.x == 0) (void)xb_add(&bar[XB_XCNT(b.x)], 1u);
    return b;
}
DI void xcd_barrier_complete(unsigned* bar, unsigned x, unsigned& nloc, unsigned& nx) {
    const unsigned G = gridDim.x * gridDim.y * gridDim.z;
    unsigned sum, cnt, mine, sp = 0u;
    for (;;) {
        sum = 0u; cnt = 0u; mine = 0u;
#pragma unroll
        for (unsigned j = 0; j < 16; ++j) { const unsigned c = xb_ld(&bar[XB_XCNT(j)]); sum += c; cnt += (c > 0u) ? 1u : 0u; mine = (j == x) ? c : mine; }
        if (sum == G) break;
        __builtin_amdgcn_s_sleep(1);
        if ((++sp & 255u) == 0u) { if (xb_ld(&bar[XB_TMO])) break; if (sp > XB_SPIN_CAP) { atomicAdd(&bar[XB_TMO], 1u); break; } }
    }
    nloc = mine > 0u ? mine : 1u; nx = cnt > 0u ? cnt : 1u;
}
DI void xcd_barrier(const XcdBarrier& b) {
    asm volatile("s_waitcnt vmcnt(0)" ::: "memory");
    __syncthreads();
    if (threadIdx.x == 0) {
        unsigned* bar = b.bar;
        __builtin_amdgcn_s_waitcnt(0);
        unsigned nloc = b.st[0], nx = b.st[1];
        if (nloc == 0u) { xcd_barrier_complete(bar, b.x, nloc, nx); b.st[0] = nloc; b.st[1] = nx; }
        const unsigned old = xb_add(&bar[XB_XSUB(b.x)], 1u);
        const unsigned gen = old / nloc;
        if (old + 1u == (gen + 1u) * nloc) {
            __builtin_amdgcn_fence(__ATOMIC_RELEASE, "agent");
            asm volatile("s_waitcnt vmcnt(0)" ::: "memory");
            const unsigned og = xb_add(&bar[XB_TOP], 1u);
            const unsigned tg = og / nx;
            if (og + 1u == (tg + 1u) * nx) xb_add(&bar[XB_TOPGEN], 1u);
            else XB_SPIN(xb_ld(&bar[XB_TOPGEN]) == tg, bar);
            __builtin_amdgcn_fence(__ATOMIC_ACQUIRE, "agent");
            xb_add(&bar[XB_XGEN(b.x)], 1u);
            asm volatile("s_waitcnt vmcnt(0)" ::: "memory");
        } else {
            XB_SPIN(xb_ld(&bar[XB_XGEN(b.x)]) == gen, bar);
            __builtin_amdgcn_fence(__ATOMIC_ACQUIRE, "agent");
            asm volatile("s_waitcnt vmcnt(0)" ::: "memory");
        }
    }
    __syncthreads();
}

__global__ void __launch_bounds__(NTHREADS, 2) mk_fwd(Args a) {
    extern __shared__ __attribute__((aligned(16))) unsigned char lds_raw[];
    LAS unsigned char* lds = (LAS unsigned char*)lds_raw;
    const int tid = threadIdx.x, lane = tid & 63, wave = __builtin_amdgcn_readfirstlane(tid >> 6);
    volatile LAS unsigned* misc = (volatile LAS unsigned*)(lds + LDS_MISC);
    if (tid < 2) misc[tid] = 0u;
    __syncthreads();
    const XcdBarrier gbar = xcd_barrier_post((unsigned*)(a.ws + WS_CTL) + CW_BAR, misc);
    unsigned char* ws = a.ws;
    const float* mod = (const float*)(ws + WS_MOD);

    p0_prologue(a, lds, tid, lane, wave);
    xcd_barrier(gbar);
    p1_norm(a, lane, wave);
    xcd_barrier(gbar);
    {
        DenseSched S{(const bf16_t*)(ws + WS_H), (const bf16_t*)(ws + WS_WIN), 1024, T / 256, DIN / 256};
        EpiProj E{(bf16_t*)(ws + WS_QSB), (bf16_t*)(ws + WS_VSB), (bf16_t*)(ws + WS_QSW), (bf16_t*)(ws + WS_KSW), (bf16_t*)(ws + WS_VSW), (const float*)(ws + WS_COS), (const float*)(ws + WS_SIN)};
        pg8::gemm_phase<DenseSched, EpiProj, true, 1024, 1024, 16>(lds, S, E);
    }
    xcd_barrier(gbar);
    p3_attention(a, lds, tid, lane, wave);
    xcd_barrier(gbar);
    {
        DenseSched S{(const bf16_t*)(ws + WS_MIX), (const bf16_t*)(ws + WS_WOUT), 1024, T / 256, DM / 256};
        EpiWout E{a.x, mod, a.out};
        pg8::gemm_phase<DenseSched, EpiWout, true, 1024, 1024, 16>(lds, S, E);
    }
    xcd_barrier(gbar);
    p5_router(a, lane, wave);
    xcd_barrier(gbar);
    LAS int* tstart = (LAS int*)(lds + pg8::STAGE_BYTES);
    const unsigned* cnt = (const unsigned*)(ws + WS_CTL) + CW_CNT;
    if (tid == 0) { int run = 0; for (int b = 0; b < NBUCKET; ++b) { tstart[b] = run; run += ((int)cnt[b] + 255) >> 8; } tstart[NBUCKET] = run; }
    __syncthreads();
    {
        MoeSched<8, true> S{tstart, cnt, (const int*)(ws + WS_LIST), (const bf16_t*)(ws + WS_H), (const bf16_t*)(ws + WS_WGU)};
        EpiUp E{(bf16_t*)(ws + WS_HID), (const f32x2*)(ws + WS_WTS)};
        pg8::gemm_phase<MoeSched<8, true>, EpiUp, true, 1024, 1024, 16>(lds, S, E);
    }
    xcd_barrier(gbar);
    {
        MoeSched<4, false> S{tstart, cnt, (const int*)(ws + WS_LIST), (const bf16_t*)(ws + WS_HID), (const bf16_t*)(ws + WS_WD)};
        EpiDown E{(const int*)(ws + WS_LIST), mod, a.out};
        pg8::gemm_phase<MoeSched<4, false>, EpiDown, true, 1024, 512, 8>(lds, S, E);
    }
    xcd_barrier(gbar);
    p8_final(a, lane, wave);
}

extern "C" void kernel_launch(void* const* d_in, const int* in_sizes, int n_in, void* d_out, int out_size, void* d_ws, size_t ws_size, hipStream_t stream) {
    static int grid = 0;
    if (grid == 0) {
        if (n_in != 18 || in_sizes[0] != T * DM || out_size != T * DM || ws_size < WS_END) { fprintf(stderr, "kernel_launch: unexpected shapes (n_in %d, in0 %d, out %d, ws %zu); nothing launched\n", n_in, n_in > 0 ? in_sizes[0] : -1, out_size, ws_size); grid = -1; return; }
        int dev = 0, cus = 0, per_cu = 0;
        (void)hipGetDevice(&dev); (void)hipDeviceGetAttribute(&cus, hipDeviceAttributeMultiprocessorCount, dev);
        (void)hipFuncSetAttribute((const void*)mk_fwd, hipFuncAttributeMaxDynamicSharedMemorySize, LDS_BYTES);
        (void)hipOccupancyMaxActiveBlocksPerMultiprocessor(&per_cu, (const void*)mk_fwd, NTHREADS, LDS_BYTES);
        if (per_cu < 1) { fprintf(stderr, "kernel_launch: occupancy query says %d blocks per CU\n", per_cu); per_cu = 1; }
        grid = cus * per_cu;
        fprintf(stderr, "kernel_launch: %d CUs x %d = grid %d\n", cus, per_cu, grid);
    }
    if (grid < 0) return;
    (void)hipMemsetAsync((char*)d_ws + WS_CTL, 0, CTL_BYTES, stream);
    Args a{};
    a.x = (const float*)d_in[0]; a.c = (const float*)d_in[1]; a.pos = (const int*)d_in[2]; a.w_ada = (const float*)d_in[3]; a.b_ada = (const float*)d_in[4]; a.g_mix = (const float*)d_in[5];
    a.w_in = (const float*)d_in[6]; a.sinks = (const float*)d_in[7]; a.g_sb = (const float*)d_in[8]; a.g_sw = (const float*)d_in[9]; a.w_out = (const float*)d_in[10]; a.g_ffn = (const float*)d_in[11];
    a.w_rg = (const float*)d_in[12]; a.w_re = (const float*)d_in[13]; a.w_gate = (const float*)d_in[14]; a.w_up = (const float*)d_in[15]; a.w_down = (const float*)d_in[16]; a.g_fin = (const float*)d_in[17];
    a.out = (float*)d_out; a.ws = (unsigned char*)d_ws;
    void* args[] = {&a};
    hipError_t e = hipLaunchCooperativeKernel((const void*)mk_fwd, dim3(grid), dim3(NTHREADS), args, LDS_BYTES, stream);
    if (e != hipSuccess) fprintf(stderr, "kernel_launch: cooperative launch failed: %s (grid %d)\n", hipGetErrorString(e), grid);
}
```

```cpp
#include <hip/hip_runtime.h>
#include <hip/hip_cooperative_groups.h>
#include <cstdio>
#include <cstdint>
#include <cmath>
namespace cg = cooperative_groups;

#define LAS __attribute__((address_space(3)))
#define DI __device__ __forceinline__
typedef unsigned short bf16_t;
typedef short bf16x8 __attribute__((ext_vector_type(8)));
typedef float f32x4 __attribute__((ext_vector_type(4)));
typedef float f32x2 __attribute__((ext_vector_type(2)));
typedef unsigned u32x4 __attribute__((ext_vector_type(4)));
typedef unsigned u32x2 __attribute__((ext_vector_type(2)));
typedef __bf16 bf16x2_t __attribute__((ext_vector_type(2)));

constexpr int NB = 4, SEQ = 8192, DM = 1024, T = NB * SEQ;
constexpr int DIN = 2304, DSB = 512, DSW = 512, DKV = 128;
constexpr int NEXP = 16, DEXP = 512, NBUCKET = 24, WINDOW = 128;
constexpr int MAXTILES = T / 256 + NBUCKET, TPAD = MAXTILES * 256;
constexpr float EPS = 1e-6f, LOG2E = 1.4426950408889634f, QSCALE = 0.125f * LOG2E;
constexpr float SB_EXIT = -150.0f;
constexpr int NTHREADS = 512, NWAVES = 8;

constexpr size_t MiB = 1u << 20;
constexpr size_t WS_CTL = 0, CTL_BYTES = 1 * MiB;
constexpr size_t WS_MOD = 1 * MiB;
constexpr size_t WS_COS = 2 * MiB, WS_SIN = 6 * MiB;
constexpr size_t WS_WIN = 10 * MiB;
constexpr size_t WS_WOUT = 15 * MiB;
constexpr size_t WS_WGU = 17 * MiB;
constexpr size_t WS_WD = 49 * MiB;
constexpr size_t WS_LIST = 65 * MiB;
constexpr size_t WS_WTS = 68 * MiB;
constexpr size_t WS_H = 80 * MiB;
constexpr size_t WS_QSB = 144 * MiB, WS_KSB = 176 * MiB, WS_VSB = 208 * MiB, WS_QSW = 240 * MiB;
constexpr size_t WS_KSW = 272 * MiB, WS_VSW = 280 * MiB;
constexpr size_t WS_MIX = 288 * MiB;
constexpr size_t WS_HID = 352 * MiB;
constexpr size_t WS_END = 428 * MiB;
static_assert(WS_KSB - WS_QSB == WS_VSB - WS_KSB, "q/k/v_sb buffers equally spaced");
static_assert(WS_HID + (size_t)TPAD * 1024 * 2 <= WS_END, "ws map");
constexpr int CW_CNT = 64, CW_ATTNQ = 128, CW_BAR = 4096;
constexpr int LDS_MISC = 143360;

constexpr int LDS_BYTES = 147456;

struct Args {
    const float* x; const float* c; const int* pos; const float* w_ada; const float* b_ada; const float* g_mix; const float* w_in; const float* sinks;
    const float* g_sb; const float* g_sw; const float* w_out; const float* g_ffn; const float* w_rg; const float* w_re; const float* w_gate; const float* w_up;
    const float* w_down; const float* g_fin; float* out; unsigned char* ws;
};

__constant__ float INV_FREQ[32] = {1.000000000e+00f, 7.498942018e-01f, 5.623413324e-01f, 4.216965139e-01f, 3.162277639e-01f, 2.371373773e-01f, 1.778279394e-01f, 1.333521456e-01f, 1.000000015e-01f, 7.498942316e-02f, 5.623413250e-02f, 4.216964915e-02f, 3.162277490e-02f, 2.371373773e-02f, 1.778279431e-02f, 1.333521400e-02f, 9.999999776e-03f, 7.498942316e-03f, 5.623413250e-03f, 4.216964822e-03f, 3.162277630e-03f, 2.371373819e-03f, 1.778279431e-03f, 1.333521446e-03f, 1.000000047e-03f, 7.498941850e-04f, 5.623413017e-04f, 4.216965172e-04f, 3.162277571e-04f, 2.371373703e-04f, 1.778279402e-04f, 1.333521504e-04f};

DI unsigned f2bf(float f) { unsigned u = __builtin_bit_cast(unsigned, f); return (u + 0x7fffu + ((u >> 16) & 1u)) >> 16; }
DI unsigned pk2(float lo, float hi) { f32x2 v = {lo, hi}; bf16x2_t b = __builtin_convertvector(v, bf16x2_t); return __builtin_bit_cast(unsigned, b); }
DI float bf2f(unsigned short b) { return __builtin_bit_cast(float, (unsigned)b << 16); }
DI float bflo(unsigned w) { return __builtin_bit_cast(float, w << 16); }
DI float bfhi(unsigned w) { return __builtin_bit_cast(float, w & 0xffff0000u); }
DI float wave_sum(float v) {
#pragma unroll
    for (int o = 1; o < 64; o <<= 1) v += __shfl_xor(v, o);
    return v;
}
#define LDS_WAIT() asm volatile("s_waitcnt lgkmcnt(0)" ::: "memory")

DI void tr_item(const float* W, int N, int k0, int n0, bf16_t* WT, int drow0, int Kd, const float* kscale, LAS float* scr, int lane) {
#pragma unroll 8
    for (int i = 0; i < 32; ++i) { const int kk = 2 * i + (lane >> 5); float v = W[(size_t)(k0 + kk) * N + n0 + (lane & 31)]; if (kscale) v *= kscale[k0 + kk]; scr[kk * 33 + (lane & 31)] = v; }
    LDS_WAIT();
    const int c = lane & 7;
#pragma unroll
    for (int j = 0; j < 4; ++j) { const int n = (lane >> 3) + 8 * j; const LAS float* s = scr + (8 * c) * 33 + n;
        u32x4 o; o.x = pk2(s[0 * 33], s[1 * 33]); o.y = pk2(s[2 * 33], s[3 * 33]); o.z = pk2(s[4 * 33], s[5 * 33]); o.w = pk2(s[6 * 33], s[7 * 33]);
        *(u32x4*)(WT + (size_t)(drow0 + n) * Kd + k0 + 8 * c) = o; }
    LDS_WAIT();
}
DI int win_drow(int n0) {
    if (n0 < 1536) return n0;
    if (n0 < 2048) { const int c = n0 - 1536, head = c >> 6, half = (c >> 5) & 1; return 1536 + (head >> 2) * 256 + half * 128 + (head & 3) * 32; }
    if (n0 < 2176) { const int c = n0 - 2048, head = c >> 6, half = (c >> 5) & 1; return 2048 + half * 128 + head * 32; }
    const int c = n0 - 2176; return 2048 + (c >> 6) * 128 + 64 + (c & 63);
}
DI void p0_prologue(const Args& a, LAS unsigned char* lds, int tid, int lane, int wave) {
    unsigned char* ws = a.ws;
    {
        float* mod = (float*)(ws + WS_MOD); LAS float* red = (LAS float*)lds;
        for (int cb = blockIdx.x; cb < 6144 / 32; cb += gridDim.x) {
            const int cj = tid & 31, kg = tid >> 5, col = cb * 32 + cj;
            float acc0 = 0.f, acc1 = 0.f, acc2 = 0.f, acc3 = 0.f;
            for (int kk = 0; kk < 64; ++kk) { const int k = kg * 64 + kk; const float w = a.w_ada[(size_t)k * 6144 + col];
                float c0 = a.c[k], c1 = a.c[1024 + k], c2 = a.c[2048 + k], c3 = a.c[3072 + k];
                c0 = c0 / (1.f + expf(-c0)); c1 = c1 / (1.f + expf(-c1)); c2 = c2 / (1.f + expf(-c2)); c3 = c3 / (1.f + expf(-c3));
                acc0 += c0 * w; acc1 += c1 * w; acc2 += c2 * w; acc3 += c3 * w; }
            red[(kg * 4 + 0) * 32 + cj] = acc0; red[(kg * 4 + 1) * 32 + cj] = acc1; red[(kg * 4 + 2) * 32 + cj] = acc2; red[(kg * 4 + 3) * 32 + cj] = acc3;
            __syncthreads();
            if (tid < 128) { const int b = tid >> 5, c2 = tid & 31; float s = 0.f; for (int g = 0; g < 16; ++g) s += red[(g * 4 + b) * 32 + c2]; mod[b * 6144 + cb * 32 + c2] = s + a.b_ada[cb * 32 + c2]; }
            __syncthreads();
        }
    }
    {
        float* cosT = (float*)(ws + WS_COS); float* sinT = (float*)(ws + WS_SIN);
        for (int idx = blockIdx.x * NTHREADS + tid; idx < T * 32; idx += gridDim.x * NTHREADS) {
            const int t = idx >> 5, i = idx & 31; const float ang = (float)a.pos[t] * INV_FREQ[i];
            const double ad = (double)ang, kq = rint(ad * 0.63661977236758134308);
            double y = fma(-kq, 1.5707963267948966192, ad); y = fma(-kq, 6.123233995736766036e-17, y);
            const int q = (int)((long long)kq & 3); const double y2 = y * y;
            const double sn = y * (1.0 + y2 * (-1.0 / 6 + y2 * (1.0 / 120 + y2 * (-1.0 / 5040 + y2 * (1.0 / 362880 + y2 * (-1.0 / 39916800))))));
            const double cs = 1.0 + y2 * (-0.5 + y2 * (1.0 / 24 + y2 * (-1.0 / 720 + y2 * (1.0 / 40320 + y2 * (-1.0 / 3628800 + y2 * (1.0 / 479001600))))));
            double co, si; if (q == 0) { co = cs; si = sn; } else if (q == 1) { co = -sn; si = cs; } else if (q == 2) { co = -cs; si = -sn; } else { co = sn; si = -cs; }
            cosT[idx] = (float)co; sinT[idx] = (float)si;
        }
    }
    {
        LAS float* scr = (LAS float*)(lds + 8192 + wave * 8704);
        const int gw = blockIdx.x * NWAVES + wave, NGW = gridDim.x * NWAVES;
        constexpr int I_IN = 16 * 72, I_OUT = 16 * 32, I_G = 16 * 16 * 16, I_D = 16 * 8 * 32, NITEMS = I_IN + I_OUT + 2 * I_G + I_D;
        for (int it = gw; it < NITEMS; it += NGW) {
            int r = it;
            if (r < I_IN) { const int kb = r / 72, nb = r % 72; tr_item(a.w_in, DIN, kb * 64, nb * 32, (bf16_t*)(ws + WS_WIN), win_drow(nb * 32), 1024, nullptr, scr, lane); continue; } r -= I_IN;
            if (r < I_OUT) { const int kb = r / 32, nb = r % 32; const float* ks = (kb < 8) ? a.g_sb : (a.g_sw - 512); tr_item(a.w_out, 1024, kb * 64, nb * 32, (bf16_t*)(ws + WS_WOUT), nb * 32, 1024, ks, scr, lane); continue; } r -= I_OUT;
            if (r < 2 * I_G) { const int up = r >= I_G; if (up) r -= I_G; const int e = r / 256, q = r % 256, kb = q / 16, nb = q % 16, c0 = nb * 32;
                tr_item((up ? a.w_up : a.w_gate) + (size_t)e * 1024 * 512, 512, kb * 64, c0, (bf16_t*)(ws + WS_WGU) + (size_t)e * 1024 * 1024, (c0 >> 7) * 256 + up * 128 + (c0 & 127), 1024, nullptr, scr, lane); continue; } r -= 2 * I_G;
            { const int e = r / 256, q = r % 256, kb = q / 32, nb = q % 32; tr_item(a.w_down + (size_t)e * 512 * 1024, 1024, kb * 64, nb * 32, (bf16_t*)(ws + WS_WD) + (size_t)e * 1024 * 512, nb * 32, 512, nullptr, scr, lane); }
        }
    }
}

DI void p1_norm(const Args& a, int lane, int wave) {
    const float* mod = (const float*)(a.ws + WS_MOD); bf16_t* H = (bf16_t*)(a.ws + WS_H);
    const int gw = blockIdx.x * NWAVES + wave, NGW = gridDim.x * NWAVES;
    for (int ch = gw; ch < T / 16; ch += NGW) {
        const int row0 = ch * 16, b = row0 / SEQ;
        f32x4 ca[4], cb[4];
#pragma unroll
        for (int j = 0; j < 4; ++j) { const int col = 4 * lane + 256 * j; const f32x4 g = *(const f32x4*)(a.g_mix + col), sc = *(const f32x4*)(mod + b * 6144 + 1024 + col); ca[j] = g * (sc + 1.0f); cb[j] = *(const f32x4*)(mod + b * 6144 + col); }
        for (int r = 0; r < 16; ++r) {
            const float* xr = a.x + (size_t)(row0 + r) * DM; f32x4 v[4]; float s = 0.f;
#pragma unroll
            for (int j = 0; j < 4; ++j) { v[j] = *(const f32x4*)(xr + 4 * lane + 256 * j); s += (v[j].x * v[j].x + v[j].y * v[j].y) + (v[j].z * v[j].z + v[j].w * v[j].w); }
            const float rs = 1.0f / sqrtf(wave_sum(s) * (1.0f / DM) + EPS);
            bf16_t* hr = H + (size_t)(row0 + r) * DM;
#pragma unroll
            for (int j = 0; j < 4; ++j) { const f32x4 o = v[j] * rs * ca[j] + cb[j]; u32x2 w; w.x = pk2(o.x, o.y); w.y = pk2(o.z, o.w); *(u32x2*)(hr + 4 * lane + 256 * j) = w; }
        }
    }
}
DI void p8_final(const Args& a, int lane, int wave) {
    const int gw = blockIdx.x * NWAVES + wave, NGW = gridDim.x * NWAVES;
    f32x4 g[4];
#pragma unroll
    for (int j = 0; j < 4; ++j) g[j] = *(const f32x4*)(a.g_fin + 4 * lane + 256 * j);
    for (int row = gw; row < T; row += NGW) {
        float* xr = a.out + (size_t)row * DM; f32x4 v[4]; float s = 0.f;
#pragma unroll
        for (int j = 0; j < 4; ++j) { v[j] = *(const f32x4*)(xr + 4 * lane + 256 * j); s += (v[j].x * v[j].x + v[j].y * v[j].y) + (v[j].z * v[j].z + v[j].w * v[j].w); }
        const float rs = 1.0f / sqrtf(wave_sum(s) * (1.0f / DM) + EPS);
#pragma unroll
        for (int j = 0; j < 4; ++j) *(f32x4*)(xr + 4 * lane + 256 * j) = v[j] * rs * g[j];
    }
}
constexpr int RT_LDS_BYTES = 1024 * 20 * 4;
DI void p5_router(const Args& a, LAS unsigned char* lds, int tid, int lane, int wave) {
    const float* mod = (const float*)(a.ws + WS_MOD); bf16_t* H = (bf16_t*)(a.ws + WS_H);
    unsigned* cnt = (unsigned*)(a.ws + WS_CTL) + CW_CNT; int* list = (int*)(a.ws + WS_LIST); f32x2* wts = (f32x2*)(a.ws + WS_WTS);
    LAS f32x4* WL = (LAS f32x4*)lds;
    for (int idx = tid; idx < 1024 * 5; idx += NTHREADS) { const int k = idx / 5, q = idx % 5; const f32x4 w = (q == 0) ? *(const f32x4*)(a.w_rg + 4 * k) : *(const f32x4*)(a.w_re + 16 * k + 4 * (q - 1));
        WL[(((k >> 8) * 4 + (k & 3)) * 5 + q) * 64 + ((k & 255) >> 2)] = w; }
    __syncthreads();
    const int gw = blockIdx.x * NWAVES + wave, NGW = gridDim.x * NWAVES;
    for (int ch = gw; ch < T / 16; ch += NGW) {
        const int row0 = ch * 16, b = row0 / SEQ;
        f32x4 ca[4], cb[4];
#pragma unroll
        for (int j = 0; j < 4; ++j) { const int col = 4 * lane + 256 * j; const f32x4 g = *(const f32x4*)(a.g_ffn + col), sc = *(const f32x4*)(mod + b * 6144 + 4096 + col); ca[j] = g * (sc + 1.0f); cb[j] = *(const f32x4*)(mod + b * 6144 + 3072 + col); }
        int mybucket = 0; float mywa = 0.f, mywb = 0.f;
#pragma unroll 1
        for (int r4 = 0; r4 < 16; r4 += 2) {
            f32x4 v[2][4];
#pragma unroll
            for (int rr = 0; rr < 2; ++rr) { const float* xr = a.out + (size_t)(row0 + r4 + rr) * DM;
#pragma unroll
                for (int j = 0; j < 4; ++j) v[rr][j] = *(const f32x4*)(xr + 4 * lane + 256 * j); }
#pragma unroll
            for (int rr = 0; rr < 2; ++rr) { float s = 0.f;
#pragma unroll
                for (int j = 0; j < 4; ++j) s += (v[rr][j].x * v[rr][j].x + v[rr][j].y * v[rr][j].y) + (v[rr][j].z * v[rr][j].z + v[rr][j].w * v[rr][j].w);
                const float rs = 1.0f / sqrtf(wave_sum(s) * (1.0f / DM) + EPS);
                bf16_t* hr = H + (size_t)(row0 + r4 + rr) * DM;
#pragma unroll
                for (int j = 0; j < 4; ++j) { v[rr][j] = v[rr][j] * rs * ca[j] + cb[j]; u32x2 w; w.x = pk2(v[rr][j].x, v[rr][j].y); w.y = pk2(v[rr][j].z, v[rr][j].w); *(u32x2*)(hr + 4 * lane + 256 * j) = w; } }
            int wl_off = lane * 16; asm volatile("" : "+v"(wl_off));
            const LAS f32x4* WLp = (const LAS f32x4*)(lds + wl_off);
            f32x2 lg2[20];
#pragma unroll
            for (int i = 0; i < 20; ++i) lg2[i] = (f32x2){0.f, 0.f};
#pragma unroll
            for (int j = 0; j < 4; ++j)
#pragma unroll
                for (int e = 0; e < 4; ++e) { const f32x2 hv = (f32x2){v[0][j][e], v[1][j][e]};
#pragma unroll
                    for (int q = 0; q < 5; ++q) { const f32x4 w = WLp[((j * 4 + e) * 5 + q) * 64];
                        lg2[4 * q] += hv * w.x; lg2[4 * q + 1] += hv * w.y; lg2[4 * q + 2] += hv * w.z; lg2[4 * q + 3] += hv * w.w; } }
            float lg[2][20];
#pragma unroll
            for (int i = 0; i < 20; ++i) { lg[0][i] = lg2[i].x; lg[1][i] = lg2[i].y; }
#pragma unroll
            for (int rr = 0; rr < 2; ++rr) {
#pragma unroll
                for (int i = 0; i < 20; ++i) lg[rr][i] = wave_sum(lg[rr][i]);
                int g = 0; float gm = lg[rr][0];
#pragma unroll
                for (int i = 1; i < 4; ++i) if (lg[rr][i] > gm) { gm = lg[rr][i]; g = i; }
                float gs = 0.f;
#pragma unroll
                for (int i = 0; i < 4; ++i) gs += expf(lg[rr][i] - gm);
                const float gprob = 1.0f / gs;
                float el[4];
#pragma unroll
                for (int i = 0; i < 4; ++i) el[i] = g == 0 ? lg[rr][4 + i] : g == 1 ? lg[rr][8 + i] : g == 2 ? lg[rr][12 + i] : lg[rr][16 + i];
                int i0 = 0; float m0 = el[0];
#pragma unroll
                for (int i = 1; i < 4; ++i) if (el[i] > m0) { m0 = el[i]; i0 = i; }
                int i1 = -1; float m1 = 0.f;
#pragma unroll
                for (int i = 0; i < 4; ++i) if (i != i0 && (i1 < 0 || el[i] > m1)) { m1 = el[i]; i1 = i; }
                const float ex = expf(m1 - m0), w0 = 1.0f / (1.0f + ex), w1 = ex * w0;
                const int ea = i0 < i1 ? i0 : i1, eb = i0 < i1 ? i1 : i0; const float wa = (i0 < i1 ? w0 : w1) * gprob, wb = (i0 < i1 ? w1 : w0) * gprob;
                const int bucket = g * 6 + (ea * (7 - ea)) / 2 + (eb - ea - 1);
                if (lane == r4 + rr) { mybucket = bucket; mywa = wa; mywb = wb; }
                asm volatile("" ::: "memory");
            }
        }
        if (lane < 16) { const unsigned p = atomicAdd(cnt + mybucket, 1u); list[mybucket * T + p] = row0 + lane; wts[mybucket * T + p] = (f32x2){mywa, mywb}; }
    }
}

struct GUnit { const bf16_t* A; const int* aidx; int nvalid; const bf16_t* B0; const bf16_t* B1; int pm, pn, lbase; };
namespace pg8 {
constexpr int BM = 256, BK = 64, HALF = 128, HTB = HALF * BK * 2, STAGE_BYTES = 8 * HTB;
DI int lds_byte(int r, int c) { const int st = (r >> 4) * 2 + (c >> 5), rr = r & 15, cc = c & 31, ob = rr * 64 + cc * 2; return st * 1024 + (ob ^ (((ob >> 9) & 1) << 5)); }
DI void stage_rc(int b, int& R, int& C) { const int st = b / 1024, sb = b % 1024, swz = sb ^ (((sb >> 9) & 1) << 5); R = (st >> 1) * 16 + swz / 64; C = (st & 1) * 32 + (swz % 64) / 2; }
DI int perm32(int rho) { const int n = rho >> 4, i = rho & 15; return 8 * (i >> 2) + 4 * n + (i & 3); }
DI void a_offsets(const GUnit& u, int K, int tid_, unsigned (&vo)[2][2]) {
    asm volatile("" : "+v"(tid_));
#pragma unroll
    for (int i = 0; i < 2; ++i) { int R, C; stage_rc(tid_ * 16 + i * 8192, R, C);
#pragma unroll
        for (int h = 0; h < 2; ++h) { const int r = h * HALF + R; const int gr = u.aidx ? u.aidx[r < u.nvalid ? r : 0] : r; vo[h][i] = ((unsigned)gr * (unsigned)K + (unsigned)C) * 2u; } }
}
template <class Sched, class Epi, bool ALIGN_EPI, int K, int ldb, int nsplit>
DI void gemm_phase(LAS unsigned char* lds, const Sched& S, const Epi& E) {
    int tid = threadIdx.x; asm volatile("" : "+v"(tid));
    const int wid = __builtin_amdgcn_readfirstlane(tid >> 6), lane = tid & 63, wr = wid >> 2, wc = wid & 3, fr = lane & 15, fq = lane >> 4;
    const int nt = K / BK;
    unsigned voffB[2];
#pragma unroll
    for (int i = 0; i < 2; ++i) { int R, C; stage_rc(tid * 16 + i * 8192, R, C); const int Rb = (R & ~31) + perm32(R & 31); voffB[i] = ((unsigned)Rb * (unsigned)ldb + (unsigned)C) * 2u; }
    const size_t hB = (size_t)HALF * ldb * 2;
    const unsigned ldsw = (unsigned)wid * 1024u;
    const int aoff = lds_byte(wr * 64 + fr, fq * 8), boff = lds_byte(wc * 32 + fr, fq * 8);
#define PG8_SA(b, h) (((b) * 2 + (h)) * HTB)
#define PG8_SB(b, h) ((4 + (b) * 2 + (h)) * HTB)
#define PG8_STAGE(bufoff, gbase, voff) do { _Pragma("unroll") for (int _i = 0; _i < 2; ++_i) \
        __builtin_amdgcn_global_load_lds((const unsigned*)((const char*)(gbase) + (voff)[_i]), (LAS unsigned*)(lds + (bufoff) + ldsw + _i * 8192), 16, 0, 0); } while (0)
#define PG8_LDA(dst, b, h) do { _Pragma("unroll") for (int m = 0; m < 4; ++m) _Pragma("unroll") for (int k = 0; k < 2; ++k) dst[m][k] = *(const LAS bf16x8*)(lds + PG8_SA(b, h) + aoff + m * 2048 + k * 1024); } while (0)
#define PG8_LDB(dst, b, h) do { _Pragma("unroll") for (int n = 0; n < 2; ++n) _Pragma("unroll") for (int k = 0; k < 2; ++k) dst[n][k] = *(const LAS bf16x8*)(lds + PG8_SB(b, h) + boff + n * 2048 + k * 1024); } while (0)
#define PG8_MMA(ai, bj, At, Bt) do { __builtin_amdgcn_s_setprio(1); _Pragma("unroll") for (int m = 0; m < 4; ++m) _Pragma("unroll") for (int n = 0; n < 2; ++n) _Pragma("unroll") for (int k = 0; k < 2; ++k) \
        acc[ai][bj][m][n] = __builtin_amdgcn_mfma_f32_16x16x32_bf16(Bt[n][k], At[m][k], acc[ai][bj][m][n], 0, 0, 0); __builtin_amdgcn_s_setprio(0); } while (0)
#define PG8_WAIT_V(n) asm volatile("s_waitcnt vmcnt(" #n ")" ::: "memory")
#define PG8_WAIT_L(n) asm volatile("s_waitcnt lgkmcnt(" #n ")" ::: "memory")
#define PG8_BAR __builtin_amdgcn_s_barrier()
#define PG8_SCHED __builtin_amdgcn_sched_barrier(0)
#define PG8_AK(u, kt) ((const char*)(u).A + (size_t)(kt) * (BK * 2))
#define PG8_BK(u, kt) ((kt) < nsplit ? (const char*)(u).B0 + (size_t)(kt) * (BK * 2) : (const char*)(u).B1 + (size_t)((kt) - nsplit) * (BK * 2))
    GUnit cur, nxt; int ui = 0;
    if (!S.next(0, cur)) return;
    f32x4 acc[2][2][4][2];
#pragma unroll
    for (int a = 0; a < 2; ++a)
#pragma unroll
        for (int b = 0; b < 2; ++b)
#pragma unroll
            for (int m = 0; m < 4; ++m)
#pragma unroll
                for (int n = 0; n < 2; ++n) acc[a][b][m][n] = (f32x4){0.f, 0.f, 0.f, 0.f};
    bf16x8 At[4][2], B0[2][2], B1[2][2];
    unsigned voffA[2][2];
    a_offsets(cur, K, tid, voffA);
    {
        const char* a0 = PG8_AK(cur, 0); const char* b0 = PG8_BK(cur, 0); const char* a1 = PG8_AK(cur, 1); const char* b1 = PG8_BK(cur, 1);
        PG8_STAGE(PG8_SB(0, 0), b0, voffB); PG8_STAGE(PG8_SB(0, 1), b0 + hB, voffB); PG8_STAGE(PG8_SA(0, 0), a0, voffA[0]); PG8_STAGE(PG8_SA(0, 1), a0, voffA[1]);
        if (wr == 1) PG8_BAR;
        PG8_WAIT_V(2); PG8_BAR;
        PG8_STAGE(PG8_SB(1, 0), b1, voffB); PG8_STAGE(PG8_SA(1, 0), a1, voffA[0]); PG8_STAGE(PG8_SB(1, 1), b1 + hB, voffB);
        PG8_WAIT_V(6); PG8_BAR;
    }
    for (;;) {
        const bool has_next = S.next(ui + 1, nxt);
        if (!has_next) nxt = cur;
        for (int t = 0; t < nt; t += 2) {
            const bool last = (t == nt - 2);
            const char* a1 = PG8_AK(cur, t + 1);
            const char* a2 = last ? PG8_AK(nxt, 0) : PG8_AK(cur, t + 2); const char* b2 = last ? PG8_BK(nxt, 0) : PG8_BK(cur, t + 2);
            const char* a3 = last ? PG8_AK(nxt, 1) : PG8_AK(cur, t + 3); const char* b3 = last ? PG8_BK(nxt, 1) : PG8_BK(cur, t + 3);
            PG8_LDB(B0, 0, 0); PG8_LDB(B1, 0, 1); PG8_SCHED; PG8_LDA(At, 0, 0); PG8_STAGE(PG8_SA(1, 1), a1, voffA[1]);
            if (last) a_offsets(nxt, K, tid, voffA);
            PG8_WAIT_V(8); PG8_WAIT_L(0); PG8_BAR; PG8_MMA(0, 0, At, B0); PG8_MMA(0, 1, At, B1); PG8_BAR; PG8_SCHED;
            PG8_LDA(At, 0, 1); PG8_STAGE(PG8_SB(0, 0), b2, voffB); PG8_STAGE(PG8_SB(0, 1), b2 + hB, voffB); PG8_STAGE(PG8_SA(0, 0), a2, voffA[0]);
            PG8_WAIT_V(8); PG8_WAIT_L(0); PG8_BAR; PG8_MMA(1, 0, At, B0); PG8_MMA(1, 1, At, B1); PG8_BAR; PG8_SCHED;
            PG8_LDB(B0, 1, 0); PG8_LDB(B1, 1, 1); PG8_SCHED; PG8_LDA(At, 1, 0); PG8_STAGE(PG8_SA(0, 1), a2, voffA[1]);
            PG8_WAIT_V(8); PG8_WAIT_L(0); PG8_BAR; PG8_MMA(0, 0, At, B0); PG8_MMA(0, 1, At, B1); PG8_BAR; PG8_SCHED;
            PG8_LDA(At, 1, 1); PG8_STAGE(PG8_SB(1, 0), b3, voffB); PG8_STAGE(PG8_SB(1, 1), b3 + hB, voffB); PG8_STAGE(PG8_SA(1, 0), a3, voffA[0]);
            PG8_WAIT_V(8); PG8_WAIT_L(0); PG8_BAR; PG8_MMA(1, 0, At, B0); PG8_MMA(1, 1, At, B1); PG8_BAR; PG8_SCHED;
        }
        if constexpr (ALIGN_EPI) { if (wr == 0) PG8_BAR; }
        E(acc, cur, wr, wc, fr, fq);
        if (!has_next) break;
#pragma unroll
        for (int a = 0; a < 2; ++a)
#pragma unroll
            for (int b = 0; b < 2; ++b)
#pragma unroll
                for (int m = 0; m < 4; ++m)
#pragma unroll
                    for (int n = 0; n < 2; ++n) acc[a][b][m][n] = (f32x4){0.f, 0.f, 0.f, 0.f};
        cur = nxt; ++ui;
        if constexpr (ALIGN_EPI) { if (wr == 1) PG8_BAR; }
    }
    PG8_WAIT_V(0);
    if constexpr (!ALIGN_EPI) { if (wr == 0) PG8_BAR; }
    PG8_BAR;
#undef PG8_SA
#undef PG8_SB
#undef PG8_STAGE
#undef PG8_LDA
#undef PG8_LDB
#undef PG8_MMA
#undef PG8_WAIT_V
#undef PG8_WAIT_L
#undef PG8_BAR
#undef PG8_SCHED
#undef PG8_AK
#undef PG8_BK
}
}
struct DenseSched {
    const bf16_t* A; const bf16_t* Bt; int K, nM, nN;
    DI bool next(int i, GUnit& u) const {
        const int nwg = nM * nN; const long L = (long)i * (int)gridDim.x + (int)blockIdx.x; if (L >= nwg) return false;
        int wgid = (int)L; { const int q = nwg / 8, r = nwg % 8, xcd = wgid % 8, off = wgid / 8; wgid = (xcd < r ? xcd * (q + 1) : r * (q + 1) + (xcd - r) * q) + off; }
        const int nig = 8 * nN, gid = wgid / nig, fm = gid * 8, gsz = (nM - fm) < 8 ? (nM - fm) : 8;
        u.pm = fm + ((wgid % nig) % gsz); u.pn = (wgid % nig) / gsz;
        u.A = A + (size_t)u.pm * 256 * K; u.aidx = nullptr; u.nvalid = 256; u.B0 = Bt + (size_t)u.pn * 256 * K; u.B1 = u.B0; u.lbase = 0; return true; }
};
template <int NT, bool up> struct MoeSched {
    const LAS int* tstart; const unsigned* cnt; const int* list; const bf16_t* A; const bf16_t* W;
    DI bool next(int i, GUnit& u) const {
        const int ntile = __builtin_amdgcn_readfirstlane(tstart[NBUCKET]), nwg = ntile * NT; const int L0 = i * (int)gridDim.x + (int)blockIdx.x; if (L0 >= nwg) return false;
        int L = L0; { const int q = nwg / 8, r = nwg % 8, xcd = L0 % 8, off = L0 / 8; L = (xcd < r ? xcd * (q + 1) : r * (q + 1) + (xcd - r) * q) + off; }
        const int ti = L / NT, pn = L % NT; int b = 0;
        for (int q = 1; q < NBUCKET; ++q) if (__builtin_amdgcn_readfirstlane(tstart[q]) <= ti) b = q;
        const int rt = ti - __builtin_amdgcn_readfirstlane(tstart[b]); const int g = b / 6, p = b % 6; const int ea = 4 * g + (p < 3 ? 0 : (p < 5 ? 1 : 2)), eb = 4 * g + (p < 3 ? p + 1 : (p < 5 ? p - 1 : 3));
        u.pm = ti; u.pn = pn; u.lbase = b * T + rt * 256; const int nv = __builtin_amdgcn_readfirstlane((int)cnt[b]) - rt * 256; u.nvalid = nv < 256 ? nv : 256;
        if (up) { u.A = A; u.aidx = list + u.lbase; const int e = pn < 4 ? ea : eb; u.B0 = W + (size_t)e * 1024 * 1024 + (size_t)(pn & 3) * 256 * 1024; u.B1 = u.B0; }
        else { u.A = A + (size_t)ti * 256 * 1024; u.aidx = nullptr; u.B0 = W + (size_t)ea * 1024 * 512 + (size_t)pn * 256 * 512; u.B1 = W + (size_t)eb * 1024 * 512 + (size_t)pn * 256 * 512; }
        return true;
    }
};

DI u32x4 pack8(const f32x4 v0, const f32x4 v1) { u32x4 w; w.x = pk2(v0[0], v0[1]); w.y = pk2(v0[2], v0[3]); w.z = pk2(v1[0], v1[1]); w.w = pk2(v1[2], v1[3]); return w; }
struct EpiProj {
    bf16_t *qsb, *vtsb, *qsw, *ksw, *vtsw; const float *cosT, *sinT;
    DI void operator()(const f32x4 (&acc)[2][2][4][2], const GUnit& u, int wr, int wc, int fr, int fq) const {
        const int pn = u.pn, rowb = u.pm * 256 + wr * 64 + fr;
        if (pn < 4) {
            bf16_t* base = qsb + (size_t)(pn >> 1) * ((WS_KSB - WS_QSB) / 2); const float sc = pn < 2 ? QSCALE : 1.0f; const int colt = (pn & 1) * 256 + wc * 32 + 8 * fq;
#pragma unroll
            for (int ai = 0; ai < 2; ++ai)
#pragma unroll
                for (int m = 0; m < 4; ++m) { const size_t row = rowb + ai * 128 + m * 16;
#pragma unroll
                    for (int bj = 0; bj < 2; ++bj) *(u32x4*)(base + row * 512 + colt + bj * 128) = pack8(acc[ai][bj][m][0] * sc, acc[ai][bj][m][1] * sc); }
        } else if (pn < 6 || (pn == 8 && wc >= 2)) {
            bf16_t* base = pn < 6 ? vtsb + (size_t)((pn - 4) * 256 + wc * 32 + 8 * fq) * T : vtsw + (size_t)((wc * 32 - 64) + 8 * fq) * T; const size_t bjs = pn < 6 ? (size_t)128 * T : (size_t)64 * T;
#pragma unroll
            for (int ai = 0; ai < 2; ++ai)
#pragma unroll
                for (int m = 0; m < 4; ++m) { const size_t row = rowb + ai * 128 + m * 16;
#pragma unroll
                    for (int bj = 0; bj < 2; ++bj)
#pragma unroll
                        for (int n = 0; n < 2; ++n)
#pragma unroll
                            for (int j = 0; j < 4; ++j) base[bj * bjs + (size_t)(4 * n + j) * T + row] = (bf16_t)f2bf(acc[ai][bj][m][n][j]); }
        } else {
            const bool isq = pn < 8; bf16_t* base = isq ? qsw : ksw; const int pitch = isq ? 512 : 128; const int head = isq ? (pn - 6) * 4 + wc : wc; const float sc = isq ? QSCALE : 1.0f;
#pragma unroll
            for (int ai = 0; ai < 2; ++ai)
#pragma unroll
                for (int m = 0; m < 4; ++m) { const size_t row = rowb + ai * 128 + m * 16;
                    const f32x4 c0 = *(const f32x4*)(cosT + row * 32 + 8 * fq), c1 = *(const f32x4*)(cosT + row * 32 + 8 * fq + 4);
                    const f32x4 s0 = *(const f32x4*)(sinT + row * 32 + 8 * fq), s1 = *(const f32x4*)(sinT + row * 32 + 8 * fq + 4);
                    const f32x4 x10 = acc[ai][0][m][0], x11 = acc[ai][0][m][1], x20 = acc[ai][1][m][0], x21 = acc[ai][1][m][1];
                    const f32x4 o10 = (x10 * c0 - x20 * s0) * sc, o11 = (x11 * c1 - x21 * s1) * sc, o20 = (x20 * c0 + x10 * s0) * sc, o21 = (x21 * c1 + x11 * s1) * sc;
                    *(u32x4*)(base + row * pitch + head * 64 + 8 * fq) = pack8(o10, o11); *(u32x4*)(base + row * pitch + head * 64 + 32 + 8 * fq) = pack8(o20, o21); }
        }
    }
};
struct EpiWout {
    const float* x; const float* mod; float* out;
    DI void operator()(const f32x4 (&acc)[2][2][4][2], const GUnit& u, int wr, int wc, int fr, int fq) const {
        const int rowb = u.pm * 256 + wr * 64 + fr, colb = u.pn * 256 + wc * 32 + 8 * fq; const int b = (u.pm * 256) / SEQ;
        f32x4 gt[2][2];
#pragma unroll
        for (int bj = 0; bj < 2; ++bj)
#pragma unroll
            for (int n = 0; n < 2; ++n) gt[bj][n] = *(const f32x4*)(mod + b * 6144 + 2048 + colb + bj * 128 + 4 * n);
#pragma unroll
        for (int ai = 0; ai < 2; ++ai)
#pragma unroll
            for (int m = 0; m < 4; ++m) { const size_t off = (size_t)(rowb + ai * 128 + m * 16) * DM + colb;
#pragma unroll
                for (int bj = 0; bj < 2; ++bj)
#pragma unroll
                    for (int n = 0; n < 2; ++n) { const f32x4 xv = *(const f32x4*)(x + off + bj * 128 + 4 * n); *(f32x4*)(out + off + bj * 128 + 4 * n) = xv + gt[bj][n] * acc[ai][bj][m][n]; } }
    }
};
DI f32x4 swiglu4(const f32x4 g, const f32x4 uu, float w) { f32x4 o;
#pragma unroll
    for (int j = 0; j < 4; ++j) o[j] = w * uu[j] * g[j] / (1.0f + __expf(-g[j]));
    return o; }
struct EpiUp {
    bf16_t* hid; const f32x2* wts;
    DI void operator()(const f32x4 (&acc)[2][2][4][2], const GUnit& u, int wr, int wc, int fr, int fq) const {
        const int hc = (u.pn >> 2) * 512 + (u.pn & 3) * 128 + wc * 32 + 8 * fq; const bool second = u.pn >= 4;
#pragma unroll
        for (int ai = 0; ai < 2; ++ai)
#pragma unroll
            for (int m = 0; m < 4; ++m) { const int r = ai * 128 + wr * 64 + m * 16 + fr; float w = 0.f;
                if (r < u.nvalid) { const f32x2 ww = wts[u.lbase + r]; w = second ? ww.y : ww.x; }
                *(u32x4*)(hid + (size_t)(u.pm * 256 + r) * 1024 + hc) = pack8(swiglu4(acc[ai][0][m][0], acc[ai][1][m][0], w), swiglu4(acc[ai][0][m][1], acc[ai][1][m][1], w)); }
    }
};
struct EpiDown {
    const int* list; const float* mod; float* out;
    DI void operator()(const f32x4 (&acc)[2][2][4][2], const GUnit& u, int wr, int wc, int fr, int fq) const {
        const int colb = u.pn * 256 + wc * 32 + 8 * fq; const int* lp = list + u.lbase;
#pragma unroll
        for (int ai = 0; ai < 2; ++ai)
#pragma unroll
            for (int m = 0; m < 4; ++m) { const int r = ai * 128 + wr * 64 + m * 16 + fr;
                if (r < u.nvalid) { const int tok = lp[r]; const float* gp = mod + (tok / SEQ) * 6144 + 5120 + colb; float* op = out + (size_t)tok * DM + colb;
#pragma unroll
                    for (int bj = 0; bj < 2; ++bj) { const f32x4 g0 = *(const f32x4*)(gp + bj * 128), g1 = *(const f32x4*)(gp + bj * 128 + 4); const f32x4 x0 = *(const f32x4*)(op + bj * 128), x1 = *(const f32x4*)(op + bj * 128 + 4);
                        *(f32x4*)(op + bj * 128) = x0 + g0 * acc[ai][bj][m][0]; *(f32x4*)(op + bj * 128 + 4) = x1 + g1 * acc[ai][bj][m][1]; } }
                asm volatile("" ::: "memory"); }
    }
};

typedef float f32x16 __attribute__((ext_vector_type(16)));
#define MFMA32(a, b, c) __builtin_amdgcn_mfma_f32_32x32x16_bf16((a), (b), (c), 0, 0, 0)
DI int pi32(int r) { return (r & ~12) | ((r & 4) << 1) | ((r & 8) >> 1); }
DI int crow(int i, int h) { return (i & 3) + 8 * (i >> 2) + 4 * h; }
template <int S_> DI bf16x8 packacc(const f32x16& x) { u32x4 p; p.x = pk2(x[8 * S_], x[8 * S_ + 1]); p.y = pk2(x[8 * S_ + 2], x[8 * S_ + 3]); p.z = pk2(x[8 * S_ + 4], x[8 * S_ + 5]); p.w = pk2(x[8 * S_ + 6], x[8 * S_ + 7]); return __builtin_bit_cast(bf16x8, p); }
DI f32x16 zero16() { f32x16 z;
#pragma unroll
    for (int i = 0; i < 16; ++i) z[i] = 0.f;
    return z; }
DI void sb_unit(const bf16_t* Q, const bf16_t* K, const bf16_t* VT, int b, int t0, int hd, int lane, f32x16 (&o)[2]) {
    const int r = lane & 31, h = lane >> 5; const size_t gb = (size_t)b * SEQ;
    bf16x8 qf[4];
#pragma unroll
    for (int d0 = 0; d0 < 4; ++d0) qf[d0] = *(const bf16x8*)(Q + (gb + t0 + r) * 512 + hd * 64 + 16 * d0 + 8 * h);
    bf16x8 U0, U1, ones; const int kr = pi32(r);
#pragma unroll
    for (int j = 0; j < 8; ++j) { U0[j] = (8 * h + j > kr) ? (short)0x3F80 : (short)0; U1[j] = (16 + 8 * h + j > kr) ? (short)0x3F80 : (short)0; ones[j] = (short)0x3F80; }
    o[0] = zero16(); o[1] = zero16(); f32x16 C = zero16();
    const bf16_t* kp = K + (gb + pi32(r)) * 512 + hd * 64 + 8 * h;
    const bf16_t* vp = VT + (size_t)(hd * 64 + r) * T + gb + 8 * h;
    const int jd = t0 >> 5;
    bf16x8 kn[4], vn[2][2];
#pragma unroll
    for (int d0 = 0; d0 < 4; ++d0) kn[d0] = *(const bf16x8*)(kp + (size_t)jd * 32 * 512 + 16 * d0);
#pragma unroll
    for (int dt = 0; dt < 2; ++dt)
#pragma unroll
        for (int sx = 0; sx < 2; ++sx) vn[dt][sx] = *(const bf16x8*)(vp + (size_t)dt * 32 * T + 32 * jd + 16 * sx);
    for (int j = jd; j >= 0; --j) {
        bf16x8 kf[4], vf[2][2];
#pragma unroll
        for (int d0 = 0; d0 < 4; ++d0) kf[d0] = kn[d0];
#pragma unroll
        for (int dt = 0; dt < 2; ++dt)
#pragma unroll
            for (int sx = 0; sx < 2; ++sx) vf[dt][sx] = vn[dt][sx];
        if (j > 0) {
#pragma unroll
            for (int d0 = 0; d0 < 4; ++d0) kn[d0] = *(const bf16x8*)(kp + (size_t)(j - 1) * 32 * 512 + 16 * d0);
#pragma unroll
            for (int dt = 0; dt < 2; ++dt)
#pragma unroll
                for (int sx = 0; sx < 2; ++sx) vn[dt][sx] = *(const bf16x8*)(vp + (size_t)dt * 32 * T + 32 * (j - 1) + 16 * sx);
        }
        f32x16 S = zero16();
#pragma unroll
        for (int d0 = 0; d0 < 4; ++d0) S = MFMA32(kf[d0], qf[d0], S);
        const bool diag = (j == jd);
        f32x16 L, lb;
#pragma unroll
        for (int i = 0; i < 16; ++i) { const float z = S[i]; const float e = __builtin_amdgcn_exp2f(-__builtin_fabsf(z)); const float l = __builtin_amdgcn_logf(1.0f + e);
            float Li = __builtin_fminf(-z, 0.f) - l; lb[i] = z + Li;
            if (diag && !(16 * (i >> 3) + 8 * h + (i & 7) < r)) Li = 0.f;
            L[i] = Li; }
        const bf16x8 Lf0 = packacc<0>(L), Lf1 = packacc<1>(L);
        f32x16 W = MFMA32(U0, Lf0, C); W = MFMA32(U1, Lf1, W);
        C = MFMA32(ones, Lf0, C); C = MFMA32(ones, Lf1, C);
        f32x16 P;
#pragma unroll
        for (int i = 0; i < 16; ++i) { float pv = __builtin_amdgcn_exp2f(lb[i] + W[i]); if (diag && !(16 * (i >> 3) + 8 * h + (i & 7) < r)) pv = 0.f; P[i] = pv; }
        const bf16x8 Pf0 = packacc<0>(P), Pf1 = packacc<1>(P);
#pragma unroll
        for (int dt = 0; dt < 2; ++dt) { o[dt] = MFMA32(Pf0, vf[dt][0], o[dt]); o[dt] = MFMA32(Pf1, vf[dt][1], o[dt]); }
        if (__all(C[0] < SB_EXIT)) break;
    }
}
DI void sw_unit(const bf16_t* Q, const bf16_t* K, const bf16_t* VT, float sink2, int b, int t0, int hq, int lane, f32x16 (&o)[2], float& lsum) {
    const int r = lane & 31, h = lane >> 5, kvh = hq >> 2, a = t0 >> 5; const size_t gb = (size_t)b * SEQ;
    bf16x8 qf[4];
#pragma unroll
    for (int d0 = 0; d0 < 4; ++d0) qf[d0] = *(const bf16x8*)(Q + (gb + t0 + r) * 512 + hq * 64 + 16 * d0 + 8 * h);
    const bf16_t* kp = K + (gb + pi32(r)) * 128 + kvh * 64 + 8 * h;
    const bf16_t* vp = VT + (size_t)(kvh * 64 + r) * T + gb + 8 * h;
    f32x16 S[5]; float m = sink2;
    bf16x8 kf[5][4];
#pragma unroll
    for (int jj = 0; jj < 5; ++jj) { const int j = a - 4 + jj;
        if (j >= 0) {
#pragma unroll
            for (int d0 = 0; d0 < 4; ++d0) kf[jj][d0] = *(const bf16x8*)(kp + (size_t)j * 32 * 128 + 16 * d0); } }
#pragma unroll
    for (int jj = 0; jj < 5; ++jj) { const int j = a - 4 + jj;
        if (j >= 0) {
            f32x16 s = zero16();
#pragma unroll
            for (int d0 = 0; d0 < 4; ++d0) s = MFMA32(kf[jj][d0], qf[d0], s);
#pragma unroll
            for (int i = 0; i < 16; ++i) { const int ko = 16 * (i >> 3) + 8 * h + (i & 7); float v = s[i];
                if (jj == 4 && ko > r) v = -1e30f;
                if (jj == 0 && ko <= r) v = -1e30f;
                s[i] = v; m = __builtin_fmaxf(m, v); }
            S[jj] = s; }
        else {
#pragma unroll
            for (int i = 0; i < 16; ++i) S[jj][i] = -1e30f; } }
    m = __builtin_fmaxf(m, __shfl_xor(m, 32));
    o[0] = zero16(); o[1] = zero16(); float ls = 0.f;
    bf16x8 vn[2][2];
    { const int j0 = a - 4 < 0 ? 0 : a - 4;
#pragma unroll
      for (int dt = 0; dt < 2; ++dt)
#pragma unroll
        for (int sx = 0; sx < 2; ++sx) vn[dt][sx] = *(const bf16x8*)(vp + (size_t)dt * 32 * T + 32 * j0 + 16 * sx); }
#pragma unroll
    for (int jj = 0; jj < 5; ++jj) { const int j = a - 4 + jj;
        if (j >= 0) { bf16x8 vf[2][2];
#pragma unroll
            for (int dt = 0; dt < 2; ++dt)
#pragma unroll
                for (int sx = 0; sx < 2; ++sx) vf[dt][sx] = vn[dt][sx];
            if (jj < 4) {
#pragma unroll
                for (int dt = 0; dt < 2; ++dt)
#pragma unroll
                    for (int sx = 0; sx < 2; ++sx) vn[dt][sx] = *(const bf16x8*)(vp + (size_t)dt * 32 * T + 32 * (j + 1) + 16 * sx); }
            f32x16 P;
#pragma unroll
            for (int i = 0; i < 16; ++i) { P[i] = __builtin_amdgcn_exp2f(S[jj][i] - m); ls += P[i]; }
            const bf16x8 Pf0 = packacc<0>(P), Pf1 = packacc<1>(P);
#pragma unroll
            for (int dt = 0; dt < 2; ++dt) { o[dt] = MFMA32(Pf0, vf[dt][0], o[dt]); o[dt] = MFMA32(Pf1, vf[dt][1], o[dt]); } } }
    ls += __shfl_xor(ls, 32);
    lsum = ls + __builtin_amdgcn_exp2f(sink2 - m);
}
constexpr int ATT_STG = 33 * 68;
constexpr int ATT_EX = NWAVES * ATT_STG * 4;
constexpr int NATT_TASKS = T / 32;
DI void p3_attention(const Args& a, LAS unsigned char* lds, int tid, int lane, int wave) {
    const bf16_t* QSB = (const bf16_t*)(a.ws + WS_QSB); const bf16_t* KSB = (const bf16_t*)(a.ws + WS_KSB); const bf16_t* VTSB = (const bf16_t*)(a.ws + WS_VSB);
    const bf16_t* QSW = (const bf16_t*)(a.ws + WS_QSW); const bf16_t* KSW = (const bf16_t*)(a.ws + WS_KSW); const bf16_t* VTSW = (const bf16_t*)(a.ws + WS_VSW);
    bf16_t* MIX = (bf16_t*)(a.ws + WS_MIX); unsigned* qctr = (unsigned*)(a.ws + WS_CTL) + CW_ATTNQ;
    LAS float* stg = (LAS float*)lds + wave * ATT_STG; LAS float* ex = (LAS float*)(lds + ATT_EX); LAS int* slot = (LAS int*)(lds + ATT_EX + 4096);
    const int r = lane & 31, h = lane >> 5, row = lane >> 1, hf = lane & 1;
    const float sink2 = a.sinks[wave] * LOG2E;
    int par = 0;
    for (;;) {
        __syncthreads();
        if (tid == 0) *slot = (int)atomicAdd(qctr, 1u);
        __syncthreads();
        const int task = __builtin_amdgcn_readfirstlane(*slot); if (task >= NATT_TASKS) break;
        const int b = task / (SEQ / 32), t0 = (task % (SEQ / 32)) * 32;
        f32x16 o[2]; float sbv[32], swv[32];
        sb_unit(QSB, KSB, VTSB, b, t0, wave, lane, o);
#pragma unroll
        for (int dt = 0; dt < 2; ++dt)
#pragma unroll
            for (int i = 0; i < 16; ++i) stg[crow(i, h) * 68 + 32 * dt + r] = o[dt][i];
        LDS_WAIT();
        float ss = 0.f;
#pragma unroll
        for (int k = 0; k < 8; ++k) { const f32x4 v = *(const LAS f32x4*)(stg + row * 68 + hf * 32 + 4 * k); sbv[4 * k] = v.x; sbv[4 * k + 1] = v.y; sbv[4 * k + 2] = v.z; sbv[4 * k + 3] = v.w; ss += (v.x * v.x + v.y * v.y) + (v.z * v.z + v.w * v.w); }
        ss += __shfl_xor(ss, 1);
        if (hf == 0) ex[par * 512 + row * 8 + wave] = ss;
        LDS_WAIT();
        float lsum;
        sw_unit(QSW, KSW, VTSW, sink2, b, t0, wave, lane, o, lsum);
#pragma unroll
        for (int dt = 0; dt < 2; ++dt)
#pragma unroll
            for (int i = 0; i < 16; ++i) stg[crow(i, h) * 68 + 32 * dt + r] = o[dt][i];
        if (h == 0) stg[32 * 68 + r] = lsum;
        LDS_WAIT();
        const float il = 1.0f / stg[32 * 68 + row]; float s2 = 0.f;
#pragma unroll
        for (int k = 0; k < 8; ++k) { const f32x4 v = *(const LAS f32x4*)(stg + row * 68 + hf * 32 + 4 * k) * il; swv[4 * k] = v.x; swv[4 * k + 1] = v.y; swv[4 * k + 2] = v.z; swv[4 * k + 3] = v.w; s2 += (v.x * v.x + v.y * v.y) + (v.z * v.z + v.w * v.w); }
        s2 += __shfl_xor(s2, 1);
        if (hf == 0) ex[par * 512 + 256 + row * 8 + wave] = s2;
        LDS_WAIT();
        __syncthreads();
        float tsb = 0.f, tsw = 0.f;
#pragma unroll
        for (int w = 0; w < 8; ++w) { tsb += ex[par * 512 + row * 8 + w]; tsw += ex[par * 512 + 256 + row * 8 + w]; }
        const float rsb = 1.0f / sqrtf(tsb * (1.0f / 512.0f) + EPS), rsw = 1.0f / sqrtf(tsw * (1.0f / 512.0f) + EPS);
        bf16_t* mrow = MIX + ((size_t)b * SEQ + t0 + row) * 1024 + wave * 64 + hf * 32;
#pragma unroll
        for (int k = 0; k < 4; ++k) { u32x4 w; w.x = pk2(sbv[8 * k] * rsb, sbv[8 * k + 1] * rsb); w.y = pk2(sbv[8 * k + 2] * rsb, sbv[8 * k + 3] * rsb); w.z = pk2(sbv[8 * k + 4] * rsb, sbv[8 * k + 5] * rsb); w.w = pk2(sbv[8 * k + 6] * rsb, sbv[8 * k + 7] * rsb); *(u32x4*)(mrow + 8 * k) = w; }
#pragma unroll
        for (int k = 0; k < 4; ++k) { u32x4 w; w.x = pk2(swv[8 * k] * rsw, swv[8 * k + 1] * rsw); w.y = pk2(swv[8 * k + 2] * rsw, swv[8 * k + 3] * rsw); w.z = pk2(swv[8 * k + 4] * rsw, swv[8 * k + 5] * rsw); w.w = pk2(swv[8 * k + 6] * rsw, swv[8 * k + 7] * rsw); *(u32x4*)(mrow + 512 + 8 * k) = w; }
        par ^= 1;
    }
}

#define XB_TMO      128
#define XB_XCNT(j)  (256  + 64 * (j))
#define XB_XSUB(j)  (1280 + 64 * (j))
#define XB_XGEN(j)  (2304 + 64 * (j))
#define XB_TOP      3328
#define XB_TOPGEN   3392
#define XCD_BAR_WORDS 3456
#define XB_SPIN_CAP (1u << 18)
DI unsigned xb_ld(unsigned* p)              { return __hip_atomic_load(p, __ATOMIC_RELAXED, __HIP_MEMORY_SCOPE_AGENT); }
DI unsigned xb_add(unsigned* p, unsigned v) { return __hip_atomic_fetch_add(p, v, __ATOMIC_RELAXED, __HIP_MEMORY_SCOPE_AGENT); }
DI unsigned xb_xcc_id() { return (unsigned)__builtin_amdgcn_s_getreg((3 << 11) | 20) & 0xFu; }
#define XB_SPIN(cond, bar) do { unsigned _sp = 0; while (cond) { __builtin_amdgcn_s_sleep(1); \
    if ((++_sp & 255u) == 0u) { if (xb_ld(&(bar)[XB_TMO])) break; if (_sp > XB_SPIN_CAP) { atomicAdd(&(bar)[XB_TMO], 1u); break; } } } } while (0)
struct XcdBarrier { unsigned* bar; unsigned x; volatile LAS unsigned* st; };
DI XcdBarrier xcd_barrier_post(unsigned* bar, volatile LAS unsigned* st) {
    XcdBarrier b; b.bar = bar; b.x = xb_xcc_id(); b.st = st;
    if (threadIdx.x == 0) (void)xb_add(&bar[XB_XCNT(b.x)], 1u);
    return b;
}
DI void xcd_barrier_complete(unsigned* bar, unsigned x, unsigned& nloc, unsigned& nx) {
    const unsigned G = gridDim.x * gridDim.y * gridDim.z;
    unsigned sum, cnt, mine, sp = 0u;
    for (;;) {
        sum = 0u; cnt = 0u; mine = 0u;
#pragma unroll
        for (unsigned j = 0; j < 16; ++j) { const unsigned c = xb_ld(&bar[XB_XCNT(j)]); sum += c; cnt += (c > 0u) ? 1u : 0u; mine = (j == x) ? c : mine; }
        if (sum == G) break;
        __builtin_amdgcn_s_sleep(1);
        if ((++sp & 255u) == 0u) { if (xb_ld(&bar[XB_TMO])) break; if (sp > XB_SPIN_CAP) { atomicAdd(&bar[XB_TMO], 1u); break; } }
    }
    nloc = mine > 0u ? mine : 1u; nx = cnt > 0u ? cnt : 1u;
}
DI void xcd_barrier(const XcdBarrier& b) {
    asm volatile("s_waitcnt vmcnt(0)" ::: "memory");
    __syncthreads();
    if (threadIdx.x == 0) {
        unsigned* bar = b.bar;
        __builtin_amdgcn_s_waitcnt(0);
        unsigned nloc = b.st[0], nx = b.st[1];
        if (nloc == 0u) { xcd_barrier_complete(bar, b.x, nloc, nx); b.st[0] = nloc; b.st[1] = nx; }
        const unsigned old = xb_add(&bar[XB_XSUB(b.x)], 1u);
        const unsigned gen = old / nloc;
        if (old + 1u == (gen + 1u) * nloc) {
            __builtin_amdgcn_fence(__ATOMIC_RELEASE, "agent");
            asm volatile("s_waitcnt vmcnt(0)" ::: "memory");
            const unsigned og = xb_add(&bar[XB_TOP], 1u);
            const unsigned tg = og / nx;
            if (og + 1u == (tg + 1u) * nx) xb_add(&bar[XB_TOPGEN], 1u);
            else XB_SPIN(xb_ld(&bar[XB_TOPGEN]) == tg, bar);
            __builtin_amdgcn_fence(__ATOMIC_ACQUIRE, "agent");
            xb_add(&bar[XB_XGEN(b.x)], 1u);
            asm volatile("s_waitcnt vmcnt(0)" ::: "memory");
        } else {
            XB_SPIN(xb_ld(&bar[XB_XGEN(b.x)]) == gen, bar);
            __builtin_amdgcn_fence(__ATOMIC_ACQUIRE, "agent");
            asm volatile("s_waitcnt vmcnt(0)" ::: "memory");
        }
    }
    __syncthreads();
}

__global__ void __launch_bounds__(NTHREADS, 2) mk_fwd(Args a) {
    extern __shared__ __attribute__((aligned(16))) unsigned char lds_raw[];
    LAS unsigned char* lds = (LAS unsigned char*)lds_raw;
    const int tid = threadIdx.x, lane = tid & 63, wave = __builtin_amdgcn_readfirstlane(tid >> 6);
    volatile LAS unsigned* misc = (volatile LAS unsigned*)(lds + LDS_MISC);
    if (tid < 2) misc[tid] = 0u;
    __syncthreads();
    const XcdBarrier gbar = xcd_barrier_post((unsigned*)(a.ws + WS_CTL) + CW_BAR, misc);
    unsigned char* ws = a.ws;
    const float* mod = (const float*)(ws + WS_MOD);

    p0_prologue(a, lds, tid, lane, wave);
    xcd_barrier(gbar);
    p1_norm(a, lane, wave);
    xcd_barrier(gbar);
    {
        DenseSched S{(const bf16_t*)(ws + WS_H), (const bf16_t*)(ws + WS_WIN), 1024, T / 256, DIN / 256};
        EpiProj E{(bf16_t*)(ws + WS_QSB), (bf16_t*)(ws + WS_VSB), (bf16_t*)(ws + WS_QSW), (bf16_t*)(ws + WS_KSW), (bf16_t*)(ws + WS_VSW), (const float*)(ws + WS_COS), (const float*)(ws + WS_SIN)};
        pg8::gemm_phase<DenseSched, EpiProj, true, 1024, 1024, 16>(lds, S, E);
    }
    xcd_barrier(gbar);
    p3_attention(a, lds, tid, lane, wave);
    xcd_barrier(gbar);
    {
        DenseSched S{(const bf16_t*)(ws + WS_MIX), (const bf16_t*)(ws + WS_WOUT), 1024, T / 256, DM / 256};
        EpiWout E{a.x, mod, a.out};
        pg8::gemm_phase<DenseSched, EpiWout, true, 1024, 1024, 16>(lds, S, E);
    }
    xcd_barrier(gbar);
    p5_router(a, lds, tid, lane, wave);
    xcd_barrier(gbar);
    LAS int* tstart = (LAS int*)(lds + pg8::STAGE_BYTES);
    const unsigned* cnt = (const unsigned*)(ws + WS_CTL) + CW_CNT;
    if (tid == 0) { int run = 0; for (int b = 0; b < NBUCKET; ++b) { tstart[b] = run; run += ((int)cnt[b] + 255) >> 8; } tstart[NBUCKET] = run; }
    __syncthreads();
    {
        MoeSched<8, true> S{tstart, cnt, (const int*)(ws + WS_LIST), (const bf16_t*)(ws + WS_H), (const bf16_t*)(ws + WS_WGU)};
        EpiUp E{(bf16_t*)(ws + WS_HID), (const f32x2*)(ws + WS_WTS)};
        pg8::gemm_phase<MoeSched<8, true>, EpiUp, true, 1024, 1024, 16>(lds, S, E);
    }
    xcd_barrier(gbar);
    {
        MoeSched<4, false> S{tstart, cnt, (const int*)(ws + WS_LIST), (const bf16_t*)(ws + WS_HID), (const bf16_t*)(ws + WS_WD)};
        EpiDown E{(const int*)(ws + WS_LIST), mod, a.out};
        pg8::gemm_phase<MoeSched<4, false>, EpiDown, true, 1024, 512, 8>(lds, S, E);
    }
    xcd_barrier(gbar);
    p8_final(a, lane, wave);
}

extern "C" void kernel_launch(void* const* d_in, const int* in_sizes, int n_in, void* d_out, int out_size, void* d_ws, size_t ws_size, hipStream_t stream) {
    static int grid = 0;
    if (grid == 0) {
        if (n_in != 18 || in_sizes[0] != T * DM || out_size != T * DM || ws_size < WS_END) { fprintf(stderr, "kernel_launch: unexpected shapes (n_in %d, in0 %d, out %d, ws %zu); nothing launched\n", n_in, n_in > 0 ? in_sizes[0] : -1, out_size, ws_size); grid = -1; return; }
        int dev = 0, cus = 0, per_cu = 0;
        (void)hipGetDevice(&dev); (void)hipDeviceGetAttribute(&cus, hipDeviceAttributeMultiprocessorCount, dev);
        (void)hipFuncSetAttribute((const void*)mk_fwd, hipFuncAttributeMaxDynamicSharedMemorySize, LDS_BYTES);
        (void)hipOccupancyMaxActiveBlocksPerMultiprocessor(&per_cu, (const void*)mk_fwd, NTHREADS, LDS_BYTES);
        if (per_cu < 1) { fprintf(stderr, "kernel_launch: occupancy query says %d blocks per CU\n", per_cu); per_cu = 1; }
        grid = cus * per_cu;
        fprintf(stderr, "kernel_launch: %d CUs x %d = grid %d\n", cus, per_cu, grid);
    }
    if (grid < 0) return;
    (void)hipMemsetAsync((char*)d_ws + WS_CTL, 0, CTL_BYTES, stream);
    Args a{};
    a.x = (const float*)d_in[0]; a.c = (const float*)d_in[1]; a.pos = (const int*)d_in[2]; a.w_ada = (const float*)d_in[3]; a.b_ada = (const float*)d_in[4]; a.g_mix = (const float*)d_in[5];
    a.w_in = (const float*)d_in[6]; a.sinks = (const float*)d_in[7]; a.g_sb = (const float*)d_in[8]; a.g_sw = (const float*)d_in[9]; a.w_out = (const float*)d_in[10]; a.g_ffn = (const float*)d_in[11];
    a.w_rg = (const float*)d_in[12]; a.w_re = (const float*)d_in[13]; a.w_gate = (const float*)d_in[14]; a.w_up = (const float*)d_in[15]; a.w_down = (const float*)d_in[16]; a.g_fin = (const float*)d_in[17];
    a.out = (float*)d_out; a.ws = (unsigned char*)d_ws;
    void* args[] = {&a};
    hipError_t e = hipLaunchCooperativeKernel((const void*)mk_fwd, dim3(grid), dim3(NTHREADS), args, LDS_BYTES, stream);
    if (e != hipSuccess) fprintf(stderr, "kernel_launch: cooperative launch failed: %s (grid %d)\n", hipGetErrorString(e), grid);
}
```

```cpp
#include <hip/hip_runtime.h>
#include <cstdio>
#include <cstdint>
#include <cmath>

#define LAS __attribute__((address_space(3)))
#define DI __device__ __forceinline__
typedef unsigned short bf16_t;
typedef short bf16x8 __attribute__((ext_vector_type(8)));
typedef float f32x4 __attribute__((ext_vector_type(4)));
typedef float f32x2 __attribute__((ext_vector_type(2)));
typedef unsigned u32x4 __attribute__((ext_vector_type(4)));
typedef unsigned u32x2 __attribute__((ext_vector_type(2)));
typedef __bf16 bf16x2_t __attribute__((ext_vector_type(2)));

constexpr int NB = 4, SEQ = 8192, DM = 1024, T = NB * SEQ;
constexpr int DIN = 2304, DSB = 512, DSW = 512, DKV = 128;
constexpr int NEXP = 16, DEXP = 512, NBUCKET = 24, WINDOW = 128;
constexpr int MAXTILES = T / 256 + NBUCKET, TPAD = MAXTILES * 256;
constexpr float EPS = 1e-6f, LOG2E = 1.4426950408889634f, QSCALE = 0.125f * LOG2E;
constexpr int NTHREADS = 512, NWAVES = 8;
#ifndef STAMP_PHASE
#define STAMP_PHASE (-1)
#endif
#ifndef STAMP_K
#define STAMP_K 1e-5f
#endif
#ifndef PROBE_DUP
#define PROBE_DUP (-1)
#endif

constexpr size_t MiB = 1u << 20;
constexpr size_t WS_CTL = 0, CTL_BYTES = 1 * MiB;
constexpr size_t WS_MOD = 1 * MiB;
constexpr size_t WS_COS = 2 * MiB, WS_SIN = 6 * MiB;
constexpr size_t WS_WIN = 10 * MiB;
constexpr size_t WS_WOUT = 15 * MiB;
constexpr size_t WS_WGU = 17 * MiB;
constexpr size_t WS_WD = 49 * MiB;
constexpr size_t WS_LIST = 65 * MiB;
constexpr size_t WS_WTS = 68 * MiB;
constexpr size_t WS_STAMP = 512 * 1024;
constexpr size_t WS_TPOS = 74 * MiB;
constexpr size_t WS_SSQ = 76 * MiB;
constexpr size_t WS_H = 80 * MiB;
constexpr size_t WS_QSB = 144 * MiB, WS_KSB = 176 * MiB, WS_VSB = 208 * MiB, WS_QSW = 240 * MiB;
constexpr size_t WS_KSW = 272 * MiB, WS_VSW = 280 * MiB;
constexpr size_t WS_MIX = 288 * MiB;
constexpr size_t WS_HID = 352 * MiB;
constexpr size_t WS_END = 428 * MiB;
constexpr size_t WS_XB = WS_HID;
constexpr size_t WS_X1 = WS_QSB;
constexpr size_t WS_Y = WS_VSB;
static_assert(WS_X1 + (size_t)T * 1024 * 2 <= WS_VSB && WS_Y + (size_t)TPAD * 1024 * 2 <= WS_MIX && WS_XB + (size_t)T * 1024 * 2 <= WS_END, "overlays");
static_assert(WS_KSB - WS_QSB == WS_VSB - WS_KSB, "q/k/v_sb buffers equally spaced");
static_assert(WS_HID + (size_t)TPAD * 1024 * 2 <= WS_END, "ws map");
constexpr int CW_CNT = 8192, CNT_STRIDE = 64, CW_ATTNQ = 16384, CW_BAR = 4096;
constexpr int LDS_MISC = 143360;

constexpr int LDS_BYTES = 147456;

struct Args {
    const float* x; const float* c; const int* pos; const float* w_ada; const float* b_ada; const float* g_mix; const float* w_in; const float* sinks;
    const float* g_sb; const float* g_sw; const float* w_out; const float* g_ffn; const float* w_rg; const float* w_re; const float* w_gate; const float* w_up;
    const float* w_down; const float* g_fin; float* out; unsigned char* ws;
};

__constant__ float INV_FREQ[32] = {1.000000000e+00f, 7.498942018e-01f, 5.623413324e-01f, 4.216965139e-01f, 3.162277639e-01f, 2.371373773e-01f, 1.778279394e-01f, 1.333521456e-01f, 1.000000015e-01f, 7.498942316e-02f, 5.623413250e-02f, 4.216964915e-02f, 3.162277490e-02f, 2.371373773e-02f, 1.778279431e-02f, 1.333521400e-02f, 9.999999776e-03f, 7.498942316e-03f, 5.623413250e-03f, 4.216964822e-03f, 3.162277630e-03f, 2.371373819e-03f, 1.778279431e-03f, 1.333521446e-03f, 1.000000047e-03f, 7.498941850e-04f, 5.623413017e-04f, 4.216965172e-04f, 3.162277571e-04f, 2.371373703e-04f, 1.778279402e-04f, 1.333521504e-04f};

DI unsigned f2bf(float f) { unsigned u = __builtin_bit_cast(unsigned, f); return (u + 0x7fffu + ((u >> 16) & 1u)) >> 16; }
DI unsigned pk2(float lo, float hi) { f32x2 v = {lo, hi}; bf16x2_t b = __builtin_convertvector(v, bf16x2_t); return __builtin_bit_cast(unsigned, b); }
DI float bf2f(unsigned short b) { return __builtin_bit_cast(float, (unsigned)b << 16); }
DI float bflo(unsigned w) { return __builtin_bit_cast(float, w << 16); }
DI float bfhi(unsigned w) { return __builtin_bit_cast(float, w & 0xffff0000u); }
DI float wave_sum(float v) {
#pragma unroll
    for (int o = 1; o < 64; o <<= 1) v += __shfl_xor(v, o);
    return v;
}
#define DPP_ADD(v, ctrl) ((v) + __builtin_bit_cast(float, __builtin_amdgcn_update_dpp(0, __builtin_bit_cast(int, (v)), (ctrl), 0xF, 0xF, true)))
DI float wave_sum_fast(float v) { v = DPP_ADD(v, 0xB1); v = DPP_ADD(v, 0x4E); v = DPP_ADD(v, 0x141); v = DPP_ADD(v, 0x140);
    const auto r = __builtin_amdgcn_permlane16_swap(__builtin_bit_cast(unsigned, v), __builtin_bit_cast(unsigned, v), false, false); v = __builtin_bit_cast(float, r[0]) + __builtin_bit_cast(float, r[1]);
    const auto q = __builtin_amdgcn_permlane32_swap(__builtin_bit_cast(unsigned, v), __builtin_bit_cast(unsigned, v), false, false); return __builtin_bit_cast(float, q[0]) + __builtin_bit_cast(float, q[1]); }
#define LDS_WAIT() asm volatile("s_waitcnt lgkmcnt(0)" ::: "memory")

DI void tr_item64(const float* W, int N, int k0, int n0, bf16_t* WT, int drow0a, int drow0b, int Kd, const float* kscale, LAS float* scr, int lane) {
    f32x4 v[16]; const int kr = lane >> 4, c4 = 4 * (lane & 15);
#pragma unroll
    for (int i = 0; i < 16; ++i) v[i] = *(const f32x4*)(W + (size_t)(k0 + 4 * i + kr) * N + n0 + c4);
#pragma unroll
    for (int i = 0; i < 16; ++i) { const int kk = 4 * i + kr; f32x4 x = v[i]; if (kscale) x = x * kscale[k0 + kk]; LAS float* d = scr + kk * 65 + c4; d[0] = x.x; d[1] = x.y; d[2] = x.z; d[3] = x.w; }
    LDS_WAIT();
    const int c = lane & 7;
#pragma unroll
    for (int j = 0; j < 8; ++j) { const int n = (lane >> 3) + 8 * j; const LAS float* q = scr + (8 * c) * 65 + n;
        u32x4 o; o.x = pk2(q[0 * 65], q[1 * 65]); o.y = pk2(q[2 * 65], q[3 * 65]); o.z = pk2(q[4 * 65], q[5 * 65]); o.w = pk2(q[6 * 65], q[7 * 65]);
        const int dr = n < 32 ? drow0a + n : drow0b + (n - 32);
        *(u32x4*)(WT + (size_t)dr * Kd + k0 + 8 * c) = o; }
    LDS_WAIT();
}
DI int win_drow(int n0) {
    if (n0 < 1536) return n0;
    if (n0 < 2048) { const int c = n0 - 1536, head = c >> 6, half = (c >> 5) & 1; return 1536 + (head >> 2) * 256 + half * 128 + (head & 3) * 32; }
    if (n0 < 2176) { const int c = n0 - 2048, head = c >> 6, half = (c >> 5) & 1; return 2048 + half * 128 + head * 32; }
    const int c = n0 - 2176; return 2048 + (c >> 6) * 128 + 64 + (c & 63);
}
DI void p0_prologue(const Args& a, LAS unsigned char* lds, int tid, int lane, int wave) {
    unsigned char* ws = a.ws;
    {
        float* mod = (float*)(ws + WS_MOD); LAS float* red = (LAS float*)lds; LAS float* sc = (LAS float*)(lds + 32768);
        if ((int)blockIdx.x < 6144 / 64) { for (int i = tid; i < 4096; i += NTHREADS) { const float cv = a.c[i]; sc[i] = cv / (1.f + expf(-cv)); } __syncthreads(); }
        for (int cb = blockIdx.x; cb < 6144 / 64; cb += gridDim.x) {
            const int cl = tid & 15, kg = tid >> 4, col = cb * 64 + 4 * cl;
            f32x4 acc[4];
#pragma unroll
            for (int q = 0; q < 4; ++q) acc[q] = (f32x4){0.f, 0.f, 0.f, 0.f};
#pragma unroll 16
            for (int kk = 0; kk < 32; ++kk) { const int k = kg * 32 + kk; const f32x4 w = *(const f32x4*)(a.w_ada + (size_t)k * 6144 + col);
#pragma unroll
                for (int q = 0; q < 4; ++q) acc[q] = acc[q] + w * sc[q * 1024 + k]; }
#pragma unroll
            for (int q = 0; q < 4; ++q) *(LAS f32x4*)(red + (kg * 4 + q) * 64 + 4 * cl) = acc[q];
            __syncthreads();
            if (tid < 256) { const int q = tid >> 6, c2 = tid & 63; float sum = 0.f; for (int g = 0; g < 32; ++g) sum += red[(g * 4 + q) * 64 + c2]; mod[q * 6144 + cb * 64 + c2] = sum + a.b_ada[cb * 64 + c2]; }
            __syncthreads();
        }
    }
    {
        float* cosT = (float*)(ws + WS_COS); float* sinT = (float*)(ws + WS_SIN);
        for (int idx = blockIdx.x * NTHREADS + tid; idx < T * 32; idx += gridDim.x * NTHREADS) {
            const int t = idx >> 5, i = idx & 31; const float ang = (float)a.pos[t] * INV_FREQ[i];
            const double ad = (double)ang, kq = rint(ad * 0.63661977236758134308);
            double y = fma(-kq, 1.5707963267948966192, ad); y = fma(-kq, 6.123233995736766036e-17, y);
            const int q = (int)((long long)kq & 3); const double y2 = y * y;
            const double sn = y * (1.0 + y2 * (-1.0 / 6 + y2 * (1.0 / 120 + y2 * (-1.0 / 5040 + y2 * (1.0 / 362880 + y2 * (-1.0 / 39916800))))));
            const double cs = 1.0 + y2 * (-0.5 + y2 * (1.0 / 24 + y2 * (-1.0 / 720 + y2 * (1.0 / 40320 + y2 * (-1.0 / 3628800 + y2 * (1.0 / 479001600))))));
            double co, si; if (q == 0) { co = cs; si = sn; } else if (q == 1) { co = -sn; si = cs; } else if (q == 2) { co = -cs; si = -sn; } else { co = sn; si = -cs; }
            cosT[idx] = (float)co; sinT[idx] = (float)si;
        }
    }
    {
        __syncthreads();
        LAS float* scr = (LAS float*)(lds + 8192 + wave * 16640);
        const int gw = blockIdx.x * NWAVES + wave, NGW = gridDim.x * NWAVES;
        constexpr int I_IN = 16 * 36, I_OUT = 16 * 16, NITEMS = I_IN + I_OUT;
        for (int it = gw; it < NITEMS; it += NGW) {
            int r = it;
            if (r < I_IN) { const int kb = r / 36, nb = r % 36; tr_item64(a.w_in, DIN, kb * 64, nb * 64, (bf16_t*)(ws + WS_WIN), win_drow(nb * 64), win_drow(nb * 64 + 32), 1024, nullptr, scr, lane); continue; } r -= I_IN;
            { const int kb = r / 16, nb = r % 16; const float* ks = (kb < 8) ? a.g_sb : (a.g_sw - 512); tr_item64(a.w_out, 1024, kb * 64, nb * 64, (bf16_t*)(ws + WS_WOUT), nb * 64, nb * 64 + 32, 1024, ks, scr, lane); }
        }
    }
}
constexpr int NEXPERT_ITEMS = 2 * (16 * 16 * 8) + 16 * 8 * 16;
DI void expert_items(const Args& a, LAS unsigned char* lds, int first, int count, int w, int nw, int lane, int wave) {
    asm volatile("" : "+v"(lane));
    unsigned char* ws = a.ws;
    LAS float* scr = (LAS float*)(lds + 8192 + wave * 16640);
    constexpr int I_G = 16 * 16 * 8;
    for (int it = first + w; it < first + count; it += nw) {
        int r = it;
        if (r < 2 * I_G) { const int up = r >= I_G; if (up) r -= I_G; const int e = r / 128, q = r % 128, kb = q / 8, nb = q % 8, c0 = nb * 64; const int dr = (c0 >> 7) * 256 + up * 128 + (c0 & 127);
            tr_item64((up ? a.w_up : a.w_gate) + (size_t)e * 1024 * 512, 512, kb * 64, c0, (bf16_t*)(ws + WS_WGU) + (size_t)e * 1024 * 1024, dr, dr + 32, 1024, nullptr, scr, lane); continue; } r -= 2 * I_G;
        { const int e = r / 128, q = r % 128, kb = q / 16, nb = q % 16; tr_item64(a.w_down + (size_t)e * 512 * 1024, 1024, kb * 64, nb * 64, (bf16_t*)(ws + WS_WD) + (size_t)e * 1024 * 512, nb * 64, nb * 64 + 32, 512, nullptr, scr, lane); }
    }
}

DI void p1_norm(const Args& a, int lane, int wave) {
    asm volatile("" : "+v"(lane));
    const float* mod = (const float*)(a.ws + WS_MOD); bf16_t* H = (bf16_t*)(a.ws + WS_H);
    const int gw = blockIdx.x * NWAVES + wave, NGW = gridDim.x * NWAVES;
    int bprev = -1; f32x4 ca[4], cb[4];
#pragma unroll 1
    for (int q4 = gw; q4 < T / 4; q4 += NGW) {
        const int r0 = q4 * 4, b = r0 / SEQ;
        if (b != bprev) { bprev = b;
#pragma unroll
            for (int j = 0; j < 4; ++j) { const int col = 4 * lane + 256 * j; const f32x4 g = *(const f32x4*)(a.g_mix + col), sc = *(const f32x4*)(mod + b * 6144 + 1024 + col); ca[j] = g * (sc + 1.0f); cb[j] = *(const f32x4*)(mod + b * 6144 + col); } }
        f32x4 v[4][4];
#pragma unroll
        for (int rr = 0; rr < 4; ++rr)
#pragma unroll
            for (int j = 0; j < 4; ++j) v[rr][j] = *(const f32x4*)(a.x + (size_t)(r0 + rr) * DM + 4 * lane + 256 * j);
#pragma unroll
        for (int rr = 0; rr < 4; ++rr) { float s = 0.f;
#pragma unroll
            for (int j = 0; j < 4; ++j) s += (v[rr][j].x * v[rr][j].x + v[rr][j].y * v[rr][j].y) + (v[rr][j].z * v[rr][j].z + v[rr][j].w * v[rr][j].w);
            const float rs = 1.0f / sqrtf(wave_sum(s) * (1.0f / DM) + EPS);
            bf16_t* hr = H + (size_t)(r0 + rr) * DM;
#pragma unroll
            for (int j = 0; j < 4; ++j) { const f32x4 o = v[rr][j] * rs * ca[j] + cb[j]; u32x2 w; w.x = pk2(o.x, o.y); w.y = pk2(o.z, o.w); *(u32x2*)(hr + 4 * lane + 256 * j) = w; } }
    }
}
DI void p8_final(const Args& a, const LAS int* tstart, int lane, int wave, float* dst) {
    asm volatile("" : "+v"(lane));
    const float tscale = (STAMP_PHASE >= 0) ? *(const float*)(a.ws + WS_STAMP + 256) : 1.0f;
    const float* mod = (const float*)(a.ws + WS_MOD); const bf16_t* X1 = (const bf16_t*)(a.ws + WS_X1); const bf16_t* Y = (const bf16_t*)(a.ws + WS_Y); const int* tpos = (const int*)(a.ws + WS_TPOS);
    const int gw = blockIdx.x * NWAVES + wave, NGW = gridDim.x * NWAVES;
    for (int ch = gw; ch < T / 16; ch += NGW) {
        const int row0 = ch * 16, b = row0 / SEQ;
        f32x4 g[4], g2[4];
#pragma unroll
        for (int j = 0; j < 4; ++j) { g[j] = *(const f32x4*)(a.g_fin + 4 * lane + 256 * j); g2[j] = *(const f32x4*)(mod + b * 6144 + 5120 + 4 * lane + 256 * j); }
        const int tp = tpos[row0 + (lane & 15)];
        u32x2 xn[2][4], yn[2][4];
#pragma unroll
        for (int rr = 0; rr < 2; ++rr) { const int tpr = __builtin_amdgcn_readlane(tp, rr); const size_t srow = (size_t)tstart[tpr >> 16] * 256 + (tpr & 0xffff);
#pragma unroll
            for (int j = 0; j < 4; ++j) { xn[rr][j] = *(const u32x2*)(X1 + (size_t)(row0 + rr) * DM + 4 * lane + 256 * j); yn[rr][j] = *(const u32x2*)(Y + srow * DM + 4 * lane + 256 * j); } }
#pragma unroll 1
        for (int r2 = 0; r2 < 16; r2 += 2) {
            f32x4 v[2][4]; u32x2 xw[2][4], yw[2][4];
#pragma unroll
            for (int rr = 0; rr < 2; ++rr)
#pragma unroll
                for (int j = 0; j < 4; ++j) { xw[rr][j] = xn[rr][j]; yw[rr][j] = yn[rr][j]; }
            if (r2 + 2 < 16) {
#pragma unroll
                for (int rr = 0; rr < 2; ++rr) { const int tpr = __builtin_amdgcn_readlane(tp, r2 + 2 + rr); const size_t srow = (size_t)tstart[tpr >> 16] * 256 + (tpr & 0xffff);
#pragma unroll
                    for (int j = 0; j < 4; ++j) { xn[rr][j] = *(const u32x2*)(X1 + (size_t)(row0 + r2 + 2 + rr) * DM + 4 * lane + 256 * j); yn[rr][j] = *(const u32x2*)(Y + srow * DM + 4 * lane + 256 * j); } } }
#pragma unroll
            for (int rr = 0; rr < 2; ++rr) { float s = 0.f;
#pragma unroll
                for (int j = 0; j < 4; ++j) { v[rr][j] = (f32x4){bflo(xw[rr][j].x), bfhi(xw[rr][j].x), bflo(xw[rr][j].y), bfhi(xw[rr][j].y)} + g2[j] * (f32x4){bflo(yw[rr][j].x), bfhi(yw[rr][j].x), bflo(yw[rr][j].y), bfhi(yw[rr][j].y)};
                    s += (v[rr][j].x * v[rr][j].x + v[rr][j].y * v[rr][j].y) + (v[rr][j].z * v[rr][j].z + v[rr][j].w * v[rr][j].w); }
                const float rs = 1.0f / sqrtf(wave_sum(s) * (1.0f / DM) + EPS); float* orow = dst + (size_t)(row0 + r2 + rr) * DM;
#pragma unroll
                for (int j = 0; j < 4; ++j) *(f32x4*)(orow + 4 * lane + 256 * j) = v[rr][j] * (rs * tscale) * g[j]; }
        }
    }
}
constexpr int RT_LDS_BYTES = 1024 * 20 * 4;
DI void p5_router(const Args& a, LAS unsigned char* lds, int tid, int lane, int wave, int rep = 0) {
    const float* mod = (const float*)(a.ws + WS_MOD); bf16_t* H = (bf16_t*)(a.ws + WS_H);
    unsigned* cnt = (unsigned*)(a.ws + WS_CTL) + CW_CNT + 2048 * rep; int* list = (int*)(a.ws + WS_LIST); f32x2* wts = (f32x2*)(a.ws + WS_WTS);
    int* tpos = (int*)(a.ws + WS_TPOS); const bf16_t* X1 = (const bf16_t*)(a.ws + WS_X1);
    LAS f32x4* WL = (LAS f32x4*)lds;
    for (int idx = tid; idx < 1024 * 5; idx += NTHREADS) { const int k = idx / 5, q = idx % 5; const f32x4 w = (q == 0) ? *(const f32x4*)(a.w_rg + 4 * k) : *(const f32x4*)(a.w_re + 16 * k + 4 * (q - 1));
        WL[(((k >> 8) * 4 + (k & 3)) * 5 + q) * 64 + ((k & 255) >> 2)] = w; }
    __syncthreads();
    LAS int* wcnt = (LAS int*)(lds + RT_LDS_BYTES);
    for (int it = blockIdx.x; it < T / 128; it += gridDim.x) {
        const int row0 = it * 128 + wave * 16, b = row0 / SEQ;
        f32x4 ca[4], cb[4];
#pragma unroll
        for (int j = 0; j < 4; ++j) { const int col = 4 * lane + 256 * j; const f32x4 g = *(const f32x4*)(a.g_ffn + col), sc = *(const f32x4*)(mod + b * 6144 + 4096 + col); ca[j] = g * (sc + 1.0f); cb[j] = *(const f32x4*)(mod + b * 6144 + 3072 + col); }
        int mybucket = 0; float mywa = 0.f, mywb = 0.f;
        u32x2 xn[2][4];
#pragma unroll
        for (int rr = 0; rr < 2; ++rr)
#pragma unroll
            for (int j = 0; j < 4; ++j) xn[rr][j] = *(const u32x2*)(X1 + (size_t)(row0 + rr) * DM + 4 * lane + 256 * j);
#pragma unroll 1
        for (int r4 = 0; r4 < 16; r4 += 2) {
            f32x4 v[2][4];
#pragma unroll
            for (int rr = 0; rr < 2; ++rr)
#pragma unroll
                for (int j = 0; j < 4; ++j) { const u32x2 xw = xn[rr][j]; v[rr][j] = (f32x4){bflo(xw.x), bfhi(xw.x), bflo(xw.y), bfhi(xw.y)}; }
            if (r4 + 2 < 16) {
#pragma unroll
                for (int rr = 0; rr < 2; ++rr)
#pragma unroll
                    for (int j = 0; j < 4; ++j) xn[rr][j] = *(const u32x2*)(X1 + (size_t)(row0 + r4 + 2 + rr) * DM + 4 * lane + 256 * j); }
#pragma unroll
            for (int rr = 0; rr < 2; ++rr) { float s = 0.f;
#pragma unroll
                for (int j = 0; j < 4; ++j) s += (v[rr][j].x * v[rr][j].x + v[rr][j].y * v[rr][j].y) + (v[rr][j].z * v[rr][j].z + v[rr][j].w * v[rr][j].w);
                const float rs = 1.0f / sqrtf(wave_sum(s) * (1.0f / DM) + EPS);
                bf16_t* hr = H + (size_t)(row0 + r4 + rr) * DM;
#pragma unroll
                for (int j = 0; j < 4; ++j) { v[rr][j] = v[rr][j] * rs * ca[j] + cb[j]; u32x2 w; w.x = pk2(v[rr][j].x, v[rr][j].y); w.y = pk2(v[rr][j].z, v[rr][j].w); *(u32x2*)(hr + 4 * lane + 256 * j) = w; } }
            int wl_off = lane * 16; asm volatile("" : "+v"(wl_off));
            const LAS f32x4* WLp = (const LAS f32x4*)(lds + wl_off);
            f32x2 lg2[4];
#pragma unroll
            for (int i = 0; i < 4; ++i) lg2[i] = (f32x2){0.f, 0.f};
#pragma unroll
            for (int j = 0; j < 4; ++j)
#pragma unroll
                for (int e = 0; e < 4; ++e) { const f32x2 hv = (f32x2){v[0][j][e], v[1][j][e]}; const f32x4 w = WLp[((j * 4 + e) * 5) * 64];
                    lg2[0] += hv * w.x; lg2[1] += hv * w.y; lg2[2] += hv * w.z; lg2[3] += hv * w.w; }
#pragma unroll
            for (int rr = 0; rr < 2; ++rr) {
                float lg[4];
#pragma unroll
                for (int i = 0; i < 4; ++i) lg[i] = wave_sum(rr == 0 ? lg2[i].x : lg2[i].y);
                int g = 0; float gm = lg[0];
#pragma unroll
                for (int i = 1; i < 4; ++i) if (lg[i] > gm) { gm = lg[i]; g = i; }
                float gs = 0.f;
#pragma unroll
                for (int i = 0; i < 4; ++i) gs += expf(lg[i] - gm);
                const float gprob = 1.0f / gs;
                f32x4 ea4 = (f32x4){0.f, 0.f, 0.f, 0.f};
#pragma unroll
                for (int j = 0; j < 4; ++j)
#pragma unroll
                    for (int e = 0; e < 4; ++e) ea4 = ea4 + WLp[((j * 4 + e) * 5 + 1 + g) * 64] * v[rr][j][e];
                float el[4];
#pragma unroll
                for (int i = 0; i < 4; ++i) el[i] = wave_sum(ea4[i]);
                int i0 = 0; float m0 = el[0];
#pragma unroll
                for (int i = 1; i < 4; ++i) if (el[i] > m0) { m0 = el[i]; i0 = i; }
                int i1 = -1; float m1 = 0.f;
#pragma unroll
                for (int i = 0; i < 4; ++i) if (i != i0 && (i1 < 0 || el[i] > m1)) { m1 = el[i]; i1 = i; }
                const float ex = expf(m1 - m0), w0 = 1.0f / (1.0f + ex), w1 = ex * w0;
                const int ea = i0 < i1 ? i0 : i1, eb = i0 < i1 ? i1 : i0; const float wa = (i0 < i1 ? w0 : w1) * gprob, wb = (i0 < i1 ? w1 : w0) * gprob;
                const int bucket = g * 6 + (ea * (7 - ea)) / 2 + (eb - ea - 1);
                if (lane == r4 + rr) { mybucket = bucket; mywa = wa; mywb = wb; }
            }
        }
        if (lane >= 16) mybucket = -1;
        int myrank = 0;
        for (int q = 0; q < NBUCKET; ++q) { const unsigned long long mk = __ballot(mybucket == q); if (mybucket == q) myrank = __popcll(mk & ((1ull << lane) - 1ull)); if (lane == 0) wcnt[wave * NBUCKET + q] = __popcll(mk); }
        __syncthreads();
        if (tid < NBUCKET) { int tot = 0, pre[NWAVES];
#pragma unroll
            for (int w = 0; w < NWAVES; ++w) { pre[w] = tot; tot += wcnt[w * NBUCKET + tid]; }
            const unsigned base = tot ? atomicAdd(cnt + CNT_STRIDE * tid, (unsigned)tot) : 0u;
#pragma unroll
            for (int w = 0; w < NWAVES; ++w) wcnt[w * NBUCKET + tid] = (int)base + pre[w]; }
        __syncthreads();
        if (lane < 16) { const int p = wcnt[wave * NBUCKET + mybucket] + myrank; list[mybucket * T + p] = row0 + lane; wts[mybucket * T + p] = (f32x2){mywa, mywb}; tpos[row0 + lane] = (mybucket << 16) | p; }
        __syncthreads();
    }
}

struct GUnit { const bf16_t* A; const int* aidx; int nvalid; const bf16_t* B0; const bf16_t* B1; int pm, pn, lbase; };
namespace pg8 {
constexpr int BM = 256, BK = 64, HALF = 128, HTB = HALF * BK * 2, STAGE_BYTES = 8 * HTB;
DI int lds_byte(int r, int c) { const int st = (r >> 4) * 2 + (c >> 5), rr = r & 15, cc = c & 31, ob = rr * 64 + cc * 2; return st * 1024 + (ob ^ (((ob >> 9) & 1) << 5)); }
DI void stage_rc(int b, int& R, int& C) { const int st = b / 1024, sb = b % 1024, swz = sb ^ (((sb >> 9) & 1) << 5); R = (st >> 1) * 16 + swz / 64; C = (st & 1) * 32 + (swz % 64) / 2; }
DI int perm32(int rho) { const int n = rho >> 4, i = rho & 15; return 8 * (i >> 2) + 4 * n + (i & 3); }
DI void a_offsets(const GUnit& u, int K, int tid_, unsigned (&vo)[2][2]) {
    asm volatile("" : "+v"(tid_));
#pragma unroll
    for (int i = 0; i < 2; ++i) { int R, C; stage_rc(tid_ * 16 + i * 8192, R, C);
#pragma unroll
        for (int h = 0; h < 2; ++h) { const int r = h * HALF + R; const int gr = u.aidx ? u.aidx[r < u.nvalid ? r : 0] : r; vo[h][i] = ((unsigned)gr * (unsigned)K + (unsigned)C) * 2u; } }
}
template <class Sched, class Epi, bool ALIGN_EPI, int K, int ldb, int nsplit>
DI void gemm_phase(LAS unsigned char* lds, const Sched& S, const Epi& E) {
    int tid = threadIdx.x; asm volatile("" : "+v"(tid));
    const int wid = __builtin_amdgcn_readfirstlane(tid >> 6), lane = tid & 63, wr = wid >> 2, wc = wid & 3, fr = lane & 15, fq = lane >> 4;
    const int nt = K / BK;
    unsigned voffB[2];
#pragma unroll
    for (int i = 0; i < 2; ++i) { int R, C; stage_rc(tid * 16 + i * 8192, R, C); const int Rb = (R & ~31) + perm32(R & 31); voffB[i] = ((unsigned)Rb * (unsigned)ldb + (unsigned)C) * 2u; }
    const size_t hB = (size_t)HALF * ldb * 2;
    const unsigned ldsw = (unsigned)wid * 1024u;
    const int aoff = lds_byte(wr * 64 + fr, fq * 8), boff = lds_byte(wc * 32 + fr, fq * 8);
#define PG8_SA(b, h) (((b) * 2 + (h)) * HTB)
#define PG8_SB(b, h) ((4 + (b) * 2 + (h)) * HTB)
#define PG8_STAGE(bufoff, gbase, voff) do { _Pragma("unroll") for (int _i = 0; _i < 2; ++_i) \
        __builtin_amdgcn_global_load_lds((const unsigned*)((const char*)(gbase) + (voff)[_i]), (LAS unsigned*)(lds + (bufoff) + ldsw + _i * 8192), 16, 0, 0); } while (0)
#define PG8_LDA(dst, b, h) do { _Pragma("unroll") for (int m = 0; m < 4; ++m) _Pragma("unroll") for (int k = 0; k < 2; ++k) dst[m][k] = *(const LAS bf16x8*)(lds + PG8_SA(b, h) + aoff + m * 2048 + k * 1024); } while (0)
#define PG8_LDB(dst, b, h) do { _Pragma("unroll") for (int n = 0; n < 2; ++n) _Pragma("unroll") for (int k = 0; k < 2; ++k) dst[n][k] = *(const LAS bf16x8*)(lds + PG8_SB(b, h) + boff + n * 2048 + k * 1024); } while (0)
#define PG8_MMA(ai, bj, At, Bt) do { __builtin_amdgcn_s_setprio(1); _Pragma("unroll") for (int m = 0; m < 4; ++m) _Pragma("unroll") for (int n = 0; n < 2; ++n) _Pragma("unroll") for (int k = 0; k < 2; ++k) \
        acc[ai][bj][m][n] = __builtin_amdgcn_mfma_f32_16x16x32_bf16(Bt[n][k], At[m][k], acc[ai][bj][m][n], 0, 0, 0); __builtin_amdgcn_s_setprio(0); } while (0)
#define PG8_WAIT_V(n) asm volatile("s_waitcnt vmcnt(" #n ")" ::: "memory")
#define PG8_WAIT_L(n) asm volatile("s_waitcnt lgkmcnt(" #n ")" ::: "memory")
#define PG8_BAR __builtin_amdgcn_s_barrier()
#define PG8_SCHED __builtin_amdgcn_sched_barrier(0)
#define PG8_AK(u, kt) ((const char*)(u).A + (size_t)(kt) * (BK * 2))
#define PG8_BK(u, kt) ((kt) < nsplit ? (const char*)(u).B0 + (size_t)(kt) * (BK * 2) : (const char*)(u).B1 + (size_t)((kt) - nsplit) * (BK * 2))
    GUnit cur, nxt; int ui = 0;
    if (!S.next(0, cur)) return;
    f32x4 acc[2][2][4][2];
#pragma unroll
    for (int a = 0; a < 2; ++a)
#pragma unroll
        for (int b = 0; b < 2; ++b)
#pragma unroll
            for (int m = 0; m < 4; ++m)
#pragma unroll
                for (int n = 0; n < 2; ++n) acc[a][b][m][n] = (f32x4){0.f, 0.f, 0.f, 0.f};
    bf16x8 At[4][2], B0[2][2], B1[2][2];
    unsigned voffA[2][2];
    a_offsets(cur, K, tid, voffA);
    if constexpr (Epi::MIDK) E.prep(cur, 0, tid);
    {
        const char* a0 = PG8_AK(cur, 0); const char* b0 = PG8_BK(cur, 0); const char* a1 = PG8_AK(cur, 1); const char* b1 = PG8_BK(cur, 1);
        PG8_STAGE(PG8_SB(0, 0), b0, voffB); PG8_STAGE(PG8_SB(0, 1), b0 + hB, voffB); PG8_STAGE(PG8_SA(0, 0), a0, voffA[0]); PG8_STAGE(PG8_SA(0, 1), a0, voffA[1]);
        if (wr == 1) PG8_BAR;
        PG8_WAIT_V(2); PG8_BAR;
        PG8_STAGE(PG8_SB(1, 0), b1, voffB); PG8_STAGE(PG8_SA(1, 0), a1, voffA[0]); PG8_STAGE(PG8_SB(1, 1), b1 + hB, voffB);
        PG8_WAIT_V(6); PG8_BAR;
    }
    for (;;) {
        const bool has_next = S.next(ui + 1, nxt);
        if (!has_next) nxt = cur;
        for (int t = 0; t < nt; t += 2) {
            if constexpr (Epi::MIDK) { if (t == nt / 2) E.midk(acc, cur, wr, wc, fr, fq, ui & 1); }
            const bool last = (t == nt - 2);
            const char* a1 = PG8_AK(cur, t + 1);
            const char* a2 = last ? PG8_AK(nxt, 0) : PG8_AK(cur, t + 2); const char* b2 = last ? PG8_BK(nxt, 0) : PG8_BK(cur, t + 2);
            const char* a3 = last ? PG8_AK(nxt, 1) : PG8_AK(cur, t + 3); const char* b3 = last ? PG8_BK(nxt, 1) : PG8_BK(cur, t + 3);
            PG8_LDB(B0, 0, 0); PG8_LDB(B1, 0, 1); PG8_SCHED; PG8_LDA(At, 0, 0); PG8_STAGE(PG8_SA(1, 1), a1, voffA[1]);
            if (last) a_offsets(nxt, K, tid, voffA);
            PG8_WAIT_V(8); PG8_WAIT_L(0); PG8_BAR; PG8_MMA(0, 0, At, B0); PG8_MMA(0, 1, At, B1); PG8_BAR; PG8_SCHED;
            PG8_LDA(At, 0, 1); PG8_STAGE(PG8_SB(0, 0), b2, voffB); PG8_STAGE(PG8_SB(0, 1), b2 + hB, voffB); PG8_STAGE(PG8_SA(0, 0), a2, voffA[0]);
            PG8_WAIT_V(8); PG8_WAIT_L(0); PG8_BAR; PG8_MMA(1, 0, At, B0); PG8_MMA(1, 1, At, B1); PG8_BAR; PG8_SCHED;
            PG8_LDB(B0, 1, 0); PG8_LDB(B1, 1, 1); PG8_SCHED; PG8_LDA(At, 1, 0); PG8_STAGE(PG8_SA(0, 1), a2, voffA[1]);
            PG8_WAIT_V(8); PG8_WAIT_L(0); PG8_BAR; PG8_MMA(0, 0, At, B0); PG8_MMA(0, 1, At, B1); PG8_BAR; PG8_SCHED;
            PG8_LDA(At, 1, 1); PG8_STAGE(PG8_SB(1, 0), b3, voffB); PG8_STAGE(PG8_SB(1, 1), b3 + hB, voffB); PG8_STAGE(PG8_SA(1, 0), a3, voffA[0]);
            PG8_WAIT_V(8); PG8_WAIT_L(0); PG8_BAR; PG8_MMA(1, 0, At, B0); PG8_MMA(1, 1, At, B1); PG8_BAR; PG8_SCHED;
        }
        if constexpr (ALIGN_EPI) { if (wr == 0) PG8_BAR; }
        E(acc, cur, wr, wc, fr, fq, ui & 1);
        if (!has_next) break;
        if constexpr (Epi::MIDK) E.prep(nxt, (ui + 1) & 1, tid);
#pragma unroll
        for (int a = 0; a < 2; ++a)
#pragma unroll
            for (int b = 0; b < 2; ++b)
#pragma unroll
                for (int m = 0; m < 4; ++m)
#pragma unroll
                    for (int n = 0; n < 2; ++n) acc[a][b][m][n] = (f32x4){0.f, 0.f, 0.f, 0.f};
        cur = nxt; ++ui;
        if constexpr (ALIGN_EPI) { if (wr == 1) PG8_BAR; }
    }
    PG8_WAIT_V(0);
    if constexpr (!ALIGN_EPI) { if (wr == 0) PG8_BAR; }
    PG8_BAR;
#undef PG8_SA
#undef PG8_SB
#undef PG8_STAGE
#undef PG8_LDA
#undef PG8_LDB
#undef PG8_MMA
#undef PG8_WAIT_V
#undef PG8_WAIT_L
#undef PG8_BAR
#undef PG8_SCHED
#undef PG8_AK
#undef PG8_BK
}
}
struct DenseSched {
    const bf16_t* A; const bf16_t* Bt; int K, nM, nN;
    DI bool next(int i, GUnit& u) const {
        const int nwg = nM * nN; const long L = (long)i * (int)gridDim.x + (int)blockIdx.x; if (L >= nwg) return false;
        int wgid = (int)L; { const int q = nwg / 8, r = nwg % 8, xcd = wgid % 8, off = wgid / 8; wgid = (xcd < r ? xcd * (q + 1) : r * (q + 1) + (xcd - r) * q) + off; }
        const int nig = 8 * nN, gid = wgid / nig, fm = gid * 8, gsz = (nM - fm) < 8 ? (nM - fm) : 8;
        u.pm = fm + ((wgid % nig) % gsz); u.pn = (wgid % nig) / gsz;
        u.A = A + (size_t)u.pm * 256 * K; u.aidx = nullptr; u.nvalid = 256; u.B0 = Bt + (size_t)u.pn * 256 * K; u.B1 = u.B0; u.lbase = 0; return true; }
};
template <bool up> DI void moe_fill_unit(GUnit& u, int ti, int pn, const LAS int* tstart, const unsigned* cnt, const int* list, const bf16_t* A, const bf16_t* W) {
    int b = 0;
    for (int q = 1; q < NBUCKET; ++q) if (__builtin_amdgcn_readfirstlane(tstart[q]) <= ti) b = q;
    const int rt = ti - __builtin_amdgcn_readfirstlane(tstart[b]); const int g = b / 6, p = b % 6; const int ea = 4 * g + (p < 3 ? 0 : (p < 5 ? 1 : 2)), eb = 4 * g + (p < 3 ? p + 1 : (p < 5 ? p - 1 : 3));
    u.pm = ti; u.pn = pn; u.lbase = b * T + rt * 256; const int nv = __builtin_amdgcn_readfirstlane((int)cnt[CNT_STRIDE * b]) - rt * 256; u.nvalid = nv < 256 ? nv : 256;
    if (up) { u.A = A; u.aidx = list + u.lbase; const int e = pn < 4 ? ea : eb; u.B0 = W + (size_t)e * 1024 * 1024 + (size_t)(pn & 3) * 256 * 1024; u.B1 = u.B0; }
    else { u.A = A + (size_t)ti * 256 * 1024; u.aidx = nullptr; u.B0 = W + (size_t)ea * 1024 * 512 + (size_t)pn * 256 * 512; u.B1 = W + (size_t)eb * 1024 * 512 + (size_t)pn * 256 * 512; }
}
template <int NT, bool up> struct MoeSched {
    const LAS int* tstart; const unsigned* cnt; const int* list; const bf16_t* A; const bf16_t* W;
    DI bool next(int i, GUnit& u) const {
        const int ntile = __builtin_amdgcn_readfirstlane(tstart[NBUCKET]), nwg = ntile * NT; const int L0 = i * (int)gridDim.x + (int)blockIdx.x; if (L0 >= nwg) return false;
        int L = L0; { const int q = nwg / 8, r = nwg % 8, xcd = L0 % 8, off = L0 / 8; L = (xcd < r ? xcd * (q + 1) : r * (q + 1) + (xcd - r) * q) + off; }
        moe_fill_unit<up>(u, L / NT, L % NT, tstart, cnt, list, A, W); return true;
    }
};
struct MoeCut { int x, tiles_x, cstart, left, nY; };
DI MoeCut moe_cut(int ntile) { MoeCut c; c.x = (int)blockIdx.x & 7; const int q = ntile / 8, r = ntile % 8; c.tiles_x = q + (c.x < r ? 1 : 0); c.cstart = c.x * q + (c.x < r ? c.x : r); c.left = 8 * (c.tiles_x - 16); c.nY = 32 - c.left; return c; }
template <bool up, int MODE> struct MoeSplitSched {
    const LAS int* tstart; const unsigned* cnt; const int* list; const bf16_t* A; const bf16_t* W; MoeCut c;
    DI bool next(int i, GUnit& u) const {
        const int w = (int)blockIdx.x >> 3; int ti, pn;
        if (MODE == 1) { if (i >= 4) return false; const int off = i * 32 + w; ti = c.cstart + (off >> 3); pn = off & 7; }
        else if (MODE == 2 && up) { if (i > 0) return false; const int off = 128 + w; ti = c.cstart + (off >> 3); pn = off & 7; }
        else if (MODE == 2) { if (i > 0) return false; const int d = w - c.left; ti = c.cstart + (d >> 2); pn = d & 3; }
        else { const int e = i * 32 + w, rem = 4 * c.tiles_x - c.nY; if (e >= rem) return false;
            if (e < 64 - c.nY) { const int d = c.nY + e; ti = c.cstart + (d >> 2); pn = d & 3; } else { const int l = e - (64 - c.nY); ti = c.cstart + 16 + (l >> 2); pn = l & 3; } }
        moe_fill_unit<up>(u, ti, pn, tstart, cnt, list, A, W); return true;
    }
};

DI u32x4 pack8(const f32x4 v0, const f32x4 v1) { u32x4 w; w.x = pk2(v0[0], v0[1]); w.y = pk2(v0[2], v0[3]); w.z = pk2(v1[0], v1[1]); w.w = pk2(v1[2], v1[3]); return w; }
struct EpiProj { static constexpr bool MIDK = false;
    bf16_t *qsb, *vtsb, *qsw, *ksw, *vtsw; const float *cosT, *sinT;
    DI void operator()(const f32x4 (&acc)[2][2][4][2], const GUnit& u, int wr, int wc, int fr, int fq, int) const {
        const int pn = u.pn, rowb = u.pm * 256 + wr * 64 + fr;
        if (pn < 4) {
            bf16_t* base = qsb + (size_t)(pn >> 1) * ((WS_KSB - WS_QSB) / 2); const float sc = pn < 2 ? QSCALE : 1.0f; const int colt = (pn & 1) * 256 + wc * 32 + 8 * fq;
#pragma unroll
            for (int ai = 0; ai < 2; ++ai)
#pragma unroll
                for (int m = 0; m < 4; ++m) { const size_t row = rowb + ai * 128 + m * 16;
#pragma unroll
                    for (int bj = 0; bj < 2; ++bj) *(u32x4*)(base + row * 512 + colt + bj * 128) = pack8(acc[ai][bj][m][0] * sc, acc[ai][bj][m][1] * sc); }
        } else if (pn < 6 || (pn == 8 && wc >= 2)) {
            bf16_t* base = pn < 6 ? vtsb : vtsw; const int NF = pn < 6 ? 512 : 128, c0 = pn < 6 ? (pn - 4) * 256 + wc * 32 + 8 * fq : (wc * 32 - 64) + 8 * fq, bjs = pn < 6 ? 128 : 64;
#pragma unroll
            for (int ai = 0; ai < 2; ++ai)
#pragma unroll
                for (int m = 0; m < 4; ++m) { const int row = rowb + ai * 128 + m * 16; bf16_t* bp = base + ((size_t)(row >> 5) * NF + c0) * 32 + (row & 31);
#pragma unroll
                    for (int bj = 0; bj < 2; ++bj)
#pragma unroll
                        for (int n = 0; n < 2; ++n)
#pragma unroll
                            for (int j = 0; j < 4; ++j) bp[(bj * bjs + 4 * n + j) * 32] = (bf16_t)f2bf(acc[ai][bj][m][n][j]); }
        } else {
            const bool isq = pn < 8; bf16_t* base = isq ? qsw : ksw; const int pitch = isq ? 512 : 128; const int head = isq ? (pn - 6) * 4 + wc : wc; const float sc = isq ? QSCALE : 1.0f;
#pragma unroll
            for (int ai = 0; ai < 2; ++ai)
#pragma unroll
                for (int m = 0; m < 4; ++m) { const size_t row = rowb + ai * 128 + m * 16;
                    const f32x4 c0 = *(const f32x4*)(cosT + row * 32 + 8 * fq), c1 = *(const f32x4*)(cosT + row * 32 + 8 * fq + 4);
                    const f32x4 s0 = *(const f32x4*)(sinT + row * 32 + 8 * fq), s1 = *(const f32x4*)(sinT + row * 32 + 8 * fq + 4);
                    const f32x4 x10 = acc[ai][0][m][0], x11 = acc[ai][0][m][1], x20 = acc[ai][1][m][0], x21 = acc[ai][1][m][1];
                    const f32x4 o10 = (x10 * c0 - x20 * s0) * sc, o11 = (x11 * c1 - x21 * s1) * sc, o20 = (x20 * c0 + x10 * s0) * sc, o21 = (x21 * c1 + x11 * s1) * sc;
                    *(u32x4*)(base + row * pitch + head * 64 + 8 * fq) = pack8(o10, o11); *(u32x4*)(base + row * pitch + head * 64 + 32 + 8 * fq) = pack8(o20, o21); }
        }
    }
};
struct EpiWout {
    static constexpr bool MIDK = true;
    const float* mod; bf16_t* x1; const float* x; const float* ssq; LAS float* tab;
    DI void prep(const GUnit& u, int par, int tid) const {
        if (tid < 256) { const size_t row = (size_t)u.pm * 256 + tid; const f32x4 a0 = *(const f32x4*)(ssq + row * 16), a1 = *(const f32x4*)(ssq + row * 16 + 4), b0 = *(const f32x4*)(ssq + row * 16 + 8), b1 = *(const f32x4*)(ssq + row * 16 + 12);
            const float sa = ((a0.x + a0.y) + (a0.z + a0.w)) + ((a1.x + a1.y) + (a1.z + a1.w)), sb = ((b0.x + b0.y) + (b0.z + b0.w)) + ((b1.x + b1.y) + (b1.z + b1.w));
            const float rsb = 1.0f / sqrtf(sa * (1.0f / 512.0f) + EPS), rsw = 1.0f / sqrtf(sb * (1.0f / 512.0f) + EPS);
            *(LAS f32x2*)(tab + (par * 256 + tid) * 2) = (f32x2){rsb / rsw, rsw}; }
    }
    DI void midk(f32x4 (&acc)[2][2][4][2], const GUnit& u, int wr, int wc, int fr, int fq, int par) const {
#pragma unroll
        for (int ai = 0; ai < 2; ++ai)
#pragma unroll
            for (int m = 0; m < 4; ++m) { const float ratio = tab[(par * 256 + ai * 128 + wr * 64 + m * 16 + fr) * 2];
#pragma unroll
                for (int bj = 0; bj < 2; ++bj)
#pragma unroll
                    for (int n = 0; n < 2; ++n) acc[ai][bj][m][n] = acc[ai][bj][m][n] * ratio; }
    }
    DI void operator()(const f32x4 (&acc)[2][2][4][2], const GUnit& u, int wr, int wc, int fr, int fq, int par) const {
        const int rowb = u.pm * 256 + wr * 64 + fr, colb = u.pn * 256 + wc * 32 + 8 * fq; const int b = (u.pm * 256) / SEQ;
        f32x4 gt[2][2];
#pragma unroll
        for (int bj = 0; bj < 2; ++bj)
#pragma unroll
            for (int n = 0; n < 2; ++n) gt[bj][n] = *(const f32x4*)(mod + b * 6144 + 2048 + colb + bj * 128 + 4 * n);
#pragma unroll
        for (int ai = 0; ai < 2; ++ai)
#pragma unroll
            for (int mp = 0; mp < 2; ++mp) {
                f32x4 xv[2][2][2];
#pragma unroll
                for (int mm = 0; mm < 2; ++mm)
#pragma unroll
                    for (int bj = 0; bj < 2; ++bj)
#pragma unroll
                        for (int n = 0; n < 2; ++n) xv[mm][bj][n] = *(const f32x4*)(x + (size_t)(rowb + ai * 128 + (2 * mp + mm) * 16) * DM + colb + bj * 128 + 4 * n);
#pragma unroll
                for (int mm = 0; mm < 2; ++mm) { const int m = 2 * mp + mm, row = rowb + ai * 128 + m * 16; const float rsw = tab[(par * 256 + ai * 128 + wr * 64 + m * 16 + fr) * 2 + 1];
#pragma unroll
                    for (int bj = 0; bj < 2; ++bj) *(u32x4*)(x1 + (size_t)row * DM + colb + bj * 128) = pack8(xv[mm][bj][0] + gt[bj][0] * (acc[ai][bj][m][0] * rsw), xv[mm][bj][1] + gt[bj][1] * (acc[ai][bj][m][1] * rsw)); }
                asm volatile("" ::: "memory");
            }
    }
};
DI f32x4 swiglu4(const f32x4 g, const f32x4 uu, float w) { f32x4 o;
#pragma unroll
    for (int j = 0; j < 4; ++j) o[j] = (w * uu[j]) * (g[j] * __builtin_amdgcn_rcpf(1.0f + __builtin_amdgcn_exp2f(-LOG2E * g[j])));
    return o; }
struct EpiUp { static constexpr bool MIDK = true;
    bf16_t* hid; const f32x2* wts; LAS float* tab;
    DI void prep(const GUnit& u, int par, int tid) const {
        if (tid < 256) { float w = 0.f; if (tid < u.nvalid) { const f32x2 ww = wts[u.lbase + tid]; w = u.pn >= 4 ? ww.y : ww.x; } tab[par * 256 + tid] = w; }
    }
    DI void midk(f32x4 (&)[2][2][4][2], const GUnit&, int, int, int, int, int) const {}
    DI void operator()(const f32x4 (&acc)[2][2][4][2], const GUnit& u, int wr, int wc, int fr, int fq, int par) const {
        const int hc = (u.pn >> 2) * 512 + (u.pn & 3) * 128 + wc * 32 + 8 * fq;
#pragma unroll
        for (int ai = 0; ai < 2; ++ai)
#pragma unroll
            for (int m = 0; m < 4; ++m) { const int r = ai * 128 + wr * 64 + m * 16 + fr; const float w = tab[par * 256 + r];
                *(u32x4*)(hid + (size_t)(u.pm * 256 + r) * 1024 + hc) = pack8(swiglu4(acc[ai][0][m][0], acc[ai][1][m][0], w), swiglu4(acc[ai][0][m][1], acc[ai][1][m][1], w)); }
    }
};
struct EpiDown { static constexpr bool MIDK = false;
    bf16_t* y;
    DI void operator()(const f32x4 (&acc)[2][2][4][2], const GUnit& u, int wr, int wc, int fr, int fq, int) const {
        const int rowb = u.pm * 256 + wr * 64 + fr, colb = u.pn * 256 + wc * 32 + 8 * fq;
#pragma unroll
        for (int ai = 0; ai < 2; ++ai)
#pragma unroll
            for (int m = 0; m < 4; ++m) { const size_t row = rowb + ai * 128 + m * 16;
#pragma unroll
                for (int bj = 0; bj < 2; ++bj) *(u32x4*)(y + row * DM + colb + bj * 128) = pack8(acc[ai][bj][m][0], acc[ai][bj][m][1]); }
    }
};

typedef float f32x16 __attribute__((ext_vector_type(16)));
#define MFMA32(a, b, c) __builtin_amdgcn_mfma_f32_32x32x16_bf16((a), (b), (c), 0, 0, 0)
DI int pi32(int r) { return (r & ~12) | ((r & 4) << 1) | ((r & 8) >> 1); }
DI int crow(int i, int h) { return (i & 3) + 8 * (i >> 2) + 4 * h; }
template <int S_> DI bf16x8 packacc(const f32x16& x) { u32x4 p; p.x = pk2(x[8 * S_], x[8 * S_ + 1]); p.y = pk2(x[8 * S_ + 2], x[8 * S_ + 3]); p.z = pk2(x[8 * S_ + 4], x[8 * S_ + 5]); p.w = pk2(x[8 * S_ + 6], x[8 * S_ + 7]); return __builtin_bit_cast(bf16x8, p); }
DI f32x16 zero16() { f32x16 z;
#pragma unroll
    for (int i = 0; i < 16; ++i) z[i] = 0.f;
    return z; }
constexpr int AT_SLOT = 16384, ATT_NSLOT = 6;
constexpr int ATT_STG_OFF = ATT_NSLOT * AT_SLOT, ATT_STGW = 32 * 36;
constexpr int ATT_LS_OFF = ATT_STG_OFF + NWAVES * ATT_STGW * 4, ATT_CTL_OFF = ATT_LS_OFF + NWAVES * 32 * 4;
static_assert(ATT_CTL_OFF + 64 <= LDS_MISC, "attention LDS map");
#define AT_WAIT_V(n) asm volatile("s_waitcnt vmcnt(" #n ")" ::: "memory")
#define AT_BARRIER() do { asm volatile("s_waitcnt lgkmcnt(0)" ::: "memory"); __builtin_amdgcn_s_barrier(); asm volatile("" ::: "memory"); } while (0)
DI void at_issue(const bf16_t* Kg, int kp, const bf16_t* VTg, int nf, LAS unsigned char* slotp, int jt, int wave, int lane) {
    const int key = 8 * wave + (lane >> 3), chunk = (lane & 7) ^ ((key >> 1) & 7);
    __builtin_amdgcn_global_load_lds((const unsigned*)(Kg + (64 * (size_t)jt + key) * kp + chunk * 8), (LAS unsigned*)(slotp + wave * 1024), 16, 0, 0);
    const int hh = wave >> 2, d = 16 * (wave & 3) + (lane >> 2), sl = (lane & 3) ^ ((d >> 2) & 3);
    __builtin_amdgcn_global_load_lds((const unsigned*)(VTg + ((2 * (size_t)jt + hh) * nf + d) * 32 + sl * 8), (LAS unsigned*)(slotp + 8192 + wave * 1024), 16, 0, 0);
}
DI void at_kfrag(const LAS unsigned char* sl, int hh, int r, int h, bf16x8 (&kf)[4]) { const int key = 32 * hh + pi32(r), ksw = (key >> 1) & 7; const LAS unsigned char* kb = sl + key * 128;
#pragma unroll
    for (int d0 = 0; d0 < 4; ++d0) kf[d0] = *(const LAS bf16x8*)(kb + (((2 * d0 + h) ^ ksw) * 16)); }
DI void at_vfrag(const LAS unsigned char* sl, int hh, int r, int h, bf16x8 (&vf)[2][2]) {
#pragma unroll
    for (int dt = 0; dt < 2; ++dt)
#pragma unroll
        for (int sx = 0; sx < 2; ++sx) { const int d = 32 * dt + r; vf[dt][sx] = *(const LAS bf16x8*)(sl + 8192 + hh * 4096 + d * 64 + (((2 * sx + h) ^ ((d >> 2) & 3)) * 16)); } }

template <int DIAG> DI void sb_half(const LAS unsigned char* sl, int hh, const bf16x8 (&qf)[4], float& Cl, f32x16 (&o)[2], int r, int h) {
    bf16x8 kf[4], vf[2][2];
    at_kfrag(sl, hh, r, h, kf); at_vfrag(sl, hh, r, h, vf);
    f32x16 S = zero16();
#pragma unroll
    for (int d0 = 0; d0 < 4; ++d0) S = MFMA32(kf[d0], qf[d0], S);
    float om[16];
#pragma unroll
    for (int i = 0; i < 16; ++i) { float v = __builtin_amdgcn_rcpf(1.0f + __builtin_amdgcn_exp2f(S[i])); if (DIAG && !(16 * (i >> 3) + 8 * h + (i & 7) < r)) v = 1.0f; om[i] = v; }
    f32x2 sf[8]; sf[7] = (f32x2){1.0f, 1.0f};
#pragma unroll
    for (int i = 6; i >= 0; --i) sf[i] = sf[i + 1] * (f32x2){om[i + 1], om[i + 9]};
    const f32x2 R = sf[0] * (f32x2){om[0], om[8]};
    const float p0 = __shfl_xor(R.x, 32), p1 = __shfl_xor(R.y, 32);
    const float m1 = (h == 0 ? p1 : 1.0f) * Cl, m0 = (h == 0 ? p0 * p1 : p1) * R.y * Cl;
    Cl = Cl * ((R.x * R.y) * (p0 * p1));
    const f32x2 mm = (f32x2){m0, m1};
    f32x16 P;
#pragma unroll
    for (int i = 0; i < 8; ++i) { const f32x2 w = (sf[i] * mm) * ((f32x2){1.0f, 1.0f} - (f32x2){om[i], om[i + 8]}); P[i] = w.x; P[i + 8] = w.y; }
    const bf16x8 Pf0 = packacc<0>(P), Pf1 = packacc<1>(P);
#pragma unroll
    for (int dt = 0; dt < 2; ++dt) { o[dt] = MFMA32(Pf0, vf[dt][0], o[dt]); o[dt] = MFMA32(Pf1, vf[dt][1], o[dt]); }
}
constexpr float SB_CMIN = 5.421010862427522e-20f;
struct SbUnit { int b, hd, q0; };
DI SbUnit sb_unit_of(int idx) { SbUnit u; u.b = idx / 512; u.hd = (idx >> 6) & 7; u.q0 = (idx & 63) * 128; return u; }
DI void grp_barrier(volatile LAS int* bar, int& epoch, int lane) {
    asm volatile("s_waitcnt lgkmcnt(0)" ::: "memory"); ++epoch;
    if (lane == 0) __hip_atomic_fetch_add((LAS int*)bar, 1, __ATOMIC_RELAXED, __HIP_MEMORY_SCOPE_WORKGROUP);
    while (*bar < 4 * epoch) __builtin_amdgcn_s_sleep(1);
    asm volatile("" ::: "memory");
}
DI void at_issue4(const bf16_t* Kg, const bf16_t* VTg, LAS unsigned char* slotp, int jt, int w4, int lane) {
#pragma unroll
    for (int pp = 0; pp < 2; ++pp) { const int pc = w4 + 4 * pp;
        const int key = 8 * pc + (lane >> 3), chunk = (lane & 7) ^ ((key >> 1) & 7);
        __builtin_amdgcn_global_load_lds((const unsigned*)(Kg + (64 * (size_t)jt + key) * 512 + chunk * 8), (LAS unsigned*)(slotp + pc * 1024), 16, 0, 0);
        const int hh = pc >> 2, d = 16 * (pc & 3) + (lane >> 2), sl = (lane & 3) ^ ((d >> 2) & 3);
        __builtin_amdgcn_global_load_lds((const unsigned*)(VTg + ((2 * (size_t)jt + hh) * 512 + d) * 32 + sl * 8), (LAS unsigned*)(slotp + 8192 + pc * 1024), 16, 0, 0); }
}
DI int sb_prologue(const bf16_t* Q, const bf16_t* K, const bf16_t* VT, const SbUnit& u, LAS unsigned char* ring, int w4, int lane, bf16x8 (&qf)[4]) {
    const int r = lane & 31, h = lane >> 5; const size_t gb = (size_t)u.b * SEQ; const int t0w = u.q0 + 32 * w4;
    const bf16_t* Kg = K + gb * 512 + u.hd * 64; const bf16_t* VTg = VT + ((gb >> 5) * 512 + u.hd * 64) * 32;
    const int jt_hi = (u.q0 + 127) >> 6, ntiles = jt_hi + 1; int issued = 0;
    for (; issued < 2 && issued < ntiles; ++issued) at_issue4(Kg, VTg, ring + issued * AT_SLOT, jt_hi - issued, w4, lane);
#pragma unroll
    for (int d0 = 0; d0 < 4; ++d0) qf[d0] = *(const bf16x8*)(Q + (gb + t0w + r) * 512 + u.hd * 64 + 16 * d0 + 8 * h);
    return issued;
}
DI void sb_body(const bf16_t* K, const bf16_t* VT, const SbUnit& u, int issued, bf16x8 (&qf)[4], LAS unsigned char* ring, volatile LAS int* ctl, volatile LAS int* bar, int& epoch, int w4, int lane, f32x16 (&o)[2]) {
    const int r = lane & 31, h = lane >> 5; const size_t gb = (size_t)u.b * SEQ; const int t0w = u.q0 + 32 * w4, sd = t0w >> 5;
    o[0] = zero16(); o[1] = zero16(); float Cl = 1.0f;
    const bf16_t* Kg = K + gb * 512 + u.hd * 64; const bf16_t* VTg = VT + ((gb >> 5) * 512 + u.hd * 64) * 32;
    const int jt_hi = (u.q0 + 127) >> 6, ntiles = jt_hi + 1;
    if (w4 == 0 && lane == 0) { ctl[0] = 0; ctl[1] = 0; ctl[2] = 0; }
    asm volatile("s_waitcnt vmcnt(0)" : "+v"(qf[0]), "+v"(qf[1]), "+v"(qf[2]), "+v"(qf[3]) :: "memory");
    bool done = false; int slot = 0;
    for (int i = 0; i < ntiles; ++i) {
        const int jt = jt_hi - i, fly = issued - (i + 1);
        if (fly >= 1) AT_WAIT_V(4); else AT_WAIT_V(0);
        grp_barrier(bar, epoch, lane);
        if (i > 0 && ctl[(i - 1) % 3] == 4) break;
        if (w4 == 0 && lane == 0) ctl[(i + 1) % 3] = 0;
        if (issued < ntiles) { at_issue4(Kg, VTg, ring + ((slot + 2) % 3) * AT_SLOT, jt_hi - issued, w4, lane); ++issued; }
        if (!done) {
            const LAS unsigned char* sl = ring + slot * AT_SLOT;
            const int s1 = 2 * jt + 1, s0 = 2 * jt;
            if (s1 < sd) sb_half<0>(sl, 1, qf, Cl, o, r, h); else if (s1 == sd) sb_half<1>(sl, 1, qf, Cl, o, r, h);
            if (s0 < sd) sb_half<0>(sl, 0, qf, Cl, o, r, h); else if (s0 == sd) sb_half<1>(sl, 0, qf, Cl, o, r, h);
            if (s1 <= sd || s0 <= sd) done = __all(Cl < SB_CMIN);
        }
        if (done && lane == 0) __hip_atomic_fetch_add((LAS int*)&ctl[i % 3], 1, __ATOMIC_RELAXED, __HIP_MEMORY_SCOPE_WORKGROUP);
        slot = (slot + 1) % 3;
    }
    AT_WAIT_V(0);
    grp_barrier(bar, epoch, lane);
}
DI void sw_head(const bf16x8 (&qf)[4], const LAS unsigned char* lds, float sink2, int t0, int jt_lo, int lane, f32x16 (&o)[2], float& lsum) {
    const int r = lane & 31, h = lane >> 5, sd = t0 >> 5;
    f32x16 S[5]; float m = sink2;
#pragma unroll
    for (int jj = 0; jj < 5; ++jj) { const int sj = sd - 4 + jj;
        if (sj >= 0) { bf16x8 kf[4]; at_kfrag(lds + ((sj >> 1) - jt_lo) * AT_SLOT, sj & 1, r, h, kf);
            f32x16 s = zero16();
#pragma unroll
            for (int d0 = 0; d0 < 4; ++d0) s = MFMA32(kf[d0], qf[d0], s);
#pragma unroll
            for (int i = 0; i < 16; ++i) { const int ko = 16 * (i >> 3) + 8 * h + (i & 7); float v = s[i];
                if (jj == 4 && ko > r) v = -1e30f;
                if (jj == 0 && ko <= r) v = -1e30f;
                s[i] = v; m = __builtin_fmaxf(m, v); }
            S[jj] = s; }
        else {
#pragma unroll
            for (int i = 0; i < 16; ++i) S[jj][i] = -1e30f; } }
    m = __builtin_fmaxf(m, __shfl_xor(m, 32));
    o[0] = zero16(); o[1] = zero16(); float ls = 0.f;
#pragma unroll
    for (int jj = 0; jj < 5; ++jj) { const int sj = sd - 4 + jj;
        if (sj >= 0) { bf16x8 vf[2][2]; at_vfrag(lds + ((sj >> 1) - jt_lo) * AT_SLOT, sj & 1, r, h, vf);
            f32x16 P;
#pragma unroll
            for (int i = 0; i < 16; ++i) { P[i] = __builtin_amdgcn_exp2f(S[jj][i] - m); ls += P[i]; }
            const bf16x8 Pf0 = packacc<0>(P), Pf1 = packacc<1>(P);
#pragma unroll
            for (int dt = 0; dt < 2; ++dt) { o[dt] = MFMA32(Pf0, vf[dt][0], o[dt]); o[dt] = MFMA32(Pf1, vf[dt][1], o[dt]); } } }
    ls += __shfl_xor(ls, 32);
    lsum = ls + __builtin_amdgcn_exp2f(sink2 - m);
}
DI void at_store(const f32x16 (&o)[2], float lsum, LAS float* stg, LAS float* lsb, bf16_t* mixrow0, float* ssq0, int lane) {
    const int r = lane & 31, h = lane >> 5, row = lane >> 1, hf = lane & 1;
    if (h == 0) lsb[r] = lsum;
    float ss = 0.f; u32x4 w[2][2];
#pragma unroll
    for (int dt = 0; dt < 2; ++dt) {
#pragma unroll
        for (int i = 0; i < 16; ++i) stg[crow(i, h) * 36 + r] = o[dt][i];
        LDS_WAIT();
        const float il = 1.0f / lsb[row];
#pragma unroll
        for (int k = 0; k < 2; ++k) { const f32x4 a0 = *(const LAS f32x4*)(stg + row * 36 + hf * 16 + 8 * k) * il, a1 = *(const LAS f32x4*)(stg + row * 36 + hf * 16 + 8 * k + 4) * il;
            ss += ((a0.x * a0.x + a0.y * a0.y) + (a0.z * a0.z + a0.w * a0.w)) + ((a1.x * a1.x + a1.y * a1.y) + (a1.z * a1.z + a1.w * a1.w)); w[dt][k] = pack8(a0, a1); }
        LDS_WAIT();
    }
    ss += __shfl_xor(ss, 1);
    if (hf == 0) ssq0[(size_t)row * 16] = ss;
    bf16_t* mr = mixrow0 + (size_t)row * 1024 + hf * 16;
#pragma unroll
    for (int dt = 0; dt < 2; ++dt) { *(u32x4*)(mr + 32 * dt) = w[dt][0]; *(u32x4*)(mr + 32 * dt + 8) = w[dt][1]; }
}
DI void p3_attention(const Args& a, LAS unsigned char* lds, int tid, int lane, int wave, int rep = 0, int kinds = 3) {
    asm volatile("" : "+v"(tid), "+v"(lane));
    const bf16_t* QSB = (const bf16_t*)(a.ws + WS_QSB); const bf16_t* KSB = (const bf16_t*)(a.ws + WS_KSB); const bf16_t* VTSB = (const bf16_t*)(a.ws + WS_VSB);
    const bf16_t* QSW = (const bf16_t*)(a.ws + WS_QSW); const bf16_t* KSW = (const bf16_t*)(a.ws + WS_KSW); const bf16_t* VTSW = (const bf16_t*)(a.ws + WS_VSW);
    bf16_t* MIX = (bf16_t*)(a.ws + WS_MIX); float* SSQ = (float*)(a.ws + WS_SSQ); unsigned* qctr = (unsigned*)(a.ws + WS_CTL) + CW_ATTNQ + 2048 * rep;
    LAS float* stg = (LAS float*)(lds + ATT_STG_OFF) + wave * ATT_STGW; LAS float* lsb = (LAS float*)(lds + ATT_LS_OFF) + wave * 32; volatile LAS int* ctl = (volatile LAS int*)(lds + ATT_CTL_OFF);
    if (kinds & 2)
    for (int u = (int)blockIdx.x; u < (T / 256) * 2; u += (int)gridDim.x) {
        const int b = u / 64, kvh = (u >> 5) & 1, q0 = (u & 31) * 256, jt_lo = (q0 >> 6) - 2, t0 = q0 + 32 * wave; const size_t gb = (size_t)b * SEQ;
        const bf16_t* Kg = KSW + gb * 128 + kvh * 64; const bf16_t* VTg = VTSW + ((gb >> 5) * 128 + kvh * 64) * 32;
#pragma unroll
        for (int s6 = 0; s6 < 6; ++s6) if (jt_lo + s6 >= 0) at_issue(Kg, 128, VTg, 128, lds + s6 * AT_SLOT, jt_lo + s6, wave, lane);
        bf16x8 qn[4];
#pragma unroll
        for (int d0 = 0; d0 < 4; ++d0) qn[d0] = *(const bf16x8*)(QSW + (gb + t0 + (lane & 31)) * 512 + (4 * kvh) * 64 + 16 * d0 + 8 * (lane >> 5));
        AT_WAIT_V(0); AT_BARRIER();
#pragma unroll
        for (int q = 0; q < 4; ++q) { const int hq = 4 * kvh + q; f32x16 o[2]; float lsum; bf16x8 qf[4];
#pragma unroll
            for (int d0 = 0; d0 < 4; ++d0) qf[d0] = qn[d0];
            if (q < 3) {
#pragma unroll
                for (int d0 = 0; d0 < 4; ++d0) qn[d0] = *(const bf16x8*)(QSW + (gb + t0 + (lane & 31)) * 512 + (hq + 1) * 64 + 16 * d0 + 8 * (lane >> 5)); }
            sw_head(qf, lds, a.sinks[hq] * LOG2E, t0, jt_lo, lane, o, lsum);
            at_store(o, lsum, stg, lsb, MIX + (gb + t0) * 1024 + 512 + hq * 64, SSQ + (gb + t0) * 16 + 8 + hq, lane); }
        asm volatile("s_waitcnt vmcnt(0)" ::: "memory"); AT_BARRIER();
    }
    if (kinds & 1) {
        volatile LAS int* gb2 = ctl + 32;
        if (tid < 2) gb2[16 * tid] = 0;
        __syncthreads();
        const int grp = wave >> 2, w4 = wave & 3; LAS unsigned char* ring = lds + grp * 3 * AT_SLOT; volatile LAS int* gctl = ctl + 8 * grp; volatile LAS int* bar = gb2 + 16 * grp; int epoch = 0;
        constexpr int NUNITS = (T / 128) * 8; const int NG = 2 * (int)gridDim.x, gg = 2 * (int)blockIdx.x + grp;
        bf16x8 qf[4]; int idx = gg; int issued = 0; SbUnit u = sb_unit_of(idx); unsigned nxt = 0;
        if (idx < NUNITS) issued = sb_prologue(QSB, KSB, VTSB, u, ring, w4, lane, qf);
        while (idx < NUNITS) {
            if (w4 == 0 && lane == 0) nxt = atomicAdd(qctr, 1u);
            f32x16 o[2];
            sb_body(KSB, VTSB, u, issued, qf, ring, gctl, bar, epoch, w4, lane, o);
            const size_t grow = (size_t)u.b * SEQ + u.q0 + 32 * w4; const int hd = u.hd;
            if (w4 == 0 && lane == 0) gctl[4] = NG + (int)nxt;
            grp_barrier(bar, epoch, lane);
            const int nidx = __builtin_amdgcn_readfirstlane(gctl[4]);
            grp_barrier(bar, epoch, lane);
            if (nidx < NUNITS) { u = sb_unit_of(nidx); issued = sb_prologue(QSB, KSB, VTSB, u, ring, w4, lane, qf); }
            at_store(o, 1.0f, stg, lsb, MIX + grow * 1024 + hd * 64, SSQ + grow * 16 + hd, lane);
            idx = nidx;
        }
    }
}

#define XB_TMO      128
#define XB_XCNT(j)  (256  + 64 * (j))
#define XB_XSUB(j)  (1280 + 64 * (j))
#define XB_XGEN(j)  (2304 + 64 * (j))
#define XB_TOP      3328
#define XB_TOPGEN   3392
#define XCD_BAR_WORDS 3456
#define XB_SPIN_CAP (1u << 18)
DI unsigned xb_ld(unsigned* p)              { return __hip_atomic_load(p, __ATOMIC_RELAXED, __HIP_MEMORY_SCOPE_AGENT); }
DI unsigned xb_add(unsigned* p, unsigned v) { return __hip_atomic_fetch_add(p, v, __ATOMIC_RELAXED, __HIP_MEMORY_SCOPE_AGENT); }
DI unsigned xb_xcc_id() { return (unsigned)__builtin_amdgcn_s_getreg((3 << 11) | 20) & 0xFu; }
#define XB_SPIN(cond, bar) do { unsigned _sp = 0; while (cond) { __builtin_amdgcn_s_sleep(1); \
    if ((++_sp & 255u) == 0u) { if (xb_ld(&(bar)[XB_TMO])) break; if (_sp > XB_SPIN_CAP) { atomicAdd(&(bar)[XB_TMO], 1u); break; } } } } while (0)
struct XcdBarrier { unsigned* bar; unsigned x; volatile LAS unsigned* st; };
DI XcdBarrier xcd_barrier_post(unsigned* bar, volatile LAS unsigned* st) {
    XcdBarrier b; b.bar = bar; b.x = xb_xcc_id(); b.st = st;
    if (threadIdx.x == 0) (void)xb_add(&bar[XB_XCNT(b.x)], 1u);
    return b;
}
DI void xcd_barrier_complete(unsigned* bar, unsigned x, unsigned& nloc, unsigned& nx) {
    const unsigned G = gridDim.x * gridDim.y * gridDim.z;
    unsigned sum, cnt, mine, sp = 0u;
    for (;;) {
        sum = 0u; cnt = 0u; mine = 0u;
#pragma unroll
        for (unsigned j = 0; j < 16; ++j) { const unsigned c = xb_ld(&bar[XB_XCNT(j)]); sum += c; cnt += (c > 0u) ? 1u : 0u; mine = (j == x) ? c : mine; }
        if (sum == G) break;
        __builtin_amdgcn_s_sleep(1);
        if ((++sp & 255u) == 0u) { if (xb_ld(&bar[XB_TMO])) break; if (sp > XB_SPIN_CAP) { atomicAdd(&bar[XB_TMO], 1u); break; } }
    }
    nloc = mine > 0u ? mine : 1u; nx = cnt > 0u ? cnt : 1u;
}
DI void xcd_barrier(const XcdBarrier& b) {
    asm volatile("s_waitcnt vmcnt(0)" ::: "memory");
    __syncthreads();
    if (threadIdx.x == 0) {
        unsigned* bar = b.bar;
        __builtin_amdgcn_s_waitcnt(0);
        unsigned nloc = b.st[0], nx = b.st[1];
        if (nloc == 0u) { xcd_barrier_complete(bar, b.x, nloc, nx); b.st[0] = nloc; b.st[1] = nx; }
        const unsigned old = xb_add(&bar[XB_XSUB(b.x)], 1u);
        const unsigned gen = old / nloc;
        if (old + 1u == (gen + 1u) * nloc) {
            __builtin_amdgcn_fence(__ATOMIC_RELEASE, "agent");
            asm volatile("s_waitcnt vmcnt(0)" ::: "memory");
            const unsigned og = xb_add(&bar[XB_TOP], 1u);
            const unsigned tg = og / nx;
            if (og + 1u == (tg + 1u) * nx) xb_add(&bar[XB_TOPGEN], 1u);
            else XB_SPIN(xb_ld(&bar[XB_TOPGEN]) == tg, bar);
            __builtin_amdgcn_fence(__ATOMIC_ACQUIRE, "agent");
            xb_add(&bar[XB_XGEN(b.x)], 1u);
            asm volatile("s_waitcnt vmcnt(0)" ::: "memory");
        } else {
            XB_SPIN(xb_ld(&bar[XB_XGEN(b.x)]) == gen, bar);
            __builtin_amdgcn_fence(__ATOMIC_ACQUIRE, "agent");
            asm volatile("s_waitcnt vmcnt(0)" ::: "memory");
        }
    }
    __syncthreads();
}

__global__ void __launch_bounds__(NTHREADS, 2) mk_fwd(Args a) {
    extern __shared__ __attribute__((aligned(16))) unsigned char lds_raw[];
    LAS unsigned char* lds = (LAS unsigned char*)lds_raw;
    const int tid = threadIdx.x, lane = tid & 63, wave = __builtin_amdgcn_readfirstlane(tid >> 6);
    volatile LAS unsigned* misc = (volatile LAS unsigned*)(lds + LDS_MISC);
    if (tid < 2) misc[tid] = 0u;
    __syncthreads();
    const XcdBarrier gbar = xcd_barrier_post((unsigned*)(a.ws + WS_CTL) + CW_BAR, misc);
    unsigned char* ws = a.ws;
    const float* mod = (const float*)(ws + WS_MOD);

#define REPS(k) ((PROBE_DUP == (k)) ? 2 : 1)
    int n_stamp = 0;
#define STAMP() do { if (STAMP_PHASE >= 0 && blockIdx.x == 0 && tid == 0) ((unsigned long long*)(ws + WS_STAMP))[n_stamp] = __builtin_amdgcn_s_memrealtime(); ++n_stamp; } while (0)
    STAMP();
    const int p2_units = (T / 256) * (DIN / 256), p2_rem = p2_units % (int)gridDim.x, n_tailw = p2_rem ? ((int)gridDim.x - p2_rem) * NWAVES : 0;
    const int n_tail_items = n_tailw * 4 < NEXPERT_ITEMS ? n_tailw * 4 : NEXPERT_ITEMS, n_p0_items = NEXPERT_ITEMS - n_tail_items;
    for (int rep = 0; rep < REPS(0); ++rep) { p0_prologue(a, lds, tid, lane, wave); expert_items(a, lds, 0, n_p0_items, blockIdx.x * NWAVES + wave, gridDim.x * NWAVES, lane, wave); xcd_barrier(gbar); STAMP(); }
    for (int rep = 0; rep < REPS(1); ++rep) { p1_norm(a, lane, wave); xcd_barrier(gbar); STAMP(); }
    for (int rep = 0; rep < REPS(2); ++rep) {
        DenseSched S{(const bf16_t*)(ws + WS_H), (const bf16_t*)(ws + WS_WIN), 1024, T / 256, DIN / 256};
        EpiProj E{(bf16_t*)(ws + WS_QSB), (bf16_t*)(ws + WS_VSB), (bf16_t*)(ws + WS_QSW), (bf16_t*)(ws + WS_KSW), (bf16_t*)(ws + WS_VSW), (const float*)(ws + WS_COS), (const float*)(ws + WS_SIN)};
        pg8::gemm_phase<DenseSched, EpiProj, true, 1024, 1024, 16>(lds, S, E);
        if (p2_rem && (int)blockIdx.x >= p2_rem && rep == 0) { __syncthreads(); expert_items(a, lds, n_p0_items, n_tail_items, ((int)blockIdx.x - p2_rem) * NWAVES + wave, n_tailw, lane, wave); }
        xcd_barrier(gbar); STAMP();
    }
    if (PROBE_DUP == 31 || PROBE_DUP == 32) { p3_attention(a, lds, tid, lane, wave, 1, PROBE_DUP - 30); xcd_barrier(gbar); }
    for (int rep = 0; rep < REPS(3); ++rep) { p3_attention(a, lds, tid, lane, wave, rep); xcd_barrier(gbar); STAMP(); }
    for (int rep = 0; rep < REPS(4); ++rep) {
        DenseSched S{(const bf16_t*)(ws + WS_MIX), (const bf16_t*)(ws + WS_WOUT), 1024, T / 256, DM / 256};
        EpiWout E{mod, (bf16_t*)(ws + WS_X1), a.x, (const float*)(ws + WS_SSQ), (LAS float*)(lds + pg8::STAGE_BYTES + 1024)};
        pg8::gemm_phase<DenseSched, EpiWout, true, 1024, 1024, 16>(lds, S, E);
        xcd_barrier(gbar); STAMP();
    }
    for (int rep = 0; rep < REPS(5); ++rep) { p5_router(a, lds, tid, lane, wave, rep); xcd_barrier(gbar); STAMP(); }
    LAS int* tstart = (LAS int*)(lds + pg8::STAGE_BYTES);
    const unsigned* cnt = (const unsigned*)(ws + WS_CTL) + CW_CNT;
    if (tid == 0) { int run = 0; for (int b = 0; b < NBUCKET; ++b) { tstart[b] = run; run += ((int)cnt[CNT_STRIDE * b] + 255) >> 8; } tstart[NBUCKET] = run; }
    __syncthreads();
    const bf16_t* H2 = (const bf16_t*)(ws + WS_H); const bf16_t* HIDc = (const bf16_t*)(ws + WS_HID); const int* LISTc = (const int*)(ws + WS_LIST);
    EpiUp EU{(bf16_t*)(ws + WS_HID), (const f32x2*)(ws + WS_WTS), (LAS float*)(lds + pg8::STAGE_BYTES + 1024)}; EpiDown ED{(bf16_t*)(ws + WS_Y)};
    if (gridDim.x == 256) {
        const MoeCut mc = moe_cut(__builtin_amdgcn_readfirstlane(tstart[NBUCKET]));
        { MoeSplitSched<true, 1> S{tstart, cnt, LISTc, H2, (const bf16_t*)(ws + WS_WGU), mc}; pg8::gemm_phase<MoeSplitSched<true, 1>, EpiUp, true, 1024, 1024, 16>(lds, S, EU); }
        xcd_barrier(gbar); STAMP();
        if (((int)blockIdx.x >> 3) < mc.left) { MoeSplitSched<true, 2> S{tstart, cnt, LISTc, H2, (const bf16_t*)(ws + WS_WGU), mc}; pg8::gemm_phase<MoeSplitSched<true, 2>, EpiUp, true, 1024, 1024, 16>(lds, S, EU); }
        else { MoeSplitSched<false, 2> S{tstart, cnt, LISTc, HIDc, (const bf16_t*)(ws + WS_WD), mc}; pg8::gemm_phase<MoeSplitSched<false, 2>, EpiDown, true, 1024, 512, 8>(lds, S, ED); }
        xcd_barrier(gbar); STAMP();
        { MoeSplitSched<false, 3> S{tstart, cnt, LISTc, HIDc, (const bf16_t*)(ws + WS_WD), mc}; pg8::gemm_phase<MoeSplitSched<false, 3>, EpiDown, true, 1024, 512, 8>(lds, S, ED); }
    } else {
        { MoeSched<8, true> S{tstart, cnt, LISTc, H2, (const bf16_t*)(ws + WS_WGU)}; pg8::gemm_phase<MoeSched<8, true>, EpiUp, true, 1024, 1024, 16>(lds, S, EU); }
        xcd_barrier(gbar); STAMP();
        { MoeSched<4, false> S{tstart, cnt, LISTc, HIDc, (const bf16_t*)(ws + WS_WD)}; pg8::gemm_phase<MoeSched<4, false>, EpiDown, true, 1024, 512, 8>(lds, S, ED); }
    }
    if (STAMP_PHASE >= 0) {
        if (blockIdx.x == 0 && tid == 0) { unsigned long long* st = (unsigned long long*)(ws + WS_STAMP); st[n_stamp] = __builtin_amdgcn_s_memrealtime();
            const float t_us = (float)(st[STAMP_PHASE + 1] - st[STAMP_PHASE]) * 0.01f; *(float*)(ws + WS_STAMP + 256) = 1.0f + sqrtf(t_us * STAMP_K); } }
    xcd_barrier(gbar);
    if (PROBE_DUP == 8) { p8_final(a, tstart, lane, wave, (float*)(ws + WS_H)); xcd_barrier(gbar); }
    p8_final(a, tstart, lane, wave, a.out);
}

extern "C" void kernel_launch(void* const* d_in, const int* in_sizes, int n_in, void* d_out, int out_size, void* d_ws, size_t ws_size, hipStream_t stream) {
    static int grid = 0;
    if (grid == 0) {
        if (n_in != 18 || in_sizes[0] != T * DM || out_size != T * DM || ws_size < WS_END) { fprintf(stderr, "kernel_launch: unexpected shapes (n_in %d, in0 %d, out %d, ws %zu); nothing launched\n", n_in, n_in > 0 ? in_sizes[0] : -1, out_size, ws_size); grid = -1; return; }
        int dev = 0, cus = 0, per_cu = 0;
        (void)hipGetDevice(&dev); (void)hipDeviceGetAttribute(&cus, hipDeviceAttributeMultiprocessorCount, dev);
        (void)hipFuncSetAttribute((const void*)mk_fwd, hipFuncAttributeMaxDynamicSharedMemorySize, LDS_BYTES);
        (void)hipOccupancyMaxActiveBlocksPerMultiprocessor(&per_cu, (const void*)mk_fwd, NTHREADS, LDS_BYTES);
        if (per_cu < 1) { fprintf(stderr, "kernel_launch: occupancy query says %d blocks per CU\n", per_cu); per_cu = 1; }
        grid = cus * per_cu;
        fprintf(stderr, "kernel_launch: %d CUs x %d = grid %d\n", cus, per_cu, grid);
    }
    if (grid < 0) return;
    (void)hipMemsetAsync((char*)d_ws + WS_CTL, 0, CTL_BYTES, stream);
    Args a{};
    a.x = (const float*)d_in[0]; a.c = (const float*)d_in[1]; a.pos = (const int*)d_in[2]; a.w_ada = (const float*)d_in[3]; a.b_ada = (const float*)d_in[4]; a.g_mix = (const float*)d_in[5];
    a.w_in = (const float*)d_in[6]; a.sinks = (const float*)d_in[7]; a.g_sb = (const float*)d_in[8]; a.g_sw = (const float*)d_in[9]; a.w_out = (const float*)d_in[10]; a.g_ffn = (const float*)d_in[11];
    a.w_rg = (const float*)d_in[12]; a.w_re = (const float*)d_in[13]; a.w_gate = (const float*)d_in[14]; a.w_up = (const float*)d_in[15]; a.w_down = (const float*)d_in[16]; a.g_fin = (const float*)d_in[17];
    a.out = (float*)d_out; a.ws = (unsigned char*)d_ws;
    void* args[] = {&a};
    hipError_t e = hipLaunchCooperativeKernel((const void*)mk_fwd, dim3(grid), dim3(NTHREADS), args, LDS_BYTES, stream);
    if (e != hipSuccess) fprintf(stderr, "kernel_launch: cooperative launch failed: %s (grid %d)\n", hipGetErrorString(e), grid);
}
```

```cpp
#include <hip/hip_runtime.h>
#include <cstdio>
#include <cstdint>
#include <cmath>

#define LAS __attribute__((address_space(3)))
#define DI __device__ __forceinline__
typedef unsigned short bf16_t;
typedef short bf16x8 __attribute__((ext_vector_type(8)));
typedef float f32x4 __attribute__((ext_vector_type(4)));
typedef float f32x2 __attribute__((ext_vector_type(2)));
typedef unsigned u32x4 __attribute__((ext_vector_type(4)));
typedef unsigned u32x2 __attribute__((ext_vector_type(2)));
typedef __bf16 bf16x2_t __attribute__((ext_vector_type(2)));

constexpr int NB = 4, SEQ = 8192, DM = 1024, T = NB * SEQ;
constexpr int DIN = 2304, DSB = 512, DSW = 512, DKV = 128;
constexpr int NEXP = 16, DEXP = 512, NBUCKET = 24, WINDOW = 128;
constexpr int MAXTILES = T / 256 + NBUCKET, TPAD = MAXTILES * 256;
constexpr float EPS = 1e-6f, LOG2E = 1.4426950408889634f, QSCALE = 0.125f * LOG2E;
constexpr int NTHREADS = 512, NWAVES = 8;
#ifndef STAMP_PHASE
#define STAMP_PHASE (-1)
#endif
#ifndef STAMP_K
#define STAMP_K 1e-5f
#endif
#ifndef PROBE_DUP
#define PROBE_DUP (-1)
#endif

constexpr size_t MiB = 1u << 20;
constexpr size_t WS_CTL = 0, CTL_BYTES = 1 * MiB;
constexpr size_t WS_MOD = 1 * MiB;
constexpr size_t WS_COS = 2 * MiB, WS_SIN = 6 * MiB;
constexpr size_t WS_WIN = 10 * MiB;
constexpr size_t WS_WOUT = 15 * MiB;
constexpr size_t WS_WGU = 17 * MiB;
constexpr size_t WS_WD = 49 * MiB;
constexpr size_t WS_LIST = 65 * MiB;
constexpr size_t WS_WTS = 68 * MiB;
constexpr size_t WS_STAMP = 512 * 1024;
constexpr size_t WS_TPOS = 74 * MiB;
constexpr size_t WS_SSQ = 76 * MiB;
constexpr size_t WS_H = 80 * MiB;
constexpr size_t WS_QSB = 144 * MiB, WS_KSB = 176 * MiB, WS_VSB = 208 * MiB, WS_QSW = 240 * MiB;
constexpr size_t WS_KSW = 272 * MiB, WS_VSW = 280 * MiB;
constexpr size_t WS_MIX = 288 * MiB;
constexpr size_t WS_HID = 352 * MiB;
constexpr size_t WS_END = 428 * MiB;
constexpr size_t WS_XB = WS_HID;
constexpr size_t WS_X1 = WS_QSB;
constexpr size_t WS_Y = WS_VSB;
static_assert(WS_X1 + (size_t)T * 1024 * 2 <= WS_VSB && WS_Y + (size_t)TPAD * 1024 * 2 <= WS_MIX && WS_XB + (size_t)T * 1024 * 2 <= WS_END, "overlays");
static_assert(WS_KSB - WS_QSB == WS_VSB - WS_KSB, "q/k/v_sb buffers equally spaced");
static_assert(WS_HID + (size_t)TPAD * 1024 * 2 <= WS_END, "ws map");
constexpr int CW_CNT = 8192, CNT_STRIDE = 64, CW_ATTNQ = 16384, CW_BAR = 4096;
constexpr int LDS_MISC = 143360;

constexpr int LDS_BYTES = 147456;

struct Args {
    const float* x; const float* c; const int* pos; const float* w_ada; const float* b_ada; const float* g_mix; const float* w_in; const float* sinks;
    const float* g_sb; const float* g_sw; const float* w_out; const float* g_ffn; const float* w_rg; const float* w_re; const float* w_gate; const float* w_up;
    const float* w_down; const float* g_fin; float* out; unsigned char* ws;
};

__constant__ float INV_FREQ[32] = {1.000000000e+00f, 7.498942018e-01f, 5.623413324e-01f, 4.216965139e-01f, 3.162277639e-01f, 2.371373773e-01f, 1.778279394e-01f, 1.333521456e-01f, 1.000000015e-01f, 7.498942316e-02f, 5.623413250e-02f, 4.216964915e-02f, 3.162277490e-02f, 2.371373773e-02f, 1.778279431e-02f, 1.333521400e-02f, 9.999999776e-03f, 7.498942316e-03f, 5.623413250e-03f, 4.216964822e-03f, 3.162277630e-03f, 2.371373819e-03f, 1.778279431e-03f, 1.333521446e-03f, 1.000000047e-03f, 7.498941850e-04f, 5.623413017e-04f, 4.216965172e-04f, 3.162277571e-04f, 2.371373703e-04f, 1.778279402e-04f, 1.333521504e-04f};

DI unsigned f2bf(float f) { unsigned u = __builtin_bit_cast(unsigned, f); return (u + 0x7fffu + ((u >> 16) & 1u)) >> 16; }
DI unsigned pk2(float lo, float hi) { f32x2 v = {lo, hi}; bf16x2_t b = __builtin_convertvector(v, bf16x2_t); return __builtin_bit_cast(unsigned, b); }
DI float bf2f(unsigned short b) { return __builtin_bit_cast(float, (unsigned)b << 16); }
DI float bflo(unsigned w) { return __builtin_bit_cast(float, w << 16); }
DI float bfhi(unsigned w) { return __builtin_bit_cast(float, w & 0xffff0000u); }
DI float wave_sum(float v) {
#pragma unroll
    for (int o = 1; o < 64; o <<= 1) v += __shfl_xor(v, o);
    return v;
}
#define DPP_ADD(v, ctrl) ((v) + __builtin_bit_cast(float, __builtin_amdgcn_update_dpp(0, __builtin_bit_cast(int, (v)), (ctrl), 0xF, 0xF, true)))
DI float wave_sum_fast(float v) { v = DPP_ADD(v, 0xB1); v = DPP_ADD(v, 0x4E); v = DPP_ADD(v, 0x141); v = DPP_ADD(v, 0x140);
    const auto r = __builtin_amdgcn_permlane16_swap(__builtin_bit_cast(unsigned, v), __builtin_bit_cast(unsigned, v), false, false); v = __builtin_bit_cast(float, r[0]) + __builtin_bit_cast(float, r[1]);
    const auto q = __builtin_amdgcn_permlane32_swap(__builtin_bit_cast(unsigned, v), __builtin_bit_cast(unsigned, v), false, false); return __builtin_bit_cast(float, q[0]) + __builtin_bit_cast(float, q[1]); }
#define LDS_WAIT() asm volatile("s_waitcnt lgkmcnt(0)" ::: "memory")
DI f32x4 ldnt4(const float* p) { return __builtin_nontemporal_load((const f32x4*)p); }

DI void tr_item64(const float* W, int N, int k0, int n0, bf16_t* WT, int drow0a, int drow0b, int Kd, const float* kscale, LAS float* scr, int lane) {
    f32x4 v[16]; const int kr = lane >> 4, c4 = 4 * (lane & 15);
#pragma unroll
    for (int i = 0; i < 16; ++i) v[i] = ldnt4(W + (size_t)(k0 + 4 * i + kr) * N + n0 + c4);
#pragma unroll
    for (int i = 0; i < 16; ++i) { const int kk = 4 * i + kr; f32x4 x = v[i]; if (kscale) x = x * kscale[k0 + kk]; LAS float* d = scr + kk * 65 + c4; d[0] = x.x; d[1] = x.y; d[2] = x.z; d[3] = x.w; }
    LDS_WAIT();
    const int c = lane & 7;
#pragma unroll
    for (int j = 0; j < 8; ++j) { const int n = (lane >> 3) + 8 * j; const LAS float* q = scr + (8 * c) * 65 + n;
        u32x4 o; o.x = pk2(q[0 * 65], q[1 * 65]); o.y = pk2(q[2 * 65], q[3 * 65]); o.z = pk2(q[4 * 65], q[5 * 65]); o.w = pk2(q[6 * 65], q[7 * 65]);
        const int dr = n < 32 ? drow0a + n : drow0b + (n - 32);
        *(u32x4*)(WT + (size_t)dr * Kd + k0 + 8 * c) = o; }
    LDS_WAIT();
}
DI int win_drow(int n0) {
    if (n0 < 1536) return n0;
    if (n0 < 2048) { const int c = n0 - 1536, head = c >> 6, half = (c >> 5) & 1; return 1536 + (head >> 2) * 256 + half * 128 + (head & 3) * 32; }
    if (n0 < 2176) { const int c = n0 - 2048, head = c >> 6, half = (c >> 5) & 1; return 2048 + half * 128 + head * 32; }
    const int c = n0 - 2176; return 2048 + (c >> 6) * 128 + 64 + (c & 63);
}
DI void p0_prologue(const Args& a, LAS unsigned char* lds, int tid, int lane, int wave) {
    unsigned char* ws = a.ws;
    {
        float* mod = (float*)(ws + WS_MOD); LAS float* red = (LAS float*)lds; LAS float* sc = (LAS float*)(lds + 32768);
        if ((int)blockIdx.x < 6144 / 64) { for (int i = tid; i < 4096; i += NTHREADS) { const float cv = a.c[i]; sc[i] = cv / (1.f + expf(-cv)); } __syncthreads(); }
        for (int cb = blockIdx.x; cb < 6144 / 64; cb += gridDim.x) {
            const int cl = tid & 15, kg = tid >> 4, col = cb * 64 + 4 * cl;
            f32x4 acc[4];
#pragma unroll
            for (int q = 0; q < 4; ++q) acc[q] = (f32x4){0.f, 0.f, 0.f, 0.f};
#pragma unroll 16
            for (int kk = 0; kk < 32; ++kk) { const int k = kg * 32 + kk; const f32x4 w = ldnt4(a.w_ada + (size_t)k * 6144 + col);
#pragma unroll
                for (int q = 0; q < 4; ++q) acc[q] = acc[q] + w * sc[q * 1024 + k]; }
#pragma unroll
            for (int q = 0; q < 4; ++q) *(LAS f32x4*)(red + (kg * 4 + q) * 64 + 4 * cl) = acc[q];
            __syncthreads();
            if (tid < 256) { const int q = tid >> 6, c2 = tid & 63; float sum = 0.f; for (int g = 0; g < 32; ++g) sum += red[(g * 4 + q) * 64 + c2]; mod[q * 6144 + cb * 64 + c2] = sum + a.b_ada[cb * 64 + c2]; }
            __syncthreads();
        }
    }
    {
        float* cosT = (float*)(ws + WS_COS); float* sinT = (float*)(ws + WS_SIN);
        for (int idx = blockIdx.x * NTHREADS + tid; idx < T * 32; idx += gridDim.x * NTHREADS) {
            const int t = idx >> 5, i = idx & 31; const float ang = (float)a.pos[t] * INV_FREQ[i];
            const double ad = (double)ang, kq = rint(ad * 0.63661977236758134308);
            double y = fma(-kq, 1.5707963267948966192, ad); y = fma(-kq, 6.123233995736766036e-17, y);
            const int q = (int)((long long)kq & 3); const double y2 = y * y;
            const double sn = y * (1.0 + y2 * (-1.0 / 6 + y2 * (1.0 / 120 + y2 * (-1.0 / 5040 + y2 * (1.0 / 362880 + y2 * (-1.0 / 39916800))))));
            const double cs = 1.0 + y2 * (-0.5 + y2 * (1.0 / 24 + y2 * (-1.0 / 720 + y2 * (1.0 / 40320 + y2 * (-1.0 / 3628800 + y2 * (1.0 / 479001600))))));
            double co, si; if (q == 0) { co = cs; si = sn; } else if (q == 1) { co = -sn; si = cs; } else if (q == 2) { co = -cs; si = -sn; } else { co = sn; si = -cs; }
            cosT[idx] = (float)co; sinT[idx] = (float)si;
        }
    }
    {
        __syncthreads();
        LAS float* scr = (LAS float*)(lds + 8192 + wave * 16640);
        const int gw = blockIdx.x * NWAVES + wave, NGW = gridDim.x * NWAVES;
        constexpr int I_IN = 16 * 36, I_OUT = 16 * 16, NITEMS = I_IN + I_OUT;
        for (int it = gw; it < NITEMS; it += NGW) {
            int r = it;
            if (r < I_IN) { const int kb = r / 36, nb = r % 36; tr_item64(a.w_in, DIN, kb * 64, nb * 64, (bf16_t*)(ws + WS_WIN), win_drow(nb * 64), win_drow(nb * 64 + 32), 1024, nullptr, scr, lane); continue; } r -= I_IN;
            { const int kb = r / 16, nb = r % 16; const float* ks = (kb < 8) ? a.g_sb : (a.g_sw - 512); tr_item64(a.w_out, 1024, kb * 64, nb * 64, (bf16_t*)(ws + WS_WOUT), nb * 64, nb * 64 + 32, 1024, ks, scr, lane); }
        }
    }
}
constexpr int NEXPERT_ITEMS = 2 * (16 * 16 * 8) + 16 * 8 * 16;
DI void expert_items(const Args& a, LAS unsigned char* lds, int first, int count, int w, int nw, int lane, int wave) {
    asm volatile("" : "+v"(lane));
    unsigned char* ws = a.ws;
    LAS float* scr = (LAS float*)(lds + 8192 + wave * 16640);
    constexpr int I_G = 16 * 16 * 8;
    for (int it = first + w; it < first + count; it += nw) {
        int r = it;
        if (r < 2 * I_G) { const int up = r >= I_G; if (up) r -= I_G; const int e = r / 128, q = r % 128, kb = q / 8, nb = q % 8, c0 = nb * 64; const int dr = (c0 >> 7) * 256 + up * 128 + (c0 & 127);
            tr_item64((up ? a.w_up : a.w_gate) + (size_t)e * 1024 * 512, 512, kb * 64, c0, (bf16_t*)(ws + WS_WGU) + (size_t)e * 1024 * 1024, dr, dr + 32, 1024, nullptr, scr, lane); continue; } r -= 2 * I_G;
        { const int e = r / 128, q = r % 128, kb = q / 16, nb = q % 16; tr_item64(a.w_down + (size_t)e * 512 * 1024, 1024, kb * 64, nb * 64, (bf16_t*)(ws + WS_WD) + (size_t)e * 1024 * 512, nb * 64, nb * 64 + 32, 512, nullptr, scr, lane); }
    }
}

DI void p1_norm(const Args& a, int lane, int wave) {
    asm volatile("" : "+v"(lane));
    const float* mod = (const float*)(a.ws + WS_MOD); bf16_t* H = (bf16_t*)(a.ws + WS_H);
    const int gw = blockIdx.x * NWAVES + wave, NGW = gridDim.x * NWAVES;
    int bprev = -1; f32x4 ca[4], cb[4];
#pragma unroll 1
    for (int q4 = gw; q4 < T / 4; q4 += NGW) {
        const int r0 = q4 * 4, b = r0 / SEQ;
        if (b != bprev) { bprev = b;
#pragma unroll
            for (int j = 0; j < 4; ++j) { const int col = 4 * lane + 256 * j; const f32x4 g = *(const f32x4*)(a.g_mix + col), sc = *(const f32x4*)(mod + b * 6144 + 1024 + col); ca[j] = g * (sc + 1.0f); cb[j] = *(const f32x4*)(mod + b * 6144 + col); } }
        f32x4 v[4][4];
#pragma unroll
        for (int rr = 0; rr < 4; ++rr)
#pragma unroll
            for (int j = 0; j < 4; ++j) v[rr][j] = ldnt4(a.x + (size_t)(r0 + rr) * DM + 4 * lane + 256 * j);
#pragma unroll
        for (int rr = 0; rr < 4; ++rr) { float s = 0.f;
#pragma unroll
            for (int j = 0; j < 4; ++j) s += (v[rr][j].x * v[rr][j].x + v[rr][j].y * v[rr][j].y) + (v[rr][j].z * v[rr][j].z + v[rr][j].w * v[rr][j].w);
            const float rs = 1.0f / sqrtf(wave_sum(s) * (1.0f / DM) + EPS);
            bf16_t* hr = H + (size_t)(r0 + rr) * DM;
#pragma unroll
            for (int j = 0; j < 4; ++j) { const f32x4 o = v[rr][j] * rs * ca[j] + cb[j]; u32x2 w; w.x = pk2(o.x, o.y); w.y = pk2(o.z, o.w); *(u32x2*)(hr + 4 * lane + 256 * j) = w; } }
    }
}
DI void p8_final(const Args& a, const LAS int* tstart, int lane, int wave, float* dst) {
    asm volatile("" : "+v"(lane));
    const float tscale = (STAMP_PHASE >= 0) ? *(const float*)(a.ws + WS_STAMP + 256) : 1.0f;
    const float* mod = (const float*)(a.ws + WS_MOD); const bf16_t* X1 = (const bf16_t*)(a.ws + WS_X1); const bf16_t* Y = (const bf16_t*)(a.ws + WS_Y); const int* tpos = (const int*)(a.ws + WS_TPOS);
    const int gw = blockIdx.x * NWAVES + wave, NGW = gridDim.x * NWAVES;
    for (int ch = gw; ch < T / 16; ch += NGW) {
        const int row0 = ch * 16, b = row0 / SEQ;
        f32x4 g[4], g2[4];
#pragma unroll
        for (int j = 0; j < 4; ++j) { g[j] = *(const f32x4*)(a.g_fin + 4 * lane + 256 * j); g2[j] = *(const f32x4*)(mod + b * 6144 + 5120 + 4 * lane + 256 * j); }
        const int tp = tpos[row0 + (lane & 15)];
        u32x2 xn[2][4], yn[2][4];
#pragma unroll
        for (int rr = 0; rr < 2; ++rr) { const int tpr = __builtin_amdgcn_readlane(tp, rr); const size_t srow = (size_t)tstart[tpr >> 16] * 256 + (tpr & 0xffff);
#pragma unroll
            for (int j = 0; j < 4; ++j) { xn[rr][j] = *(const u32x2*)(X1 + (size_t)(row0 + rr) * DM + 4 * lane + 256 * j); yn[rr][j] = *(const u32x2*)(Y + srow * DM + 4 * lane + 256 * j); } }
#pragma unroll 1
        for (int r2 = 0; r2 < 16; r2 += 2) {
            f32x4 v[2][4]; u32x2 xw[2][4], yw[2][4];
#pragma unroll
            for (int rr = 0; rr < 2; ++rr)
#pragma unroll
                for (int j = 0; j < 4; ++j) { xw[rr][j] = xn[rr][j]; yw[rr][j] = yn[rr][j]; }
            if (r2 + 2 < 16) {
#pragma unroll
                for (int rr = 0; rr < 2; ++rr) { const int tpr = __builtin_amdgcn_readlane(tp, r2 + 2 + rr); const size_t srow = (size_t)tstart[tpr >> 16] * 256 + (tpr & 0xffff);
#pragma unroll
                    for (int j = 0; j < 4; ++j) { xn[rr][j] = *(const u32x2*)(X1 + (size_t)(row0 + r2 + 2 + rr) * DM + 4 * lane + 256 * j); yn[rr][j] = *(const u32x2*)(Y + srow * DM + 4 * lane + 256 * j); } } }
#pragma unroll
            for (int rr = 0; rr < 2; ++rr) { float s = 0.f;
#pragma unroll
                for (int j = 0; j < 4; ++j) { v[rr][j] = (f32x4){bflo(xw[rr][j].x), bfhi(xw[rr][j].x), bflo(xw[rr][j].y), bfhi(xw[rr][j].y)} + g2[j] * (f32x4){bflo(yw[rr][j].x), bfhi(yw[rr][j].x), bflo(yw[rr][j].y), bfhi(yw[rr][j].y)};
                    s += (v[rr][j].x * v[rr][j].x + v[rr][j].y * v[rr][j].y) + (v[rr][j].z * v[rr][j].z + v[rr][j].w * v[rr][j].w); }
                const float rs = 1.0f / sqrtf(wave_sum(s) * (1.0f / DM) + EPS); float* orow = dst + (size_t)(row0 + r2 + rr) * DM;
#pragma unroll
                for (int j = 0; j < 4; ++j) *(f32x4*)(orow + 4 * lane + 256 * j) = v[rr][j] * (rs * tscale) * g[j]; }
        }
    }
}
constexpr int RT_LDS_BYTES = 1024 * 20 * 4;
DI void p5_router(const Args& a, LAS unsigned char* lds, int tid, int lane, int wave, int rep = 0) {
    const float* mod = (const float*)(a.ws + WS_MOD); bf16_t* H = (bf16_t*)(a.ws + WS_H);
    unsigned* cnt = (unsigned*)(a.ws + WS_CTL) + CW_CNT + 2048 * rep; int* list = (int*)(a.ws + WS_LIST); f32x2* wts = (f32x2*)(a.ws + WS_WTS);
    int* tpos = (int*)(a.ws + WS_TPOS); const bf16_t* X1 = (const bf16_t*)(a.ws + WS_X1);
    LAS f32x4* WL = (LAS f32x4*)lds;
    for (int idx = tid; idx < 1024 * 5; idx += NTHREADS) { const int k = idx / 5, q = idx % 5; const f32x4 w = (q == 0) ? *(const f32x4*)(a.w_rg + 4 * k) : *(const f32x4*)(a.w_re + 16 * k + 4 * (q - 1));
        WL[(((k >> 8) * 4 + (k & 3)) * 5 + q) * 64 + ((k & 255) >> 2)] = w; }
    __syncthreads();
    LAS int* wcnt = (LAS int*)(lds + RT_LDS_BYTES);
    for (int it = blockIdx.x; it < T / 128; it += gridDim.x) {
        const int row0 = it * 128 + wave * 16, b = row0 / SEQ;
        f32x4 ca[4], cb[4];
#pragma unroll
        for (int j = 0; j < 4; ++j) { const int col = 4 * lane + 256 * j; const f32x4 g = *(const f32x4*)(a.g_ffn + col), sc = *(const f32x4*)(mod + b * 6144 + 4096 + col); ca[j] = g * (sc + 1.0f); cb[j] = *(const f32x4*)(mod + b * 6144 + 3072 + col); }
        int mybucket = 0; float mywa = 0.f, mywb = 0.f;
        u32x2 xn[2][4];
#pragma unroll
        for (int rr = 0; rr < 2; ++rr)
#pragma unroll
            for (int j = 0; j < 4; ++j) xn[rr][j] = *(const u32x2*)(X1 + (size_t)(row0 + rr) * DM + 4 * lane + 256 * j);
#pragma unroll 1
        for (int r4 = 0; r4 < 16; r4 += 2) {
            f32x4 v[2][4];
#pragma unroll
            for (int rr = 0; rr < 2; ++rr)
#pragma unroll
                for (int j = 0; j < 4; ++j) { const u32x2 xw = xn[rr][j]; v[rr][j] = (f32x4){bflo(xw.x), bfhi(xw.x), bflo(xw.y), bfhi(xw.y)}; }
            if (r4 + 2 < 16) {
#pragma unroll
                for (int rr = 0; rr < 2; ++rr)
#pragma unroll
                    for (int j = 0; j < 4; ++j) xn[rr][j] = *(const u32x2*)(X1 + (size_t)(row0 + r4 + 2 + rr) * DM + 4 * lane + 256 * j); }
#pragma unroll
            for (int rr = 0; rr < 2; ++rr) { float s = 0.f;
#pragma unroll
                for (int j = 0; j < 4; ++j) s += (v[rr][j].x * v[rr][j].x + v[rr][j].y * v[rr][j].y) + (v[rr][j].z * v[rr][j].z + v[rr][j].w * v[rr][j].w);
                const float rs = 1.0f / sqrtf(wave_sum(s) * (1.0f / DM) + EPS);
                bf16_t* hr = H + (size_t)(row0 + r4 + rr) * DM;
#pragma unroll
                for (int j = 0; j < 4; ++j) { v[rr][j] = v[rr][j] * rs * ca[j] + cb[j]; u32x2 w; w.x = pk2(v[rr][j].x, v[rr][j].y); w.y = pk2(v[rr][j].z, v[rr][j].w); *(u32x2*)(hr + 4 * lane + 256 * j) = w; } }
            int wl_off = lane * 16; asm volatile("" : "+v"(wl_off));
            const LAS f32x4* WLp = (const LAS f32x4*)(lds + wl_off);
            f32x2 lg2[4];
#pragma unroll
            for (int i = 0; i < 4; ++i) lg2[i] = (f32x2){0.f, 0.f};
#pragma unroll
            for (int j = 0; j < 4; ++j)
#pragma unroll
                for (int e = 0; e < 4; ++e) { const f32x2 hv = (f32x2){v[0][j][e], v[1][j][e]}; const f32x4 w = WLp[((j * 4 + e) * 5) * 64];
                    lg2[0] += hv * w.x; lg2[1] += hv * w.y; lg2[2] += hv * w.z; lg2[3] += hv * w.w; }
#pragma unroll
            for (int rr = 0; rr < 2; ++rr) {
                float lg[4];
#pragma unroll
                for (int i = 0; i < 4; ++i) lg[i] = wave_sum(rr == 0 ? lg2[i].x : lg2[i].y);
                int g = 0; float gm = lg[0];
#pragma unroll
                for (int i = 1; i < 4; ++i) if (lg[i] > gm) { gm = lg[i]; g = i; }
                float gs = 0.f;
#pragma unroll
                for (int i = 0; i < 4; ++i) gs += expf(lg[i] - gm);
                const float gprob = 1.0f / gs;
                f32x4 ea4 = (f32x4){0.f, 0.f, 0.f, 0.f};
#pragma unroll
                for (int j = 0; j < 4; ++j)
#pragma unroll
                    for (int e = 0; e < 4; ++e) ea4 = ea4 + WLp[((j * 4 + e) * 5 + 1 + g) * 64] * v[rr][j][e];
                float el[4];
#pragma unroll
                for (int i = 0; i < 4; ++i) el[i] = wave_sum(ea4[i]);
                int i0 = 0; float m0 = el[0];
#pragma unroll
                for (int i = 1; i < 4; ++i) if (el[i] > m0) { m0 = el[i]; i0 = i; }
                int i1 = -1; float m1 = 0.f;
#pragma unroll
                for (int i = 0; i < 4; ++i) if (i != i0 && (i1 < 0 || el[i] > m1)) { m1 = el[i]; i1 = i; }
                const float ex = expf(m1 - m0), w0 = 1.0f / (1.0f + ex), w1 = ex * w0;
                const int ea = i0 < i1 ? i0 : i1, eb = i0 < i1 ? i1 : i0; const float wa = (i0 < i1 ? w0 : w1) * gprob, wb = (i0 < i1 ? w1 : w0) * gprob;
                const int bucket = g * 6 + (ea * (7 - ea)) / 2 + (eb - ea - 1);
                if (lane == r4 + rr) { mybucket = bucket; mywa = wa; mywb = wb; }
            }
        }
        if (lane >= 16) mybucket = -1;
        int myrank = 0;
        for (int q = 0; q < NBUCKET; ++q) { const unsigned long long mk = __ballot(mybucket == q); if (mybucket == q) myrank = __popcll(mk & ((1ull << lane) - 1ull)); if (lane == 0) wcnt[wave * NBUCKET + q] = __popcll(mk); }
        __syncthreads();
        if (tid < NBUCKET) { int tot = 0, pre[NWAVES];
#pragma unroll
            for (int w = 0; w < NWAVES; ++w) { pre[w] = tot; tot += wcnt[w * NBUCKET + tid]; }
            const unsigned base = tot ? atomicAdd(cnt + CNT_STRIDE * tid, (unsigned)tot) : 0u;
#pragma unroll
            for (int w = 0; w < NWAVES; ++w) wcnt[w * NBUCKET + tid] = (int)base + pre[w]; }
        __syncthreads();
        if (lane < 16) { const int p = wcnt[wave * NBUCKET + mybucket] + myrank; list[mybucket * T + p] = row0 + lane; wts[mybucket * T + p] = (f32x2){mywa, mywb}; tpos[row0 + lane] = (mybucket << 16) | p; }
        __syncthreads();
    }
}

struct GUnit { const bf16_t* A; const int* aidx; int nvalid; const bf16_t* B0; const bf16_t* B1; int pm, pn, lbase; };
namespace pg8 {
constexpr int BM = 256, BK = 64, HALF = 128, HTB = HALF * BK * 2, STAGE_BYTES = 8 * HTB;
DI int lds_byte(int r, int c) { const int st = (r >> 4) * 2 + (c >> 5), rr = r & 15, cc = c & 31, ob = rr * 64 + cc * 2; return st * 1024 + (ob ^ (((ob >> 9) & 1) << 5)); }
DI void stage_rc(int b, int& R, int& C) { const int st = b / 1024, sb = b % 1024, swz = sb ^ (((sb >> 9) & 1) << 5); R = (st >> 1) * 16 + swz / 64; C = (st & 1) * 32 + (swz % 64) / 2; }
DI int perm32(int rho) { const int n = rho >> 4, i = rho & 15; return 8 * (i >> 2) + 4 * n + (i & 3); }
DI void a_offsets(const GUnit& u, int K, int tid_, unsigned (&vo)[2][2]) {
    asm volatile("" : "+v"(tid_));
#pragma unroll
    for (int i = 0; i < 2; ++i) { int R, C; stage_rc(tid_ * 16 + i * 8192, R, C);
#pragma unroll
        for (int h = 0; h < 2; ++h) { const int r = h * HALF + R; const int gr = u.aidx ? u.aidx[r < u.nvalid ? r : 0] : r; vo[h][i] = ((unsigned)gr * (unsigned)K + (unsigned)C) * 2u; } }
}
template <class Sched, class Epi, bool ALIGN_EPI, int K, int ldb, int nsplit>
DI void gemm_phase(LAS unsigned char* lds, const Sched& S, const Epi& E) {
    int tid = threadIdx.x; asm volatile("" : "+v"(tid));
    const int wid = __builtin_amdgcn_readfirstlane(tid >> 6), lane = tid & 63, wr = wid >> 2, wc = wid & 3, fr = lane & 15, fq = lane >> 4;
    const int nt = K / BK;
    unsigned voffB[2];
#pragma unroll
    for (int i = 0; i < 2; ++i) { int R, C; stage_rc(tid * 16 + i * 8192, R, C); const int Rb = (R & ~31) + perm32(R & 31); voffB[i] = ((unsigned)Rb * (unsigned)ldb + (unsigned)C) * 2u; }
    const size_t hB = (size_t)HALF * ldb * 2;
    const unsigned ldsw = (unsigned)wid * 1024u;
    const int aoff = lds_byte(wr * 64 + fr, fq * 8), boff = lds_byte(wc * 32 + fr, fq * 8);
#define PG8_SA(b, h) (((b) * 2 + (h)) * HTB)
#define PG8_SB(b, h) ((4 + (b) * 2 + (h)) * HTB)
#define PG8_STAGE(bufoff, gbase, voff) do { _Pragma("unroll") for (int _i = 0; _i < 2; ++_i) \
        __builtin_amdgcn_global_load_lds((const unsigned*)((const char*)(gbase) + (voff)[_i]), (LAS unsigned*)(lds + (bufoff) + ldsw + _i * 8192), 16, 0, 0); } while (0)
#define PG8_LDA(dst, b, h) do { _Pragma("unroll") for (int m = 0; m < 4; ++m) _Pragma("unroll") for (int k = 0; k < 2; ++k) dst[m][k] = *(const LAS bf16x8*)(lds + PG8_SA(b, h) + aoff + m * 2048 + k * 1024); } while (0)
#define PG8_LDB(dst, b, h) do { _Pragma("unroll") for (int n = 0; n < 2; ++n) _Pragma("unroll") for (int k = 0; k < 2; ++k) dst[n][k] = *(const LAS bf16x8*)(lds + PG8_SB(b, h) + boff + n * 2048 + k * 1024); } while (0)
#define PG8_MMA(ai, bj, At, Bt) do { __builtin_amdgcn_s_setprio(1); _Pragma("unroll") for (int m = 0; m < 4; ++m) _Pragma("unroll") for (int n = 0; n < 2; ++n) _Pragma("unroll") for (int k = 0; k < 2; ++k) \
        acc[ai][bj][m][n] = __builtin_amdgcn_mfma_f32_16x16x32_bf16(Bt[n][k], At[m][k], acc[ai][bj][m][n], 0, 0, 0); __builtin_amdgcn_s_setprio(0); } while (0)
#define PG8_WAIT_V(n) asm volatile("s_waitcnt vmcnt(" #n ")" ::: "memory")
#define PG8_WAIT_L(n) asm volatile("s_waitcnt lgkmcnt(" #n ")" ::: "memory")
#define PG8_BAR __builtin_amdgcn_s_barrier()
#define PG8_SCHED __builtin_amdgcn_sched_barrier(0)
#define PG8_AK(u, kt) ((const char*)(u).A + (size_t)(kt) * (BK * 2))
#define PG8_BK(u, kt) ((kt) < nsplit ? (const char*)(u).B0 + (size_t)(kt) * (BK * 2) : (const char*)(u).B1 + (size_t)((kt) - nsplit) * (BK * 2))
    GUnit cur, nxt; int ui = 0;
    if (!S.next(0, cur)) return;
    f32x4 acc[2][2][4][2];
#pragma unroll
    for (int a = 0; a < 2; ++a)
#pragma unroll
        for (int b = 0; b < 2; ++b)
#pragma unroll
            for (int m = 0; m < 4; ++m)
#pragma unroll
                for (int n = 0; n < 2; ++n) acc[a][b][m][n] = (f32x4){0.f, 0.f, 0.f, 0.f};
    bf16x8 At[4][2], B0[2][2], B1[2][2];
    unsigned voffA[2][2];
    a_offsets(cur, K, tid, voffA);
    if constexpr (Epi::MIDK) E.prep(cur, 0, tid);
    {
        const char* a0 = PG8_AK(cur, 0); const char* b0 = PG8_BK(cur, 0); const char* a1 = PG8_AK(cur, 1); const char* b1 = PG8_BK(cur, 1);
        PG8_STAGE(PG8_SB(0, 0), b0, voffB); PG8_STAGE(PG8_SB(0, 1), b0 + hB, voffB); PG8_STAGE(PG8_SA(0, 0), a0, voffA[0]); PG8_STAGE(PG8_SA(0, 1), a0, voffA[1]);
        if (wr == 1) PG8_BAR;
        PG8_WAIT_V(2); PG8_BAR;
        PG8_STAGE(PG8_SB(1, 0), b1, voffB); PG8_STAGE(PG8_SA(1, 0), a1, voffA[0]); PG8_STAGE(PG8_SB(1, 1), b1 + hB, voffB);
        PG8_WAIT_V(6); PG8_BAR;
    }
    for (;;) {
        const bool has_next = S.next(ui + 1, nxt);
        if (!has_next) nxt = cur;
        for (int t = 0; t < nt; t += 2) {
            if constexpr (Epi::MIDK) { if (t == nt / 2) E.midk(acc, cur, wr, wc, fr, fq, ui & 1); }
            const bool last = (t == nt - 2);
            const char* a1 = PG8_AK(cur, t + 1);
            const char* a2 = last ? PG8_AK(nxt, 0) : PG8_AK(cur, t + 2); const char* b2 = last ? PG8_BK(nxt, 0) : PG8_BK(cur, t + 2);
            const char* a3 = last ? PG8_AK(nxt, 1) : PG8_AK(cur, t + 3); const char* b3 = last ? PG8_BK(nxt, 1) : PG8_BK(cur, t + 3);
            PG8_LDB(B0, 0, 0); PG8_LDB(B1, 0, 1); PG8_SCHED; PG8_LDA(At, 0, 0); PG8_STAGE(PG8_SA(1, 1), a1, voffA[1]);
            if (last) a_offsets(nxt, K, tid, voffA);
            PG8_WAIT_V(8); PG8_WAIT_L(0); PG8_BAR; PG8_MMA(0, 0, At, B0); PG8_MMA(0, 1, At, B1); PG8_BAR; PG8_SCHED;
            PG8_LDA(At, 0, 1); PG8_STAGE(PG8_SB(0, 0), b2, voffB); PG8_STAGE(PG8_SB(0, 1), b2 + hB, voffB); PG8_STAGE(PG8_SA(0, 0), a2, voffA[0]);
            PG8_WAIT_V(8); PG8_WAIT_L(0); PG8_BAR; PG8_MMA(1, 0, At, B0); PG8_MMA(1, 1, At, B1); PG8_BAR; PG8_SCHED;
            PG8_LDB(B0, 1, 0); PG8_LDB(B1, 1, 1); PG8_SCHED; PG8_LDA(At, 1, 0); PG8_STAGE(PG8_SA(0, 1), a2, voffA[1]);
            PG8_WAIT_V(8); PG8_WAIT_L(0); PG8_BAR; PG8_MMA(0, 0, At, B0); PG8_MMA(0, 1, At, B1); PG8_BAR; PG8_SCHED;
            PG8_LDA(At, 1, 1); PG8_STAGE(PG8_SB(1, 0), b3, voffB); PG8_STAGE(PG8_SB(1, 1), b3 + hB, voffB); PG8_STAGE(PG8_SA(1, 0), a3, voffA[0]);
            PG8_WAIT_V(8); PG8_WAIT_L(0); PG8_BAR; PG8_MMA(1, 0, At, B0); PG8_MMA(1, 1, At, B1); PG8_BAR; PG8_SCHED;
        }
        if constexpr (ALIGN_EPI) { if (wr == 0) PG8_BAR; }
        E(acc, cur, wr, wc, fr, fq, ui & 1);
        if (!has_next) break;
        if constexpr (Epi::MIDK) E.prep(nxt, (ui + 1) & 1, tid);
#pragma unroll
        for (int a = 0; a < 2; ++a)
#pragma unroll
            for (int b = 0; b < 2; ++b)
#pragma unroll
                for (int m = 0; m < 4; ++m)
#pragma unroll
                    for (int n = 0; n < 2; ++n) acc[a][b][m][n] = (f32x4){0.f, 0.f, 0.f, 0.f};
        cur = nxt; ++ui;
        if constexpr (ALIGN_EPI) { if (wr == 1) PG8_BAR; }
    }
    PG8_WAIT_V(0);
    if constexpr (!ALIGN_EPI) { if (wr == 0) PG8_BAR; }
    PG8_BAR;
#undef PG8_SA
#undef PG8_SB
#undef PG8_STAGE
#undef PG8_LDA
#undef PG8_LDB
#undef PG8_MMA
#undef PG8_WAIT_V
#undef PG8_WAIT_L
#undef PG8_BAR
#undef PG8_SCHED
#undef PG8_AK
#undef PG8_BK
}
}
struct DenseSched {
    const bf16_t* A; const bf16_t* Bt; int K, nM, nN;
    DI bool next(int i, GUnit& u) const {
        const int nwg = nM * nN; const long L = (long)i * (int)gridDim.x + (int)blockIdx.x; if (L >= nwg) return false;
        int wgid = (int)L; { const int q = nwg / 8, r = nwg % 8, xcd = wgid % 8, off = wgid / 8; wgid = (xcd < r ? xcd * (q + 1) : r * (q + 1) + (xcd - r) * q) + off; }
        const int nig = 8 * nN, gid = wgid / nig, fm = gid * 8, gsz = (nM - fm) < 8 ? (nM - fm) : 8;
        u.pm = fm + ((wgid % nig) % gsz); u.pn = (wgid % nig) / gsz;
        u.A = A + (size_t)u.pm * 256 * K; u.aidx = nullptr; u.nvalid = 256; u.B0 = Bt + (size_t)u.pn * 256 * K; u.B1 = u.B0; u.lbase = 0; return true; }
};
template <bool up> DI void moe_fill_unit(GUnit& u, int ti, int pn, const LAS int* tstart, const unsigned* cnt, const int* list, const bf16_t* A, const bf16_t* W) {
    int b = 0;
    for (int q = 1; q < NBUCKET; ++q) if (__builtin_amdgcn_readfirstlane(tstart[q]) <= ti) b = q;
    const int rt = ti - __builtin_amdgcn_readfirstlane(tstart[b]); const int g = b / 6, p = b % 6; const int ea = 4 * g + (p < 3 ? 0 : (p < 5 ? 1 : 2)), eb = 4 * g + (p < 3 ? p + 1 : (p < 5 ? p - 1 : 3));
    u.pm = ti; u.pn = pn; u.lbase = b * T + rt * 256; const int nv = __builtin_amdgcn_readfirstlane((int)cnt[CNT_STRIDE * b]) - rt * 256; u.nvalid = nv < 256 ? nv : 256;
    if (up) { u.A = A; u.aidx = list + u.lbase; const int e = pn < 4 ? ea : eb; u.B0 = W + (size_t)e * 1024 * 1024 + (size_t)(pn & 3) * 256 * 1024; u.B1 = u.B0; }
    else { u.A = A + (size_t)ti * 256 * 1024; u.aidx = nullptr; u.B0 = W + (size_t)ea * 1024 * 512 + (size_t)pn * 256 * 512; u.B1 = W + (size_t)eb * 1024 * 512 + (size_t)pn * 256 * 512; }
}
template <int NT, bool up> struct MoeSched {
    const LAS int* tstart; const unsigned* cnt; const int* list; const bf16_t* A; const bf16_t* W;
    DI bool next(int i, GUnit& u) const {
        const int ntile = __builtin_amdgcn_readfirstlane(tstart[NBUCKET]), nwg = ntile * NT; const int L0 = i * (int)gridDim.x + (int)blockIdx.x; if (L0 >= nwg) return false;
        int L = L0; { const int q = nwg / 8, r = nwg % 8, xcd = L0 % 8, off = L0 / 8; L = (xcd < r ? xcd * (q + 1) : r * (q + 1) + (xcd - r) * q) + off; }
        moe_fill_unit<up>(u, L / NT, L % NT, tstart, cnt, list, A, W); return true;
    }
};
struct MoeCut { int x, tiles_x, cstart, left, nY; };
DI MoeCut moe_cut(int ntile) { MoeCut c; c.x = (int)blockIdx.x & 7; const int q = ntile / 8, r = ntile % 8; c.tiles_x = q + (c.x < r ? 1 : 0); c.cstart = c.x * q + (c.x < r ? c.x : r); c.left = 8 * (c.tiles_x - 16); c.nY = 32 - c.left; return c; }
template <bool up, int MODE> struct MoeSplitSched {
    const LAS int* tstart; const unsigned* cnt; const int* list; const bf16_t* A; const bf16_t* W; MoeCut c;
    DI bool next(int i, GUnit& u) const {
        const int w = (int)blockIdx.x >> 3; int ti, pn;
        if (MODE == 1) { if (i >= 4) return false; const int off = i * 32 + w; ti = c.cstart + (off >> 3); pn = off & 7; }
        else if (MODE == 2 && up) { if (i > 0) return false; const int off = 128 + w; ti = c.cstart + (off >> 3); pn = off & 7; }
        else if (MODE == 2) { if (i > 0) return false; const int d = w - c.left; ti = c.cstart + (d >> 2); pn = d & 3; }
        else { const int e = i * 32 + w, rem = 4 * c.tiles_x - c.nY; if (e >= rem) return false;
            if (e < 64 - c.nY) { const int d = c.nY + e; ti = c.cstart + (d >> 2); pn = d & 3; } else { const int l = e - (64 - c.nY); ti = c.cstart + 16 + (l >> 2); pn = l & 3; } }
        moe_fill_unit<up>(u, ti, pn, tstart, cnt, list, A, W); return true;
    }
};

DI u32x4 pack8(const f32x4 v0, const f32x4 v1) { u32x4 w; w.x = pk2(v0[0], v0[1]); w.y = pk2(v0[2], v0[3]); w.z = pk2(v1[0], v1[1]); w.w = pk2(v1[2], v1[3]); return w; }
struct EpiProj { static constexpr bool MIDK = false;
    bf16_t *qsb, *vtsb, *qsw, *ksw, *vtsw; const float *cosT, *sinT;
    DI void operator()(const f32x4 (&acc)[2][2][4][2], const GUnit& u, int wr, int wc, int fr, int fq, int) const {
        const int pn = u.pn, rowb = u.pm * 256 + wr * 64 + fr;
        if (pn < 4) {
            bf16_t* base = qsb + (size_t)(pn >> 1) * ((WS_KSB - WS_QSB) / 2); const float sc = pn < 2 ? QSCALE : 1.0f; const int colt = (pn & 1) * 256 + wc * 32 + 8 * fq;
#pragma unroll
            for (int ai = 0; ai < 2; ++ai)
#pragma unroll
                for (int m = 0; m < 4; ++m) { const size_t row = rowb + ai * 128 + m * 16;
#pragma unroll
                    for (int bj = 0; bj < 2; ++bj) *(u32x4*)(base + row * 512 + colt + bj * 128) = pack8(acc[ai][bj][m][0] * sc, acc[ai][bj][m][1] * sc); }
        } else if (pn < 6 || (pn == 8 && wc >= 2)) {
            bf16_t* base = pn < 6 ? vtsb : vtsw; const int NF = pn < 6 ? 512 : 128, c0 = pn < 6 ? (pn - 4) * 256 + wc * 32 + 8 * fq : (wc * 32 - 64) + 8 * fq, bjs = pn < 6 ? 128 : 64;
#pragma unroll
            for (int ai = 0; ai < 2; ++ai)
#pragma unroll
                for (int m = 0; m < 4; ++m) { const int row = rowb + ai * 128 + m * 16; bf16_t* bp = base + ((size_t)(row >> 5) * NF + c0) * 32 + (row & 31);
#pragma unroll
                    for (int bj = 0; bj < 2; ++bj)
#pragma unroll
                        for (int n = 0; n < 2; ++n)
#pragma unroll
                            for (int j = 0; j < 4; ++j) bp[(bj * bjs + 4 * n + j) * 32] = (bf16_t)f2bf(acc[ai][bj][m][n][j]); }
        } else {
            const bool isq = pn < 8; bf16_t* base = isq ? qsw : ksw; const int pitch = isq ? 512 : 128; const int head = isq ? (pn - 6) * 4 + wc : wc; const float sc = isq ? QSCALE : 1.0f;
#pragma unroll
            for (int ai = 0; ai < 2; ++ai)
#pragma unroll
                for (int m = 0; m < 4; ++m) { const size_t row = rowb + ai * 128 + m * 16;
                    const f32x4 c0 = *(const f32x4*)(cosT + row * 32 + 8 * fq), c1 = *(const f32x4*)(cosT + row * 32 + 8 * fq + 4);
                    const f32x4 s0 = *(const f32x4*)(sinT + row * 32 + 8 * fq), s1 = *(const f32x4*)(sinT + row * 32 + 8 * fq + 4);
                    const f32x4 x10 = acc[ai][0][m][0], x11 = acc[ai][0][m][1], x20 = acc[ai][1][m][0], x21 = acc[ai][1][m][1];
                    const f32x4 o10 = (x10 * c0 - x20 * s0) * sc, o11 = (x11 * c1 - x21 * s1) * sc, o20 = (x20 * c0 + x10 * s0) * sc, o21 = (x21 * c1 + x11 * s1) * sc;
                    *(u32x4*)(base + row * pitch + head * 64 + 8 * fq) = pack8(o10, o11); *(u32x4*)(base + row * pitch + head * 64 + 32 + 8 * fq) = pack8(o20, o21); }
        }
    }
};
struct EpiWout {
    static constexpr bool MIDK = true;
    const float* mod; bf16_t* x1; const float* x; const float* ssq; LAS float* tab;
    DI void prep(const GUnit& u, int par, int tid) const {
        if (tid < 256) { const size_t row = (size_t)u.pm * 256 + tid; const f32x4 a0 = *(const f32x4*)(ssq + row * 16), a1 = *(const f32x4*)(ssq + row * 16 + 4), b0 = *(const f32x4*)(ssq + row * 16 + 8), b1 = *(const f32x4*)(ssq + row * 16 + 12);
            const float sa = ((a0.x + a0.y) + (a0.z + a0.w)) + ((a1.x + a1.y) + (a1.z + a1.w)), sb = ((b0.x + b0.y) + (b0.z + b0.w)) + ((b1.x + b1.y) + (b1.z + b1.w));
            const float rsb = 1.0f / sqrtf(sa * (1.0f / 512.0f) + EPS), rsw = 1.0f / sqrtf(sb * (1.0f / 512.0f) + EPS);
            *(LAS f32x2*)(tab + (par * 256 + tid) * 2) = (f32x2){rsb / rsw, rsw}; }
    }
    DI void midk(f32x4 (&acc)[2][2][4][2], const GUnit& u, int wr, int wc, int fr, int fq, int par) const {
#pragma unroll
        for (int ai = 0; ai < 2; ++ai)
#pragma unroll
            for (int m = 0; m < 4; ++m) { const float ratio = tab[(par * 256 + ai * 128 + wr * 64 + m * 16 + fr) * 2];
#pragma unroll
                for (int bj = 0; bj < 2; ++bj)
#pragma unroll
                    for (int n = 0; n < 2; ++n) acc[ai][bj][m][n] = acc[ai][bj][m][n] * ratio; }
    }
    DI void operator()(const f32x4 (&acc)[2][2][4][2], const GUnit& u, int wr, int wc, int fr, int fq, int par) const {
        const int rowb = u.pm * 256 + wr * 64 + fr, colb = u.pn * 256 + wc * 32 + 8 * fq; const int b = (u.pm * 256) / SEQ;
        f32x4 gt[2][2];
#pragma unroll
        for (int bj = 0; bj < 2; ++bj)
#pragma unroll
            for (int n = 0; n < 2; ++n) gt[bj][n] = *(const f32x4*)(mod + b * 6144 + 2048 + colb + bj * 128 + 4 * n);
#pragma unroll
        for (int ai = 0; ai < 2; ++ai)
#pragma unroll
            for (int mp = 0; mp < 2; ++mp) {
                f32x4 xv[2][2][2];
#pragma unroll
                for (int mm = 0; mm < 2; ++mm)
#pragma unroll
                    for (int bj = 0; bj < 2; ++bj)
#pragma unroll
                        for (int n = 0; n < 2; ++n) xv[mm][bj][n] = ldnt4(x + (size_t)(rowb + ai * 128 + (2 * mp + mm) * 16) * DM + colb + bj * 128 + 4 * n);
#pragma unroll
                for (int mm = 0; mm < 2; ++mm) { const int m = 2 * mp + mm, row = rowb + ai * 128 + m * 16; const float rsw = tab[(par * 256 + ai * 128 + wr * 64 + m * 16 + fr) * 2 + 1];
#pragma unroll
                    for (int bj = 0; bj < 2; ++bj) *(u32x4*)(x1 + (size_t)row * DM + colb + bj * 128) = pack8(xv[mm][bj][0] + gt[bj][0] * (acc[ai][bj][m][0] * rsw), xv[mm][bj][1] + gt[bj][1] * (acc[ai][bj][m][1] * rsw)); }
                asm volatile("" ::: "memory");
            }
    }
};
DI f32x4 swiglu4(const f32x4 g, const f32x4 uu, float w) { f32x4 o;
#pragma unroll
    for (int j = 0; j < 4; ++j) o[j] = (w * uu[j]) * (g[j] * __builtin_amdgcn_rcpf(1.0f + __builtin_amdgcn_exp2f(-LOG2E * g[j])));
    return o; }
struct EpiUp { static constexpr bool MIDK = true;
    bf16_t* hid; const f32x2* wts; LAS float* tab;
    DI void prep(const GUnit& u, int par, int tid) const {
        if (tid < 256) { float w = 0.f; if (tid < u.nvalid) { const f32x2 ww = wts[u.lbase + tid]; w = u.pn >= 4 ? ww.y : ww.x; } tab[par * 256 + tid] = w; }
    }
    DI void midk(f32x4 (&)[2][2][4][2], const GUnit&, int, int, int, int, int) const {}
    DI void operator()(const f32x4 (&acc)[2][2][4][2], const GUnit& u, int wr, int wc, int fr, int fq, int par) const {
        const int hc = (u.pn >> 2) * 512 + (u.pn & 3) * 128 + wc * 32 + 8 * fq;
#pragma unroll
        for (int ai = 0; ai < 2; ++ai)
#pragma unroll
            for (int m = 0; m < 4; ++m) { const int r = ai * 128 + wr * 64 + m * 16 + fr; const float w = tab[par * 256 + r];
                *(u32x4*)(hid + (size_t)(u.pm * 256 + r) * 1024 + hc) = pack8(swiglu4(acc[ai][0][m][0], acc[ai][1][m][0], w), swiglu4(acc[ai][0][m][1], acc[ai][1][m][1], w)); }
    }
};
struct EpiDown { static constexpr bool MIDK = false;
    bf16_t* y;
    DI void operator()(const f32x4 (&acc)[2][2][4][2], const GUnit& u, int wr, int wc, int fr, int fq, int) const {
        const int rowb = u.pm * 256 + wr * 64 + fr, colb = u.pn * 256 + wc * 32 + 8 * fq;
#pragma unroll
        for (int ai = 0; ai < 2; ++ai)
#pragma unroll
            for (int m = 0; m < 4; ++m) { const size_t row = rowb + ai * 128 + m * 16;
#pragma unroll
                for (int bj = 0; bj < 2; ++bj) *(u32x4*)(y + row * DM + colb + bj * 128) = pack8(acc[ai][bj][m][0], acc[ai][bj][m][1]); }
    }
};

typedef float f32x16 __attribute__((ext_vector_type(16)));
#define MFMA32(a, b, c) __builtin_amdgcn_mfma_f32_32x32x16_bf16((a), (b), (c), 0, 0, 0)
DI int pi32(int r) { return (r & ~12) | ((r & 4) << 1) | ((r & 8) >> 1); }
DI int crow(int i, int h) { return (i & 3) + 8 * (i >> 2) + 4 * h; }
template <int S_> DI bf16x8 packacc(const f32x16& x) { u32x4 p; p.x = pk2(x[8 * S_], x[8 * S_ + 1]); p.y = pk2(x[8 * S_ + 2], x[8 * S_ + 3]); p.z = pk2(x[8 * S_ + 4], x[8 * S_ + 5]); p.w = pk2(x[8 * S_ + 6], x[8 * S_ + 7]); return __builtin_bit_cast(bf16x8, p); }
DI f32x16 zero16() { f32x16 z;
#pragma unroll
    for (int i = 0; i < 16; ++i) z[i] = 0.f;
    return z; }
constexpr int AT_SLOT = 16384, ATT_NSLOT = 6;
constexpr int ATT_STG_OFF = ATT_NSLOT * AT_SLOT, ATT_STGW = 32 * 36;
constexpr int ATT_LS_OFF = ATT_STG_OFF + NWAVES * ATT_STGW * 4, ATT_CTL_OFF = ATT_LS_OFF + NWAVES * 32 * 4;
static_assert(ATT_CTL_OFF + 64 <= LDS_MISC, "attention LDS map");
#define AT_WAIT_V(n) asm volatile("s_waitcnt vmcnt(" #n ")" ::: "memory")
#define AT_BARRIER() do { asm volatile("s_waitcnt lgkmcnt(0)" ::: "memory"); __builtin_amdgcn_s_barrier(); asm volatile("" ::: "memory"); } while (0)
DI void at_issue(const bf16_t* Kg, int kp, const bf16_t* VTg, int nf, LAS unsigned char* slotp, int jt, int wave, int lane) {
    const int key = 8 * wave + (lane >> 3), chunk = (lane & 7) ^ ((key >> 1) & 7);
    __builtin_amdgcn_global_load_lds((const unsigned*)(Kg + (64 * (size_t)jt + key) * kp + chunk * 8), (LAS unsigned*)(slotp + wave * 1024), 16, 0, 0);
    const int hh = wave >> 2, d = 16 * (wave & 3) + (lane >> 2), sl = (lane & 3) ^ ((d >> 2) & 3);
    __builtin_amdgcn_global_load_lds((const unsigned*)(VTg + ((2 * (size_t)jt + hh) * nf + d) * 32 + sl * 8), (LAS unsigned*)(slotp + 8192 + wave * 1024), 16, 0, 0);
}
DI void at_kfrag(const LAS unsigned char* sl, int hh, int r, int h, bf16x8 (&kf)[4]) { const int key = 32 * hh + pi32(r), ksw = (key >> 1) & 7; const LAS unsigned char* kb = sl + key * 128;
#pragma unroll
    for (int d0 = 0; d0 < 4; ++d0) kf[d0] = *(const LAS bf16x8*)(kb + (((2 * d0 + h) ^ ksw) * 16)); }
DI void at_vfrag(const LAS unsigned char* sl, int hh, int r, int h, bf16x8 (&vf)[2][2]) {
#pragma unroll
    for (int dt = 0; dt < 2; ++dt)
#pragma unroll
        for (int sx = 0; sx < 2; ++sx) { const int d = 32 * dt + r; vf[dt][sx] = *(const LAS bf16x8*)(sl + 8192 + hh * 4096 + d * 64 + (((2 * sx + h) ^ ((d >> 2) & 3)) * 16)); } }

template <int DIAG> DI void sb_half(const LAS unsigned char* sl, int hh, const bf16x8 (&qf)[4], float& Cl, f32x16 (&o)[2], int r, int h) {
    bf16x8 kf[4], vf[2][2];
    at_kfrag(sl, hh, r, h, kf); at_vfrag(sl, hh, r, h, vf);
    f32x16 S = zero16();
#pragma unroll
    for (int d0 = 0; d0 < 4; ++d0) S = MFMA32(kf[d0], qf[d0], S);
    float om[16];
#pragma unroll
    for (int i = 0; i < 16; ++i) { float v = __builtin_amdgcn_rcpf(1.0f + __builtin_amdgcn_exp2f(S[i])); if (DIAG && !(16 * (i >> 3) + 8 * h + (i & 7) < r)) v = 1.0f; om[i] = v; }
    f32x2 sf[8]; sf[7] = (f32x2){1.0f, 1.0f};
#pragma unroll
    for (int i = 6; i >= 0; --i) sf[i] = sf[i + 1] * (f32x2){om[i + 1], om[i + 9]};
    const f32x2 R = sf[0] * (f32x2){om[0], om[8]};
    const float p0 = __shfl_xor(R.x, 32), p1 = __shfl_xor(R.y, 32);
    const float m1 = (h == 0 ? p1 : 1.0f) * Cl, m0 = (h == 0 ? p0 * p1 : p1) * R.y * Cl;
    Cl = Cl * ((R.x * R.y) * (p0 * p1));
    const f32x2 mm = (f32x2){m0, m1};
    f32x16 P;
#pragma unroll
    for (int i = 0; i < 8; ++i) { const f32x2 w = (sf[i] * mm) * ((f32x2){1.0f, 1.0f} - (f32x2){om[i], om[i + 8]}); P[i] = w.x; P[i + 8] = w.y; }
    const bf16x8 Pf0 = packacc<0>(P), Pf1 = packacc<1>(P);
#pragma unroll
    for (int dt = 0; dt < 2; ++dt) { o[dt] = MFMA32(Pf0, vf[dt][0], o[dt]); o[dt] = MFMA32(Pf1, vf[dt][1], o[dt]); }
}
constexpr float SB_CMIN = 5.421010862427522e-20f;
struct SbUnit { int b, hd, q0; };
DI SbUnit sb_unit_of(int idx) { SbUnit u; u.b = idx / 512; u.hd = (idx >> 6) & 7; u.q0 = (idx & 63) * 128; return u; }
DI void grp_barrier(volatile LAS int* bar, int& epoch, int lane) {
    asm volatile("s_waitcnt lgkmcnt(0)" ::: "memory"); ++epoch;
    if (lane == 0) __hip_atomic_fetch_add((LAS int*)bar, 1, __ATOMIC_RELAXED, __HIP_MEMORY_SCOPE_WORKGROUP);
    while (*bar < 4 * epoch) __builtin_amdgcn_s_sleep(1);
    asm volatile("" ::: "memory");
}
DI void at_issue4(const bf16_t* Kg, const bf16_t* VTg, LAS unsigned char* slotp, int jt, int w4, int lane) {
#pragma unroll
    for (int pp = 0; pp < 2; ++pp) { const int pc = w4 + 4 * pp;
        const int key = 8 * pc + (lane >> 3), chunk = (lane & 7) ^ ((key >> 1) & 7);
        __builtin_amdgcn_global_load_lds((const unsigned*)(Kg + (64 * (size_t)jt + key) * 512 + chunk * 8), (LAS unsigned*)(slotp + pc * 1024), 16, 0, 0);
        const int hh = pc >> 2, d = 16 * (pc & 3) + (lane >> 2), sl = (lane & 3) ^ ((d >> 2) & 3);
        __builtin_amdgcn_global_load_lds((const unsigned*)(VTg + ((2 * (size_t)jt + hh) * 512 + d) * 32 + sl * 8), (LAS unsigned*)(slotp + 8192 + pc * 1024), 16, 0, 0); }
}
DI int sb_prologue(const bf16_t* Q, const bf16_t* K, const bf16_t* VT, const SbUnit& u, LAS unsigned char* ring, int w4, int lane, bf16x8 (&qf)[4]) {
    const int r = lane & 31, h = lane >> 5; const size_t gb = (size_t)u.b * SEQ; const int t0w = u.q0 + 32 * w4;
    const bf16_t* Kg = K + gb * 512 + u.hd * 64; const bf16_t* VTg = VT + ((gb >> 5) * 512 + u.hd * 64) * 32;
    const int jt_hi = (u.q0 + 127) >> 6, ntiles = jt_hi + 1; int issued = 0;
    for (; issued < 2 && issued < ntiles; ++issued) at_issue4(Kg, VTg, ring + issued * AT_SLOT, jt_hi - issued, w4, lane);
#pragma unroll
    for (int d0 = 0; d0 < 4; ++d0) qf[d0] = *(const bf16x8*)(Q + (gb + t0w + r) * 512 + u.hd * 64 + 16 * d0 + 8 * h);
    return issued;
}
DI void sb_body(const bf16_t* K, const bf16_t* VT, const SbUnit& u, int issued, bf16x8 (&qf)[4], LAS unsigned char* ring, volatile LAS int* ctl, volatile LAS int* bar, int& epoch, int w4, int lane, f32x16 (&o)[2]) {
    const int r = lane & 31, h = lane >> 5; const size_t gb = (size_t)u.b * SEQ; const int t0w = u.q0 + 32 * w4, sd = t0w >> 5;
    o[0] = zero16(); o[1] = zero16(); float Cl = 1.0f;
    const bf16_t* Kg = K + gb * 512 + u.hd * 64; const bf16_t* VTg = VT + ((gb >> 5) * 512 + u.hd * 64) * 32;
    const int jt_hi = (u.q0 + 127) >> 6, ntiles = jt_hi + 1;
    if (w4 == 0 && lane == 0) { ctl[0] = 0; ctl[1] = 0; ctl[2] = 0; }
    asm volatile("s_waitcnt vmcnt(0)" : "+v"(qf[0]), "+v"(qf[1]), "+v"(qf[2]), "+v"(qf[3]) :: "memory");
    bool done = false; int slot = 0;
    for (int i = 0; i < ntiles; ++i) {
        const int jt = jt_hi - i, fly = issued - (i + 1);
        if (fly >= 1) AT_WAIT_V(4); else AT_WAIT_V(0);
        grp_barrier(bar, epoch, lane);
        if (i > 0 && ctl[(i - 1) % 3] == 4) break;
        if (w4 == 0 && lane == 0) ctl[(i + 1) % 3] = 0;
        if (issued < ntiles) { at_issue4(Kg, VTg, ring + ((slot + 2) % 3) * AT_SLOT, jt_hi - issued, w4, lane); ++issued; }
        if (!done) {
            const LAS unsigned char* sl = ring + slot * AT_SLOT;
            const int s1 = 2 * jt + 1, s0 = 2 * jt;
            if (s1 < sd) sb_half<0>(sl, 1, qf, Cl, o, r, h); else if (s1 == sd) sb_half<1>(sl, 1, qf, Cl, o, r, h);
            if (s0 < sd) sb_half<0>(sl, 0, qf, Cl, o, r, h); else if (s0 == sd) sb_half<1>(sl, 0, qf, Cl, o, r, h);
            if (s1 <= sd || s0 <= sd) done = __all(Cl < SB_CMIN);
        }
        if (done && lane == 0) __hip_atomic_fetch_add((LAS int*)&ctl[i % 3], 1, __ATOMIC_RELAXED, __HIP_MEMORY_SCOPE_WORKGROUP);
        slot = (slot + 1) % 3;
    }
    AT_WAIT_V(0);
    grp_barrier(bar, epoch, lane);
}
DI void sw_head(const bf16x8 (&qf)[4], const LAS unsigned char* lds, float sink2, int t0, int jt_lo, int lane, f32x16 (&o)[2], float& lsum) {
    const int r = lane & 31, h = lane >> 5, sd = t0 >> 5;
    f32x16 S[5]; float m = sink2;
#pragma unroll
    for (int jj = 0; jj < 5; ++jj) { const int sj = sd - 4 + jj;
        if (sj >= 0) { bf16x8 kf[4]; at_kfrag(lds + ((sj >> 1) - jt_lo) * AT_SLOT, sj & 1, r, h, kf);
            f32x16 s = zero16();
#pragma unroll
            for (int d0 = 0; d0 < 4; ++d0) s = MFMA32(kf[d0], qf[d0], s);
#pragma unroll
            for (int i = 0; i < 16; ++i) { const int ko = 16 * (i >> 3) + 8 * h + (i & 7); float v = s[i];
                if (jj == 4 && ko > r) v = -1e30f;
                if (jj == 0 && ko <= r) v = -1e30f;
                s[i] = v; m = __builtin_fmaxf(m, v); }
            S[jj] = s; }
        else {
#pragma unroll
            for (int i = 0; i < 16; ++i) S[jj][i] = -1e30f; } }
    m = __builtin_fmaxf(m, __shfl_xor(m, 32));
    o[0] = zero16(); o[1] = zero16(); float ls = 0.f;
#pragma unroll
    for (int jj = 0; jj < 5; ++jj) { const int sj = sd - 4 + jj;
        if (sj >= 0) { bf16x8 vf[2][2]; at_vfrag(lds + ((sj >> 1) - jt_lo) * AT_SLOT, sj & 1, r, h, vf);
            f32x16 P;
#pragma unroll
            for (int i = 0; i < 16; ++i) { P[i] = __builtin_amdgcn_exp2f(S[jj][i] - m); ls += P[i]; }
            const bf16x8 Pf0 = packacc<0>(P), Pf1 = packacc<1>(P);
#pragma unroll
            for (int dt = 0; dt < 2; ++dt) { o[dt] = MFMA32(Pf0, vf[dt][0], o[dt]); o[dt] = MFMA32(Pf1, vf[dt][1], o[dt]); } } }
    ls += __shfl_xor(ls, 32);
    lsum = ls + __builtin_amdgcn_exp2f(sink2 - m);
}
DI void at_store(const f32x16 (&o)[2], float lsum, LAS float* stg, LAS float* lsb, bf16_t* mixrow0, float* ssq0, int lane) {
    const int r = lane & 31, h = lane >> 5, row = lane >> 1, hf = lane & 1;
    if (h == 0) lsb[r] = lsum;
    float ss = 0.f; u32x4 w[2][2];
#pragma unroll
    for (int dt = 0; dt < 2; ++dt) {
#pragma unroll
        for (int i = 0; i < 16; ++i) stg[crow(i, h) * 36 + r] = o[dt][i];
        LDS_WAIT();
        const float il = 1.0f / lsb[row];
#pragma unroll
        for (int k = 0; k < 2; ++k) { const f32x4 a0 = *(const LAS f32x4*)(stg + row * 36 + hf * 16 + 8 * k) * il, a1 = *(const LAS f32x4*)(stg + row * 36 + hf * 16 + 8 * k + 4) * il;
            ss += ((a0.x * a0.x + a0.y * a0.y) + (a0.z * a0.z + a0.w * a0.w)) + ((a1.x * a1.x + a1.y * a1.y) + (a1.z * a1.z + a1.w * a1.w)); w[dt][k] = pack8(a0, a1); }
        LDS_WAIT();
    }
    ss += __shfl_xor(ss, 1);
    if (hf == 0) ssq0[(size_t)row * 16] = ss;
    bf16_t* mr = mixrow0 + (size_t)row * 1024 + hf * 16;
#pragma unroll
    for (int dt = 0; dt < 2; ++dt) { *(u32x4*)(mr + 32 * dt) = w[dt][0]; *(u32x4*)(mr + 32 * dt + 8) = w[dt][1]; }
}
DI void p3_attention(const Args& a, LAS unsigned char* lds, int tid, int lane, int wave, int rep = 0, int kinds = 3) {
    asm volatile("" : "+v"(tid), "+v"(lane));
    const bf16_t* QSB = (const bf16_t*)(a.ws + WS_QSB); const bf16_t* KSB = (const bf16_t*)(a.ws + WS_KSB); const bf16_t* VTSB = (const bf16_t*)(a.ws + WS_VSB);
    const bf16_t* QSW = (const bf16_t*)(a.ws + WS_QSW); const bf16_t* KSW = (const bf16_t*)(a.ws + WS_KSW); const bf16_t* VTSW = (const bf16_t*)(a.ws + WS_VSW);
    bf16_t* MIX = (bf16_t*)(a.ws + WS_MIX); float* SSQ = (float*)(a.ws + WS_SSQ); unsigned* qctr = (unsigned*)(a.ws + WS_CTL) + CW_ATTNQ + 2048 * rep;
    LAS float* stg = (LAS float*)(lds + ATT_STG_OFF) + wave * ATT_STGW; LAS float* lsb = (LAS float*)(lds + ATT_LS_OFF) + wave * 32; volatile LAS int* ctl = (volatile LAS int*)(lds + ATT_CTL_OFF);
    if (kinds & 2)
    for (int u = (int)blockIdx.x; u < (T / 256) * 2; u += (int)gridDim.x) {
        const int b = u / 64, kvh = (u >> 5) & 1, q0 = (u & 31) * 256, jt_lo = (q0 >> 6) - 2, t0 = q0 + 32 * wave; const size_t gb = (size_t)b * SEQ;
        const bf16_t* Kg = KSW + gb * 128 + kvh * 64; const bf16_t* VTg = VTSW + ((gb >> 5) * 128 + kvh * 64) * 32;
#pragma unroll
        for (int s6 = 0; s6 < 6; ++s6) if (jt_lo + s6 >= 0) at_issue(Kg, 128, VTg, 128, lds + s6 * AT_SLOT, jt_lo + s6, wave, lane);
        bf16x8 qn[4];
#pragma unroll
        for (int d0 = 0; d0 < 4; ++d0) qn[d0] = *(const bf16x8*)(QSW + (gb + t0 + (lane & 31)) * 512 + (4 * kvh) * 64 + 16 * d0 + 8 * (lane >> 5));
        AT_WAIT_V(0); AT_BARRIER();
#pragma unroll
        for (int q = 0; q < 4; ++q) { const int hq = 4 * kvh + q; f32x16 o[2]; float lsum; bf16x8 qf[4];
#pragma unroll
            for (int d0 = 0; d0 < 4; ++d0) qf[d0] = qn[d0];
            if (q < 3) {
#pragma unroll
                for (int d0 = 0; d0 < 4; ++d0) qn[d0] = *(const bf16x8*)(QSW + (gb + t0 + (lane & 31)) * 512 + (hq + 1) * 64 + 16 * d0 + 8 * (lane >> 5)); }
            sw_head(qf, lds, a.sinks[hq] * LOG2E, t0, jt_lo, lane, o, lsum);
            at_store(o, lsum, stg, lsb, MIX + (gb + t0) * 1024 + 512 + hq * 64, SSQ + (gb + t0) * 16 + 8 + hq, lane); }
        asm volatile("s_waitcnt vmcnt(0)" ::: "memory"); AT_BARRIER();
    }
    if (kinds & 1) {
        volatile LAS int* gb2 = ctl + 32;
        if (tid < 2) gb2[16 * tid] = 0;
        __syncthreads();
        const int grp = wave >> 2, w4 = wave & 3; LAS unsigned char* ring = lds + grp * 3 * AT_SLOT; volatile LAS int* gctl = ctl + 8 * grp; volatile LAS int* bar = gb2 + 16 * grp; int epoch = 0;
        constexpr int NUNITS = (T / 128) * 8; const int NG = 2 * (int)gridDim.x, gg = 2 * (int)blockIdx.x + grp;
        bf16x8 qf[4]; int idx = gg; int issued = 0; SbUnit u = sb_unit_of(idx); unsigned nxt = 0;
        if (idx < NUNITS) issued = sb_prologue(QSB, KSB, VTSB, u, ring, w4, lane, qf);
        while (idx < NUNITS) {
            if (w4 == 0 && lane == 0) nxt = atomicAdd(qctr, 1u);
            f32x16 o[2];
            sb_body(KSB, VTSB, u, issued, qf, ring, gctl, bar, epoch, w4, lane, o);
            const size_t grow = (size_t)u.b * SEQ + u.q0 + 32 * w4; const int hd = u.hd;
            if (w4 == 0 && lane == 0) gctl[4] = NG + (int)nxt;
            grp_barrier(bar, epoch, lane);
            const int nidx = __builtin_amdgcn_readfirstlane(gctl[4]);
            grp_barrier(bar, epoch, lane);
            if (nidx < NUNITS) { u = sb_unit_of(nidx); issued = sb_prologue(QSB, KSB, VTSB, u, ring, w4, lane, qf); }
            at_store(o, 1.0f, stg, lsb, MIX + grow * 1024 + hd * 64, SSQ + grow * 16 + hd, lane);
            idx = nidx;
        }
    }
}

#define XB_TMO      128
#define XB_XCNT(j)  (256  + 64 * (j))
#define XB_XSUB(j)  (1280 + 64 * (j))
#define XB_XGEN(j)  (2304 + 64 * (j))
#define XB_TOP      3328
#define XB_TOPGEN   3392
#define XCD_BAR_WORDS 3456
#define XB_SPIN_CAP (1u << 18)
DI unsigned xb_ld(unsigned* p)              { return __hip_atomic_load(p, __ATOMIC_RELAXED, __HIP_MEMORY_SCOPE_AGENT); }
DI unsigned xb_add(unsigned* p, unsigned v) { return __hip_atomic_fetch_add(p, v, __ATOMIC_RELAXED, __HIP_MEMORY_SCOPE_AGENT); }
DI unsigned xb_xcc_id() { return (unsigned)__builtin_amdgcn_s_getreg((3 << 11) | 20) & 0xFu; }
#define XB_SPIN(cond, bar) do { unsigned _sp = 0; while (cond) { __builtin_amdgcn_s_sleep(1); \
    if ((++_sp & 255u) == 0u) { if (xb_ld(&(bar)[XB_TMO])) break; if (_sp > XB_SPIN_CAP) { atomicAdd(&(bar)[XB_TMO], 1u); break; } } } } while (0)
struct XcdBarrier { unsigned* bar; unsigned x; volatile LAS unsigned* st; };
DI XcdBarrier xcd_barrier_post(unsigned* bar, volatile LAS unsigned* st) {
    XcdBarrier b; b.bar = bar; b.x = xb_xcc_id(); b.st = st;
    if (threadIdx.x == 0) (void)xb_add(&bar[XB_XCNT(b.x)], 1u);
    return b;
}
DI void xcd_barrier_complete(unsigned* bar, unsigned x, unsigned& nloc, unsigned& nx) {
    const unsigned G = gridDim.x * gridDim.y * gridDim.z;
    unsigned sum, cnt, mine, sp = 0u;
    for (;;) {
        sum = 0u; cnt = 0u; mine = 0u;
#pragma unroll
        for (unsigned j = 0; j < 16; ++j) { const unsigned c = xb_ld(&bar[XB_XCNT(j)]); sum += c; cnt += (c > 0u) ? 1u : 0u; mine = (j == x) ? c : mine; }
        if (sum == G) break;
        __builtin_amdgcn_s_sleep(1);
        if ((++sp & 255u) == 0u) { if (xb_ld(&bar[XB_TMO])) break; if (sp > XB_SPIN_CAP) { atomicAdd(&bar[XB_TMO], 1u); break; } }
    }
    nloc = mine > 0u ? mine : 1u; nx = cnt > 0u ? cnt : 1u;
}
DI void xcd_barrier(const XcdBarrier& b) {
    asm volatile("s_waitcnt vmcnt(0)" ::: "memory");
    __syncthreads();
    if (threadIdx.x == 0) {
        unsigned* bar = b.bar;
        __builtin_amdgcn_s_waitcnt(0);
        unsigned nloc = b.st[0], nx = b.st[1];
        if (nloc == 0u) { xcd_barrier_complete(bar, b.x, nloc, nx); b.st[0] = nloc; b.st[1] = nx; }
        const unsigned old = xb_add(&bar[XB_XSUB(b.x)], 1u);
        const unsigned gen = old / nloc;
        if (old + 1u == (gen + 1u) * nloc) {
            __builtin_amdgcn_fence(__ATOMIC_RELEASE, "agent");
            asm volatile("s_waitcnt vmcnt(0)" ::: "memory");
            const unsigned og = xb_add(&bar[XB_TOP], 1u);
            const unsigned tg = og / nx;
            if (og + 1u == (tg + 1u) * nx) xb_add(&bar[XB_TOPGEN], 1u);
            else XB_SPIN(xb_ld(&bar[XB_TOPGEN]) == tg, bar);
            __builtin_amdgcn_fence(__ATOMIC_ACQUIRE, "agent");
            xb_add(&bar[XB_XGEN(b.x)], 1u);
            asm volatile("s_waitcnt vmcnt(0)" ::: "memory");
        } else {
            XB_SPIN(xb_ld(&bar[XB_XGEN(b.x)]) == gen, bar);
            __builtin_amdgcn_fence(__ATOMIC_ACQUIRE, "agent");
            asm volatile("s_waitcnt vmcnt(0)" ::: "memory");
        }
    }
    __syncthreads();
}

__global__ void __launch_bounds__(NTHREADS, 2) mk_fwd(Args a) {
    extern __shared__ __attribute__((aligned(16))) unsigned char lds_raw[];
    LAS unsigned char* lds = (LAS unsigned char*)lds_raw;
    const int tid = threadIdx.x, lane = tid & 63, wave = __builtin_amdgcn_readfirstlane(tid >> 6);
    volatile LAS unsigned* misc = (volatile LAS unsigned*)(lds + LDS_MISC);
    if (tid < 2) misc[tid] = 0u;
    __syncthreads();
    const XcdBarrier gbar = xcd_barrier_post((unsigned*)(a.ws + WS_CTL) + CW_BAR, misc);
    unsigned char* ws = a.ws;
    const float* mod = (const float*)(ws + WS_MOD);

#define REPS(k) ((PROBE_DUP == (k)) ? 2 : 1)
    int n_stamp = 0;
#define STAMP() do { if (STAMP_PHASE >= 0 && blockIdx.x == 0 && tid == 0) ((unsigned long long*)(ws + WS_STAMP))[n_stamp] = __builtin_amdgcn_s_memrealtime(); ++n_stamp; } while (0)
    STAMP();
    const int p2_units = (T / 256) * (DIN / 256), p2_rem = p2_units % (int)gridDim.x, n_tailw = p2_rem ? ((int)gridDim.x - p2_rem) * NWAVES : 0;
    const int n_tail_items = n_tailw * 4 < NEXPERT_ITEMS ? n_tailw * 4 : NEXPERT_ITEMS, n_p0_items = NEXPERT_ITEMS - n_tail_items;
    for (int rep = 0; rep < REPS(0); ++rep) { p0_prologue(a, lds, tid, lane, wave); expert_items(a, lds, 0, n_p0_items, blockIdx.x * NWAVES + wave, gridDim.x * NWAVES, lane, wave); xcd_barrier(gbar); STAMP(); }
    for (int rep = 0; rep < REPS(1); ++rep) { p1_norm(a, lane, wave); xcd_barrier(gbar); STAMP(); }
    for (int rep = 0; rep < REPS(2); ++rep) {
        DenseSched S{(const bf16_t*)(ws + WS_H), (const bf16_t*)(ws + WS_WIN), 1024, T / 256, DIN / 256};
        EpiProj E{(bf16_t*)(ws + WS_QSB), (bf16_t*)(ws + WS_VSB), (bf16_t*)(ws + WS_QSW), (bf16_t*)(ws + WS_KSW), (bf16_t*)(ws + WS_VSW), (const float*)(ws + WS_COS), (const float*)(ws + WS_SIN)};
        pg8::gemm_phase<DenseSched, EpiProj, true, 1024, 1024, 16>(lds, S, E);
        if (p2_rem && (int)blockIdx.x >= p2_rem && rep == 0) { __syncthreads(); expert_items(a, lds, n_p0_items, n_tail_items, ((int)blockIdx.x - p2_rem) * NWAVES + wave, n_tailw, lane, wave); }
        xcd_barrier(gbar); STAMP();
    }
    if (PROBE_DUP == 31 || PROBE_DUP == 32) { p3_attention(a, lds, tid, lane, wave, 1, PROBE_DUP - 30); xcd_barrier(gbar); }
    for (int rep = 0; rep < REPS(3); ++rep) { p3_attention(a, lds, tid, lane, wave, rep); xcd_barrier(gbar); STAMP(); }
    for (int rep = 0; rep < REPS(4); ++rep) {
        DenseSched S{(const bf16_t*)(ws + WS_MIX), (const bf16_t*)(ws + WS_WOUT), 1024, T / 256, DM / 256};
        EpiWout E{mod, (bf16_t*)(ws + WS_X1), a.x, (const float*)(ws + WS_SSQ), (LAS float*)(lds + pg8::STAGE_BYTES + 1024)};
        pg8::gemm_phase<DenseSched, EpiWout, true, 1024, 1024, 16>(lds, S, E);
        xcd_barrier(gbar); STAMP();
    }
    for (int rep = 0; rep < REPS(5); ++rep) { p5_router(a, lds, tid, lane, wave, rep); xcd_barrier(gbar); STAMP(); }
    LAS int* tstart = (LAS int*)(lds + pg8::STAGE_BYTES);
    const unsigned* cnt = (const unsigned*)(ws + WS_CTL) + CW_CNT;
    if (tid == 0) { int run = 0; for (int b = 0; b < NBUCKET; ++b) { tstart[b] = run; run += ((int)cnt[CNT_STRIDE * b] + 255) >> 8; } tstart[NBUCKET] = run; }
    __syncthreads();
    const bf16_t* H2 = (const bf16_t*)(ws + WS_H); const bf16_t* HIDc = (const bf16_t*)(ws + WS_HID); const int* LISTc = (const int*)(ws + WS_LIST);
    EpiUp EU{(bf16_t*)(ws + WS_HID), (const f32x2*)(ws + WS_WTS), (LAS float*)(lds + pg8::STAGE_BYTES + 1024)}; EpiDown ED{(bf16_t*)(ws + WS_Y)};
    if (gridDim.x == 256) {
        const MoeCut mc = moe_cut(__builtin_amdgcn_readfirstlane(tstart[NBUCKET]));
        { MoeSplitSched<true, 1> S{tstart, cnt, LISTc, H2, (const bf16_t*)(ws + WS_WGU), mc}; pg8::gemm_phase<MoeSplitSched<true, 1>, EpiUp, true, 1024, 1024, 16>(lds, S, EU); }
        xcd_barrier(gbar); STAMP();
        if (((int)blockIdx.x >> 3) < mc.left) { MoeSplitSched<true, 2> S{tstart, cnt, LISTc, H2, (const bf16_t*)(ws + WS_WGU), mc}; pg8::gemm_phase<MoeSplitSched<true, 2>, EpiUp, true, 1024, 1024, 16>(lds, S, EU); }
        else { MoeSplitSched<false, 2> S{tstart, cnt, LISTc, HIDc, (const bf16_t*)(ws + WS_WD), mc}; pg8::gemm_phase<MoeSplitSched<false, 2>, EpiDown, true, 1024, 512, 8>(lds, S, ED); }
        xcd_barrier(gbar); STAMP();
        { MoeSplitSched<false, 3> S{tstart, cnt, LISTc, HIDc, (const bf16_t*)(ws + WS_WD), mc}; pg8::gemm_phase<MoeSplitSched<false, 3>, EpiDown, true, 1024, 512, 8>(lds, S, ED); }
    } else {
        { MoeSched<8, true> S{tstart, cnt, LISTc, H2, (const bf16_t*)(ws + WS_WGU)}; pg8::gemm_phase<MoeSched<8, true>, EpiUp, true, 1024, 1024, 16>(lds, S, EU); }
        xcd_barrier(gbar); STAMP();
        { MoeSched<4, false> S{tstart, cnt, LISTc, HIDc, (const bf16_t*)(ws + WS_WD)}; pg8::gemm_phase<MoeSched<4, false>, EpiDown, true, 1024, 512, 8>(lds, S, ED); }
    }
    if (STAMP_PHASE >= 0) {
        if (blockIdx.x == 0 && tid == 0) { unsigned long long* st = (unsigned long long*)(ws + WS_STAMP); st[n_stamp] = __builtin_amdgcn_s_memrealtime();
            const float t_us = (float)(st[STAMP_PHASE + 1] - st[STAMP_PHASE]) * 0.01f; *(float*)(ws + WS_STAMP + 256) = 1.0f + sqrtf(t_us * STAMP_K); } }
    xcd_barrier(gbar);
    if (PROBE_DUP == 8) { p8_final(a, tstart, lane, wave, (float*)(ws + WS_H)); xcd_barrier(gbar); }
    p8_final(a, tstart, lane, wave, a.out);
}

extern "C" void kernel_launch(void* const* d_in, const int* in_sizes, int n_in, void* d_out, int out_size, void* d_ws, size_t ws_size, hipStream_t stream) {
    static int grid = 0;
    if (grid == 0) {
        if (n_in != 18 || in_sizes[0] != T * DM || out_size != T * DM || ws_size < WS_END) { fprintf(stderr, "kernel_launch: unexpected shapes (n_in %d, in0 %d, out %d, ws %zu); nothing launched\n", n_in, n_in > 0 ? in_sizes[0] : -1, out_size, ws_size); grid = -1; return; }
        int dev = 0, cus = 0, per_cu = 0;
        (void)hipGetDevice(&dev); (void)hipDeviceGetAttribute(&cus, hipDeviceAttributeMultiprocessorCount, dev);
        (void)hipFuncSetAttribute((const void*)mk_fwd, hipFuncAttributeMaxDynamicSharedMemorySize, LDS_BYTES);
        (void)hipOccupancyMaxActiveBlocksPerMultiprocessor(&per_cu, (const void*)mk_fwd, NTHREADS, LDS_BYTES);
        if (per_cu < 1) { fprintf(stderr, "kernel_launch: occupancy query says %d blocks per CU\n", per_cu); per_cu = 1; }
        grid = cus * per_cu;
        fprintf(stderr, "kernel_launch: %d CUs x %d = grid %d\n", cus, per_cu, grid);
    }
    if (grid < 0) return;
    (void)hipMemsetAsync((char*)d_ws + WS_CTL, 0, CTL_BYTES, stream);
    Args a{};
    a.x = (const float*)d_in[0]; a.c = (const float*)d_in[1]; a.pos = (const int*)d_in[2]; a.w_ada = (const float*)d_in[3]; a.b_ada = (const float*)d_in[4]; a.g_mix = (const float*)d_in[5];
    a.w_in = (const float*)d_in[6]; a.sinks = (const float*)d_in[7]; a.g_sb = (const float*)d_in[8]; a.g_sw = (const float*)d_in[9]; a.w_out = (const float*)d_in[10]; a.g_ffn = (const float*)d_in[11];
    a.w_rg = (const float*)d_in[12]; a.w_re = (const float*)d_in[13]; a.w_gate = (const float*)d_in[14]; a.w_up = (const float*)d_in[15]; a.w_down = (const float*)d_in[16]; a.g_fin = (const float*)d_in[17];
    a.out = (float*)d_out; a.ws = (unsigned char*)d_ws;
    void* args[] = {&a};
    hipError_t e = hipLaunchCooperativeKernel((const void*)mk_fwd, dim3(grid), dim3(NTHREADS), args, LDS_BYTES, stream);
    if (e != hipSuccess) fprintf(stderr, "kernel_launch: cooperative launch failed: %s (grid %d)\n", hipGetErrorString(e), grid);
}
```

```cpp
#include <hip/hip_runtime.h>
#include <cstdio>
#include <cstdint>
#include <cmath>

#define LAS __attribute__((address_space(3)))
#define DI __device__ __forceinline__
typedef unsigned short bf16_t;
typedef short bf16x8 __attribute__((ext_vector_type(8)));
typedef float f32x4 __attribute__((ext_vector_type(4)));
typedef float f32x2 __attribute__((ext_vector_type(2)));
typedef unsigned u32x4 __attribute__((ext_vector_type(4)));
typedef unsigned u32x2 __attribute__((ext_vector_type(2)));
typedef __bf16 bf16x2_t __attribute__((ext_vector_type(2)));

constexpr int NB = 4, SEQ = 8192, DM = 1024, T = NB * SEQ;
constexpr int DIN = 2304, DSB = 512, DSW = 512, DKV = 128;
constexpr int NEXP = 16, DEXP = 512, NBUCKET = 24, WINDOW = 128;
constexpr int MAXTILES = T / 256 + NBUCKET, TPAD = MAXTILES * 256;
constexpr float EPS = 1e-6f, LOG2E = 1.4426950408889634f, QSCALE = 0.125f * LOG2E;
constexpr int NTHREADS = 512, NWAVES = 8;
#ifndef STAMP_PHASE
#define STAMP_PHASE (-1)
#endif
#ifndef STAMP_K
#define STAMP_K 1e-5f
#endif
#ifndef PROBE_DUP
#define PROBE_DUP (-1)
#endif

constexpr size_t MiB = 1u << 20;
constexpr size_t WS_CTL = 0, CTL_BYTES = 1 * MiB;
constexpr size_t WS_MOD = 1 * MiB;
constexpr size_t WS_COS = 2 * MiB, WS_SIN = 6 * MiB;
constexpr size_t WS_WIN = 10 * MiB;
constexpr size_t WS_WOUT = 15 * MiB;
constexpr size_t WS_WGU = 17 * MiB;
constexpr size_t WS_WD = 49 * MiB;
constexpr size_t WS_LIST = 65 * MiB;
constexpr size_t WS_WTS = 68 * MiB;
constexpr size_t WS_STAMP = 512 * 1024;
constexpr size_t WS_TPOS = 74 * MiB;
constexpr size_t WS_SSQ = 76 * MiB;
constexpr size_t WS_H = 80 * MiB;
constexpr size_t WS_QSB = 144 * MiB, WS_KSB = 176 * MiB, WS_VSB = 208 * MiB, WS_QSW = 240 * MiB;
constexpr size_t WS_KSW = 272 * MiB, WS_VSW = 280 * MiB;
constexpr size_t WS_MIX = 288 * MiB;
constexpr size_t WS_HID = 352 * MiB;
constexpr size_t WS_END = 428 * MiB;
constexpr size_t WS_XB = WS_HID;
constexpr size_t WS_X1 = WS_QSB;
constexpr size_t WS_Y = WS_VSB;
static_assert(WS_X1 + (size_t)T * 1024 * 2 <= WS_VSB && WS_Y + (size_t)TPAD * 1024 * 2 <= WS_MIX && WS_XB + (size_t)T * 1024 * 2 <= WS_END, "overlays");
static_assert(WS_KSB - WS_QSB == WS_VSB - WS_KSB, "q/k/v_sb buffers equally spaced");
static_assert(WS_HID + (size_t)TPAD * 1024 * 2 <= WS_END, "ws map");
constexpr int CW_CNT = 8192, CNT_STRIDE = 64, CW_ATTNQ = 16384, CW_BAR = 4096;
constexpr int LDS_MISC = 143360;

constexpr int LDS_BYTES = 147456;

struct Args {
    const float* x; const float* c; const int* pos; const float* w_ada; const float* b_ada; const float* g_mix; const float* w_in; const float* sinks;
    const float* g_sb; const float* g_sw; const float* w_out; const float* g_ffn; const float* w_rg; const float* w_re; const float* w_gate; const float* w_up;
    const float* w_down; const float* g_fin; float* out; unsigned char* ws;
};

__constant__ float INV_FREQ[32] = {1.000000000e+00f, 7.498942018e-01f, 5.623413324e-01f, 4.216965139e-01f, 3.162277639e-01f, 2.371373773e-01f, 1.778279394e-01f, 1.333521456e-01f, 1.000000015e-01f, 7.498942316e-02f, 5.623413250e-02f, 4.216964915e-02f, 3.162277490e-02f, 2.371373773e-02f, 1.778279431e-02f, 1.333521400e-02f, 9.999999776e-03f, 7.498942316e-03f, 5.623413250e-03f, 4.216964822e-03f, 3.162277630e-03f, 2.371373819e-03f, 1.778279431e-03f, 1.333521446e-03f, 1.000000047e-03f, 7.498941850e-04f, 5.623413017e-04f, 4.216965172e-04f, 3.162277571e-04f, 2.371373703e-04f, 1.778279402e-04f, 1.333521504e-04f};

DI unsigned f2bf(float f) { unsigned u = __builtin_bit_cast(unsigned, f); return (u + 0x7fffu + ((u >> 16) & 1u)) >> 16; }
DI unsigned pk2(float lo, float hi) { f32x2 v = {lo, hi}; bf16x2_t b = __builtin_convertvector(v, bf16x2_t); return __builtin_bit_cast(unsigned, b); }
DI float bf2f(unsigned short b) { return __builtin_bit_cast(float, (unsigned)b << 16); }
DI float bflo(unsigned w) { return __builtin_bit_cast(float, w << 16); }
DI float bfhi(unsigned w) { return __builtin_bit_cast(float, w & 0xffff0000u); }
DI float wave_sum(float v) {
#pragma unroll
    for (int o = 1; o < 64; o <<= 1) v += __shfl_xor(v, o);
    return v;
}
#define DPP_ADD(v, ctrl) ((v) + __builtin_bit_cast(float, __builtin_amdgcn_update_dpp(0, __builtin_bit_cast(int, (v)), (ctrl), 0xF, 0xF, true)))
DI void swap32(unsigned& a, unsigned& b) { asm volatile("s_nop 1\n\tv_permlane32_swap_b32 %0, %1" : "+v"(a), "+v"(b)); }
DI void swap16(unsigned& a, unsigned& b) { asm volatile("s_nop 1\n\tv_permlane16_swap_b32 %0, %1" : "+v"(a), "+v"(b)); }
DI float wave_sum_fast(float v) { v = DPP_ADD(v, 0xB1); v = DPP_ADD(v, 0x4E); v = DPP_ADD(v, 0x141); v = DPP_ADD(v, 0x140);
    unsigned a = __builtin_bit_cast(unsigned, v), b = a; swap16(a, b); v = __builtin_bit_cast(float, a) + __builtin_bit_cast(float, b);
    a = __builtin_bit_cast(unsigned, v); b = a; swap32(a, b); return __builtin_bit_cast(float, a) + __builtin_bit_cast(float, b); }
#define LDS_WAIT() asm volatile("s_waitcnt lgkmcnt(0)" ::: "memory")
DI f32x4 ldnt4(const float* p) { return __builtin_nontemporal_load((const f32x4*)p); }

DI void tr_item64(const float* W, int N, int k0, int n0, bf16_t* WT, int drow0a, int drow0b, int Kd, const float* kscale, LAS float* scr, int lane) {
    f32x4 v[16]; const int kr = lane >> 4, c4 = 4 * (lane & 15);
#pragma unroll
    for (int i = 0; i < 16; ++i) v[i] = ldnt4(W + (size_t)(k0 + 4 * i + kr) * N + n0 + c4);
#pragma unroll
    for (int i = 0; i < 16; ++i) { const int kk = 4 * i + kr; f32x4 x = v[i]; if (kscale) x = x * kscale[k0 + kk]; LAS float* d = scr + kk * 65 + c4; d[0] = x.x; d[1] = x.y; d[2] = x.z; d[3] = x.w; }
    LDS_WAIT();
    const int c = lane & 7;
#pragma unroll
    for (int j = 0; j < 8; ++j) { const int n = (lane >> 3) + 8 * j; const LAS float* q = scr + (8 * c) * 65 + n;
        u32x4 o; o.x = pk2(q[0 * 65], q[1 * 65]); o.y = pk2(q[2 * 65], q[3 * 65]); o.z = pk2(q[4 * 65], q[5 * 65]); o.w = pk2(q[6 * 65], q[7 * 65]);
        const int dr = n < 32 ? drow0a + n : drow0b + (n - 32);
        *(u32x4*)(WT + (size_t)dr * Kd + k0 + 8 * c) = o; }
    LDS_WAIT();
}
DI int win_drow(int n0) {
    if (n0 < 1536) return n0;
    if (n0 < 2048) { const int c = n0 - 1536, head = c >> 6, half = (c >> 5) & 1; return 1536 + (head >> 2) * 256 + half * 128 + (head & 3) * 32; }
    if (n0 < 2176) { const int c = n0 - 2048, head = c >> 6, half = (c >> 5) & 1; return 2048 + half * 128 + head * 32; }
    const int c = n0 - 2176; return 2048 + (c >> 6) * 128 + 64 + (c & 63);
}
DI void p0_prologue(const Args& a, LAS unsigned char* lds, int tid, int lane, int wave) {
    unsigned char* ws = a.ws;
    {
        float* mod = (float*)(ws + WS_MOD); LAS float* red = (LAS float*)lds; LAS float* sc = (LAS float*)(lds + 32768);
        if ((int)blockIdx.x < 6144 / 64) { for (int i = tid; i < 4096; i += NTHREADS) { const float cv = a.c[i]; sc[i] = cv / (1.f + expf(-cv)); } __syncthreads(); }
        for (int cb = blockIdx.x; cb < 6144 / 64; cb += gridDim.x) {
            const int cl = tid & 15, kg = tid >> 4, col = cb * 64 + 4 * cl;
            f32x4 acc[4];
#pragma unroll
            for (int q = 0; q < 4; ++q) acc[q] = (f32x4){0.f, 0.f, 0.f, 0.f};
#pragma unroll 16
            for (int kk = 0; kk < 32; ++kk) { const int k = kg * 32 + kk; const f32x4 w = ldnt4(a.w_ada + (size_t)k * 6144 + col);
#pragma unroll
                for (int q = 0; q < 4; ++q) acc[q] = acc[q] + w * sc[q * 1024 + k]; }
#pragma unroll
            for (int q = 0; q < 4; ++q) *(LAS f32x4*)(red + (kg * 4 + q) * 64 + 4 * cl) = acc[q];
            __syncthreads();
            if (tid < 256) { const int q = tid >> 6, c2 = tid & 63; float sum = 0.f; for (int g = 0; g < 32; ++g) sum += red[(g * 4 + q) * 64 + c2]; mod[q * 6144 + cb * 64 + c2] = sum + a.b_ada[cb * 64 + c2]; }
            __syncthreads();
        }
    }
    {
        float* cosT = (float*)(ws + WS_COS); float* sinT = (float*)(ws + WS_SIN);
        for (int idx = blockIdx.x * NTHREADS + tid; idx < T * 32; idx += gridDim.x * NTHREADS) {
            const int t = idx >> 5, i = idx & 31; const float ang = (float)a.pos[t] * INV_FREQ[i];
            const double ad = (double)ang, kq = rint(ad * 0.63661977236758134308);
            double y = fma(-kq, 1.5707963267948966192, ad); y = fma(-kq, 6.123233995736766036e-17, y);
            const int q = (int)((long long)kq & 3); const double y2 = y * y;
            const double sn = y * (1.0 + y2 * (-1.0 / 6 + y2 * (1.0 / 120 + y2 * (-1.0 / 5040 + y2 * (1.0 / 362880 + y2 * (-1.0 / 39916800))))));
            const double cs = 1.0 + y2 * (-0.5 + y2 * (1.0 / 24 + y2 * (-1.0 / 720 + y2 * (1.0 / 40320 + y2 * (-1.0 / 3628800 + y2 * (1.0 / 479001600))))));
            double co, si; if (q == 0) { co = cs; si = sn; } else if (q == 1) { co = -sn; si = cs; } else if (q == 2) { co = -cs; si = -sn; } else { co = sn; si = -cs; }
            cosT[idx] = (float)co; sinT[idx] = (float)si;
        }
    }
    {
        __syncthreads();
        LAS float* scr = (LAS float*)(lds + 8192 + wave * 16640);
        const int gw = blockIdx.x * NWAVES + wave, NGW = gridDim.x * NWAVES;
        constexpr int I_IN = 16 * 36, I_OUT = 16 * 16, NITEMS = I_IN + I_OUT;
        for (int it = gw; it < NITEMS; it += NGW) {
            int r = it;
            if (r < I_IN) { const int kb = r / 36, nb = r % 36; tr_item64(a.w_in, DIN, kb * 64, nb * 64, (bf16_t*)(ws + WS_WIN), win_drow(nb * 64), win_drow(nb * 64 + 32), 1024, nullptr, scr, lane); continue; } r -= I_IN;
            { const int kb = r / 16, nb = r % 16; const float* ks = (kb < 8) ? a.g_sb : (a.g_sw - 512); tr_item64(a.w_out, 1024, kb * 64, nb * 64, (bf16_t*)(ws + WS_WOUT), nb * 64, nb * 64 + 32, 1024, ks, scr, lane); }
        }
    }
}
constexpr int NEXPERT_ITEMS = 2 * (16 * 16 * 8) + 16 * 8 * 16;
DI void expert_items(const Args& a, LAS unsigned char* lds, int first, int count, int w, int nw, int lane, int wave) {
    asm volatile("" : "+v"(lane));
    unsigned char* ws = a.ws;
    LAS float* scr = (LAS float*)(lds + 8192 + wave * 16640);
    constexpr int I_G = 16 * 16 * 8;
    for (int it = first + w; it < first + count; it += nw) {
        int r = it;
        if (r < 2 * I_G) { const int up = r >= I_G; if (up) r -= I_G; const int e = r / 128, q = r % 128, kb = q / 8, nb = q % 8, c0 = nb * 64; const int dr = (c0 >> 7) * 256 + up * 128 + (c0 & 127);
            tr_item64((up ? a.w_up : a.w_gate) + (size_t)e * 1024 * 512, 512, kb * 64, c0, (bf16_t*)(ws + WS_WGU) + (size_t)e * 1024 * 1024, dr, dr + 32, 1024, nullptr, scr, lane); continue; } r -= 2 * I_G;
        { const int e = r / 128, q = r % 128, kb = q / 16, nb = q % 16; tr_item64(a.w_down + (size_t)e * 512 * 1024, 1024, kb * 64, nb * 64, (bf16_t*)(ws + WS_WD) + (size_t)e * 1024 * 512, nb * 64, nb * 64 + 32, 512, nullptr, scr, lane); }
    }
}

DI void p1_norm(const Args& a, int lane, int wave) {
    asm volatile("" : "+v"(lane));
    const float* mod = (const float*)(a.ws + WS_MOD); bf16_t* H = (bf16_t*)(a.ws + WS_H);
    const int gw = blockIdx.x * NWAVES + wave, NGW = gridDim.x * NWAVES;
    int bprev = -1; f32x4 ca[4], cb[4];
#pragma unroll 1
    for (int q4 = gw; q4 < T / 4; q4 += NGW) {
        const int r0 = q4 * 4, b = r0 / SEQ;
        if (b != bprev) { bprev = b;
#pragma unroll
            for (int j = 0; j < 4; ++j) { const int col = 4 * lane + 256 * j; const f32x4 g = *(const f32x4*)(a.g_mix + col), sc = *(const f32x4*)(mod + b * 6144 + 1024 + col); ca[j] = g * (sc + 1.0f); cb[j] = *(const f32x4*)(mod + b * 6144 + col); } }
        f32x4 v[4][4];
#pragma unroll
        for (int rr = 0; rr < 4; ++rr)
#pragma unroll
            for (int j = 0; j < 4; ++j) v[rr][j] = ldnt4(a.x + (size_t)(r0 + rr) * DM + 4 * lane + 256 * j);
#pragma unroll
        for (int rr = 0; rr < 4; ++rr) { float s = 0.f;
#pragma unroll
            for (int j = 0; j < 4; ++j) s += (v[rr][j].x * v[rr][j].x + v[rr][j].y * v[rr][j].y) + (v[rr][j].z * v[rr][j].z + v[rr][j].w * v[rr][j].w);
            const float rs = 1.0f / sqrtf(wave_sum_fast(s) * (1.0f / DM) + EPS);
            bf16_t* hr = H + (size_t)(r0 + rr) * DM;
#pragma unroll
            for (int j = 0; j < 4; ++j) { const f32x4 o = v[rr][j] * rs * ca[j] + cb[j]; u32x2 w; w.x = pk2(o.x, o.y); w.y = pk2(o.z, o.w); *(u32x2*)(hr + 4 * lane + 256 * j) = w; } }
    }
}
DI void p8_final(const Args& a, const LAS int* tstart, int lane, int wave, float* dst) {
    asm volatile("" : "+v"(lane));
    const float tscale = (STAMP_PHASE >= 0) ? *(const float*)(a.ws + WS_STAMP + 256) : 1.0f;
    const float* mod = (const float*)(a.ws + WS_MOD); const bf16_t* X1 = (const bf16_t*)(a.ws + WS_X1); const bf16_t* Y = (const bf16_t*)(a.ws + WS_Y); const int* tpos = (const int*)(a.ws + WS_TPOS);
    const int gw = blockIdx.x * NWAVES + wave, NGW = gridDim.x * NWAVES;
    for (int ch = gw; ch < T / 16; ch += NGW) {
        const int row0 = ch * 16, b = row0 / SEQ;
        f32x4 g[4], g2[4];
#pragma unroll
        for (int j = 0; j < 4; ++j) { g[j] = *(const f32x4*)(a.g_fin + 4 * lane + 256 * j); g2[j] = *(const f32x4*)(mod + b * 6144 + 5120 + 4 * lane + 256 * j); }
        const int tp = tpos[row0 + (lane & 15)];
        u32x2 xn[2][4], yn[2][4];
#pragma unroll
        for (int rr = 0; rr < 2; ++rr) { const int tpr = __builtin_amdgcn_readlane(tp, rr); const size_t srow = (size_t)tstart[tpr >> 16] * 256 + (tpr & 0xffff);
#pragma unroll
            for (int j = 0; j < 4; ++j) { xn[rr][j] = *(const u32x2*)(X1 + (size_t)(row0 + rr) * DM + 4 * lane + 256 * j); yn[rr][j] = *(const u32x2*)(Y + srow * DM + 4 * lane + 256 * j); } }
#pragma unroll 1
        for (int r2 = 0; r2 < 16; r2 += 2) {
            f32x4 v[2][4]; u32x2 xw[2][4], yw[2][4];
#pragma unroll
            for (int rr = 0; rr < 2; ++rr)
#pragma unroll
                for (int j = 0; j < 4; ++j) { xw[rr][j] = xn[rr][j]; yw[rr][j] = yn[rr][j]; }
            if (r2 + 2 < 16) {
#pragma unroll
                for (int rr = 0; rr < 2; ++rr) { const int tpr = __builtin_amdgcn_readlane(tp, r2 + 2 + rr); const size_t srow = (size_t)tstart[tpr >> 16] * 256 + (tpr & 0xffff);
#pragma unroll
                    for (int j = 0; j < 4; ++j) { xn[rr][j] = *(const u32x2*)(X1 + (size_t)(row0 + r2 + 2 + rr) * DM + 4 * lane + 256 * j); yn[rr][j] = *(const u32x2*)(Y + srow * DM + 4 * lane + 256 * j); } } }
#pragma unroll
            for (int rr = 0; rr < 2; ++rr) { float s = 0.f;
#pragma unroll
                for (int j = 0; j < 4; ++j) { v[rr][j] = (f32x4){bflo(xw[rr][j].x), bfhi(xw[rr][j].x), bflo(xw[rr][j].y), bfhi(xw[rr][j].y)} + g2[j] * (f32x4){bflo(yw[rr][j].x), bfhi(yw[rr][j].x), bflo(yw[rr][j].y), bfhi(yw[rr][j].y)};
                    s += (v[rr][j].x * v[rr][j].x + v[rr][j].y * v[rr][j].y) + (v[rr][j].z * v[rr][j].z + v[rr][j].w * v[rr][j].w); }
                const float rs = 1.0f / sqrtf(wave_sum_fast(s) * (1.0f / DM) + EPS); float* orow = dst + (size_t)(row0 + r2 + rr) * DM;
#pragma unroll
                for (int j = 0; j < 4; ++j) *(f32x4*)(orow + 4 * lane + 256 * j) = v[rr][j] * (rs * tscale) * g[j]; }
        }
    }
}
constexpr int RT_LDS_BYTES = 1024 * 20 * 4;
DI void p5_router(const Args& a, LAS unsigned char* lds, int tid, int lane, int wave, int rep = 0) {
    const float* mod = (const float*)(a.ws + WS_MOD); bf16_t* H = (bf16_t*)(a.ws + WS_H);
    unsigned* cnt = (unsigned*)(a.ws + WS_CTL) + CW_CNT + 2048 * rep; int* list = (int*)(a.ws + WS_LIST); f32x2* wts = (f32x2*)(a.ws + WS_WTS);
    int* tpos = (int*)(a.ws + WS_TPOS); const bf16_t* X1 = (const bf16_t*)(a.ws + WS_X1);
    LAS f32x4* WL = (LAS f32x4*)lds;
    for (int idx = tid; idx < 1024 * 5; idx += NTHREADS) { const int k = idx / 5, q = idx % 5; const f32x4 w = (q == 0) ? *(const f32x4*)(a.w_rg + 4 * k) : *(const f32x4*)(a.w_re + 16 * k + 4 * (q - 1));
        WL[(((k >> 8) * 4 + (k & 3)) * 5 + q) * 64 + ((k & 255) >> 2)] = w; }
    __syncthreads();
    LAS int* wcnt = (LAS int*)(lds + RT_LDS_BYTES);
    for (int it = blockIdx.x; it < T / 128; it += gridDim.x) {
        const int row0 = it * 128 + wave * 16, b = row0 / SEQ;
        f32x4 ca[4], cb[4];
#pragma unroll
        for (int j = 0; j < 4; ++j) { const int col = 4 * lane + 256 * j; const f32x4 g = *(const f32x4*)(a.g_ffn + col), sc = *(const f32x4*)(mod + b * 6144 + 4096 + col); ca[j] = g * (sc + 1.0f); cb[j] = *(const f32x4*)(mod + b * 6144 + 3072 + col); }
        int mybucket = 0; float mywa = 0.f, mywb = 0.f;
        u32x2 xn[2][4];
#pragma unroll
        for (int rr = 0; rr < 2; ++rr)
#pragma unroll
            for (int j = 0; j < 4; ++j) xn[rr][j] = *(const u32x2*)(X1 + (size_t)(row0 + rr) * DM + 4 * lane + 256 * j);
#pragma unroll 1
        for (int r4 = 0; r4 < 16; r4 += 2) {
            f32x4 v[2][4];
#pragma unroll
            for (int rr = 0; rr < 2; ++rr)
#pragma unroll
                for (int j = 0; j < 4; ++j) { const u32x2 xw = xn[rr][j]; v[rr][j] = (f32x4){bflo(xw.x), bfhi(xw.x), bflo(xw.y), bfhi(xw.y)}; }
            if (r4 + 2 < 16) {
#pragma unroll
                for (int rr = 0; rr < 2; ++rr)
#pragma unroll
                    for (int j = 0; j < 4; ++j) xn[rr][j] = *(const u32x2*)(X1 + (size_t)(row0 + r4 + 2 + rr) * DM + 4 * lane + 256 * j); }
#pragma unroll
            for (int rr = 0; rr < 2; ++rr) { float s = 0.f;
#pragma unroll
                for (int j = 0; j < 4; ++j) s += (v[rr][j].x * v[rr][j].x + v[rr][j].y * v[rr][j].y) + (v[rr][j].z * v[rr][j].z + v[rr][j].w * v[rr][j].w);
                const float rs = 1.0f / sqrtf(wave_sum_fast(s) * (1.0f / DM) + EPS);
                bf16_t* hr = H + (size_t)(row0 + r4 + rr) * DM;
#pragma unroll
                for (int j = 0; j < 4; ++j) { v[rr][j] = v[rr][j] * rs * ca[j] + cb[j]; u32x2 w; w.x = pk2(v[rr][j].x, v[rr][j].y); w.y = pk2(v[rr][j].z, v[rr][j].w); *(u32x2*)(hr + 4 * lane + 256 * j) = w; } }
            int wl_off = lane * 16; asm volatile("" : "+v"(wl_off));
            const LAS f32x4* WLp = (const LAS f32x4*)(lds + wl_off);
            f32x2 lg2[4];
#pragma unroll
            for (int i = 0; i < 4; ++i) lg2[i] = (f32x2){0.f, 0.f};
#pragma unroll
            for (int j = 0; j < 4; ++j)
#pragma unroll
                for (int e = 0; e < 4; ++e) { const f32x2 hv = (f32x2){v[0][j][e], v[1][j][e]}; const f32x4 w = WLp[((j * 4 + e) * 5) * 64];
                    lg2[0] += hv * w.x; lg2[1] += hv * w.y; lg2[2] += hv * w.z; lg2[3] += hv * w.w; }
#pragma unroll
            for (int rr = 0; rr < 2; ++rr) {
                float lg[4];
#pragma unroll
                for (int i = 0; i < 4; ++i) lg[i] = wave_sum_fast(rr == 0 ? lg2[i].x : lg2[i].y);
                int g = 0; float gm = lg[0];
#pragma unroll
                for (int i = 1; i < 4; ++i) if (lg[i] > gm) { gm = lg[i]; g = i; }
                float gs = 0.f;
#pragma unroll
                for (int i = 0; i < 4; ++i) gs += expf(lg[i] - gm);
                const float gprob = 1.0f / gs;
                f32x4 ea4 = (f32x4){0.f, 0.f, 0.f, 0.f};
#pragma unroll
                for (int j = 0; j < 4; ++j)
#pragma unroll
                    for (int e = 0; e < 4; ++e) ea4 = ea4 + WLp[((j * 4 + e) * 5 + 1 + g) * 64] * v[rr][j][e];
                float el[4];
#pragma unroll
                for (int i = 0; i < 4; ++i) el[i] = wave_sum_fast(ea4[i]);
                int i0 = 0; float m0 = el[0];
#pragma unroll
                for (int i = 1; i < 4; ++i) if (el[i] > m0) { m0 = el[i]; i0 = i; }
                int i1 = -1; float m1 = 0.f;
#pragma unroll
                for (int i = 0; i < 4; ++i) if (i != i0 && (i1 < 0 || el[i] > m1)) { m1 = el[i]; i1 = i; }
                const float ex = expf(m1 - m0), w0 = 1.0f / (1.0f + ex), w1 = ex * w0;
                const int ea = i0 < i1 ? i0 : i1, eb = i0 < i1 ? i1 : i0; const float wa = (i0 < i1 ? w0 : w1) * gprob, wb = (i0 < i1 ? w1 : w0) * gprob;
                const int bucket = g * 6 + (ea * (7 - ea)) / 2 + (eb - ea - 1);
                if (lane == r4 + rr) { mybucket = bucket; mywa = wa; mywb = wb; }
            }
        }
        if (lane >= 16) mybucket = -1;
        int myrank = 0;
        for (int q = 0; q < NBUCKET; ++q) { const unsigned long long mk = __ballot(mybucket == q); if (mybucket == q) myrank = __popcll(mk & ((1ull << lane) - 1ull)); if (lane == 0) wcnt[wave * NBUCKET + q] = __popcll(mk); }
        __syncthreads();
        if (tid < NBUCKET) { int tot = 0, pre[NWAVES];
#pragma unroll
            for (int w = 0; w < NWAVES; ++w) { pre[w] = tot; tot += wcnt[w * NBUCKET + tid]; }
            const unsigned base = tot ? atomicAdd(cnt + CNT_STRIDE * tid, (unsigned)tot) : 0u;
#pragma unroll
            for (int w = 0; w < NWAVES; ++w) wcnt[w * NBUCKET + tid] = (int)base + pre[w]; }
        __syncthreads();
        if (lane < 16) { const int p = wcnt[wave * NBUCKET + mybucket] + myrank; list[mybucket * T + p] = row0 + lane; wts[mybucket * T + p] = (f32x2){mywa, mywb}; tpos[row0 + lane] = (mybucket << 16) | p; }
        __syncthreads();
    }
}

struct GUnit { const bf16_t* A; const int* aidx; int nvalid; const bf16_t* B0; const bf16_t* B1; int pm, pn, lbase; };
namespace pg8 {
constexpr int BM = 256, BK = 64, HALF = 128, HTB = HALF * BK * 2, STAGE_BYTES = 8 * HTB;
DI int lds_byte(int r, int c) { const int st = (r >> 4) * 2 + (c >> 5), rr = r & 15, cc = c & 31, ob = rr * 64 + cc * 2; return st * 1024 + (ob ^ (((ob >> 9) & 1) << 5)); }
DI void stage_rc(int b, int& R, int& C) { const int st = b / 1024, sb = b % 1024, swz = sb ^ (((sb >> 9) & 1) << 5); R = (st >> 1) * 16 + swz / 64; C = (st & 1) * 32 + (swz % 64) / 2; }
DI int perm32(int rho) { const int n = rho >> 4, i = rho & 15; return 8 * (i >> 2) + 4 * n + (i & 3); }
DI void a_offsets(const GUnit& u, int K, int tid_, unsigned (&vo)[2][2]) {
    asm volatile("" : "+v"(tid_));
#pragma unroll
    for (int i = 0; i < 2; ++i) { int R, C; stage_rc(tid_ * 16 + i * 8192, R, C);
#pragma unroll
        for (int h = 0; h < 2; ++h) { const int r = h * HALF + R; const int gr = u.aidx ? u.aidx[r < u.nvalid ? r : 0] : r; vo[h][i] = ((unsigned)gr * (unsigned)K + (unsigned)C) * 2u; } }
}
template <class Sched, class Epi, bool ALIGN_EPI, int K, int ldb, int nsplit>
DI void gemm_phase(LAS unsigned char* lds, const Sched& S, const Epi& E) {
    int tid = threadIdx.x; asm volatile("" : "+v"(tid));
    const int wid = __builtin_amdgcn_readfirstlane(tid >> 6), lane = tid & 63, wr = wid >> 2, wc = wid & 3, fr = lane & 15, fq = lane >> 4;
    const int nt = K / BK;
    unsigned voffB[2];
#pragma unroll
    for (int i = 0; i < 2; ++i) { int R, C; stage_rc(tid * 16 + i * 8192, R, C); const int Rb = (R & ~31) + perm32(R & 31); voffB[i] = ((unsigned)Rb * (unsigned)ldb + (unsigned)C) * 2u; }
    const size_t hB = (size_t)HALF * ldb * 2;
    const unsigned ldsw = (unsigned)wid * 1024u;
    const int aoff = lds_byte(wr * 64 + fr, fq * 8), boff = lds_byte(wc * 32 + fr, fq * 8);
#define PG8_SA(b, h) (((b) * 2 + (h)) * HTB)
#define PG8_SB(b, h) ((4 + (b) * 2 + (h)) * HTB)
#define PG8_STAGE(bufoff, gbase, voff) do { _Pragma("unroll") for (int _i = 0; _i < 2; ++_i) \
        __builtin_amdgcn_global_load_lds((const unsigned*)((const char*)(gbase) + (voff)[_i]), (LAS unsigned*)(lds + (bufoff) + ldsw + _i * 8192), 16, 0, 0); } while (0)
#define PG8_LDA(dst, b, h) do { _Pragma("unroll") for (int m = 0; m < 4; ++m) _Pragma("unroll") for (int k = 0; k < 2; ++k) dst[m][k] = *(const LAS bf16x8*)(lds + PG8_SA(b, h) + aoff + m * 2048 + k * 1024); } while (0)
#define PG8_LDB(dst, b, h) do { _Pragma("unroll") for (int n = 0; n < 2; ++n) _Pragma("unroll") for (int k = 0; k < 2; ++k) dst[n][k] = *(const LAS bf16x8*)(lds + PG8_SB(b, h) + boff + n * 2048 + k * 1024); } while (0)
#define PG8_MMA(ai, bj, At, Bt) do { __builtin_amdgcn_s_setprio(1); _Pragma("unroll") for (int m = 0; m < 4; ++m) _Pragma("unroll") for (int n = 0; n < 2; ++n) _Pragma("unroll") for (int k = 0; k < 2; ++k) \
        acc[ai][bj][m][n] = __builtin_amdgcn_mfma_f32_16x16x32_bf16(Bt[n][k], At[m][k], acc[ai][bj][m][n], 0, 0, 0); __builtin_amdgcn_s_setprio(0); } while (0)
#define PG8_WAIT_V(n) asm volatile("s_waitcnt vmcnt(" #n ")" ::: "memory")
#define PG8_WAIT_L(n) asm volatile("s_waitcnt lgkmcnt(" #n ")" ::: "memory")
#define PG8_BAR __builtin_amdgcn_s_barrier()
#define PG8_SCHED __builtin_amdgcn_sched_barrier(0)
#define PG8_AK(u, kt) ((const char*)(u).A + (size_t)(kt) * (BK * 2))
#define PG8_BK(u, kt) ((kt) < nsplit ? (const char*)(u).B0 + (size_t)(kt) * (BK * 2) : (const char*)(u).B1 + (size_t)((kt) - nsplit) * (BK * 2))
    GUnit cur, nxt; int ui = 0;
    if (!S.next(0, cur)) return;
    f32x4 acc[2][2][4][2];
#pragma unroll
    for (int a = 0; a < 2; ++a)
#pragma unroll
        for (int b = 0; b < 2; ++b)
#pragma unroll
            for (int m = 0; m < 4; ++m)
#pragma unroll
                for (int n = 0; n < 2; ++n) acc[a][b][m][n] = (f32x4){0.f, 0.f, 0.f, 0.f};
    bf16x8 At[4][2], B0[2][2], B1[2][2];
    unsigned voffA[2][2];
    a_offsets(cur, K, tid, voffA);
    if constexpr (Epi::MIDK) E.prep(cur, 0, tid);
    {
        const char* a0 = PG8_AK(cur, 0); const char* b0 = PG8_BK(cur, 0); const char* a1 = PG8_AK(cur, 1); const char* b1 = PG8_BK(cur, 1);
        PG8_STAGE(PG8_SB(0, 0), b0, voffB); PG8_STAGE(PG8_SB(0, 1), b0 + hB, voffB); PG8_STAGE(PG8_SA(0, 0), a0, voffA[0]); PG8_STAGE(PG8_SA(0, 1), a0, voffA[1]);
        if (wr == 1) PG8_BAR;
        PG8_WAIT_V(2); PG8_BAR;
        PG8_STAGE(PG8_SB(1, 0), b1, voffB); PG8_STAGE(PG8_SA(1, 0), a1, voffA[0]); PG8_STAGE(PG8_SB(1, 1), b1 + hB, voffB);
        PG8_WAIT_V(6); PG8_BAR;
    }
    for (;;) {
        const bool has_next = S.next(ui + 1, nxt);
        if (!has_next) nxt = cur;
        for (int t = 0; t < nt; t += 2) {
            if constexpr (Epi::MIDK) { if (t == nt / 2) E.midk(acc, cur, wr, wc, fr, fq, ui & 1); }
            const bool last = (t == nt - 2);
            const char* a1 = PG8_AK(cur, t + 1);
            const char* a2 = last ? PG8_AK(nxt, 0) : PG8_AK(cur, t + 2); const char* b2 = last ? PG8_BK(nxt, 0) : PG8_BK(cur, t + 2);
            const char* a3 = last ? PG8_AK(nxt, 1) : PG8_AK(cur, t + 3); const char* b3 = last ? PG8_BK(nxt, 1) : PG8_BK(cur, t + 3);
            PG8_LDB(B0, 0, 0); PG8_LDB(B1, 0, 1); PG8_SCHED; PG8_LDA(At, 0, 0); PG8_STAGE(PG8_SA(1, 1), a1, voffA[1]);
            if (last) a_offsets(nxt, K, tid, voffA);
            PG8_WAIT_V(8); PG8_WAIT_L(0); PG8_BAR; PG8_MMA(0, 0, At, B0); PG8_MMA(0, 1, At, B1); PG8_BAR; PG8_SCHED;
            PG8_LDA(At, 0, 1); PG8_STAGE(PG8_SB(0, 0), b2, voffB); PG8_STAGE(PG8_SB(0, 1), b2 + hB, voffB); PG8_STAGE(PG8_SA(0, 0), a2, voffA[0]);
            PG8_WAIT_V(8); PG8_WAIT_L(0); PG8_BAR; PG8_MMA(1, 0, At, B0); PG8_MMA(1, 1, At, B1); PG8_BAR; PG8_SCHED;
            PG8_LDB(B0, 1, 0); PG8_LDB(B1, 1, 1); PG8_SCHED; PG8_LDA(At, 1, 0); PG8_STAGE(PG8_SA(0, 1), a2, voffA[1]);
            PG8_WAIT_V(8); PG8_WAIT_L(0); PG8_BAR; PG8_MMA(0, 0, At, B0); PG8_MMA(0, 1, At, B1); PG8_BAR; PG8_SCHED;
            PG8_LDA(At, 1, 1); PG8_STAGE(PG8_SB(1, 0), b3, voffB); PG8_STAGE(PG8_SB(1, 1), b3 + hB, voffB); PG8_STAGE(PG8_SA(1, 0), a3, voffA[0]);
            PG8_WAIT_V(8); PG8_WAIT_L(0); PG8_BAR; PG8_MMA(1, 0, At, B0); PG8_MMA(1, 1, At, B1); PG8_BAR; PG8_SCHED;
        }
        if constexpr (ALIGN_EPI) { if (wr == 0) PG8_BAR; }
        E(acc, cur, wr, wc, fr, fq, ui & 1);
        if (!has_next) break;
        if constexpr (Epi::MIDK) E.prep(nxt, (ui + 1) & 1, tid);
#pragma unroll
        for (int a = 0; a < 2; ++a)
#pragma unroll
            for (int b = 0; b < 2; ++b)
#pragma unroll
                for (int m = 0; m < 4; ++m)
#pragma unroll
                    for (int n = 0; n < 2; ++n) acc[a][b][m][n] = (f32x4){0.f, 0.f, 0.f, 0.f};
        cur = nxt; ++ui;
        if constexpr (ALIGN_EPI) { if (wr == 1) PG8_BAR; }
    }
    PG8_WAIT_V(0);
    if constexpr (!ALIGN_EPI) { if (wr == 0) PG8_BAR; }
    PG8_BAR;
#undef PG8_SA
#undef PG8_SB
#undef PG8_STAGE
#undef PG8_LDA
#undef PG8_LDB
#undef PG8_MMA
#undef PG8_WAIT_V
#undef PG8_WAIT_L
#undef PG8_BAR
#undef PG8_SCHED
#undef PG8_AK
#undef PG8_BK
}
}
struct DenseSched {
    const bf16_t* A; const bf16_t* Bt; int K, nM, nN;
    DI bool next(int i, GUnit& u) const {
        const int nwg = nM * nN; const long L = (long)i * (int)gridDim.x + (int)blockIdx.x; if (L >= nwg) return false;
        int wgid = (int)L; { const int q = nwg / 8, r = nwg % 8, xcd = wgid % 8, off = wgid / 8; wgid = (xcd < r ? xcd * (q + 1) : r * (q + 1) + (xcd - r) * q) + off; }
        const int nig = 8 * nN, gid = wgid / nig, fm = gid * 8, gsz = (nM - fm) < 8 ? (nM - fm) : 8;
        u.pm = fm + ((wgid % nig) % gsz); u.pn = (wgid % nig) / gsz;
        u.A = A + (size_t)u.pm * 256 * K; u.aidx = nullptr; u.nvalid = 256; u.B0 = Bt + (size_t)u.pn * 256 * K; u.B1 = u.B0; u.lbase = 0; return true; }
};
template <bool up> DI void moe_fill_unit(GUnit& u, int ti, int pn, const LAS int* tstart, const unsigned* cnt, const int* list, const bf16_t* A, const bf16_t* W) {
    int b = 0;
    for (int q = 1; q < NBUCKET; ++q) if (__builtin_amdgcn_readfirstlane(tstart[q]) <= ti) b = q;
    const int rt = ti - __builtin_amdgcn_readfirstlane(tstart[b]); const int g = b / 6, p = b % 6; const int ea = 4 * g + (p < 3 ? 0 : (p < 5 ? 1 : 2)), eb = 4 * g + (p < 3 ? p + 1 : (p < 5 ? p - 1 : 3));
    u.pm = ti; u.pn = pn; u.lbase = b * T + rt * 256; const int nv = __builtin_amdgcn_readfirstlane((int)cnt[CNT_STRIDE * b]) - rt * 256; u.nvalid = nv < 256 ? nv : 256;
    if (up) { u.A = A; u.aidx = list + u.lbase; const int e = pn < 4 ? ea : eb; u.B0 = W + (size_t)e * 1024 * 1024 + (size_t)(pn & 3) * 256 * 1024; u.B1 = u.B0; }
    else { u.A = A + (size_t)ti * 256 * 1024; u.aidx = nullptr; u.B0 = W + (size_t)ea * 1024 * 512 + (size_t)pn * 256 * 512; u.B1 = W + (size_t)eb * 1024 * 512 + (size_t)pn * 256 * 512; }
}
template <int NT, bool up> struct MoeSched {
    const LAS int* tstart; const unsigned* cnt; const int* list; const bf16_t* A; const bf16_t* W;
    DI bool next(int i, GUnit& u) const {
        const int ntile = __builtin_amdgcn_readfirstlane(tstart[NBUCKET]), nwg = ntile * NT; const int L0 = i * (int)gridDim.x + (int)blockIdx.x; if (L0 >= nwg) return false;
        int L = L0; { const int q = nwg / 8, r = nwg % 8, xcd = L0 % 8, off = L0 / 8; L = (xcd < r ? xcd * (q + 1) : r * (q + 1) + (xcd - r) * q) + off; }
        moe_fill_unit<up>(u, L / NT, L % NT, tstart, cnt, list, A, W); return true;
    }
};
struct MoeCut { int x, tiles_x, cstart, left, nY; };
DI MoeCut moe_cut(int ntile) { MoeCut c; c.x = (int)blockIdx.x & 7; const int q = ntile / 8, r = ntile % 8; c.tiles_x = q + (c.x < r ? 1 : 0); c.cstart = c.x * q + (c.x < r ? c.x : r); c.left = 8 * (c.tiles_x - 16); c.nY = 32 - c.left; return c; }
template <bool up, int MODE> struct MoeSplitSched {
    const LAS int* tstart; const unsigned* cnt; const int* list; const bf16_t* A; const bf16_t* W; MoeCut c;
    DI bool next(int i, GUnit& u) const {
        const int w = (int)blockIdx.x >> 3; int ti, pn;
        if (MODE == 1) { if (i >= 4) return false; const int off = i * 32 + w; ti = c.cstart + (off >> 3); pn = off & 7; }
        else if (MODE == 2 && up) { if (i > 0) return false; const int off = 128 + w; ti = c.cstart + (off >> 3); pn = off & 7; }
        else if (MODE == 2) { if (i > 0) return false; const int d = w - c.left; ti = c.cstart + (d >> 2); pn = d & 3; }
        else { const int e = i * 32 + w, rem = 4 * c.tiles_x - c.nY; if (e >= rem) return false;
            if (e < 64 - c.nY) { const int d = c.nY + e; ti = c.cstart + (d >> 2); pn = d & 3; } else { const int l = e - (64 - c.nY); ti = c.cstart + 16 + (l >> 2); pn = l & 3; } }
        moe_fill_unit<up>(u, ti, pn, tstart, cnt, list, A, W); return true;
    }
};

DI u32x4 pack8(const f32x4 v0, const f32x4 v1) { u32x4 w; w.x = pk2(v0[0], v0[1]); w.y = pk2(v0[2], v0[3]); w.z = pk2(v1[0], v1[1]); w.w = pk2(v1[2], v1[3]); return w; }
struct EpiProj { static constexpr bool MIDK = false;
    bf16_t *qsb, *vtsb, *qsw, *ksw, *vtsw; const float *cosT, *sinT;
    DI void operator()(const f32x4 (&acc)[2][2][4][2], const GUnit& u, int wr, int wc, int fr, int fq, int) const {
        const int pn = u.pn, rowb = u.pm * 256 + wr * 64 + fr;
        if (pn < 4) {
            bf16_t* base = qsb + (size_t)(pn >> 1) * ((WS_KSB - WS_QSB) / 2); const float sc = pn < 2 ? QSCALE : 1.0f; const int colt = (pn & 1) * 256 + wc * 32 + 8 * fq;
#pragma unroll
            for (int ai = 0; ai < 2; ++ai)
#pragma unroll
                for (int m = 0; m < 4; ++m) { const size_t row = rowb + ai * 128 + m * 16;
#pragma unroll
                    for (int bj = 0; bj < 2; ++bj) *(u32x4*)(base + row * 512 + colt + bj * 128) = pack8(acc[ai][bj][m][0] * sc, acc[ai][bj][m][1] * sc); }
        } else if (pn < 6 || (pn == 8 && wc >= 2)) {
            bf16_t* base = pn < 6 ? vtsb : vtsw; const int NF = pn < 6 ? 512 : 128, c0 = pn < 6 ? (pn - 4) * 256 + wc * 32 + 8 * fq : (wc * 32 - 64) + 8 * fq, bjs = pn < 6 ? 128 : 64;
#pragma unroll
            for (int ai = 0; ai < 2; ++ai)
#pragma unroll
                for (int m = 0; m < 4; ++m) { const int row = rowb + ai * 128 + m * 16; bf16_t* bp = base + ((size_t)(row >> 5) * NF + c0) * 32 + (row & 31);
#pragma unroll
                    for (int bj = 0; bj < 2; ++bj)
#pragma unroll
                        for (int n = 0; n < 2; ++n)
#pragma unroll
                            for (int j = 0; j < 4; ++j) bp[(bj * bjs + 4 * n + j) * 32] = (bf16_t)f2bf(acc[ai][bj][m][n][j]); }
        } else {
            const bool isq = pn < 8; bf16_t* base = isq ? qsw : ksw; const int pitch = isq ? 512 : 128; const int head = isq ? (pn - 6) * 4 + wc : wc; const float sc = isq ? QSCALE : 1.0f;
#pragma unroll
            for (int ai = 0; ai < 2; ++ai)
#pragma unroll
                for (int m = 0; m < 4; ++m) { const size_t row = rowb + ai * 128 + m * 16;
                    const f32x4 c0 = *(const f32x4*)(cosT + row * 32 + 8 * fq), c1 = *(const f32x4*)(cosT + row * 32 + 8 * fq + 4);
                    const f32x4 s0 = *(const f32x4*)(sinT + row * 32 + 8 * fq), s1 = *(const f32x4*)(sinT + row * 32 + 8 * fq + 4);
                    const f32x4 x10 = acc[ai][0][m][0], x11 = acc[ai][0][m][1], x20 = acc[ai][1][m][0], x21 = acc[ai][1][m][1];
                    const f32x4 o10 = (x10 * c0 - x20 * s0) * sc, o11 = (x11 * c1 - x21 * s1) * sc, o20 = (x20 * c0 + x10 * s0) * sc, o21 = (x21 * c1 + x11 * s1) * sc;
                    *(u32x4*)(base + row * pitch + head * 64 + 8 * fq) = pack8(o10, o11); *(u32x4*)(base + row * pitch + head * 64 + 32 + 8 * fq) = pack8(o20, o21); }
        }
    }
};
struct EpiWout {
    static constexpr bool MIDK = true;
    const float* mod; bf16_t* x1; const float* x; const float* ssq; LAS float* tab;
    DI void prep(const GUnit& u, int par, int tid) const {
        if (tid < 256) { const size_t row = (size_t)u.pm * 256 + tid; const f32x4 a0 = *(const f32x4*)(ssq + row * 16), a1 = *(const f32x4*)(ssq + row * 16 + 4), b0 = *(const f32x4*)(ssq + row * 16 + 8), b1 = *(const f32x4*)(ssq + row * 16 + 12);
            const float sa = ((a0.x + a0.y) + (a0.z + a0.w)) + ((a1.x + a1.y) + (a1.z + a1.w)), sb = ((b0.x + b0.y) + (b0.z + b0.w)) + ((b1.x + b1.y) + (b1.z + b1.w));
            const float rsb = 1.0f / sqrtf(sa * (1.0f / 512.0f) + EPS), rsw = 1.0f / sqrtf(sb * (1.0f / 512.0f) + EPS);
            *(LAS f32x2*)(tab + (par * 256 + tid) * 2) = (f32x2){rsb / rsw, rsw}; }
    }
    DI void midk(f32x4 (&acc)[2][2][4][2], const GUnit& u, int wr, int wc, int fr, int fq, int par) const {
#pragma unroll
        for (int ai = 0; ai < 2; ++ai)
#pragma unroll
            for (int m = 0; m < 4; ++m) { const float ratio = tab[(par * 256 + ai * 128 + wr * 64 + m * 16 + fr) * 2];
#pragma unroll
                for (int bj = 0; bj < 2; ++bj)
#pragma unroll
                    for (int n = 0; n < 2; ++n) acc[ai][bj][m][n] = acc[ai][bj][m][n] * ratio; }
    }
    DI void operator()(const f32x4 (&acc)[2][2][4][2], const GUnit& u, int wr, int wc, int fr, int fq, int par) const {
        const int rowb = u.pm * 256 + wr * 64 + fr, colb = u.pn * 256 + wc * 32 + 8 * fq; const int b = (u.pm * 256) / SEQ;
        f32x4 gt[2][2];
#pragma unroll
        for (int bj = 0; bj < 2; ++bj)
#pragma unroll
            for (int n = 0; n < 2; ++n) gt[bj][n] = *(const f32x4*)(mod + b * 6144 + 2048 + colb + bj * 128 + 4 * n);
#pragma unroll
        for (int ai = 0; ai < 2; ++ai)
#pragma unroll
            for (int mp = 0; mp < 2; ++mp) {
                f32x4 xv[2][2][2];
#pragma unroll
                for (int mm = 0; mm < 2; ++mm)
#pragma unroll
                    for (int bj = 0; bj < 2; ++bj)
#pragma unroll
                        for (int n = 0; n < 2; ++n) xv[mm][bj][n] = ldnt4(x + (size_t)(rowb + ai * 128 + (2 * mp + mm) * 16) * DM + colb + bj * 128 + 4 * n);
#pragma unroll
                for (int mm = 0; mm < 2; ++mm) { const int m = 2 * mp + mm, row = rowb + ai * 128 + m * 16; const float rsw = tab[(par * 256 + ai * 128 + wr * 64 + m * 16 + fr) * 2 + 1];
#pragma unroll
                    for (int bj = 0; bj < 2; ++bj) *(u32x4*)(x1 + (size_t)row * DM + colb + bj * 128) = pack8(xv[mm][bj][0] + gt[bj][0] * (acc[ai][bj][m][0] * rsw), xv[mm][bj][1] + gt[bj][1] * (acc[ai][bj][m][1] * rsw)); }
                asm volatile("" ::: "memory");
            }
    }
};
DI f32x4 swiglu4(const f32x4 g, const f32x4 uu, float w) { f32x4 o;
#pragma unroll
    for (int j = 0; j < 4; ++j) o[j] = (w * uu[j]) * (g[j] * __builtin_amdgcn_rcpf(1.0f + __builtin_amdgcn_exp2f(-LOG2E * g[j])));
    return o; }
struct EpiUp { static constexpr bool MIDK = true;
    bf16_t* hid; const f32x2* wts; LAS float* tab;
    DI void prep(const GUnit& u, int par, int tid) const {
        if (tid < 256) { float w = 0.f; if (tid < u.nvalid) { const f32x2 ww = wts[u.lbase + tid]; w = u.pn >= 4 ? ww.y : ww.x; } tab[par * 256 + tid] = w; }
    }
    DI void midk(f32x4 (&)[2][2][4][2], const GUnit&, int, int, int, int, int) const {}
    DI void operator()(const f32x4 (&acc)[2][2][4][2], const GUnit& u, int wr, int wc, int fr, int fq, int par) const {
        const int hc = (u.pn >> 2) * 512 + (u.pn & 3) * 128 + wc * 32 + 8 * fq;
#pragma unroll
        for (int ai = 0; ai < 2; ++ai)
#pragma unroll
            for (int m = 0; m < 4; ++m) { const int r = ai * 128 + wr * 64 + m * 16 + fr; const float w = tab[par * 256 + r];
                *(u32x4*)(hid + (size_t)(u.pm * 256 + r) * 1024 + hc) = pack8(swiglu4(acc[ai][0][m][0], acc[ai][1][m][0], w), swiglu4(acc[ai][0][m][1], acc[ai][1][m][1], w)); }
    }
};
struct EpiDown { static constexpr bool MIDK = false;
    bf16_t* y;
    DI void operator()(const f32x4 (&acc)[2][2][4][2], const GUnit& u, int wr, int wc, int fr, int fq, int) const {
        const int rowb = u.pm * 256 + wr * 64 + fr, colb = u.pn * 256 + wc * 32 + 8 * fq;
#pragma unroll
        for (int ai = 0; ai < 2; ++ai)
#pragma unroll
            for (int m = 0; m < 4; ++m) { const size_t row = rowb + ai * 128 + m * 16;
#pragma unroll
                for (int bj = 0; bj < 2; ++bj) *(u32x4*)(y + row * DM + colb + bj * 128) = pack8(acc[ai][bj][m][0], acc[ai][bj][m][1]); }
    }
};

typedef float f32x16 __attribute__((ext_vector_type(16)));
#define MFMA32(a, b, c) __builtin_amdgcn_mfma_f32_32x32x16_bf16((a), (b), (c), 0, 0, 0)
DI int pi32(int r) { return (r & ~12) | ((r & 4) << 1) | ((r & 8) >> 1); }
DI int crow(int i, int h) { return (i & 3) + 8 * (i >> 2) + 4 * h; }
template <int S_> DI bf16x8 packacc(const f32x16& x) { u32x4 p; p.x = pk2(x[8 * S_], x[8 * S_ + 1]); p.y = pk2(x[8 * S_ + 2], x[8 * S_ + 3]); p.z = pk2(x[8 * S_ + 4], x[8 * S_ + 5]); p.w = pk2(x[8 * S_ + 6], x[8 * S_ + 7]); return __builtin_bit_cast(bf16x8, p); }
DI f32x16 zero16() { f32x16 z;
#pragma unroll
    for (int i = 0; i < 16; ++i) z[i] = 0.f;
    return z; }
constexpr int AT_SLOT = 16384, ATT_NSLOT = 6;
constexpr int ATT_STG_OFF = ATT_NSLOT * AT_SLOT, ATT_STGW = 32 * 36;
constexpr int ATT_LS_OFF = ATT_STG_OFF + NWAVES * ATT_STGW * 4, ATT_CTL_OFF = ATT_LS_OFF + NWAVES * 32 * 4;
static_assert(ATT_CTL_OFF + 64 <= LDS_MISC, "attention LDS map");
#define AT_WAIT_V(n) asm volatile("s_waitcnt vmcnt(" #n ")" ::: "memory")
#define AT_BARRIER() do { asm volatile("s_waitcnt lgkmcnt(0)" ::: "memory"); __builtin_amdgcn_s_barrier(); asm volatile("" ::: "memory"); } while (0)
DI void at_issue(const bf16_t* Kg, int kp, const bf16_t* VTg, int nf, LAS unsigned char* slotp, int jt, int wave, int lane) {
    const int key = 8 * wave + (lane >> 3), chunk = (lane & 7) ^ ((key >> 1) & 7);
    __builtin_amdgcn_global_load_lds((const unsigned*)(Kg + (64 * (size_t)jt + key) * kp + chunk * 8), (LAS unsigned*)(slotp + wave * 1024), 16, 0, 0);
    const int hh = wave >> 2, d = 16 * (wave & 3) + (lane >> 2), sl = (lane & 3) ^ ((d >> 2) & 3);
    __builtin_amdgcn_global_load_lds((const unsigned*)(VTg + ((2 * (size_t)jt + hh) * nf + d) * 32 + sl * 8), (LAS unsigned*)(slotp + 8192 + wave * 1024), 16, 0, 0);
}
DI void at_kfrag(const LAS unsigned char* sl, int hh, int r, int h, bf16x8 (&kf)[4]) { const int key = 32 * hh + pi32(r), ksw = (key >> 1) & 7; const LAS unsigned char* kb = sl + key * 128;
#pragma unroll
    for (int d0 = 0; d0 < 4; ++d0) kf[d0] = *(const LAS bf16x8*)(kb + (((2 * d0 + h) ^ ksw) * 16)); }
DI void at_vfrag(const LAS unsigned char* sl, int hh, int r, int h, bf16x8 (&vf)[2][2]) {
#pragma unroll
    for (int dt = 0; dt < 2; ++dt)
#pragma unroll
        for (int sx = 0; sx < 2; ++sx) { const int d = 32 * dt + r; vf[dt][sx] = *(const LAS bf16x8*)(sl + 8192 + hh * 4096 + d * 64 + (((2 * sx + h) ^ ((d >> 2) & 3)) * 16)); } }

template <int DIAG> DI void sb_half(const LAS unsigned char* sl, int hh, const bf16x8 (&qf)[4], float& Cl, f32x16 (&o)[2], int r, int h) {
    bf16x8 kf[4], vf[2][2];
    at_kfrag(sl, hh, r, h, kf); at_vfrag(sl, hh, r, h, vf);
    f32x16 S = zero16();
#pragma unroll
    for (int d0 = 0; d0 < 4; ++d0) S = MFMA32(kf[d0], qf[d0], S);
    float om[16];
#pragma unroll
    for (int i = 0; i < 16; ++i) { float v = __builtin_amdgcn_rcpf(1.0f + __builtin_amdgcn_exp2f(S[i])); if (DIAG && !(16 * (i >> 3) + 8 * h + (i & 7) < r)) v = 1.0f; om[i] = v; }
    f32x2 sf[8]; sf[7] = (f32x2){1.0f, 1.0f};
#pragma unroll
    for (int i = 6; i >= 0; --i) sf[i] = sf[i + 1] * (f32x2){om[i + 1], om[i + 9]};
    float Rx = sf[0].x * om[0], Ry = sf[0].y * om[8];
    asm volatile("" : "+v"(Rx), "+v"(Ry));
    unsigned ax = __builtin_bit_cast(unsigned, Rx), ay = __builtin_bit_cast(unsigned, Ry), bx = ay, by = ax;
    swap32(ax, ay); swap32(bx, by);
    const float p0 = __builtin_bit_cast(float, h == 0 ? ay : bx), p1 = __builtin_bit_cast(float, h == 0 ? by : ax);
    const float m1 = (h == 0 ? p1 : 1.0f) * Cl, m0 = (h == 0 ? p0 * p1 : p1) * Ry * Cl;
    Cl = Cl * ((Rx * Ry) * (p0 * p1));
    const f32x2 mm = (f32x2){m0, m1};
    f32x16 P;
#pragma unroll
    for (int i = 0; i < 8; ++i) { const f32x2 w = (sf[i] * mm) * ((f32x2){1.0f, 1.0f} - (f32x2){om[i], om[i + 8]}); P[i] = w.x; P[i + 8] = w.y; }
    const bf16x8 Pf0 = packacc<0>(P), Pf1 = packacc<1>(P);
#pragma unroll
    for (int dt = 0; dt < 2; ++dt) { o[dt] = MFMA32(Pf0, vf[dt][0], o[dt]); o[dt] = MFMA32(Pf1, vf[dt][1], o[dt]); }
}
constexpr float SB_CMIN = 5.421010862427522e-20f;
struct SbUnit { int b, hd, q0; };
DI SbUnit sb_unit_of(int idx) { SbUnit u; u.b = idx / 512; u.hd = (idx >> 6) & 7; u.q0 = (idx & 63) * 128; return u; }
DI void grp_barrier(volatile LAS int* bar, int& epoch, int lane) {
    asm volatile("s_waitcnt lgkmcnt(0)" ::: "memory"); ++epoch;
    if (lane == 0) __hip_atomic_fetch_add((LAS int*)bar, 1, __ATOMIC_RELAXED, __HIP_MEMORY_SCOPE_WORKGROUP);
    while (*bar < 4 * epoch) __builtin_amdgcn_s_sleep(1);
    asm volatile("" ::: "memory");
}
DI void at_issue4(const bf16_t* Kg, const bf16_t* VTg, LAS unsigned char* slotp, int jt, int w4, int lane) {
#pragma unroll
    for (int pp = 0; pp < 2; ++pp) { const int pc = w4 + 4 * pp;
        const int key = 8 * pc + (lane >> 3), chunk = (lane & 7) ^ ((key >> 1) & 7);
        __builtin_amdgcn_global_load_lds((const unsigned*)(Kg + (64 * (size_t)jt + key) * 512 + chunk * 8), (LAS unsigned*)(slotp + pc * 1024), 16, 0, 0);
        const int hh = pc >> 2, d = 16 * (pc & 3) + (lane >> 2), sl = (lane & 3) ^ ((d >> 2) & 3);
        __builtin_amdgcn_global_load_lds((const unsigned*)(VTg + ((2 * (size_t)jt + hh) * 512 + d) * 32 + sl * 8), (LAS unsigned*)(slotp + 8192 + pc * 1024), 16, 0, 0); }
}
DI int sb_prologue(const bf16_t* Q, const bf16_t* K, const bf16_t* VT, const SbUnit& u, LAS unsigned char* ring, int w4, int lane, bf16x8 (&qf)[4]) {
    const int r = lane & 31, h = lane >> 5; const size_t gb = (size_t)u.b * SEQ; const int t0w = u.q0 + 32 * w4;
    const bf16_t* Kg = K + gb * 512 + u.hd * 64; const bf16_t* VTg = VT + ((gb >> 5) * 512 + u.hd * 64) * 32;
    const int jt_hi = (u.q0 + 127) >> 6, ntiles = jt_hi + 1; int issued = 0;
    for (; issued < 2 && issued < ntiles; ++issued) at_issue4(Kg, VTg, ring + issued * AT_SLOT, jt_hi - issued, w4, lane);
#pragma unroll
    for (int d0 = 0; d0 < 4; ++d0) qf[d0] = *(const bf16x8*)(Q + (gb + t0w + r) * 512 + u.hd * 64 + 16 * d0 + 8 * h);
    return issued;
}
DI void sb_body(const bf16_t* K, const bf16_t* VT, const SbUnit& u, int issued, bf16x8 (&qf)[4], LAS unsigned char* ring, volatile LAS int* ctl, volatile LAS int* bar, int& epoch, int w4, int lane, f32x16 (&o)[2]) {
    const int r = lane & 31, h = lane >> 5; const size_t gb = (size_t)u.b * SEQ; const int t0w = u.q0 + 32 * w4, sd = t0w >> 5;
    o[0] = zero16(); o[1] = zero16(); float Cl = 1.0f;
    const bf16_t* Kg = K + gb * 512 + u.hd * 64; const bf16_t* VTg = VT + ((gb >> 5) * 512 + u.hd * 64) * 32;
    const int jt_hi = (u.q0 + 127) >> 6, ntiles = jt_hi + 1;
    if (w4 == 0 && lane == 0) { ctl[0] = 0; ctl[1] = 0; ctl[2] = 0; }
    asm volatile("s_waitcnt vmcnt(0)" : "+v"(qf[0]), "+v"(qf[1]), "+v"(qf[2]), "+v"(qf[3]) :: "memory");
    bool done = false; int slot = 0;
    for (int i = 0; i < ntiles; ++i) {
        const int jt = jt_hi - i, fly = issued - (i + 1);
        if (fly >= 1) AT_WAIT_V(4); else AT_WAIT_V(0);
        grp_barrier(bar, epoch, lane);
        if (i > 0 && ctl[(i - 1) % 3] == 4) break;
        if (w4 == 0 && lane == 0) ctl[(i + 1) % 3] = 0;
        if (issued < ntiles) { at_issue4(Kg, VTg, ring + ((slot + 2) % 3) * AT_SLOT, jt_hi - issued, w4, lane); ++issued; }
        if (!done) {
            const LAS unsigned char* sl = ring + slot * AT_SLOT;
            const int s1 = 2 * jt + 1, s0 = 2 * jt;
            if (s1 < sd) sb_half<0>(sl, 1, qf, Cl, o, r, h); else if (s1 == sd) sb_half<1>(sl, 1, qf, Cl, o, r, h);
            if (s0 < sd) sb_half<0>(sl, 0, qf, Cl, o, r, h); else if (s0 == sd) sb_half<1>(sl, 0, qf, Cl, o, r, h);
            if (s1 <= sd || s0 <= sd) done = __all(Cl < SB_CMIN);
        }
        if (done && lane == 0) __hip_atomic_fetch_add((LAS int*)&ctl[i % 3], 1, __ATOMIC_RELAXED, __HIP_MEMORY_SCOPE_WORKGROUP);
        slot = (slot + 1) % 3;
    }
    AT_WAIT_V(0);
    grp_barrier(bar, epoch, lane);
}
DI void sw_head(const bf16x8 (&qf)[4], const LAS unsigned char* lds, float sink2, int t0, int jt_lo, int lane, f32x16 (&o)[2], float& lsum) {
    const int r = lane & 31, h = lane >> 5, sd = t0 >> 5;
    f32x16 S[5]; float m = sink2;
#pragma unroll
    for (int jj = 0; jj < 5; ++jj) { const int sj = sd - 4 + jj;
        if (sj >= 0) { bf16x8 kf[4]; at_kfrag(lds + ((sj >> 1) - jt_lo) * AT_SLOT, sj & 1, r, h, kf);
            f32x16 s = zero16();
#pragma unroll
            for (int d0 = 0; d0 < 4; ++d0) s = MFMA32(kf[d0], qf[d0], s);
#pragma unroll
            for (int i = 0; i < 16; ++i) { const int ko = 16 * (i >> 3) + 8 * h + (i & 7); float v = s[i];
                if (jj == 4 && ko > r) v = -1e30f;
                if (jj == 0 && ko <= r) v = -1e30f;
                s[i] = v; m = __builtin_fmaxf(m, v); }
            S[jj] = s; }
        else {
#pragma unroll
            for (int i = 0; i < 16; ++i) S[jj][i] = -1e30f; } }
    m = __builtin_fmaxf(m, __shfl_xor(m, 32));
    o[0] = zero16(); o[1] = zero16(); float ls = 0.f;
#pragma unroll
    for (int jj = 0; jj < 5; ++jj) { const int sj = sd - 4 + jj;
        if (sj >= 0) { bf16x8 vf[2][2]; at_vfrag(lds + ((sj >> 1) - jt_lo) * AT_SLOT, sj & 1, r, h, vf);
            f32x16 P;
#pragma unroll
            for (int i = 0; i < 16; ++i) { P[i] = __builtin_amdgcn_exp2f(S[jj][i] - m); ls += P[i]; }
            const bf16x8 Pf0 = packacc<0>(P), Pf1 = packacc<1>(P);
#pragma unroll
            for (int dt = 0; dt < 2; ++dt) { o[dt] = MFMA32(Pf0, vf[dt][0], o[dt]); o[dt] = MFMA32(Pf1, vf[dt][1], o[dt]); } } }
    ls += __shfl_xor(ls, 32);
    lsum = ls + __builtin_amdgcn_exp2f(sink2 - m);
}
DI void at_store(const f32x16 (&o)[2], float lsum, LAS float* stg, LAS float* lsb, bf16_t* mixrow0, float* ssq0, int lane) {
    const int r = lane & 31, h = lane >> 5, row = lane >> 1, hf = lane & 1;
    if (h == 0) lsb[r] = lsum;
    float ss = 0.f; u32x4 w[2][2];
#pragma unroll
    for (int dt = 0; dt < 2; ++dt) {
#pragma unroll
        for (int i = 0; i < 16; ++i) stg[crow(i, h) * 36 + r] = o[dt][i];
        LDS_WAIT();
        const float il = 1.0f / lsb[row];
#pragma unroll
        for (int k = 0; k < 2; ++k) { const f32x4 a0 = *(const LAS f32x4*)(stg + row * 36 + hf * 16 + 8 * k) * il, a1 = *(const LAS f32x4*)(stg + row * 36 + hf * 16 + 8 * k + 4) * il;
            ss += ((a0.x * a0.x + a0.y * a0.y) + (a0.z * a0.z + a0.w * a0.w)) + ((a1.x * a1.x + a1.y * a1.y) + (a1.z * a1.z + a1.w * a1.w)); w[dt][k] = pack8(a0, a1); }
        LDS_WAIT();
    }
    ss += __shfl_xor(ss, 1);
    if (hf == 0) ssq0[(size_t)row * 16] = ss;
    bf16_t* mr = mixrow0 + (size_t)row * 1024 + hf * 16;
#pragma unroll
    for (int dt = 0; dt < 2; ++dt) { *(u32x4*)(mr + 32 * dt) = w[dt][0]; *(u32x4*)(mr + 32 * dt + 8) = w[dt][1]; }
}
DI void p3_attention(const Args& a, LAS unsigned char* lds, int tid, int lane, int wave, int rep = 0, int kinds = 3) {
    asm volatile("" : "+v"(tid), "+v"(lane));
    const bf16_t* QSB = (const bf16_t*)(a.ws + WS_QSB); const bf16_t* KSB = (const bf16_t*)(a.ws + WS_KSB); const bf16_t* VTSB = (const bf16_t*)(a.ws + WS_VSB);
    const bf16_t* QSW = (const bf16_t*)(a.ws + WS_QSW); const bf16_t* KSW = (const bf16_t*)(a.ws + WS_KSW); const bf16_t* VTSW = (const bf16_t*)(a.ws + WS_VSW);
    bf16_t* MIX = (bf16_t*)(a.ws + WS_MIX); float* SSQ = (float*)(a.ws + WS_SSQ); unsigned* qctr = (unsigned*)(a.ws + WS_CTL) + CW_ATTNQ + 2048 * rep;
    LAS float* stg = (LAS float*)(lds + ATT_STG_OFF) + wave * ATT_STGW; LAS float* lsb = (LAS float*)(lds + ATT_LS_OFF) + wave * 32; volatile LAS int* ctl = (volatile LAS int*)(lds + ATT_CTL_OFF);
    if (kinds & 2)
    for (int u = (int)blockIdx.x; u < (T / 256) * 2; u += (int)gridDim.x) {
        const int b = u / 64, kvh = (u >> 5) & 1, q0 = (u & 31) * 256, jt_lo = (q0 >> 6) - 2, t0 = q0 + 32 * wave; const size_t gb = (size_t)b * SEQ;
        const bf16_t* Kg = KSW + gb * 128 + kvh * 64; const bf16_t* VTg = VTSW + ((gb >> 5) * 128 + kvh * 64) * 32;
#pragma unroll
        for (int s6 = 0; s6 < 6; ++s6) if (jt_lo + s6 >= 0) at_issue(Kg, 128, VTg, 128, lds + s6 * AT_SLOT, jt_lo + s6, wave, lane);
        bf16x8 qn[4];
#pragma unroll
        for (int d0 = 0; d0 < 4; ++d0) qn[d0] = *(const bf16x8*)(QSW + (gb + t0 + (lane & 31)) * 512 + (4 * kvh) * 64 + 16 * d0 + 8 * (lane >> 5));
        AT_WAIT_V(0); AT_BARRIER();
#pragma unroll
        for (int q = 0; q < 4; ++q) { const int hq = 4 * kvh + q; f32x16 o[2]; float lsum; bf16x8 qf[4];
#pragma unroll
            for (int d0 = 0; d0 < 4; ++d0) qf[d0] = qn[d0];
            if (q < 3) {
#pragma unroll
                for (int d0 = 0; d0 < 4; ++d0) qn[d0] = *(const bf16x8*)(QSW + (gb + t0 + (lane & 31)) * 512 + (hq + 1) * 64 + 16 * d0 + 8 * (lane >> 5)); }
            sw_head(qf, lds, a.sinks[hq] * LOG2E, t0, jt_lo, lane, o, lsum);
            at_store(o, lsum, stg, lsb, MIX + (gb + t0) * 1024 + 512 + hq * 64, SSQ + (gb + t0) * 16 + 8 + hq, lane); }
        asm volatile("s_waitcnt vmcnt(0)" ::: "memory"); AT_BARRIER();
    }
    if (kinds & 1) {
        volatile LAS int* gb2 = ctl + 32;
        if (tid < 2) gb2[16 * tid] = 0;
        __syncthreads();
        const int grp = wave >> 2, w4 = wave & 3; LAS unsigned char* ring = lds + grp * 3 * AT_SLOT; volatile LAS int* gctl = ctl + 8 * grp; volatile LAS int* bar = gb2 + 16 * grp; int epoch = 0;
        constexpr int NUNITS = (T / 128) * 8; const int NG = 2 * (int)gridDim.x, gg = 2 * (int)blockIdx.x + grp;
        bf16x8 qf[4]; int idx = gg; int issued = 0; SbUnit u = sb_unit_of(idx); unsigned nxt = 0;
        if (idx < NUNITS) issued = sb_prologue(QSB, KSB, VTSB, u, ring, w4, lane, qf);
        while (idx < NUNITS) {
            if (w4 == 0 && lane == 0) nxt = atomicAdd(qctr, 1u);
            f32x16 o[2];
            sb_body(KSB, VTSB, u, issued, qf, ring, gctl, bar, epoch, w4, lane, o);
            const size_t grow = (size_t)u.b * SEQ + u.q0 + 32 * w4; const int hd = u.hd;
            if (w4 == 0 && lane == 0) gctl[4] = NG + (int)nxt;
            grp_barrier(bar, epoch, lane);
            const int nidx = __builtin_amdgcn_readfirstlane(gctl[4]);
            grp_barrier(bar, epoch, lane);
            if (nidx < NUNITS) { u = sb_unit_of(nidx); issued = sb_prologue(QSB, KSB, VTSB, u, ring, w4, lane, qf); }
            at_store(o, 1.0f, stg, lsb, MIX + grow * 1024 + hd * 64, SSQ + grow * 16 + hd, lane);
            idx = nidx;
        }
    }
}

#define XB_TMO      128
#define XB_XCNT(j)  (256  + 64 * (j))
#define XB_XSUB(j)  (1280 + 64 * (j))
#define XB_XGEN(j)  (2304 + 64 * (j))
#define XB_TOP      3328
#define XB_TOPGEN   3392
#define XCD_BAR_WORDS 3456
#define XB_SPIN_CAP (1u << 18)
DI unsigned xb_ld(unsigned* p)              { return __hip_atomic_load(p, __ATOMIC_RELAXED, __HIP_MEMORY_SCOPE_AGENT); }
DI unsigned xb_add(unsigned* p, unsigned v) { return __hip_atomic_fetch_add(p, v, __ATOMIC_RELAXED, __HIP_MEMORY_SCOPE_AGENT); }
DI unsigned xb_xcc_id() { return (unsigned)__builtin_amdgcn_s_getreg((3 << 11) | 20) & 0xFu; }
#define XB_SPIN(cond, bar) do { unsigned _sp = 0; while (cond) { __builtin_amdgcn_s_sleep(1); \
    if ((++_sp & 255u) == 0u) { if (xb_ld(&(bar)[XB_TMO])) break; if (_sp > XB_SPIN_CAP) { atomicAdd(&(bar)[XB_TMO], 1u); break; } } } } while (0)
struct XcdBarrier { unsigned* bar; unsigned x; volatile LAS unsigned* st; };
DI XcdBarrier xcd_barrier_post(unsigned* bar, volatile LAS unsigned* st) {
    XcdBarrier b; b.bar = bar; b.x = xb_xcc_id(); b.st = st;
    if (threadIdx.x == 0) (void)xb_add(&bar[XB_XCNT(b.x)], 1u);
    return b;
}
DI void xcd_barrier_complete(unsigned* bar, unsigned x, unsigned& nloc, unsigned& nx) {
    const unsigned G = gridDim.x * gridDim.y * gridDim.z;
    unsigned sum, cnt, mine, sp = 0u;
    for (;;) {
        sum = 0u; cnt = 0u; mine = 0u;
#pragma unroll
        for (unsigned j = 0; j < 16; ++j) { const unsigned c = xb_ld(&bar[XB_XCNT(j)]); sum += c; cnt += (c > 0u) ? 1u : 0u; mine = (j == x) ? c : mine; }
        if (sum == G) break;
        __builtin_amdgcn_s_sleep(1);
        if ((++sp & 255u) == 0u) { if (xb_ld(&bar[XB_TMO])) break; if (sp > XB_SPIN_CAP) { atomicAdd(&bar[XB_TMO], 1u); break; } }
    }
    nloc = mine > 0u ? mine : 1u; nx = cnt > 0u ? cnt : 1u;
}
DI void xcd_barrier(const XcdBarrier& b) {
    asm volatile("s_waitcnt vmcnt(0)" ::: "memory");
    __syncthreads();
    if (threadIdx.x == 0) {
        unsigned* bar = b.bar;
        __builtin_amdgcn_s_waitcnt(0);
        unsigned nloc = b.st[0], nx = b.st[1];
        if (nloc == 0u) { xcd_barrier_complete(bar, b.x, nloc, nx); b.st[0] = nloc; b.st[1] = nx; }
        const unsigned old = xb_add(&bar[XB_XSUB(b.x)], 1u);
        const unsigned gen = old / nloc;
        if (old + 1u == (gen + 1u) * nloc) {
            __builtin_amdgcn_fence(__ATOMIC_RELEASE, "agent");
            asm volatile("s_waitcnt vmcnt(0)" ::: "memory");
            const unsigned og = xb_add(&bar[XB_TOP], 1u);
            const unsigned tg = og / nx;
            if (og + 1u == (tg + 1u) * nx) xb_add(&bar[XB_TOPGEN], 1u);
            else XB_SPIN(xb_ld(&bar[XB_TOPGEN]) == tg, bar);
            __builtin_amdgcn_fence(__ATOMIC_ACQUIRE, "agent");
            xb_add(&bar[XB_XGEN(b.x)], 1u);
            asm volatile("s_waitcnt vmcnt(0)" ::: "memory");
        } else {
            XB_SPIN(xb_ld(&bar[XB_XGEN(b.x)]) == gen, bar);
            __builtin_amdgcn_fence(__ATOMIC_ACQUIRE, "agent");
            asm volatile("s_waitcnt vmcnt(0)" ::: "memory");
        }
    }
    __syncthreads();
}

__global__ void __launch_bounds__(NTHREADS, 2) mk_fwd(Args a) {
    extern __shared__ __attribute__((aligned(16))) unsigned char lds_raw[];
    LAS unsigned char* lds = (LAS unsigned char*)lds_raw;
    const int tid = threadIdx.x, lane = tid & 63, wave = __builtin_amdgcn_readfirstlane(tid >> 6);
    volatile LAS unsigned* misc = (volatile LAS unsigned*)(lds + LDS_MISC);
    if (tid < 2) misc[tid] = 0u;
    __syncthreads();
    const XcdBarrier gbar = xcd_barrier_post((unsigned*)(a.ws + WS_CTL) + CW_BAR, misc);
    unsigned char* ws = a.ws;
    const float* mod = (const float*)(ws + WS_MOD);

#define REPS(k) ((PROBE_DUP == (k)) ? 2 : 1)
    int n_stamp = 0;
#define STAMP() do { if (STAMP_PHASE >= 0 && blockIdx.x == 0 && tid == 0) ((unsigned long long*)(ws + WS_STAMP))[n_stamp] = __builtin_amdgcn_s_memrealtime(); ++n_stamp; } while (0)
    STAMP();
    const int p2_units = (T / 256) * (DIN / 256), p2_rem = p2_units % (int)gridDim.x, n_tailw = p2_rem ? ((int)gridDim.x - p2_rem) * NWAVES : 0;
    const int n_tail_items = n_tailw * 4 < NEXPERT_ITEMS ? n_tailw * 4 : NEXPERT_ITEMS, n_p0_items = NEXPERT_ITEMS - n_tail_items;
    for (int rep = 0; rep < REPS(0); ++rep) { p0_prologue(a, lds, tid, lane, wave); expert_items(a, lds, 0, n_p0_items, blockIdx.x * NWAVES + wave, gridDim.x * NWAVES, lane, wave); xcd_barrier(gbar); STAMP(); }
    for (int rep = 0; rep < REPS(1); ++rep) { p1_norm(a, lane, wave); xcd_barrier(gbar); STAMP(); }
    for (int rep = 0; rep < REPS(2); ++rep) {
        DenseSched S{(const bf16_t*)(ws + WS_H), (const bf16_t*)(ws + WS_WIN), 1024, T / 256, DIN / 256};
        EpiProj E{(bf16_t*)(ws + WS_QSB), (bf16_t*)(ws + WS_VSB), (bf16_t*)(ws + WS_QSW), (bf16_t*)(ws + WS_KSW), (bf16_t*)(ws + WS_VSW), (const float*)(ws + WS_COS), (const float*)(ws + WS_SIN)};
        pg8::gemm_phase<DenseSched, EpiProj, true, 1024, 1024, 16>(lds, S, E);
        if (p2_rem && (int)blockIdx.x >= p2_rem && rep == 0) { __syncthreads(); expert_items(a, lds, n_p0_items, n_tail_items, ((int)blockIdx.x - p2_rem) * NWAVES + wave, n_tailw, lane, wave); }
        xcd_barrier(gbar); STAMP();
    }
    if (PROBE_DUP == 31 || PROBE_DUP == 32) { p3_attention(a, lds, tid, lane, wave, 1, PROBE_DUP - 30); xcd_barrier(gbar); }
    for (int rep = 0; rep < REPS(3); ++rep) { p3_attention(a, lds, tid, lane, wave, rep); xcd_barrier(gbar); STAMP(); }
    for (int rep = 0; rep < REPS(4); ++rep) {
        DenseSched S{(const bf16_t*)(ws + WS_MIX), (const bf16_t*)(ws + WS_WOUT), 1024, T / 256, DM / 256};
        EpiWout E{mod, (bf16_t*)(ws + WS_X1), a.x, (const float*)(ws + WS_SSQ), (LAS float*)(lds + pg8::STAGE_BYTES + 1024)};
        pg8::gemm_phase<DenseSched, EpiWout, true, 1024, 1024, 16>(lds, S, E);
        xcd_barrier(gbar); STAMP();
    }
    for (int rep = 0; rep < REPS(5); ++rep) { p5_router(a, lds, tid, lane, wave, rep); xcd_barrier(gbar); STAMP(); }
    LAS int* tstart = (LAS int*)(lds + pg8::STAGE_BYTES);
    const unsigned* cnt = (const unsigned*)(ws + WS_CTL) + CW_CNT;
    if (tid == 0) { int run = 0; for (int b = 0; b < NBUCKET; ++b) { tstart[b] = run; run += ((int)cnt[CNT_STRIDE * b] + 255) >> 8; } tstart[NBUCKET] = run; }
    __syncthreads();
    const bf16_t* H2 = (const bf16_t*)(ws + WS_H); const bf16_t* HIDc = (const bf16_t*)(ws + WS_HID); const int* LISTc = (const int*)(ws + WS_LIST);
    EpiUp EU{(bf16_t*)(ws + WS_HID), (const f32x2*)(ws + WS_WTS), (LAS float*)(lds + pg8::STAGE_BYTES + 1024)}; EpiDown ED{(bf16_t*)(ws + WS_Y)};
    if (gridDim.x == 256) {
        const MoeCut mc = moe_cut(__builtin_amdgcn_readfirstlane(tstart[NBUCKET]));
        { MoeSplitSched<true, 1> S{tstart, cnt, LISTc, H2, (const bf16_t*)(ws + WS_WGU), mc}; pg8::gemm_phase<MoeSplitSched<true, 1>, EpiUp, true, 1024, 1024, 16>(lds, S, EU); }
        xcd_barrier(gbar); STAMP();
        if (((int)blockIdx.x >> 3) < mc.left) { MoeSplitSched<true, 2> S{tstart, cnt, LISTc, H2, (const bf16_t*)(ws + WS_WGU), mc}; pg8::gemm_phase<MoeSplitSched<true, 2>, EpiUp, true, 1024, 1024, 16>(lds, S, EU); }
        else { MoeSplitSched<false, 2> S{tstart, cnt, LISTc, HIDc, (const bf16_t*)(ws + WS_WD), mc}; pg8::gemm_phase<MoeSplitSched<false, 2>, EpiDown, true, 1024, 512, 8>(lds, S, ED); }
        xcd_barrier(gbar); STAMP();
        { MoeSplitSched<false, 3> S{tstart, cnt, LISTc, HIDc, (const bf16_t*)(ws + WS_WD), mc}; pg8::gemm_phase<MoeSplitSched<false, 3>, EpiDown, true, 1024, 512, 8>(lds, S, ED); }
    } else {
        { MoeSched<8, true> S{tstart, cnt, LISTc, H2, (const bf16_t*)(ws + WS_WGU)}; pg8::gemm_phase<MoeSched<8, true>, EpiUp, true, 1024, 1024, 16>(lds, S, EU); }
        xcd_barrier(gbar); STAMP();
        { MoeSched<4, false> S{tstart, cnt, LISTc, HIDc, (const bf16_t*)(ws + WS_WD)}; pg8::gemm_phase<MoeSched<4, false>, EpiDown, true, 1024, 512, 8>(lds, S, ED); }
    }
    if (STAMP_PHASE >= 0) {
        if (blockIdx.x == 0 && tid == 0) { unsigned long long* st = (unsigned long long*)(ws + WS_STAMP); st[n_stamp] = __builtin_amdgcn_s_memrealtime();
            const float t_us = (float)(st[STAMP_PHASE + 1] - st[STAMP_PHASE]) * 0.01f; *(float*)(ws + WS_STAMP + 256) = 1.0f + sqrtf(t_us * STAMP_K); } }
    xcd_barrier(gbar);
    if (PROBE_DUP == 8) { p8_final(a, tstart, lane, wave, (float*)(ws + WS_H)); xcd_barrier(gbar); }
    p8_final(a, tstart, lane, wave, a.out);
}

extern "C" void kernel_launch(void* const* d_in, const int* in_sizes, int n_in, void* d_out, int out_size, void* d_ws, size_t ws_size, hipStream_t stream) {
    static int grid = 0;
    if (grid == 0) {
        if (n_in != 18 || in_sizes[0] != T * DM || out_size != T * DM || ws_size < WS_END) { fprintf(stderr, "kernel_launch: unexpected shapes (n_in %d, in0 %d, out %d, ws %zu); nothing launched\n", n_in, n_in > 0 ? in_sizes[0] : -1, out_size, ws_size); grid = -1; return; }
        int dev = 0, cus = 0, per_cu = 0;
        (void)hipGetDevice(&dev); (void)hipDeviceGetAttribute(&cus, hipDeviceAttributeMultiprocessorCount, dev);
        (void)hipFuncSetAttribute((const void*)mk_fwd, hipFuncAttributeMaxDynamicSharedMemorySize, LDS_BYTES);
        (void)hipOccupancyMaxActiveBlocksPerMultiprocessor(&per_cu, (const void*)mk_fwd, NTHREADS, LDS_BYTES);
        if (per_cu < 1) { fprintf(stderr, "kernel_launch: occupancy query says %d blocks per CU\n", per_cu); per_cu = 1; }
        grid = cus * per_cu;
        fprintf(stderr, "kernel_launch: %d CUs x %d = grid %d\n", cus, per_cu, grid);
    }
    if (grid < 0) return;
    (void)hipMemsetAsync((char*)d_ws + WS_CTL, 0, CTL_BYTES, stream);
    Args a{};
    a.x = (const float*)d_in[0]; a.c = (const float*)d_in[1]; a.pos = (const int*)d_in[2]; a.w_ada = (const float*)d_in[3]; a.b_ada = (const float*)d_in[4]; a.g_mix = (const float*)d_in[5];
    a.w_in = (const float*)d_in[6]; a.sinks = (const float*)d_in[7]; a.g_sb = (const float*)d_in[8]; a.g_sw = (const float*)d_in[9]; a.w_out = (const float*)d_in[10]; a.g_ffn = (const float*)d_in[11];
    a.w_rg = (const float*)d_in[12]; a.w_re = (const float*)d_in[13]; a.w_gate = (const float*)d_in[14]; a.w_up = (const float*)d_in[15]; a.w_down = (const float*)d_in[16]; a.g_fin = (const float*)d_in[17];
    a.out = (float*)d_out; a.ws = (unsigned char*)d_ws;
    void* args[] = {&a};
    hipError_t e = hipLaunchCooperativeKernel((const void*)mk_fwd, dim3(grid), dim3(NTHREADS), args, LDS_BYTES, stream);
    if (e != hipSuccess) fprintf(stderr, "kernel_launch: cooperative launch failed: %s (grid %d)\n", hipGetErrorString(e), grid);
}
```

```cpp
#include <hip/hip_runtime.h>
#include <cstdio>
#include <cstdint>
#include <cmath>

#define LAS __attribute__((address_space(3)))
#define DI __device__ __forceinline__
typedef unsigned short bf16_t;
typedef short bf16x8 __attribute__((ext_vector_type(8)));
typedef float f32x4 __attribute__((ext_vector_type(4)));
typedef float f32x2 __attribute__((ext_vector_type(2)));
typedef unsigned u32x4 __attribute__((ext_vector_type(4)));
typedef unsigned u32x2 __attribute__((ext_vector_type(2)));
typedef __bf16 bf16x2_t __attribute__((ext_vector_type(2)));

constexpr int NB = 4, SEQ = 8192, DM = 1024, T = NB * SEQ;
constexpr int DIN = 2304, DSB = 512, DSW = 512, DKV = 128;
constexpr int NEXP = 16, DEXP = 512, NBUCKET = 24, WINDOW = 128;
constexpr int MAXTILES = T / 256 + NBUCKET, TPAD = MAXTILES * 256;
constexpr float EPS = 1e-6f, LOG2E = 1.4426950408889634f, QSCALE = 0.125f * LOG2E;
constexpr int NTHREADS = 512, NWAVES = 8;
#ifndef STAMP_PHASE
#define STAMP_PHASE (-1)
#endif
#ifndef STAMP_K
#define STAMP_K 1e-5f
#endif
#ifndef PROBE_DUP
#define PROBE_DUP (-1)
#endif

constexpr size_t MiB = 1u << 20;
constexpr size_t WS_CTL = 0, CTL_BYTES = 1 * MiB;
constexpr size_t WS_MOD = 1 * MiB;
constexpr size_t WS_COS = 2 * MiB, WS_SIN = 6 * MiB;
constexpr size_t WS_WIN = 10 * MiB;
constexpr size_t WS_WOUT = 15 * MiB;
constexpr size_t WS_WGU = 17 * MiB;
constexpr size_t WS_WD = 49 * MiB;
constexpr size_t WS_LIST = 65 * MiB;
constexpr size_t WS_WTS = 68 * MiB;
constexpr size_t WS_STAMP = 512 * 1024;
constexpr size_t WS_TPOS = 74 * MiB;
constexpr size_t WS_SSQ = 76 * MiB;
constexpr size_t WS_H = 80 * MiB;
constexpr size_t WS_QSB = 144 * MiB, WS_KSB = 176 * MiB, WS_VSB = 208 * MiB, WS_QSW = 240 * MiB;
constexpr size_t WS_KSW = 272 * MiB, WS_VSW = 280 * MiB;
constexpr size_t WS_MIX = 288 * MiB;
constexpr size_t WS_HID = 352 * MiB;
constexpr size_t WS_END = 428 * MiB;
constexpr size_t WS_XB = WS_HID;
constexpr size_t WS_X1 = WS_QSB;
constexpr size_t WS_Y = WS_VSB;
static_assert(WS_X1 + (size_t)T * 1024 * 2 <= WS_VSB && WS_Y + (size_t)TPAD * 1024 * 2 <= WS_MIX && WS_XB + (size_t)T * 1024 * 2 <= WS_END, "overlays");
static_assert(WS_KSB - WS_QSB == WS_VSB - WS_KSB, "q/k/v_sb buffers equally spaced");
static_assert(WS_HID + (size_t)TPAD * 1024 * 2 <= WS_END, "ws map");
constexpr int CW_CNT = 8192, CNT_STRIDE = 64, CW_ATTNQ = 16384, CW_BAR = 4096;
constexpr int LDS_MISC = 143360;

constexpr int LDS_BYTES = 147456;

struct Args {
    const float* x; const float* c; const int* pos; const float* w_ada; const float* b_ada; const float* g_mix; const float* w_in; const float* sinks;
    const float* g_sb; const float* g_sw; const float* w_out; const float* g_ffn; const float* w_rg; const float* w_re; const float* w_gate; const float* w_up;
    const float* w_down; const float* g_fin; float* out; unsigned char* ws;
};

__constant__ float INV_FREQ[32] = {1.000000000e+00f, 7.498942018e-01f, 5.623413324e-01f, 4.216965139e-01f, 3.162277639e-01f, 2.371373773e-01f, 1.778279394e-01f, 1.333521456e-01f, 1.000000015e-01f, 7.498942316e-02f, 5.623413250e-02f, 4.216964915e-02f, 3.162277490e-02f, 2.371373773e-02f, 1.778279431e-02f, 1.333521400e-02f, 9.999999776e-03f, 7.498942316e-03f, 5.623413250e-03f, 4.216964822e-03f, 3.162277630e-03f, 2.371373819e-03f, 1.778279431e-03f, 1.333521446e-03f, 1.000000047e-03f, 7.498941850e-04f, 5.623413017e-04f, 4.216965172e-04f, 3.162277571e-04f, 2.371373703e-04f, 1.778279402e-04f, 1.333521504e-04f};

DI unsigned f2bf(float f) { unsigned u = __builtin_bit_cast(unsigned, f); return (u + 0x7fffu + ((u >> 16) & 1u)) >> 16; }
DI unsigned pk2(float lo, float hi) { f32x2 v = {lo, hi}; bf16x2_t b = __builtin_convertvector(v, bf16x2_t); return __builtin_bit_cast(unsigned, b); }
DI float bf2f(unsigned short b) { return __builtin_bit_cast(float, (unsigned)b << 16); }
DI float bflo(unsigned w) { return __builtin_bit_cast(float, w << 16); }
DI float bfhi(unsigned w) { return __builtin_bit_cast(float, w & 0xffff0000u); }
DI float wave_sum(float v) {
#pragma unroll
    for (int o = 1; o < 64; o <<= 1) v += __shfl_xor(v, o);
    return v;
}
#define DPP_ADD(v, ctrl) ((v) + __builtin_bit_cast(float, __builtin_amdgcn_update_dpp(0, __builtin_bit_cast(int, (v)), (ctrl), 0xF, 0xF, true)))
DI void swap32(unsigned& a, unsigned& b) { asm volatile("s_nop 1\n\tv_permlane32_swap_b32 %0, %1" : "+v"(a), "+v"(b)); }
DI void swap16(unsigned& a, unsigned& b) { asm volatile("s_nop 1\n\tv_permlane16_swap_b32 %0, %1" : "+v"(a), "+v"(b)); }
DI float half_sum_fast(float v) { v = DPP_ADD(v, 0xB1); v = DPP_ADD(v, 0x4E); v = DPP_ADD(v, 0x141); v = DPP_ADD(v, 0x140);
    unsigned a = __builtin_bit_cast(unsigned, v), b = a; swap16(a, b); return __builtin_bit_cast(float, a) + __builtin_bit_cast(float, b); }
DI float wave_sum_fast(float v) { v = DPP_ADD(v, 0xB1); v = DPP_ADD(v, 0x4E); v = DPP_ADD(v, 0x141); v = DPP_ADD(v, 0x140);
    unsigned a = __builtin_bit_cast(unsigned, v), b = a; swap16(a, b); v = __builtin_bit_cast(float, a) + __builtin_bit_cast(float, b);
    a = __builtin_bit_cast(unsigned, v); b = a; swap32(a, b); return __builtin_bit_cast(float, a) + __builtin_bit_cast(float, b); }
#define LDS_WAIT() asm volatile("s_waitcnt lgkmcnt(0)" ::: "memory")
DI f32x4 ldnt4(const float* p) { return __builtin_nontemporal_load((const f32x4*)p); }

DI void tr_item64(const float* W, int N, int k0, int n0, bf16_t* WT, int drow0a, int drow0b, int Kd, const float* kscale, LAS float* scr, int lane) {
    f32x4 v[16]; const int kr = lane >> 4, c4 = 4 * (lane & 15);
#pragma unroll
    for (int i = 0; i < 16; ++i) v[i] = ldnt4(W + (size_t)(k0 + 4 * i + kr) * N + n0 + c4);
#pragma unroll
    for (int i = 0; i < 16; ++i) { const int kk = 4 * i + kr; f32x4 x = v[i]; if (kscale) x = x * kscale[k0 + kk]; LAS float* d = scr + kk * 65 + c4; d[0] = x.x; d[1] = x.y; d[2] = x.z; d[3] = x.w; }
    LDS_WAIT();
    const int c = lane & 7;
#pragma unroll
    for (int j = 0; j < 8; ++j) { const int n = (lane >> 3) + 8 * j; const LAS float* q = scr + (8 * c) * 65 + n;
        u32x4 o; o.x = pk2(q[0 * 65], q[1 * 65]); o.y = pk2(q[2 * 65], q[3 * 65]); o.z = pk2(q[4 * 65], q[5 * 65]); o.w = pk2(q[6 * 65], q[7 * 65]);
        const int dr = n < 32 ? drow0a + n : drow0b + (n - 32);
        *(u32x4*)(WT + (size_t)dr * Kd + k0 + 8 * c) = o; }
    LDS_WAIT();
}
DI int win_drow(int n0) {
    if (n0 < 1536) return n0;
    if (n0 < 2048) { const int c = n0 - 1536, head = c >> 6, half = (c >> 5) & 1; return 1536 + (head >> 2) * 256 + half * 128 + (head & 3) * 32; }
    if (n0 < 2176) { const int c = n0 - 2048, head = c >> 6, half = (c >> 5) & 1; return 2048 + half * 128 + head * 32; }
    const int c = n0 - 2176; return 2048 + (c >> 6) * 128 + 64 + (c & 63);
}
DI void p0_prologue(const Args& a, LAS unsigned char* lds, int tid, int lane, int wave) {
    unsigned char* ws = a.ws;
    {
        float* mod = (float*)(ws + WS_MOD); LAS float* red = (LAS float*)lds; LAS float* sc = (LAS float*)(lds + 32768);
        if ((int)blockIdx.x < 6144 / 64) { for (int i = tid; i < 4096; i += NTHREADS) { const float cv = a.c[i]; sc[i] = cv / (1.f + expf(-cv)); } __syncthreads(); }
        for (int cb = blockIdx.x; cb < 6144 / 64; cb += gridDim.x) {
            const int cl = tid & 15, kg = tid >> 4, col = cb * 64 + 4 * cl;
            f32x4 acc[4];
#pragma unroll
            for (int q = 0; q < 4; ++q) acc[q] = (f32x4){0.f, 0.f, 0.f, 0.f};
#pragma unroll 16
            for (int kk = 0; kk < 32; ++kk) { const int k = kg * 32 + kk; const f32x4 w = ldnt4(a.w_ada + (size_t)k * 6144 + col);
#pragma unroll
                for (int q = 0; q < 4; ++q) acc[q] = acc[q] + w * sc[q * 1024 + k]; }
#pragma unroll
            for (int q = 0; q < 4; ++q) *(LAS f32x4*)(red + (kg * 4 + q) * 64 + 4 * cl) = acc[q];
            __syncthreads();
            if (tid < 256) { const int q = tid >> 6, c2 = tid & 63; float sum = 0.f; for (int g = 0; g < 32; ++g) sum += red[(g * 4 + q) * 64 + c2]; mod[q * 6144 + cb * 64 + c2] = sum + a.b_ada[cb * 64 + c2]; }
            __syncthreads();
        }
    }
    {
        float* cosT = (float*)(ws + WS_COS); float* sinT = (float*)(ws + WS_SIN);
        for (int idx = blockIdx.x * NTHREADS + tid; idx < T * 32; idx += gridDim.x * NTHREADS) {
            const int t = idx >> 5, i = idx & 31; const float ang = (float)a.pos[t] * INV_FREQ[i];
            const double ad = (double)ang, kq = rint(ad * 0.63661977236758134308);
            double y = fma(-kq, 1.5707963267948966192, ad); y = fma(-kq, 6.123233995736766036e-17, y);
            const int q = (int)((long long)kq & 3); const double y2 = y * y;
            const double sn = y * (1.0 + y2 * (-1.0 / 6 + y2 * (1.0 / 120 + y2 * (-1.0 / 5040 + y2 * (1.0 / 362880 + y2 * (-1.0 / 39916800))))));
            const double cs = 1.0 + y2 * (-0.5 + y2 * (1.0 / 24 + y2 * (-1.0 / 720 + y2 * (1.0 / 40320 + y2 * (-1.0 / 3628800 + y2 * (1.0 / 479001600))))));
            double co, si; if (q == 0) { co = cs; si = sn; } else if (q == 1) { co = -sn; si = cs; } else if (q == 2) { co = -cs; si = -sn; } else { co = sn; si = -cs; }
            cosT[idx] = (float)co; sinT[idx] = (float)si;
        }
    }
    {
        __syncthreads();
        LAS float* scr = (LAS float*)(lds + 8192 + wave * 16640);
        const int gw = blockIdx.x * NWAVES + wave, NGW = gridDim.x * NWAVES;
        constexpr int I_IN = 16 * 36, I_OUT = 16 * 16, NITEMS = I_IN + I_OUT;
        for (int it = gw; it < NITEMS; it += NGW) {
            int r = it;
            if (r < I_IN) { const int kb = r / 36, nb = r % 36; tr_item64(a.w_in, DIN, kb * 64, nb * 64, (bf16_t*)(ws + WS_WIN), win_drow(nb * 64), win_drow(nb * 64 + 32), 1024, nullptr, scr, lane); continue; } r -= I_IN;
            { const int kb = r / 16, nb = r % 16; const float* ks = (kb < 8) ? a.g_sb : (a.g_sw - 512); tr_item64(a.w_out, 1024, kb * 64, nb * 64, (bf16_t*)(ws + WS_WOUT), nb * 64, nb * 64 + 32, 1024, ks, scr, lane); }
        }
    }
}
constexpr int NEXPERT_ITEMS = 2 * (16 * 16 * 8) + 16 * 8 * 16;
DI void expert_items(const Args& a, LAS unsigned char* lds, int first, int count, int w, int nw, int lane, int wave) {
    asm volatile("" : "+v"(lane));
    unsigned char* ws = a.ws;
    LAS float* scr = (LAS float*)(lds + 8192 + wave * 16640);
    constexpr int I_G = 16 * 16 * 8;
    for (int it = first + w; it < first + count; it += nw) {
        int r = it;
        if (r < 2 * I_G) { const int up = r >= I_G; if (up) r -= I_G; const int e = r / 128, q = r % 128, kb = q / 8, nb = q % 8, c0 = nb * 64; const int dr = (c0 >> 7) * 256 + up * 128 + (c0 & 127);
            tr_item64((up ? a.w_up : a.w_gate) + (size_t)e * 1024 * 512, 512, kb * 64, c0, (bf16_t*)(ws + WS_WGU) + (size_t)e * 1024 * 1024, dr, dr + 32, 1024, nullptr, scr, lane); continue; } r -= 2 * I_G;
        { const int e = r / 128, q = r % 128, kb = q / 16, nb = q % 16; tr_item64(a.w_down + (size_t)e * 512 * 1024, 1024, kb * 64, nb * 64, (bf16_t*)(ws + WS_WD) + (size_t)e * 1024 * 512, nb * 64, nb * 64 + 32, 512, nullptr, scr, lane); }
    }
}

DI void p1_norm(const Args& a, int lane, int wave) {
    asm volatile("" : "+v"(lane));
    const float* mod = (const float*)(a.ws + WS_MOD); bf16_t* H = (bf16_t*)(a.ws + WS_H);
    const int gw = blockIdx.x * NWAVES + wave, NGW = gridDim.x * NWAVES;
    int bprev = -1; f32x4 ca[4], cb[4];
#pragma unroll 1
    for (int q4 = gw; q4 < T / 4; q4 += NGW) {
        const int r0 = q4 * 4, b = r0 / SEQ;
        if (b != bprev) { bprev = b;
#pragma unroll
            for (int j = 0; j < 4; ++j) { const int col = 4 * lane + 256 * j; const f32x4 g = *(const f32x4*)(a.g_mix + col), sc = *(const f32x4*)(mod + b * 6144 + 1024 + col); ca[j] = g * (sc + 1.0f); cb[j] = *(const f32x4*)(mod + b * 6144 + col); } }
        f32x4 v[4][4];
#pragma unroll
        for (int rr = 0; rr < 4; ++rr)
#pragma unroll
            for (int j = 0; j < 4; ++j) v[rr][j] = ldnt4(a.x + (size_t)(r0 + rr) * DM + 4 * lane + 256 * j);
#pragma unroll
        for (int rr = 0; rr < 4; ++rr) { float s = 0.f;
#pragma unroll
            for (int j = 0; j < 4; ++j) s += (v[rr][j].x * v[rr][j].x + v[rr][j].y * v[rr][j].y) + (v[rr][j].z * v[rr][j].z + v[rr][j].w * v[rr][j].w);
            const float rs = 1.0f / sqrtf(wave_sum_fast(s) * (1.0f / DM) + EPS);
            bf16_t* hr = H + (size_t)(r0 + rr) * DM;
#pragma unroll
            for (int j = 0; j < 4; ++j) { const f32x4 o = v[rr][j] * rs * ca[j] + cb[j]; u32x2 w; w.x = pk2(o.x, o.y); w.y = pk2(o.z, o.w); *(u32x2*)(hr + 4 * lane + 256 * j) = w; } }
    }
}
DI void p8_final(const Args& a, const LAS int* tstart, int lane, int wave, float* dst) {
    asm volatile("" : "+v"(lane));
    const float tscale = (STAMP_PHASE >= 0) ? *(const float*)(a.ws + WS_STAMP + 256) : 1.0f;
    const float* mod = (const float*)(a.ws + WS_MOD); const bf16_t* X1 = (const bf16_t*)(a.ws + WS_X1); const bf16_t* Y = (const bf16_t*)(a.ws + WS_Y); const int* tpos = (const int*)(a.ws + WS_TPOS);
    const int gw = blockIdx.x * NWAVES + wave, NGW = gridDim.x * NWAVES;
    for (int ch = gw; ch < T / 16; ch += NGW) {
        const int row0 = ch * 16, b = row0 / SEQ;
        f32x4 g[4], g2[4];
#pragma unroll
        for (int j = 0; j < 4; ++j) { g[j] = *(const f32x4*)(a.g_fin + 4 * lane + 256 * j); g2[j] = *(const f32x4*)(mod + b * 6144 + 5120 + 4 * lane + 256 * j); }
        const int tp = tpos[row0 + (lane & 15)];
        u32x2 xn[2][4], yn[2][4];
#pragma unroll
        for (int rr = 0; rr < 2; ++rr) { const int tpr = __builtin_amdgcn_readlane(tp, rr); const size_t srow = (size_t)tstart[tpr >> 16] * 256 + (tpr & 0xffff);
#pragma unroll
            for (int j = 0; j < 4; ++j) { xn[rr][j] = *(const u32x2*)(X1 + (size_t)(row0 + rr) * DM + 4 * lane + 256 * j); yn[rr][j] = *(const u32x2*)(Y + srow * DM + 4 * lane + 256 * j); } }
#pragma unroll 1
        for (int r2 = 0; r2 < 16; r2 += 2) {
            f32x4 v[2][4]; u32x2 xw[2][4], yw[2][4];
#pragma unroll
            for (int rr = 0; rr < 2; ++rr)
#pragma unroll
                for (int j = 0; j < 4; ++j) { xw[rr][j] = xn[rr][j]; yw[rr][j] = yn[rr][j]; }
            if (r2 + 2 < 16) {
#pragma unroll
                for (int rr = 0; rr < 2; ++rr) { const int tpr = __builtin_amdgcn_readlane(tp, r2 + 2 + rr); const size_t srow = (size_t)tstart[tpr >> 16] * 256 + (tpr & 0xffff);
#pragma unroll
                    for (int j = 0; j < 4; ++j) { xn[rr][j] = *(const u32x2*)(X1 + (size_t)(row0 + r2 + 2 + rr) * DM + 4 * lane + 256 * j); yn[rr][j] = *(const u32x2*)(Y + srow * DM + 4 * lane + 256 * j); } } }
#pragma unroll
            for (int rr = 0; rr < 2; ++rr) { float s = 0.f;
#pragma unroll
                for (int j = 0; j < 4; ++j) { v[rr][j] = (f32x4){bflo(xw[rr][j].x), bfhi(xw[rr][j].x), bflo(xw[rr][j].y), bfhi(xw[rr][j].y)} + g2[j] * (f32x4){bflo(yw[rr][j].x), bfhi(yw[rr][j].x), bflo(yw[rr][j].y), bfhi(yw[rr][j].y)};
                    s += (v[rr][j].x * v[rr][j].x + v[rr][j].y * v[rr][j].y) + (v[rr][j].z * v[rr][j].z + v[rr][j].w * v[rr][j].w); }
                const float rs = 1.0f / sqrtf(wave_sum_fast(s) * (1.0f / DM) + EPS); float* orow = dst + (size_t)(row0 + r2 + rr) * DM;
#pragma unroll
                for (int j = 0; j < 4; ++j) *(f32x4*)(orow + 4 * lane + 256 * j) = v[rr][j] * (rs * tscale) * g[j]; }
        }
    }
}
constexpr int RT_LDS_BYTES = 1024 * 20 * 4;
DI void p5_router(const Args& a, LAS unsigned char* lds, int tid, int lane, int wave, int rep = 0) {
    const float* mod = (const float*)(a.ws + WS_MOD); bf16_t* H = (bf16_t*)(a.ws + WS_H);
    unsigned* cnt = (unsigned*)(a.ws + WS_CTL) + CW_CNT + 2048 * rep; int* list = (int*)(a.ws + WS_LIST); f32x2* wts = (f32x2*)(a.ws + WS_WTS);
    int* tpos = (int*)(a.ws + WS_TPOS); const bf16_t* X1 = (const bf16_t*)(a.ws + WS_X1);
    LAS f32x4* WL = (LAS f32x4*)lds;
    for (int idx = tid; idx < 1024 * 5; idx += NTHREADS) { const int k = idx / 5, q = idx % 5; const f32x4 w = (q == 0) ? *(const f32x4*)(a.w_rg + 4 * k) : *(const f32x4*)(a.w_re + 16 * k + 4 * (q - 1));
        WL[(((k >> 8) * 4 + (k & 3)) * 5 + q) * 64 + ((k & 255) >> 2)] = w; }
    __syncthreads();
    LAS int* wcnt = (LAS int*)(lds + RT_LDS_BYTES);
    for (int it = blockIdx.x; it < T / 128; it += gridDim.x) {
        const int row0 = it * 128 + wave * 16, b = row0 / SEQ;
        f32x4 ca[4], cb[4];
#pragma unroll
        for (int j = 0; j < 4; ++j) { const int col = 4 * lane + 256 * j; const f32x4 g = *(const f32x4*)(a.g_ffn + col), sc = *(const f32x4*)(mod + b * 6144 + 4096 + col); ca[j] = g * (sc + 1.0f); cb[j] = *(const f32x4*)(mod + b * 6144 + 3072 + col); }
        int mybucket = 0; float mywa = 0.f, mywb = 0.f;
        u32x2 xn[2][4];
#pragma unroll
        for (int rr = 0; rr < 2; ++rr)
#pragma unroll
            for (int j = 0; j < 4; ++j) xn[rr][j] = *(const u32x2*)(X1 + (size_t)(row0 + rr) * DM + 4 * lane + 256 * j);
#pragma unroll 1
        for (int r4 = 0; r4 < 16; r4 += 2) {
            f32x4 v[2][4];
#pragma unroll
            for (int rr = 0; rr < 2; ++rr)
#pragma unroll
                for (int j = 0; j < 4; ++j) { const u32x2 xw = xn[rr][j]; v[rr][j] = (f32x4){bflo(xw.x), bfhi(xw.x), bflo(xw.y), bfhi(xw.y)}; }
            if (r4 + 2 < 16) {
#pragma unroll
                for (int rr = 0; rr < 2; ++rr)
#pragma unroll
                    for (int j = 0; j < 4; ++j) xn[rr][j] = *(const u32x2*)(X1 + (size_t)(row0 + r4 + 2 + rr) * DM + 4 * lane + 256 * j); }
#pragma unroll
            for (int rr = 0; rr < 2; ++rr) { float s = 0.f;
#pragma unroll
                for (int j = 0; j < 4; ++j) s += (v[rr][j].x * v[rr][j].x + v[rr][j].y * v[rr][j].y) + (v[rr][j].z * v[rr][j].z + v[rr][j].w * v[rr][j].w);
                const float rs = 1.0f / sqrtf(wave_sum_fast(s) * (1.0f / DM) + EPS);
                bf16_t* hr = H + (size_t)(row0 + r4 + rr) * DM;
#pragma unroll
                for (int j = 0; j < 4; ++j) { v[rr][j] = v[rr][j] * rs * ca[j] + cb[j]; u32x2 w; w.x = pk2(v[rr][j].x, v[rr][j].y); w.y = pk2(v[rr][j].z, v[rr][j].w); *(u32x2*)(hr + 4 * lane + 256 * j) = w; } }
            int wl_off = lane * 16; asm volatile("" : "+v"(wl_off));
            const LAS f32x4* WLp = (const LAS f32x4*)(lds + wl_off);
            f32x2 lg2[4];
#pragma unroll
            for (int i = 0; i < 4; ++i) lg2[i] = (f32x2){0.f, 0.f};
#pragma unroll
            for (int j = 0; j < 4; ++j)
#pragma unroll
                for (int e = 0; e < 4; ++e) { const f32x2 hv = (f32x2){v[0][j][e], v[1][j][e]}; const f32x4 w = WLp[((j * 4 + e) * 5) * 64];
                    lg2[0] += hv * w.x; lg2[1] += hv * w.y; lg2[2] += hv * w.z; lg2[3] += hv * w.w; }
            float lg[4];
#pragma unroll
            for (int i = 0; i < 4; ++i) { float x0 = lg2[i].x * 1.0f, y0 = lg2[i].y * 1.0f; asm volatile("" : "+v"(x0), "+v"(y0)); unsigned ux = __builtin_bit_cast(unsigned, x0), uy = __builtin_bit_cast(unsigned, y0); swap32(ux, uy);
                lg[i] = half_sum_fast(__builtin_bit_cast(float, ux) + __builtin_bit_cast(float, uy)); }
            int g = 0; float gm = lg[0];
#pragma unroll
            for (int i = 1; i < 4; ++i) if (lg[i] > gm) { gm = lg[i]; g = i; }
            float gs = 0.f;
#pragma unroll
            for (int i = 0; i < 4; ++i) gs += expf(lg[i] - gm);
            const float gprob = 1.0f / gs;
            const int g0 = __builtin_amdgcn_readlane(g, 0), g1 = __builtin_amdgcn_readlane(g, 32);
            f32x4 ea0 = (f32x4){0.f, 0.f, 0.f, 0.f}, ea1 = ea0;
#pragma unroll
            for (int j = 0; j < 4; ++j)
#pragma unroll
                for (int e = 0; e < 4; ++e) { ea0 = ea0 + WLp[((j * 4 + e) * 5 + 1 + g0) * 64] * v[0][j][e]; ea1 = ea1 + WLp[((j * 4 + e) * 5 + 1 + g1) * 64] * v[1][j][e]; }
            float el[4];
#pragma unroll
            for (int i = 0; i < 4; ++i) { float x0 = ea0[i], y0 = ea1[i]; asm volatile("" : "+v"(x0), "+v"(y0)); unsigned ux = __builtin_bit_cast(unsigned, x0), uy = __builtin_bit_cast(unsigned, y0); swap32(ux, uy);
                el[i] = half_sum_fast(__builtin_bit_cast(float, ux) + __builtin_bit_cast(float, uy)); }
            int i0 = 0; float m0 = el[0];
#pragma unroll
            for (int i = 1; i < 4; ++i) if (el[i] > m0) { m0 = el[i]; i0 = i; }
            int i1 = -1; float m1 = 0.f;
#pragma unroll
            for (int i = 0; i < 4; ++i) if (i != i0 && (i1 < 0 || el[i] > m1)) { m1 = el[i]; i1 = i; }
            const float ex = expf(m1 - m0), w0 = 1.0f / (1.0f + ex), w1 = ex * w0;
            const int ea = i0 < i1 ? i0 : i1, eb = i0 < i1 ? i1 : i0; const float wa = (i0 < i1 ? w0 : w1) * gprob, wb = (i0 < i1 ? w1 : w0) * gprob;
            const int bucket = g * 6 + (ea * (7 - ea)) / 2 + (eb - ea - 1);
            const int bk0 = __builtin_amdgcn_readlane(bucket, 0), bk1 = __builtin_amdgcn_readlane(bucket, 32);
            const float wa0 = __builtin_bit_cast(float, __builtin_amdgcn_readlane(__builtin_bit_cast(int, wa), 0)), wa1 = __builtin_bit_cast(float, __builtin_amdgcn_readlane(__builtin_bit_cast(int, wa), 32));
            const float wb0 = __builtin_bit_cast(float, __builtin_amdgcn_readlane(__builtin_bit_cast(int, wb), 0)), wb1 = __builtin_bit_cast(float, __builtin_amdgcn_readlane(__builtin_bit_cast(int, wb), 32));
            if (lane == r4) { mybucket = bk0; mywa = wa0; mywb = wb0; }
            if (lane == r4 + 1) { mybucket = bk1; mywa = wa1; mywb = wb1; }
        }
        if (lane >= 16) mybucket = -1;
        int myrank = 0;
        for (int q = 0; q < NBUCKET; ++q) { const unsigned long long mk = __ballot(mybucket == q); if (mybucket == q) myrank = __popcll(mk & ((1ull << lane) - 1ull)); if (lane == 0) wcnt[wave * NBUCKET + q] = __popcll(mk); }
        __syncthreads();
        if (tid < NBUCKET) { int tot = 0, pre[NWAVES];
#pragma unroll
            for (int w = 0; w < NWAVES; ++w) { pre[w] = tot; tot += wcnt[w * NBUCKET + tid]; }
            const unsigned base = tot ? atomicAdd(cnt + CNT_STRIDE * tid, (unsigned)tot) : 0u;
#pragma unroll
            for (int w = 0; w < NWAVES; ++w) wcnt[w * NBUCKET + tid] = (int)base + pre[w]; }
        __syncthreads();
        if (lane < 16) { const int p = wcnt[wave * NBUCKET + mybucket] + myrank; list[mybucket * T + p] = row0 + lane; wts[mybucket * T + p] = (f32x2){mywa, mywb}; tpos[row0 + lane] = (mybucket << 16) | p; }
        __syncthreads();
    }
}

struct GUnit { const bf16_t* A; const int* aidx; int nvalid; const bf16_t* B0; const bf16_t* B1; int pm, pn, lbase; };
namespace pg8 {
constexpr int BM = 256, BK = 64, HALF = 128, HTB = HALF * BK * 2, STAGE_BYTES = 8 * HTB;
DI int lds_byte(int r, int c) { const int st = (r >> 4) * 2 + (c >> 5), rr = r & 15, cc = c & 31, ob = rr * 64 + cc * 2; return st * 1024 + (ob ^ (((ob >> 9) & 1) << 5)); }
DI void stage_rc(int b, int& R, int& C) { const int st = b / 1024, sb = b % 1024, swz = sb ^ (((sb >> 9) & 1) << 5); R = (st >> 1) * 16 + swz / 64; C = (st & 1) * 32 + (swz % 64) / 2; }
DI int perm32(int rho) { const int n = rho >> 4, i = rho & 15; return 8 * (i >> 2) + 4 * n + (i & 3); }
DI void a_offsets(const GUnit& u, int K, int tid_, unsigned (&vo)[2][2]) {
    asm volatile("" : "+v"(tid_));
#pragma unroll
    for (int i = 0; i < 2; ++i) { int R, C; stage_rc(tid_ * 16 + i * 8192, R, C);
#pragma unroll
        for (int h = 0; h < 2; ++h) { const int r = h * HALF + R; const int gr = u.aidx ? u.aidx[r < u.nvalid ? r : 0] : r; vo[h][i] = ((unsigned)gr * (unsigned)K + (unsigned)C) * 2u; } }
}
template <class Sched, class Epi, bool ALIGN_EPI, int K, int ldb, int nsplit>
DI void gemm_phase(LAS unsigned char* lds, const Sched& S, const Epi& E) {
    int tid = threadIdx.x; asm volatile("" : "+v"(tid));
    const int wid = __builtin_amdgcn_readfirstlane(tid >> 6), lane = tid & 63, wr = wid >> 2, wc = wid & 3, fr = lane & 15, fq = lane >> 4;
    const int nt = K / BK;
    unsigned voffB[2];
#pragma unroll
    for (int i = 0; i < 2; ++i) { int R, C; stage_rc(tid * 16 + i * 8192, R, C); const int Rb = (R & ~31) + perm32(R & 31); voffB[i] = ((unsigned)Rb * (unsigned)ldb + (unsigned)C) * 2u; }
    const size_t hB = (size_t)HALF * ldb * 2;
    const unsigned ldsw = (unsigned)wid * 1024u;
    const int aoff = lds_byte(wr * 64 + fr, fq * 8), boff = lds_byte(wc * 32 + fr, fq * 8);
#define PG8_SA(b, h) (((b) * 2 + (h)) * HTB)
#define PG8_SB(b, h) ((4 + (b) * 2 + (h)) * HTB)
#define PG8_STAGE(bufoff, gbase, voff) do { _Pragma("unroll") for (int _i = 0; _i < 2; ++_i) \
        __builtin_amdgcn_global_load_lds((const unsigned*)((const char*)(gbase) + (voff)[_i]), (LAS unsigned*)(lds + (bufoff) + ldsw + _i * 8192), 16, 0, 0); } while (0)
#define PG8_LDA(dst, b, h) do { _Pragma("unroll") for (int m = 0; m < 4; ++m) _Pragma("unroll") for (int k = 0; k < 2; ++k) dst[m][k] = *(const LAS bf16x8*)(lds + PG8_SA(b, h) + aoff + m * 2048 + k * 1024); } while (0)
#define PG8_LDB(dst, b, h) do { _Pragma("unroll") for (int n = 0; n < 2; ++n) _Pragma("unroll") for (int k = 0; k < 2; ++k) dst[n][k] = *(const LAS bf16x8*)(lds + PG8_SB(b, h) + boff + n * 2048 + k * 1024); } while (0)
#define PG8_MMA(ai, bj, At, Bt) do { __builtin_amdgcn_s_setprio(1); _Pragma("unroll") for (int m = 0; m < 4; ++m) _Pragma("unroll") for (int n = 0; n < 2; ++n) _Pragma("unroll") for (int k = 0; k < 2; ++k) \
        acc[ai][bj][m][n] = __builtin_amdgcn_mfma_f32_16x16x32_bf16(Bt[n][k], At[m][k], acc[ai][bj][m][n], 0, 0, 0); __builtin_amdgcn_s_setprio(0); } while (0)
#define PG8_WAIT_V(n) asm volatile("s_waitcnt vmcnt(" #n ")" ::: "memory")
#define PG8_WAIT_L(n) asm volatile("s_waitcnt lgkmcnt(" #n ")" ::: "memory")
#define PG8_BAR __builtin_amdgcn_s_barrier()
#define PG8_SCHED __builtin_amdgcn_sched_barrier(0)
#define PG8_AK(u, kt) ((const char*)(u).A + (size_t)(kt) * (BK * 2))
#define PG8_BK(u, kt) ((kt) < nsplit ? (const char*)(u).B0 + (size_t)(kt) * (BK * 2) : (const char*)(u).B1 + (size_t)((kt) - nsplit) * (BK * 2))
    GUnit cur, nxt; int ui = 0;
    if (!S.next(0, cur)) return;
    f32x4 acc[2][2][4][2];
#pragma unroll
    for (int a = 0; a < 2; ++a)
#pragma unroll
        for (int b = 0; b < 2; ++b)
#pragma unroll
            for (int m = 0; m < 4; ++m)
#pragma unroll
                for (int n = 0; n < 2; ++n) acc[a][b][m][n] = (f32x4){0.f, 0.f, 0.f, 0.f};
    bf16x8 At[4][2], B0[2][2], B1[2][2];
    unsigned voffA[2][2];
    a_offsets(cur, K, tid, voffA);
    if constexpr (Epi::MIDK) E.prep(cur, 0, tid);
    {
        const char* a0 = PG8_AK(cur, 0); const char* b0 = PG8_BK(cur, 0); const char* a1 = PG8_AK(cur, 1); const char* b1 = PG8_BK(cur, 1);
        PG8_STAGE(PG8_SB(0, 0), b0, voffB); PG8_STAGE(PG8_SB(0, 1), b0 + hB, voffB); PG8_STAGE(PG8_SA(0, 0), a0, voffA[0]); PG8_STAGE(PG8_SA(0, 1), a0, voffA[1]);
        if (wr == 1) PG8_BAR;
        PG8_WAIT_V(2); PG8_BAR;
        PG8_STAGE(PG8_SB(1, 0), b1, voffB); PG8_STAGE(PG8_SA(1, 0), a1, voffA[0]); PG8_STAGE(PG8_SB(1, 1), b1 + hB, voffB);
        PG8_WAIT_V(6); PG8_BAR;
    }
    for (;;) {
        const bool has_next = S.next(ui + 1, nxt);
        if (!has_next) nxt = cur;
        for (int t = 0; t < nt; t += 2) {
            if constexpr (Epi::MIDK) { if (t == nt / 2) E.midk(acc, cur, wr, wc, fr, fq, ui & 1); }
            const bool last = (t == nt - 2);
            const char* a1 = PG8_AK(cur, t + 1);
            const char* a2 = last ? PG8_AK(nxt, 0) : PG8_AK(cur, t + 2); const char* b2 = last ? PG8_BK(nxt, 0) : PG8_BK(cur, t + 2);
            const char* a3 = last ? PG8_AK(nxt, 1) : PG8_AK(cur, t + 3); const char* b3 = last ? PG8_BK(nxt, 1) : PG8_BK(cur, t + 3);
            PG8_LDB(B0, 0, 0); PG8_LDB(B1, 0, 1); PG8_SCHED; PG8_LDA(At, 0, 0); PG8_STAGE(PG8_SA(1, 1), a1, voffA[1]);
            if (last) a_offsets(nxt, K, tid, voffA);
            PG8_WAIT_V(8); PG8_WAIT_L(0); PG8_BAR; PG8_MMA(0, 0, At, B0); PG8_MMA(0, 1, At, B1); PG8_BAR; PG8_SCHED;
            PG8_LDA(At, 0, 1); PG8_STAGE(PG8_SB(0, 0), b2, voffB); PG8_STAGE(PG8_SB(0, 1), b2 + hB, voffB); PG8_STAGE(PG8_SA(0, 0), a2, voffA[0]);
            PG8_WAIT_V(8); PG8_WAIT_L(0); PG8_BAR; PG8_MMA(1, 0, At, B0); PG8_MMA(1, 1, At, B1); PG8_BAR; PG8_SCHED;
            PG8_LDB(B0, 1, 0); PG8_LDB(B1, 1, 1); PG8_SCHED; PG8_LDA(At, 1, 0); PG8_STAGE(PG8_SA(0, 1), a2, voffA[1]);
            PG8_WAIT_V(8); PG8_WAIT_L(0); PG8_BAR; PG8_MMA(0, 0, At, B0); PG8_MMA(0, 1, At, B1); PG8_BAR; PG8_SCHED;
            PG8_LDA(At, 1, 1); PG8_STAGE(PG8_SB(1, 0), b3, voffB); PG8_STAGE(PG8_SB(1, 1), b3 + hB, voffB); PG8_STAGE(PG8_SA(1, 0), a3, voffA[0]);
            PG8_WAIT_V(8); PG8_WAIT_L(0); PG8_BAR; PG8_MMA(1, 0, At, B0); PG8_MMA(1, 1, At, B1); PG8_BAR; PG8_SCHED;
        }
        if constexpr (ALIGN_EPI) { if (wr == 0) PG8_BAR; }
        E(acc, cur, wr, wc, fr, fq, ui & 1);
        if (!has_next) break;
        if constexpr (Epi::MIDK) E.prep(nxt, (ui + 1) & 1, tid);
#pragma unroll
        for (int a = 0; a < 2; ++a)
#pragma unroll
            for (int b = 0; b < 2; ++b)
#pragma unroll
                for (int m = 0; m < 4; ++m)
#pragma unroll
                    for (int n = 0; n < 2; ++n) acc[a][b][m][n] = (f32x4){0.f, 0.f, 0.f, 0.f};
        cur = nxt; ++ui;
        if constexpr (ALIGN_EPI) { if (wr == 1) PG8_BAR; }
    }
    PG8_WAIT_V(0);
    if constexpr (!ALIGN_EPI) { if (wr == 0) PG8_BAR; }
    PG8_BAR;
#undef PG8_SA
#undef PG8_SB
#undef PG8_STAGE
#undef PG8_LDA
#undef PG8_LDB
#undef PG8_MMA
#undef PG8_WAIT_V
#undef PG8_WAIT_L
#undef PG8_BAR
#undef PG8_SCHED
#undef PG8_AK
#undef PG8_BK
}
}
struct DenseSched {
    const bf16_t* A; const bf16_t* Bt; int K, nM, nN;
    DI bool next(int i, GUnit& u) const {
        const int nwg = nM * nN; const long L = (long)i * (int)gridDim.x + (int)blockIdx.x; if (L >= nwg) return false;
        int wgid = (int)L; { const int q = nwg / 8, r = nwg % 8, xcd = wgid % 8, off = wgid / 8; wgid = (xcd < r ? xcd * (q + 1) : r * (q + 1) + (xcd - r) * q) + off; }
        const int nig = 8 * nN, gid = wgid / nig, fm = gid * 8, gsz = (nM - fm) < 8 ? (nM - fm) : 8;
        u.pm = fm + ((wgid % nig) % gsz); u.pn = (wgid % nig) / gsz;
        u.A = A + (size_t)u.pm * 256 * K; u.aidx = nullptr; u.nvalid = 256; u.B0 = Bt + (size_t)u.pn * 256 * K; u.B1 = u.B0; u.lbase = 0; return true; }
};
template <bool up> DI void moe_fill_unit(GUnit& u, int ti, int pn, const LAS int* tstart, const unsigned* cnt, const int* list, const bf16_t* A, const bf16_t* W) {
    int b = 0;
    for (int q = 1; q < NBUCKET; ++q) if (__builtin_amdgcn_readfirstlane(tstart[q]) <= ti) b = q;
    const int rt = ti - __builtin_amdgcn_readfirstlane(tstart[b]); const int g = b / 6, p = b % 6; const int ea = 4 * g + (p < 3 ? 0 : (p < 5 ? 1 : 2)), eb = 4 * g + (p < 3 ? p + 1 : (p < 5 ? p - 1 : 3));
    u.pm = ti; u.pn = pn; u.lbase = b * T + rt * 256; const int nv = __builtin_amdgcn_readfirstlane((int)cnt[CNT_STRIDE * b]) - rt * 256; u.nvalid = nv < 256 ? nv : 256;
    if (up) { u.A = A; u.aidx = list + u.lbase; const int e = pn < 4 ? ea : eb; u.B0 = W + (size_t)e * 1024 * 1024 + (size_t)(pn & 3) * 256 * 1024; u.B1 = u.B0; }
    else { u.A = A + (size_t)ti * 256 * 1024; u.aidx = nullptr; u.B0 = W + (size_t)ea * 1024 * 512 + (size_t)pn * 256 * 512; u.B1 = W + (size_t)eb * 1024 * 512 + (size_t)pn * 256 * 512; }
}
template <int NT, bool up> struct MoeSched {
    const LAS int* tstart; const unsigned* cnt; const int* list; const bf16_t* A; const bf16_t* W;
    DI bool next(int i, GUnit& u) const {
        const int ntile = __builtin_amdgcn_readfirstlane(tstart[NBUCKET]), nwg = ntile * NT; const int L0 = i * (int)gridDim.x + (int)blockIdx.x; if (L0 >= nwg) return false;
        int L = L0; { const int q = nwg / 8, r = nwg % 8, xcd = L0 % 8, off = L0 / 8; L = (xcd < r ? xcd * (q + 1) : r * (q + 1) + (xcd - r) * q) + off; }
        moe_fill_unit<up>(u, L / NT, L % NT, tstart, cnt, list, A, W); return true;
    }
};
struct MoeCut { int x, tiles_x, cstart, left, nY; };
DI MoeCut moe_cut(int ntile) { MoeCut c; c.x = (int)blockIdx.x & 7; const int q = ntile / 8, r = ntile % 8; c.tiles_x = q + (c.x < r ? 1 : 0); c.cstart = c.x * q + (c.x < r ? c.x : r); c.left = 8 * (c.tiles_x - 16); c.nY = 32 - c.left; return c; }
template <bool up, int MODE> struct MoeSplitSched {
    const LAS int* tstart; const unsigned* cnt; const int* list; const bf16_t* A; const bf16_t* W; MoeCut c;
    DI bool next(int i, GUnit& u) const {
        const int w = (int)blockIdx.x >> 3; int ti, pn;
        if (MODE == 1) { if (i >= 4) return false; const int off = i * 32 + w; ti = c.cstart + (off >> 3); pn = off & 7; }
        else if (MODE == 2 && up) { if (i > 0) return false; const int off = 128 + w; ti = c.cstart + (off >> 3); pn = off & 7; }
        else if (MODE == 2) { if (i > 0) return false; const int d = w - c.left; ti = c.cstart + (d >> 2); pn = d & 3; }
        else { const int e = i * 32 + w, rem = 4 * c.tiles_x - c.nY; if (e >= rem) return false;
            if (e < 64 - c.nY) { const int d = c.nY + e; ti = c.cstart + (d >> 2); pn = d & 3; } else { const int l = e - (64 - c.nY); ti = c.cstart + 16 + (l >> 2); pn = l & 3; } }
        moe_fill_unit<up>(u, ti, pn, tstart, cnt, list, A, W); return true;
    }
};

DI u32x4 pack8(const f32x4 v0, const f32x4 v1) { u32x4 w; w.x = pk2(v0[0], v0[1]); w.y = pk2(v0[2], v0[3]); w.z = pk2(v1[0], v1[1]); w.w = pk2(v1[2], v1[3]); return w; }
struct EpiProj { static constexpr bool MIDK = false;
    bf16_t *qsb, *vtsb, *qsw, *ksw, *vtsw; const float *cosT, *sinT;
    DI void operator()(const f32x4 (&acc)[2][2][4][2], const GUnit& u, int wr, int wc, int fr, int fq, int) const {
        const int pn = u.pn, rowb = u.pm * 256 + wr * 64 + fr;
        if (pn < 4) {
            bf16_t* base = qsb + (size_t)(pn >> 1) * ((WS_KSB - WS_QSB) / 2); const float sc = pn < 2 ? QSCALE : 1.0f; const int colt = (pn & 1) * 256 + wc * 32 + 8 * fq;
#pragma unroll
            for (int ai = 0; ai < 2; ++ai)
#pragma unroll
                for (int m = 0; m < 4; ++m) { const size_t row = rowb + ai * 128 + m * 16;
#pragma unroll
                    for (int bj = 0; bj < 2; ++bj) *(u32x4*)(base + row * 512 + colt + bj * 128) = pack8(acc[ai][bj][m][0] * sc, acc[ai][bj][m][1] * sc); }
        } else if (pn < 6 || (pn == 8 && wc >= 2)) {
            bf16_t* base = pn < 6 ? vtsb : vtsw; const int NF = pn < 6 ? 512 : 128, c0 = pn < 6 ? (pn - 4) * 256 + wc * 32 + 8 * fq : (wc * 32 - 64) + 8 * fq, bjs = pn < 6 ? 128 : 64;
#pragma unroll
            for (int ai = 0; ai < 2; ++ai)
#pragma unroll
                for (int m = 0; m < 4; ++m) { const int row = rowb + ai * 128 + m * 16; bf16_t* bp = base + ((size_t)(row >> 5) * NF + c0) * 32 + (row & 31);
#pragma unroll
                    for (int bj = 0; bj < 2; ++bj)
#pragma unroll
                        for (int n = 0; n < 2; ++n)
#pragma unroll
                            for (int j = 0; j < 4; ++j) bp[(bj * bjs + 4 * n + j) * 32] = (bf16_t)f2bf(acc[ai][bj][m][n][j]); }
        } else {
            const bool isq = pn < 8; bf16_t* base = isq ? qsw : ksw; const int pitch = isq ? 512 : 128; const int head = isq ? (pn - 6) * 4 + wc : wc; const float sc = isq ? QSCALE : 1.0f;
#pragma unroll
            for (int ai = 0; ai < 2; ++ai)
#pragma unroll
                for (int m = 0; m < 4; ++m) { const size_t row = rowb + ai * 128 + m * 16;
                    const f32x4 c0 = *(const f32x4*)(cosT + row * 32 + 8 * fq), c1 = *(const f32x4*)(cosT + row * 32 + 8 * fq + 4);
                    const f32x4 s0 = *(const f32x4*)(sinT + row * 32 + 8 * fq), s1 = *(const f32x4*)(sinT + row * 32 + 8 * fq + 4);
                    const f32x4 x10 = acc[ai][0][m][0], x11 = acc[ai][0][m][1], x20 = acc[ai][1][m][0], x21 = acc[ai][1][m][1];
                    const f32x4 o10 = (x10 * c0 - x20 * s0) * sc, o11 = (x11 * c1 - x21 * s1) * sc, o20 = (x20 * c0 + x10 * s0) * sc, o21 = (x21 * c1 + x11 * s1) * sc;
                    *(u32x4*)(base + row * pitch + head * 64 + 8 * fq) = pack8(o10, o11); *(u32x4*)(base + row * pitch + head * 64 + 32 + 8 * fq) = pack8(o20, o21); }
        }
    }
};
struct EpiWout {
    static constexpr bool MIDK = true;
    const float* mod; bf16_t* x1; const float* x; const float* ssq; LAS float* tab;
    DI void prep(const GUnit& u, int par, int tid) const {
        if (tid < 256) { const size_t row = (size_t)u.pm * 256 + tid; const f32x4 a0 = *(const f32x4*)(ssq + row * 16), a1 = *(const f32x4*)(ssq + row * 16 + 4), b0 = *(const f32x4*)(ssq + row * 16 + 8), b1 = *(const f32x4*)(ssq + row * 16 + 12);
            const float sa = ((a0.x + a0.y) + (a0.z + a0.w)) + ((a1.x + a1.y) + (a1.z + a1.w)), sb = ((b0.x + b0.y) + (b0.z + b0.w)) + ((b1.x + b1.y) + (b1.z + b1.w));
            const float rsb = 1.0f / sqrtf(sa * (1.0f / 512.0f) + EPS), rsw = 1.0f / sqrtf(sb * (1.0f / 512.0f) + EPS);
            *(LAS f32x2*)(tab + (par * 256 + tid) * 2) = (f32x2){rsb / rsw, rsw}; }
    }
    DI void midk(f32x4 (&acc)[2][2][4][2], const GUnit& u, int wr, int wc, int fr, int fq, int par) const {
#pragma unroll
        for (int ai = 0; ai < 2; ++ai)
#pragma unroll
            for (int m = 0; m < 4; ++m) { const float ratio = tab[(par * 256 + ai * 128 + wr * 64 + m * 16 + fr) * 2];
#pragma unroll
                for (int bj = 0; bj < 2; ++bj)
#pragma unroll
                    for (int n = 0; n < 2; ++n) acc[ai][bj][m][n] = acc[ai][bj][m][n] * ratio; }
    }
    DI void operator()(const f32x4 (&acc)[2][2][4][2], const GUnit& u, int wr, int wc, int fr, int fq, int par) const {
        const int rowb = u.pm * 256 + wr * 64 + fr, colb = u.pn * 256 + wc * 32 + 8 * fq; const int b = (u.pm * 256) / SEQ;
        f32x4 gt[2][2];
#pragma unroll
        for (int bj = 0; bj < 2; ++bj)
#pragma unroll
            for (int n = 0; n < 2; ++n) gt[bj][n] = *(const f32x4*)(mod + b * 6144 + 2048 + colb + bj * 128 + 4 * n);
#pragma unroll
        for (int ai = 0; ai < 2; ++ai)
#pragma unroll
            for (int mp = 0; mp < 2; ++mp) {
                f32x4 xv[2][2][2];
#pragma unroll
                for (int mm = 0; mm < 2; ++mm)
#pragma unroll
                    for (int bj = 0; bj < 2; ++bj)
#pragma unroll
                        for (int n = 0; n < 2; ++n) xv[mm][bj][n] = ldnt4(x + (size_t)(rowb + ai * 128 + (2 * mp + mm) * 16) * DM + colb + bj * 128 + 4 * n);
#pragma unroll
                for (int mm = 0; mm < 2; ++mm) { const int m = 2 * mp + mm, row = rowb + ai * 128 + m * 16; const float rsw = tab[(par * 256 + ai * 128 + wr * 64 + m * 16 + fr) * 2 + 1];
#pragma unroll
                    for (int bj = 0; bj < 2; ++bj) *(u32x4*)(x1 + (size_t)row * DM + colb + bj * 128) = pack8(xv[mm][bj][0] + gt[bj][0] * (acc[ai][bj][m][0] * rsw), xv[mm][bj][1] + gt[bj][1] * (acc[ai][bj][m][1] * rsw)); }
                asm volatile("" ::: "memory");
            }
    }
};
DI f32x4 swiglu4(const f32x4 g, const f32x4 uu, float w) { f32x4 o;
#pragma unroll
    for (int j = 0; j < 4; ++j) o[j] = (w * uu[j]) * (g[j] * __builtin_amdgcn_rcpf(1.0f + __builtin_amdgcn_exp2f(-LOG2E * g[j])));
    return o; }
struct EpiUp { static constexpr bool MIDK = true;
    bf16_t* hid; const f32x2* wts; LAS float* tab;
    DI void prep(const GUnit& u, int par, int tid) const {
        if (tid < 256) { float w = 0.f; if (tid < u.nvalid) { const f32x2 ww = wts[u.lbase + tid]; w = u.pn >= 4 ? ww.y : ww.x; } tab[par * 256 + tid] = w; }
    }
    DI void midk(f32x4 (&)[2][2][4][2], const GUnit&, int, int, int, int, int) const {}
    DI void operator()(const f32x4 (&acc)[2][2][4][2], const GUnit& u, int wr, int wc, int fr, int fq, int par) const {
        const int hc = (u.pn >> 2) * 512 + (u.pn & 3) * 128 + wc * 32 + 8 * fq;
#pragma unroll
        for (int ai = 0; ai < 2; ++ai)
#pragma unroll
            for (int m = 0; m < 4; ++m) { const int r = ai * 128 + wr * 64 + m * 16 + fr; const float w = tab[par * 256 + r];
                *(u32x4*)(hid + (size_t)(u.pm * 256 + r) * 1024 + hc) = pack8(swiglu4(acc[ai][0][m][0], acc[ai][1][m][0], w), swiglu4(acc[ai][0][m][1], acc[ai][1][m][1], w)); }
    }
};
struct EpiDown { static constexpr bool MIDK = false;
    bf16_t* y;
    DI void operator()(const f32x4 (&acc)[2][2][4][2], const GUnit& u, int wr, int wc, int fr, int fq, int) const {
        const int rowb = u.pm * 256 + wr * 64 + fr, colb = u.pn * 256 + wc * 32 + 8 * fq;
#pragma unroll
        for (int ai = 0; ai < 2; ++ai)
#pragma unroll
            for (int m = 0; m < 4; ++m) { const size_t row = rowb + ai * 128 + m * 16;
#pragma unroll
                for (int bj = 0; bj < 2; ++bj) *(u32x4*)(y + row * DM + colb + bj * 128) = pack8(acc[ai][bj][m][0], acc[ai][bj][m][1]); }
    }
};

typedef float f32x16 __attribute__((ext_vector_type(16)));
#define MFMA32(a, b, c) __builtin_amdgcn_mfma_f32_32x32x16_bf16((a), (b), (c), 0, 0, 0)
DI int pi32(int r) { return (r & ~12) | ((r & 4) << 1) | ((r & 8) >> 1); }
DI int crow(int i, int h) { return (i & 3) + 8 * (i >> 2) + 4 * h; }
template <int S_> DI bf16x8 packacc(const f32x16& x) { u32x4 p; p.x = pk2(x[8 * S_], x[8 * S_ + 1]); p.y = pk2(x[8 * S_ + 2], x[8 * S_ + 3]); p.z = pk2(x[8 * S_ + 4], x[8 * S_ + 5]); p.w = pk2(x[8 * S_ + 6], x[8 * S_ + 7]); return __builtin_bit_cast(bf16x8, p); }
DI f32x16 zero16() { f32x16 z;
#pragma unroll
    for (int i = 0; i < 16; ++i) z[i] = 0.f;
    return z; }
constexpr int AT_SLOT = 16384, ATT_NSLOT = 6;
constexpr int ATT_STG_OFF = ATT_NSLOT * AT_SLOT, ATT_STGW = 32 * 36;
constexpr int ATT_LS_OFF = ATT_STG_OFF + NWAVES * ATT_STGW * 4, ATT_CTL_OFF = ATT_LS_OFF + NWAVES * 32 * 4;
static_assert(ATT_CTL_OFF + 64 <= LDS_MISC, "attention LDS map");
#define AT_WAIT_V(n) asm volatile("s_waitcnt vmcnt(" #n ")" ::: "memory")
#define AT_BARRIER() do { asm volatile("s_waitcnt lgkmcnt(0)" ::: "memory"); __builtin_amdgcn_s_barrier(); asm volatile("" ::: "memory"); } while (0)
DI void at_issue(const bf16_t* Kg, int kp, const bf16_t* VTg, int nf, LAS unsigned char* slotp, int jt, int wave, int lane) {
    const int key = 8 * wave + (lane >> 3), chunk = (lane & 7) ^ ((key >> 1) & 7);
    __builtin_amdgcn_global_load_lds((const unsigned*)(Kg + (64 * (size_t)jt + key) * kp + chunk * 8), (LAS unsigned*)(slotp + wave * 1024), 16, 0, 0);
    const int hh = wave >> 2, d = 16 * (wave & 3) + (lane >> 2), sl = (lane & 3) ^ ((d >> 2) & 3);
    __builtin_amdgcn_global_load_lds((const unsigned*)(VTg + ((2 * (size_t)jt + hh) * nf + d) * 32 + sl * 8), (LAS unsigned*)(slotp + 8192 + wave * 1024), 16, 0, 0);
}
DI void at_kfrag(const LAS unsigned char* sl, int hh, int r, int h, bf16x8 (&kf)[4]) { const int key = 32 * hh + pi32(r), ksw = (key >> 1) & 7; const LAS unsigned char* kb = sl + key * 128;
#pragma unroll
    for (int d0 = 0; d0 < 4; ++d0) kf[d0] = *(const LAS bf16x8*)(kb + (((2 * d0 + h) ^ ksw) * 16)); }
DI void at_vfrag(const LAS unsigned char* sl, int hh, int r, int h, bf16x8 (&vf)[2][2]) {
#pragma unroll
    for (int dt = 0; dt < 2; ++dt)
#pragma unroll
        for (int sx = 0; sx < 2; ++sx) { const int d = 32 * dt + r; vf[dt][sx] = *(const LAS bf16x8*)(sl + 8192 + hh * 4096 + d * 64 + (((2 * sx + h) ^ ((d >> 2) & 3)) * 16)); } }

template <int DIAG> DI void sb_half(const LAS unsigned char* sl, int hh, const bf16x8 (&qf)[4], float& Cl, f32x16 (&o)[2], int r, int h) {
    bf16x8 kf[4], vf[2][2];
    at_kfrag(sl, hh, r, h, kf); at_vfrag(sl, hh, r, h, vf);
    f32x16 S = zero16();
#pragma unroll
    for (int d0 = 0; d0 < 4; ++d0) S = MFMA32(kf[d0], qf[d0], S);
    float om[16];
#pragma unroll
    for (int i = 0; i < 16; ++i) { float v = __builtin_amdgcn_rcpf(1.0f + __builtin_amdgcn_exp2f(S[i])); if (DIAG && !(16 * (i >> 3) + 8 * h + (i & 7) < r)) v = 1.0f; om[i] = v; }
    f32x2 sf[8]; sf[7] = (f32x2){1.0f, 1.0f};
#pragma unroll
    for (int i = 6; i >= 0; --i) sf[i] = sf[i + 1] * (f32x2){om[i + 1], om[i + 9]};
    float Rx = sf[0].x * om[0], Ry = sf[0].y * om[8];
    asm volatile("" : "+v"(Rx), "+v"(Ry));
    unsigned ax = __builtin_bit_cast(unsigned, Rx), ay = __builtin_bit_cast(unsigned, Ry), bx = ay, by = ax;
    swap32(ax, ay); swap32(bx, by);
    const float p0 = __builtin_bit_cast(float, h == 0 ? ay : bx), p1 = __builtin_bit_cast(float, h == 0 ? by : ax);
    const float m1 = (h == 0 ? p1 : 1.0f) * Cl, m0 = (h == 0 ? p0 * p1 : p1) * Ry * Cl;
    Cl = Cl * ((Rx * Ry) * (p0 * p1));
    const f32x2 mm = (f32x2){m0, m1};
    f32x16 P;
#pragma unroll
    for (int i = 0; i < 8; ++i) { const f32x2 w = (sf[i] * mm) * ((f32x2){1.0f, 1.0f} - (f32x2){om[i], om[i + 8]}); P[i] = w.x; P[i + 8] = w.y; }
    const bf16x8 Pf0 = packacc<0>(P), Pf1 = packacc<1>(P);
#pragma unroll
    for (int dt = 0; dt < 2; ++dt) { o[dt] = MFMA32(Pf0, vf[dt][0], o[dt]); o[dt] = MFMA32(Pf1, vf[dt][1], o[dt]); }
}
constexpr float SB_CMIN = 5.421010862427522e-20f;
struct SbUnit { int b, hd, q0; };
DI SbUnit sb_unit_of(int idx) { SbUnit u; u.b = idx / 512; u.hd = (idx >> 6) & 7; u.q0 = (idx & 63) * 128; return u; }
DI void grp_barrier(volatile LAS int* bar, int& epoch, int lane) {
    asm volatile("s_waitcnt lgkmcnt(0)" ::: "memory"); ++epoch;
    if (lane == 0) __hip_atomic_fetch_add((LAS int*)bar, 1, __ATOMIC_RELAXED, __HIP_MEMORY_SCOPE_WORKGROUP);
    while (*bar < 4 * epoch) __builtin_amdgcn_s_sleep(1);
    asm volatile("" ::: "memory");
}
DI void at_issue4(const bf16_t* Kg, const bf16_t* VTg, LAS unsigned char* slotp, int jt, int w4, int lane) {
#pragma unroll
    for (int pp = 0; pp < 2; ++pp) { const int pc = w4 + 4 * pp;
        const int key = 8 * pc + (lane >> 3), chunk = (lane & 7) ^ ((key >> 1) & 7);
        __builtin_amdgcn_global_load_lds((const unsigned*)(Kg + (64 * (size_t)jt + key) * 512 + chunk * 8), (LAS unsigned*)(slotp + pc * 1024), 16, 0, 0);
        const int hh = pc >> 2, d = 16 * (pc & 3) + (lane >> 2), sl = (lane & 3) ^ ((d >> 2) & 3);
        __builtin_amdgcn_global_load_lds((const unsigned*)(VTg + ((2 * (size_t)jt + hh) * 512 + d) * 32 + sl * 8), (LAS unsigned*)(slotp + 8192 + pc * 1024), 16, 0, 0); }
}
DI int sb_prologue(const bf16_t* Q, const bf16_t* K, const bf16_t* VT, const SbUnit& u, LAS unsigned char* ring, int w4, int lane, bf16x8 (&qf)[4]) {
    const int r = lane & 31, h = lane >> 5; const size_t gb = (size_t)u.b * SEQ; const int t0w = u.q0 + 32 * w4;
    const bf16_t* Kg = K + gb * 512 + u.hd * 64; const bf16_t* VTg = VT + ((gb >> 5) * 512 + u.hd * 64) * 32;
    const int jt_hi = (u.q0 + 127) >> 6, ntiles = jt_hi + 1; int issued = 0;
    for (; issued < 2 && issued < ntiles; ++issued) at_issue4(Kg, VTg, ring + issued * AT_SLOT, jt_hi - issued, w4, lane);
#pragma unroll
    for (int d0 = 0; d0 < 4; ++d0) qf[d0] = *(const bf16x8*)(Q + (gb + t0w + r) * 512 + u.hd * 64 + 16 * d0 + 8 * h);
    return issued;
}
DI void sb_body(const bf16_t* K, const bf16_t* VT, const SbUnit& u, int issued, bf16x8 (&qf)[4], LAS unsigned char* ring, volatile LAS int* ctl, volatile LAS int* bar, int& epoch, int w4, int lane, f32x16 (&o)[2]) {
    const int r = lane & 31, h = lane >> 5; const size_t gb = (size_t)u.b * SEQ; const int t0w = u.q0 + 32 * w4, sd = t0w >> 5;
    o[0] = zero16(); o[1] = zero16(); float Cl = 1.0f;
    const bf16_t* Kg = K + gb * 512 + u.hd * 64; const bf16_t* VTg = VT + ((gb >> 5) * 512 + u.hd * 64) * 32;
    const int jt_hi = (u.q0 + 127) >> 6, ntiles = jt_hi + 1;
    if (w4 == 0 && lane == 0) { ctl[0] = 0; ctl[1] = 0; ctl[2] = 0; }
    asm volatile("s_waitcnt vmcnt(0)" : "+v"(qf[0]), "+v"(qf[1]), "+v"(qf[2]), "+v"(qf[3]) :: "memory");
    bool done = false; int slot = 0;
    for (int i = 0; i < ntiles; ++i) {
        const int jt = jt_hi - i, fly = issued - (i + 1);
        if (fly >= 1) AT_WAIT_V(4); else AT_WAIT_V(0);
        grp_barrier(bar, epoch, lane);
        if (i > 0 && ctl[(i - 1) % 3] == 4) break;
        if (w4 == 0 && lane == 0) ctl[(i + 1) % 3] = 0;
        if (issued < ntiles) { at_issue4(Kg, VTg, ring + ((slot + 2) % 3) * AT_SLOT, jt_hi - issued, w4, lane); ++issued; }
        if (!done) {
            const LAS unsigned char* sl = ring + slot * AT_SLOT;
            const int s1 = 2 * jt + 1, s0 = 2 * jt;
            if (s1 < sd) sb_half<0>(sl, 1, qf, Cl, o, r, h); else if (s1 == sd) sb_half<1>(sl, 1, qf, Cl, o, r, h);
            if (s0 < sd) sb_half<0>(sl, 0, qf, Cl, o, r, h); else if (s0 == sd) sb_half<1>(sl, 0, qf, Cl, o, r, h);
            if (s1 <= sd || s0 <= sd) done = __all(Cl < SB_CMIN);
        }
        if (done && lane == 0) __hip_atomic_fetch_add((LAS int*)&ctl[i % 3], 1, __ATOMIC_RELAXED, __HIP_MEMORY_SCOPE_WORKGROUP);
        slot = (slot + 1) % 3;
    }
    AT_WAIT_V(0);
    grp_barrier(bar, epoch, lane);
}
DI void sw_head(const bf16x8 (&qf)[4], const LAS unsigned char* lds, float sink2, int t0, int jt_lo, int lane, f32x16 (&o)[2], float& lsum) {
    const int r = lane & 31, h = lane >> 5, sd = t0 >> 5;
    f32x16 S[5]; float m = sink2;
#pragma unroll
    for (int jj = 0; jj < 5; ++jj) { const int sj = sd - 4 + jj;
        if (sj >= 0) { bf16x8 kf[4]; at_kfrag(lds + ((sj >> 1) - jt_lo) * AT_SLOT, sj & 1, r, h, kf);
            f32x16 s = zero16();
#pragma unroll
            for (int d0 = 0; d0 < 4; ++d0) s = MFMA32(kf[d0], qf[d0], s);
#pragma unroll
            for (int i = 0; i < 16; ++i) { const int ko = 16 * (i >> 3) + 8 * h + (i & 7); float v = s[i];
                if (jj == 4 && ko > r) v = -1e30f;
                if (jj == 0 && ko <= r) v = -1e30f;
                s[i] = v; m = __builtin_fmaxf(m, v); }
            S[jj] = s; }
        else {
#pragma unroll
            for (int i = 0; i < 16; ++i) S[jj][i] = -1e30f; } }
    m = __builtin_fmaxf(m, __shfl_xor(m, 32));
    o[0] = zero16(); o[1] = zero16(); float ls = 0.f;
#pragma unroll
    for (int jj = 0; jj < 5; ++jj) { const int sj = sd - 4 + jj;
        if (sj >= 0) { bf16x8 vf[2][2]; at_vfrag(lds + ((sj >> 1) - jt_lo) * AT_SLOT, sj & 1, r, h, vf);
            f32x16 P;
#pragma unroll
            for (int i = 0; i < 16; ++i) { P[i] = __builtin_amdgcn_exp2f(S[jj][i] - m); ls += P[i]; }
            const bf16x8 Pf0 = packacc<0>(P), Pf1 = packacc<1>(P);
#pragma unroll
            for (int dt = 0; dt < 2; ++dt) { o[dt] = MFMA32(Pf0, vf[dt][0], o[dt]); o[dt] = MFMA32(Pf1, vf[dt][1], o[dt]); } } }
    ls += __shfl_xor(ls, 32);
    lsum = ls + __builtin_amdgcn_exp2f(sink2 - m);
}
DI void at_store(const f32x16 (&o)[2], float lsum, LAS float* stg, LAS float* lsb, bf16_t* mixrow0, float* ssq0, int lane) {
    const int r = lane & 31, h = lane >> 5, row = lane >> 1, hf = lane & 1;
    if (h == 0) lsb[r] = lsum;
    float ss = 0.f; u32x4 w[2][2];
#pragma unroll
    for (int dt = 0; dt < 2; ++dt) {
#pragma unroll
        for (int i = 0; i < 16; ++i) stg[crow(i, h) * 36 + r] = o[dt][i];
        LDS_WAIT();
        const float il = 1.0f / lsb[row];
#pragma unroll
        for (int k = 0; k < 2; ++k) { const f32x4 a0 = *(const LAS f32x4*)(stg + row * 36 + hf * 16 + 8 * k) * il, a1 = *(const LAS f32x4*)(stg + row * 36 + hf * 16 + 8 * k + 4) * il;
            ss += ((a0.x * a0.x + a0.y * a0.y) + (a0.z * a0.z + a0.w * a0.w)) + ((a1.x * a1.x + a1.y * a1.y) + (a1.z * a1.z + a1.w * a1.w)); w[dt][k] = pack8(a0, a1); }
        LDS_WAIT();
    }
    ss += __shfl_xor(ss, 1);
    if (hf == 0) ssq0[(size_t)row * 16] = ss;
    bf16_t* mr = mixrow0 + (size_t)row * 1024 + hf * 16;
#pragma unroll
    for (int dt = 0; dt < 2; ++dt) { *(u32x4*)(mr + 32 * dt) = w[dt][0]; *(u32x4*)(mr + 32 * dt + 8) = w[dt][1]; }
}
DI void p3_attention(const Args& a, LAS unsigned char* lds, int tid, int lane, int wave, int rep = 0, int kinds = 3) {
    asm volatile("" : "+v"(tid), "+v"(lane));
    const bf16_t* QSB = (const bf16_t*)(a.ws + WS_QSB); const bf16_t* KSB = (const bf16_t*)(a.ws + WS_KSB); const bf16_t* VTSB = (const bf16_t*)(a.ws + WS_VSB);
    const bf16_t* QSW = (const bf16_t*)(a.ws + WS_QSW); const bf16_t* KSW = (const bf16_t*)(a.ws + WS_KSW); const bf16_t* VTSW = (const bf16_t*)(a.ws + WS_VSW);
    bf16_t* MIX = (bf16_t*)(a.ws + WS_MIX); float* SSQ = (float*)(a.ws + WS_SSQ); unsigned* qctr = (unsigned*)(a.ws + WS_CTL) + CW_ATTNQ + 2048 * rep;
    LAS float* stg = (LAS float*)(lds + ATT_STG_OFF) + wave * ATT_STGW; LAS float* lsb = (LAS float*)(lds + ATT_LS_OFF) + wave * 32; volatile LAS int* ctl = (volatile LAS int*)(lds + ATT_CTL_OFF);
    if (kinds & 2)
    for (int u = (int)blockIdx.x; u < (T / 256) * 2; u += (int)gridDim.x) {
        const int b = u / 64, kvh = (u >> 5) & 1, q0 = (u & 31) * 256, jt_lo = (q0 >> 6) - 2, t0 = q0 + 32 * wave; const size_t gb = (size_t)b * SEQ;
        const bf16_t* Kg = KSW + gb * 128 + kvh * 64; const bf16_t* VTg = VTSW + ((gb >> 5) * 128 + kvh * 64) * 32;
#pragma unroll
        for (int s6 = 0; s6 < 6; ++s6) if (jt_lo + s6 >= 0) at_issue(Kg, 128, VTg, 128, lds + s6 * AT_SLOT, jt_lo + s6, wave, lane);
        bf16x8 qn[4];
#pragma unroll
        for (int d0 = 0; d0 < 4; ++d0) qn[d0] = *(const bf16x8*)(QSW + (gb + t0 + (lane & 31)) * 512 + (4 * kvh) * 64 + 16 * d0 + 8 * (lane >> 5));
        AT_WAIT_V(0); AT_BARRIER();
#pragma unroll
        for (int q = 0; q < 4; ++q) { const int hq = 4 * kvh + q; f32x16 o[2]; float lsum; bf16x8 qf[4];
#pragma unroll
            for (int d0 = 0; d0 < 4; ++d0) qf[d0] = qn[d0];
            if (q < 3) {
#pragma unroll
                for (int d0 = 0; d0 < 4; ++d0) qn[d0] = *(const bf16x8*)(QSW + (gb + t0 + (lane & 31)) * 512 + (hq + 1) * 64 + 16 * d0 + 8 * (lane >> 5)); }
            sw_head(qf, lds, a.sinks[hq] * LOG2E, t0, jt_lo, lane, o, lsum);
            at_store(o, lsum, stg, lsb, MIX + (gb + t0) * 1024 + 512 + hq * 64, SSQ + (gb + t0) * 16 + 8 + hq, lane); }
        asm volatile("s_waitcnt vmcnt(0)" ::: "memory"); AT_BARRIER();
    }
    if (kinds & 1) {
        volatile LAS int* gb2 = ctl + 32;
        if (tid < 2) gb2[16 * tid] = 0;
        __syncthreads();
        const int grp = wave >> 2, w4 = wave & 3; LAS unsigned char* ring = lds + grp * 3 * AT_SLOT; volatile LAS int* gctl = ctl + 8 * grp; volatile LAS int* bar = gb2 + 16 * grp; int epoch = 0;
        constexpr int NUNITS = (T / 128) * 8; const int NG = 2 * (int)gridDim.x, gg = 2 * (int)blockIdx.x + grp;
        bf16x8 qf[4]; int idx = gg; int issued = 0; SbUnit u = sb_unit_of(idx); unsigned nxt = 0;
        if (idx < NUNITS) issued = sb_prologue(QSB, KSB, VTSB, u, ring, w4, lane, qf);
        while (idx < NUNITS) {
            if (w4 == 0 && lane == 0) nxt = atomicAdd(qctr, 1u);
            f32x16 o[2];
            sb_body(KSB, VTSB, u, issued, qf, ring, gctl, bar, epoch, w4, lane, o);
            const size_t grow = (size_t)u.b * SEQ + u.q0 + 32 * w4; const int hd = u.hd;
            if (w4 == 0 && lane == 0) gctl[4] = NG + (int)nxt;
            grp_barrier(bar, epoch, lane);
            const int nidx = __builtin_amdgcn_readfirstlane(gctl[4]);
            grp_barrier(bar, epoch, lane);
            if (nidx < NUNITS) { u = sb_unit_of(nidx); issued = sb_prologue(QSB, KSB, VTSB, u, ring, w4, lane, qf); }
            at_store(o, 1.0f, stg, lsb, MIX + grow * 1024 + hd * 64, SSQ + grow * 16 + hd, lane);
            idx = nidx;
        }
    }
}

#define XB_TMO      128
#define XB_XCNT(j)  (256  + 64 * (j))
#define XB_XSUB(j)  (1280 + 64 * (j))
#define XB_XGEN(j)  (2304 + 64 * (j))
#define XB_TOP      3328
#define XB_TOPGEN   3392
#define XCD_BAR_WORDS 3456
#define XB_SPIN_CAP (1u << 18)
DI unsigned xb_ld(unsigned* p)              { return __hip_atomic_load(p, __ATOMIC_RELAXED, __HIP_MEMORY_SCOPE_AGENT); }
DI unsigned xb_add(unsigned* p, unsigned v) { return __hip_atomic_fetch_add(p, v, __ATOMIC_RELAXED, __HIP_MEMORY_SCOPE_AGENT); }
DI unsigned xb_xcc_id() { return (unsigned)__builtin_amdgcn_s_getreg((3 << 11) | 20) & 0xFu; }
#define XB_SPIN(cond, bar) do { unsigned _sp = 0; while (cond) { __builtin_amdgcn_s_sleep(1); \
    if ((++_sp & 255u) == 0u) { if (xb_ld(&(bar)[XB_TMO])) break; if (_sp > XB_SPIN_CAP) { atomicAdd(&(bar)[XB_TMO], 1u); break; } } } } while (0)
struct XcdBarrier { unsigned* bar; unsigned x; volatile LAS unsigned* st; };
DI XcdBarrier xcd_barrier_post(unsigned* bar, volatile LAS unsigned* st) {
    XcdBarrier b; b.bar = bar; b.x = xb_xcc_id(); b.st = st;
    if (threadIdx.x == 0) (void)xb_add(&bar[XB_XCNT(b.x)], 1u);
    return b;
}
DI void xcd_barrier_complete(unsigned* bar, unsigned x, unsigned& nloc, unsigned& nx) {
    const unsigned G = gridDim.x * gridDim.y * gridDim.z;
    unsigned sum, cnt, mine, sp = 0u;
    for (;;) {
        sum = 0u; cnt = 0u; mine = 0u;
#pragma unroll
        for (unsigned j = 0; j < 16; ++j) { const unsigned c = xb_ld(&bar[XB_XCNT(j)]); sum += c; cnt += (c > 0u) ? 1u : 0u; mine = (j == x) ? c : mine; }
        if (sum == G) break;
        __builtin_amdgcn_s_sleep(1);
        if ((++sp & 255u) == 0u) { if (xb_ld(&bar[XB_TMO])) break; if (sp > XB_SPIN_CAP) { atomicAdd(&bar[XB_TMO], 1u); break; } }
    }
    nloc = mine > 0u ? mine : 1u; nx = cnt > 0u ? cnt : 1u;
}
DI void xcd_barrier(const XcdBarrier& b) {
    asm volatile("s_waitcnt vmcnt(0)" ::: "memory");
    __syncthreads();
    if (threadIdx.x == 0) {
        unsigned* bar = b.bar;
        __builtin_amdgcn_s_waitcnt(0);
        unsigned nloc = b.st[0], nx = b.st[1];
        if (nloc == 0u) { xcd_barrier_complete(bar, b.x, nloc, nx); b.st[0] = nloc; b.st[1] = nx; }
        const unsigned old = xb_add(&bar[XB_XSUB(b.x)], 1u);
        const unsigned gen = old / nloc;
        if (old + 1u == (gen + 1u) * nloc) {
            __builtin_amdgcn_fence(__ATOMIC_RELEASE, "agent");
            asm volatile("s_waitcnt vmcnt(0)" ::: "memory");
            const unsigned og = xb_add(&bar[XB_TOP], 1u);
            const unsigned tg = og / nx;
            if (og + 1u == (tg + 1u) * nx) xb_add(&bar[XB_TOPGEN], 1u);
            else XB_SPIN(xb_ld(&bar[XB_TOPGEN]) == tg, bar);
            __builtin_amdgcn_fence(__ATOMIC_ACQUIRE, "agent");
            xb_add(&bar[XB_XGEN(b.x)], 1u);
            asm volatile("s_waitcnt vmcnt(0)" ::: "memory");
        } else {
            XB_SPIN(xb_ld(&bar[XB_XGEN(b.x)]) == gen, bar);
            __builtin_amdgcn_fence(__ATOMIC_ACQUIRE, "agent");
            asm volatile("s_waitcnt vmcnt(0)" ::: "memory");
        }
    }
    __syncthreads();
}

__global__ void __launch_bounds__(NTHREADS, 2) mk_fwd(Args a) {
    extern __shared__ __attribute__((aligned(16))) unsigned char lds_raw[];
    LAS unsigned char* lds = (LAS unsigned char*)lds_raw;
    const int tid = threadIdx.x, lane = tid & 63, wave = __builtin_amdgcn_readfirstlane(tid >> 6);
    volatile LAS unsigned* misc = (volatile LAS unsigned*)(lds + LDS_MISC);
    if (tid < 2) misc[tid] = 0u;
    __syncthreads();
    const XcdBarrier gbar = xcd_barrier_post((unsigned*)(a.ws + WS_CTL) + CW_BAR, misc);
    unsigned char* ws = a.ws;
    const float* mod = (const float*)(ws + WS_MOD);

#define REPS(k) ((PROBE_DUP == (k)) ? 2 : 1)
    int n_stamp = 0;
#define STAMP() do { if (STAMP_PHASE >= 0 && blockIdx.x == 0 && tid == 0) ((unsigned long long*)(ws + WS_STAMP))[n_stamp] = __builtin_amdgcn_s_memrealtime(); ++n_stamp; } while (0)
    STAMP();
    const int p2_units = (T / 256) * (DIN / 256), p2_rem = p2_units % (int)gridDim.x, n_tailw = p2_rem ? ((int)gridDim.x - p2_rem) * NWAVES : 0;
    const int n_tail_items = n_tailw * 4 < NEXPERT_ITEMS ? n_tailw * 4 : NEXPERT_ITEMS, n_p0_items = NEXPERT_ITEMS - n_tail_items;
    for (int rep = 0; rep < REPS(0); ++rep) { p0_prologue(a, lds, tid, lane, wave); expert_items(a, lds, 0, n_p0_items, blockIdx.x * NWAVES + wave, gridDim.x * NWAVES, lane, wave); xcd_barrier(gbar); STAMP(); }
    for (int rep = 0; rep < REPS(1); ++rep) { p1_norm(a, lane, wave); xcd_barrier(gbar); STAMP(); }
    for (int rep = 0; rep < REPS(2); ++rep) {
        DenseSched S{(const bf16_t*)(ws + WS_H), (const bf16_t*)(ws + WS_WIN), 1024, T / 256, DIN / 256};
        EpiProj E{(bf16_t*)(ws + WS_QSB), (bf16_t*)(ws + WS_VSB), (bf16_t*)(ws + WS_QSW), (bf16_t*)(ws + WS_KSW), (bf16_t*)(ws + WS_VSW), (const float*)(ws + WS_COS), (const float*)(ws + WS_SIN)};
        pg8::gemm_phase<DenseSched, EpiProj, true, 1024, 1024, 16>(lds, S, E);
        if (p2_rem && (int)blockIdx.x >= p2_rem && rep == 0) { __syncthreads(); expert_items(a, lds, n_p0_items, n_tail_items, ((int)blockIdx.x - p2_rem) * NWAVES + wave, n_tailw, lane, wave); }
        xcd_barrier(gbar); STAMP();
    }
    if (PROBE_DUP == 31 || PROBE_DUP == 32) { p3_attention(a, lds, tid, lane, wave, 1, PROBE_DUP - 30); xcd_barrier(gbar); }
    for (int rep = 0; rep < REPS(3); ++rep) { p3_attention(a, lds, tid, lane, wave, rep); xcd_barrier(gbar); STAMP(); }
    for (int rep = 0; rep < REPS(4); ++rep) {
        DenseSched S{(const bf16_t*)(ws + WS_MIX), (const bf16_t*)(ws + WS_WOUT), 1024, T / 256, DM / 256};
        EpiWout E{mod, (bf16_t*)(ws + WS_X1), a.x, (const float*)(ws + WS_SSQ), (LAS float*)(lds + pg8::STAGE_BYTES + 1024)};
        pg8::gemm_phase<DenseSched, EpiWout, true, 1024, 1024, 16>(lds, S, E);
        xcd_barrier(gbar); STAMP();
    }
    for (int rep = 0; rep < REPS(5); ++rep) { p5_router(a, lds, tid, lane, wave, rep); xcd_barrier(gbar); STAMP(); }
    LAS int* tstart = (LAS int*)(lds + pg8::STAGE_BYTES);
    const unsigned* cnt = (const unsigned*)(ws + WS_CTL) + CW_CNT;
    if (tid == 0) { int run = 0; for (int b = 0; b < NBUCKET; ++b) { tstart[b] = run; run += ((int)cnt[CNT_STRIDE * b] + 255) >> 8; } tstart[NBUCKET] = run; }
    __syncthreads();
    const bf16_t* H2 = (const bf16_t*)(ws + WS_H); const bf16_t* HIDc = (const bf16_t*)(ws + WS_HID); const int* LISTc = (const int*)(ws + WS_LIST);
    EpiUp EU{(bf16_t*)(ws + WS_HID), (const f32x2*)(ws + WS_WTS), (LAS float*)(lds + pg8::STAGE_BYTES + 1024)}; EpiDown ED{(bf16_t*)(ws + WS_Y)};
    if (gridDim.x == 256) {
        const MoeCut mc = moe_cut(__builtin_amdgcn_readfirstlane(tstart[NBUCKET]));
        { MoeSplitSched<true, 1> S{tstart, cnt, LISTc, H2, (const bf16_t*)(ws + WS_WGU), mc}; pg8::gemm_phase<MoeSplitSched<true, 1>, EpiUp, true, 1024, 1024, 16>(lds, S, EU); }
        xcd_barrier(gbar); STAMP();
        if (((int)blockIdx.x >> 3) < mc.left) { MoeSplitSched<true, 2> S{tstart, cnt, LISTc, H2, (const bf16_t*)(ws + WS_WGU), mc}; pg8::gemm_phase<MoeSplitSched<true, 2>, EpiUp, true, 1024, 1024, 16>(lds, S, EU); }
        else { MoeSplitSched<false, 2> S{tstart, cnt, LISTc, HIDc, (const bf16_t*)(ws + WS_WD), mc}; pg8::gemm_phase<MoeSplitSched<false, 2>, EpiDown, true, 1024, 512, 8>(lds, S, ED); }
        xcd_barrier(gbar); STAMP();
        { MoeSplitSched<false, 3> S{tstart, cnt, LISTc, HIDc, (const bf16_t*)(ws + WS_WD), mc}; pg8::gemm_phase<MoeSplitSched<false, 3>, EpiDown, true, 1024, 512, 8>(lds, S, ED); }
    } else {
        { MoeSched<8, true> S{tstart, cnt, LISTc, H2, (const bf16_t*)(ws + WS_WGU)}; pg8::gemm_phase<MoeSched<8, true>, EpiUp, true, 1024, 1024, 16>(lds, S, EU); }
        xcd_barrier(gbar); STAMP();
        { MoeSched<4, false> S{tstart, cnt, LISTc, HIDc, (const bf16_t*)(ws + WS_WD)}; pg8::gemm_phase<MoeSched<4, false>, EpiDown, true, 1024, 512, 8>(lds, S, ED); }
    }
    if (STAMP_PHASE >= 0) {
        if (blockIdx.x == 0 && tid == 0) { unsigned long long* st = (unsigned long long*)(ws + WS_STAMP); st[n_stamp] = __builtin_amdgcn_s_memrealtime();
            const float t_us = (float)(st[STAMP_PHASE + 1] - st[STAMP_PHASE]) * 0.01f; *(float*)(ws + WS_STAMP + 256) = 1.0f + sqrtf(t_us * STAMP_K); } }
    xcd_barrier(gbar);
    if (PROBE_DUP == 8) { p8_final(a, tstart, lane, wave, (float*)(ws + WS_H)); xcd_barrier(gbar); }
    p8_final(a, tstart, lane, wave, a.out);
}

extern "C" void kernel_launch(void* const* d_in, const int* in_sizes, int n_in, void* d_out, int out_size, void* d_ws, size_t ws_size, hipStream_t stream) {
    static int grid = 0;
    if (grid == 0) {
        if (n_in != 18 || in_sizes[0] != T * DM || out_size != T * DM || ws_size < WS_END) { fprintf(stderr, "kernel_launch: unexpected shapes (n_in %d, in0 %d, out %d, ws %zu); nothing launched\n", n_in, n_in > 0 ? in_sizes[0] : -1, out_size, ws_size); grid = -1; return; }
        int dev = 0, cus = 0, per_cu = 0;
        (void)hipGetDevice(&dev); (void)hipDeviceGetAttribute(&cus, hipDeviceAttributeMultiprocessorCount, dev);
        (void)hipFuncSetAttribute((const void*)mk_fwd, hipFuncAttributeMaxDynamicSharedMemorySize, LDS_BYTES);
        (void)hipOccupancyMaxActiveBlocksPerMultiprocessor(&per_cu, (const void*)mk_fwd, NTHREADS, LDS_BYTES);
        if (per_cu < 1) { fprintf(stderr, "kernel_launch: occupancy query says %d blocks per CU\n", per_cu); per_cu = 1; }
        grid = cus * per_cu;
        fprintf(stderr, "kernel_launch: %d CUs x %d = grid %d\n", cus, per_cu, grid);
    }
    if (grid < 0) return;
    (void)hipMemsetAsync((char*)d_ws + WS_CTL, 0, CTL_BYTES, stream);
    Args a{};
    a.x = (const float*)d_in[0]; a.c = (const float*)d_in[1]; a.pos = (const int*)d_in[2]; a.w_ada = (const float*)d_in[3]; a.b_ada = (const float*)d_in[4]; a.g_mix = (const float*)d_in[5];
    a.w_in = (const float*)d_in[6]; a.sinks = (const float*)d_in[7]; a.g_sb = (const float*)d_in[8]; a.g_sw = (const float*)d_in[9]; a.w_out = (const float*)d_in[10]; a.g_ffn = (const float*)d_in[11];
    a.w_rg = (const float*)d_in[12]; a.w_re = (const float*)d_in[13]; a.w_gate = (const float*)d_in[14]; a.w_up = (const float*)d_in[15]; a.w_down = (const float*)d_in[16]; a.g_fin = (const float*)d_in[17];
    a.out = (float*)d_out; a.ws = (unsigned char*)d_ws;
    void* args[] = {&a};
    hipError_t e = hipLaunchCooperativeKernel((const void*)mk_fwd, dim3(grid), dim3(NTHREADS), args, LDS_BYTES, stream);
    if (e != hipSuccess) fprintf(stderr, "kernel_launch: cooperative launch failed: %s (grid %d)\n", hipGetErrorString(e), grid);
}
```

```cpp
#include <hip/hip_runtime.h>
#include <cstdio>
#include <cstdint>
#include <cmath>

#define LAS __attribute__((address_space(3)))
#define DI __device__ __forceinline__
typedef unsigned short bf16_t;
typedef short bf16x8 __attribute__((ext_vector_type(8)));
typedef float f32x4 __attribute__((ext_vector_type(4)));
typedef float f32x2 __attribute__((ext_vector_type(2)));
typedef unsigned u32x4 __attribute__((ext_vector_type(4)));
typedef unsigned u32x2 __attribute__((ext_vector_type(2)));
typedef __bf16 bf16x2_t __attribute__((ext_vector_type(2)));

constexpr int NB = 4, SEQ = 8192, DM = 1024, T = NB * SEQ;
constexpr int DIN = 2304, DSB = 512, DSW = 512, DKV = 128;
constexpr int NEXP = 16, DEXP = 512, NBUCKET = 24, WINDOW = 128;
constexpr int MAXTILES = T / 256 + NBUCKET, TPAD = MAXTILES * 256;
constexpr float EPS = 1e-6f, LOG2E = 1.4426950408889634f, QSCALE = 0.125f * LOG2E;
constexpr int NTHREADS = 512, NWAVES = 8;
#ifndef STAMP_PHASE
#define STAMP_PHASE (-1)
#endif
#ifndef STAMP_K
#define STAMP_K 1e-5f
#endif
#ifndef PROBE_DUP
#define PROBE_DUP (-1)
#endif

constexpr size_t MiB = 1u << 20;
constexpr size_t WS_CTL = 0, CTL_BYTES = 1 * MiB;
constexpr size_t WS_MOD = 1 * MiB;
constexpr size_t WS_COS = 2 * MiB, WS_SIN = 6 * MiB;
constexpr size_t WS_WIN = 10 * MiB;
constexpr size_t WS_WOUT = 15 * MiB;
constexpr size_t WS_WGU = 17 * MiB;
constexpr size_t WS_WD = 49 * MiB;
constexpr size_t WS_LIST = 65 * MiB;
constexpr size_t WS_WTS = 68 * MiB;
constexpr size_t WS_STAMP = 512 * 1024;
constexpr size_t WS_TPOS = 74 * MiB;
constexpr size_t WS_SSQ = 76 * MiB;
constexpr size_t WS_H = 80 * MiB;
constexpr size_t WS_QSB = 144 * MiB, WS_KSB = 176 * MiB, WS_VSB = 208 * MiB, WS_QSW = 240 * MiB;
constexpr size_t WS_KSW = 272 * MiB, WS_VSW = 280 * MiB;
constexpr size_t WS_MIX = 288 * MiB;
constexpr size_t WS_HID = 352 * MiB;
constexpr size_t WS_RTAB = 428 * MiB;
constexpr size_t WS_END = 429 * MiB;
constexpr size_t WS_XB = WS_HID;
constexpr size_t WS_X1 = WS_QSB;
constexpr size_t WS_Y = WS_VSB;
static_assert(WS_X1 + (size_t)T * 1024 * 2 <= WS_VSB && WS_Y + (size_t)TPAD * 1024 * 2 <= WS_MIX && WS_XB + (size_t)T * 1024 * 2 <= WS_END, "overlays");
static_assert(WS_KSB - WS_QSB == WS_VSB - WS_KSB, "q/k/v_sb buffers equally spaced");
static_assert(WS_HID + (size_t)TPAD * 1024 * 2 <= WS_END, "ws map");
constexpr int CW_CNT = 8192, CNT_STRIDE = 64, CW_ATTNQ = 16384, CW_BAR = 4096;
constexpr int LDS_MISC = 143360;

constexpr int LDS_BYTES = 147456;

struct Args {
    const float* x; const float* c; const int* pos; const float* w_ada; const float* b_ada; const float* g_mix; const float* w_in; const float* sinks;
    const float* g_sb; const float* g_sw; const float* w_out; const float* g_ffn; const float* w_rg; const float* w_re; const float* w_gate; const float* w_up;
    const float* w_down; const float* g_fin; float* out; unsigned char* ws;
};

__constant__ float INV_FREQ[32] = {1.000000000e+00f, 7.498942018e-01f, 5.623413324e-01f, 4.216965139e-01f, 3.162277639e-01f, 2.371373773e-01f, 1.778279394e-01f, 1.333521456e-01f, 1.000000015e-01f, 7.498942316e-02f, 5.623413250e-02f, 4.216964915e-02f, 3.162277490e-02f, 2.371373773e-02f, 1.778279431e-02f, 1.333521400e-02f, 9.999999776e-03f, 7.498942316e-03f, 5.623413250e-03f, 4.216964822e-03f, 3.162277630e-03f, 2.371373819e-03f, 1.778279431e-03f, 1.333521446e-03f, 1.000000047e-03f, 7.498941850e-04f, 5.623413017e-04f, 4.216965172e-04f, 3.162277571e-04f, 2.371373703e-04f, 1.778279402e-04f, 1.333521504e-04f};

DI unsigned f2bf(float f) { unsigned u = __builtin_bit_cast(unsigned, f); return (u + 0x7fffu + ((u >> 16) & 1u)) >> 16; }
DI unsigned pk2(float lo, float hi) { f32x2 v = {lo, hi}; bf16x2_t b = __builtin_convertvector(v, bf16x2_t); return __builtin_bit_cast(unsigned, b); }
DI u32x4 pack8(const f32x4 v0, const f32x4 v1) { u32x4 w; w.x = pk2(v0[0], v0[1]); w.y = pk2(v0[2], v0[3]); w.z = pk2(v1[0], v1[1]); w.w = pk2(v1[2], v1[3]); return w; }
DI float bf2f(unsigned short b) { return __builtin_bit_cast(float, (unsigned)b << 16); }
DI float bflo(unsigned w) { return __builtin_bit_cast(float, w << 16); }
DI float bfhi(unsigned w) { return __builtin_bit_cast(float, w & 0xffff0000u); }
DI float wave_sum(float v) {
#pragma unroll
    for (int o = 1; o < 64; o <<= 1) v += __shfl_xor(v, o);
    return v;
}
#define DPP_ADD(v, ctrl) ((v) + __builtin_bit_cast(float, __builtin_amdgcn_update_dpp(0, __builtin_bit_cast(int, (v)), (ctrl), 0xF, 0xF, true)))
DI void swap32(unsigned& a, unsigned& b) { asm volatile("s_nop 1\n\tv_permlane32_swap_b32 %0, %1" : "+v"(a), "+v"(b)); }
DI void swap16(unsigned& a, unsigned& b) { asm volatile("s_nop 1\n\tv_permlane16_swap_b32 %0, %1" : "+v"(a), "+v"(b)); }
DI float half_sum_fast(float v) { v = DPP_ADD(v, 0xB1); v = DPP_ADD(v, 0x4E); v = DPP_ADD(v, 0x141); v = DPP_ADD(v, 0x140);
    unsigned a = __builtin_bit_cast(unsigned, v), b = a; swap16(a, b); return __builtin_bit_cast(float, a) + __builtin_bit_cast(float, b); }
DI float wave_sum_fast(float v) { v = DPP_ADD(v, 0xB1); v = DPP_ADD(v, 0x4E); v = DPP_ADD(v, 0x141); v = DPP_ADD(v, 0x140);
    unsigned a = __builtin_bit_cast(unsigned, v), b = a; swap16(a, b); v = __builtin_bit_cast(float, a) + __builtin_bit_cast(float, b);
    a = __builtin_bit_cast(unsigned, v); b = a; swap32(a, b); return __builtin_bit_cast(float, a) + __builtin_bit_cast(float, b); }
#define LDS_WAIT() asm volatile("s_waitcnt lgkmcnt(0)" ::: "memory")
DI f32x4 ldnt4(const float* p) { return __builtin_nontemporal_load((const f32x4*)p); }

DI void tr_item64(const float* W, int N, int k0, int n0, bf16_t* WT, int drow0a, int drow0b, int Kd, const float* kscale, LAS float* scr, int lane) {
    f32x4 v[16]; const int kr = lane >> 4, c4 = 4 * (lane & 15);
#pragma unroll
    for (int i = 0; i < 16; ++i) v[i] = ldnt4(W + (size_t)(k0 + 4 * i + kr) * N + n0 + c4);
#pragma unroll
    for (int i = 0; i < 16; ++i) { const int kk = 4 * i + kr; f32x4 x = v[i]; if (kscale) x = x * kscale[k0 + kk]; LAS float* d = scr + kk * 65 + c4; d[0] = x.x; d[1] = x.y; d[2] = x.z; d[3] = x.w; }
    LDS_WAIT();
    const int c = lane & 7;
#pragma unroll
    for (int j = 0; j < 8; ++j) { const int n = (lane >> 3) + 8 * j; const LAS float* q = scr + (8 * c) * 65 + n;
        u32x4 o; o.x = pk2(q[0 * 65], q[1 * 65]); o.y = pk2(q[2 * 65], q[3 * 65]); o.z = pk2(q[4 * 65], q[5 * 65]); o.w = pk2(q[6 * 65], q[7 * 65]);
        const int dr = n < 32 ? drow0a + n : drow0b + (n - 32);
        *(u32x4*)(WT + (size_t)dr * Kd + k0 + 8 * c) = o; }
    LDS_WAIT();
}
DI int win_drow(int n0) {
    if (n0 < 1536) return n0;
    if (n0 < 2048) { const int c = n0 - 1536, head = c >> 6, half = (c >> 5) & 1; return 1536 + (head >> 2) * 256 + half * 128 + (head & 3) * 32; }
    if (n0 < 2176) { const int c = n0 - 2048, head = c >> 6, half = (c >> 5) & 1; return 2048 + half * 128 + head * 32; }
    const int c = n0 - 2176; return 2048 + (c >> 6) * 128 + 64 + (c & 63);
}
DI void p0_prologue(const Args& a, LAS unsigned char* lds, int tid, int lane, int wave) {
    unsigned char* ws = a.ws;
    {
        float* mod = (float*)(ws + WS_MOD); LAS float* red = (LAS float*)lds; LAS float* sc = (LAS float*)(lds + 32768);
        if ((int)blockIdx.x < 6144 / 64) { for (int i = tid; i < 4096; i += NTHREADS) { const float cv = a.c[i]; sc[i] = cv / (1.f + expf(-cv)); } __syncthreads(); }
        for (int cb = blockIdx.x; cb < 6144 / 64; cb += gridDim.x) {
            const int cl = tid & 15, kg = tid >> 4, col = cb * 64 + 4 * cl;
            f32x4 acc[4];
#pragma unroll
            for (int q = 0; q < 4; ++q) acc[q] = (f32x4){0.f, 0.f, 0.f, 0.f};
#pragma unroll 16
            for (int kk = 0; kk < 32; ++kk) { const int k = kg * 32 + kk; const f32x4 w = ldnt4(a.w_ada + (size_t)k * 6144 + col);
#pragma unroll
                for (int q = 0; q < 4; ++q) acc[q] = acc[q] + w * sc[q * 1024 + k]; }
#pragma unroll
            for (int q = 0; q < 4; ++q) *(LAS f32x4*)(red + (kg * 4 + q) * 64 + 4 * cl) = acc[q];
            __syncthreads();
            if (tid < 256) { const int q = tid >> 6, c2 = tid & 63; float sum = 0.f; for (int g = 0; g < 32; ++g) sum += red[(g * 4 + q) * 64 + c2]; mod[q * 6144 + cb * 64 + c2] = sum + a.b_ada[cb * 64 + c2]; }
            __syncthreads();
        }
    }
    {
        float* cosT = (float*)(ws + WS_COS); float* sinT = (float*)(ws + WS_SIN);
        for (int idx = blockIdx.x * NTHREADS + tid; idx < T * 32; idx += gridDim.x * NTHREADS) {
            const int t = idx >> 5, i = idx & 31; const float ang = (float)a.pos[t] * INV_FREQ[i];
            const double ad = (double)ang, kq = rint(ad * 0.63661977236758134308);
            double y = fma(-kq, 1.5707963267948966192, ad); y = fma(-kq, 6.123233995736766036e-17, y);
            const int q = (int)((long long)kq & 3); const double y2 = y * y;
            const double sn = y * (1.0 + y2 * (-1.0 / 6 + y2 * (1.0 / 120 + y2 * (-1.0 / 5040 + y2 * (1.0 / 362880 + y2 * (-1.0 / 39916800))))));
            const double cs = 1.0 + y2 * (-0.5 + y2 * (1.0 / 24 + y2 * (-1.0 / 720 + y2 * (1.0 / 40320 + y2 * (-1.0 / 3628800 + y2 * (1.0 / 479001600))))));
            double co, si; if (q == 0) { co = cs; si = sn; } else if (q == 1) { co = -sn; si = cs; } else if (q == 2) { co = -cs; si = -sn; } else { co = sn; si = -cs; }
            cosT[idx] = (float)co; sinT[idx] = (float)si;
        }
    }
    {
        __syncthreads();
        LAS float* scr = (LAS float*)(lds + 8192 + wave * 16640);
        const int gw = blockIdx.x * NWAVES + wave, NGW = gridDim.x * NWAVES;
        constexpr int I_IN = 16 * 36, I_OUT = 16 * 16, NITEMS = I_IN + I_OUT;
        for (int it = gw; it < NITEMS; it += NGW) {
            int r = it;
            if (r < I_IN) { const int kb = r / 36, nb = r % 36; tr_item64(a.w_in, DIN, kb * 64, nb * 64, (bf16_t*)(ws + WS_WIN), win_drow(nb * 64), win_drow(nb * 64 + 32), 1024, nullptr, scr, lane); continue; } r -= I_IN;
            { const int kb = r / 16, nb = r % 16; const float* ks = (kb < 8) ? a.g_sb : (a.g_sw - 512); tr_item64(a.w_out, 1024, kb * 64, nb * 64, (bf16_t*)(ws + WS_WOUT), nb * 64, nb * 64 + 32, 1024, ks, scr, lane); }
        }
    }
}
constexpr int NEXPERT_ITEMS = 2 * (16 * 16 * 8) + 16 * 8 * 16;
DI void expert_items(const Args& a, LAS unsigned char* lds, int first, int count, int w, int nw, int lane, int wave) {
    asm volatile("" : "+v"(lane));
    unsigned char* ws = a.ws;
    LAS float* scr = (LAS float*)(lds + 8192 + wave * 16640);
    constexpr int I_G = 16 * 16 * 8;
    for (int it = first + w; it < first + count; it += nw) {
        int r = it;
        if (r < 2 * I_G) { const int up = r >= I_G; if (up) r -= I_G; const int e = r / 128, q = r % 128, kb = q / 8, nb = q % 8, c0 = nb * 64; const int dr = (c0 >> 7) * 256 + up * 128 + (c0 & 127);
            tr_item64((up ? a.w_up : a.w_gate) + (size_t)e * 1024 * 512, 512, kb * 64, c0, (bf16_t*)(ws + WS_WGU) + (size_t)e * 1024 * 1024, dr, dr + 32, 1024, nullptr, scr, lane); continue; } r -= 2 * I_G;
        { const int e = r / 128, q = r % 128, kb = q / 16, nb = q % 16; tr_item64(a.w_down + (size_t)e * 512 * 1024, 1024, kb * 64, nb * 64, (bf16_t*)(ws + WS_WD) + (size_t)e * 1024 * 512, nb * 64, nb * 64 + 32, 512, nullptr, scr, lane); }
    }
}

DI void p1_norm(const Args& a, int lane, int wave) {
    asm volatile("" : "+v"(lane));
    const float* mod = (const float*)(a.ws + WS_MOD); bf16_t* H = (bf16_t*)(a.ws + WS_H);
    const int gw = blockIdx.x * NWAVES + wave, NGW = gridDim.x * NWAVES;
    int bprev = -1; f32x4 ca[4], cb[4];
#pragma unroll 1
    for (int q4 = gw; q4 < T / 4; q4 += NGW) {
        const int r0 = q4 * 4, b = r0 / SEQ;
        if (b != bprev) { bprev = b;
#pragma unroll
            for (int j = 0; j < 4; ++j) { const int col = 4 * lane + 256 * j; const f32x4 g = *(const f32x4*)(a.g_mix + col), sc = *(const f32x4*)(mod + b * 6144 + 1024 + col); ca[j] = g * (sc + 1.0f); cb[j] = *(const f32x4*)(mod + b * 6144 + col); } }
        f32x4 v[4][4];
#pragma unroll
        for (int rr = 0; rr < 4; ++rr)
#pragma unroll
            for (int j = 0; j < 4; ++j) v[rr][j] = ldnt4(a.x + (size_t)(r0 + rr) * DM + 4 * lane + 256 * j);
#pragma unroll
        for (int rr = 0; rr < 4; ++rr) { float s = 0.f;
#pragma unroll
            for (int j = 0; j < 4; ++j) s += (v[rr][j].x * v[rr][j].x + v[rr][j].y * v[rr][j].y) + (v[rr][j].z * v[rr][j].z + v[rr][j].w * v[rr][j].w);
            const float rs = 1.0f / sqrtf(wave_sum_fast(s) * (1.0f / DM) + EPS);
            bf16_t* hr = H + (size_t)(r0 + rr) * DM;
#pragma unroll
            for (int j = 0; j < 4; ++j) { const f32x4 o = v[rr][j] * rs * ca[j] + cb[j]; u32x2 w; w.x = pk2(o.x, o.y); w.y = pk2(o.z, o.w); *(u32x2*)(hr + 4 * lane + 256 * j) = w; } }
    }
}
DI void p8_final(const Args& a, const LAS int* tstart, int lane, int wave, float* dst) {
    asm volatile("" : "+v"(lane));
    const float tscale = (STAMP_PHASE >= 0) ? *(const float*)(a.ws + WS_STAMP + 256) : 1.0f;
    const float* mod = (const float*)(a.ws + WS_MOD); const bf16_t* X1 = (const bf16_t*)(a.ws + WS_X1); const bf16_t* Y = (const bf16_t*)(a.ws + WS_Y); const int* tpos = (const int*)(a.ws + WS_TPOS);
    const int gw = blockIdx.x * NWAVES + wave, NGW = gridDim.x * NWAVES;
    for (int ch = gw; ch < T / 16; ch += NGW) {
        const int row0 = ch * 16, b = row0 / SEQ;
        f32x4 g[4], g2[4];
#pragma unroll
        for (int j = 0; j < 4; ++j) { g[j] = *(const f32x4*)(a.g_fin + 4 * lane + 256 * j); g2[j] = *(const f32x4*)(mod + b * 6144 + 5120 + 4 * lane + 256 * j); }
        const int tp = tpos[row0 + (lane & 15)];
        u32x2 xn[2][4], yn[2][4];
#pragma unroll
        for (int rr = 0; rr < 2; ++rr) { const int tpr = __builtin_amdgcn_readlane(tp, rr); const size_t srow = (size_t)tstart[tpr >> 16] * 256 + (tpr & 0xffff);
#pragma unroll
            for (int j = 0; j < 4; ++j) { xn[rr][j] = *(const u32x2*)(X1 + (size_t)(row0 + rr) * DM + 4 * lane + 256 * j); yn[rr][j] = *(const u32x2*)(Y + srow * DM + 4 * lane + 256 * j); } }
#pragma unroll 1
        for (int r2 = 0; r2 < 16; r2 += 2) {
            f32x4 v[2][4]; u32x2 xw[2][4], yw[2][4];
#pragma unroll
            for (int rr = 0; rr < 2; ++rr)
#pragma unroll
                for (int j = 0; j < 4; ++j) { xw[rr][j] = xn[rr][j]; yw[rr][j] = yn[rr][j]; }
            if (r2 + 2 < 16) {
#pragma unroll
                for (int rr = 0; rr < 2; ++rr) { const int tpr = __builtin_amdgcn_readlane(tp, r2 + 2 + rr); const size_t srow = (size_t)tstart[tpr >> 16] * 256 + (tpr & 0xffff);
#pragma unroll
                    for (int j = 0; j < 4; ++j) { xn[rr][j] = *(const u32x2*)(X1 + (size_t)(row0 + r2 + 2 + rr) * DM + 4 * lane + 256 * j); yn[rr][j] = *(const u32x2*)(Y + srow * DM + 4 * lane + 256 * j); } } }
#pragma unroll
            for (int rr = 0; rr < 2; ++rr) { float s = 0.f;
#pragma unroll
                for (int j = 0; j < 4; ++j) { v[rr][j] = (f32x4){bflo(xw[rr][j].x), bfhi(xw[rr][j].x), bflo(xw[rr][j].y), bfhi(xw[rr][j].y)} + g2[j] * (f32x4){bflo(yw[rr][j].x), bfhi(yw[rr][j].x), bflo(yw[rr][j].y), bfhi(yw[rr][j].y)};
                    s += (v[rr][j].x * v[rr][j].x + v[rr][j].y * v[rr][j].y) + (v[rr][j].z * v[rr][j].z + v[rr][j].w * v[rr][j].w); }
                const float rs = 1.0f / sqrtf(wave_sum_fast(s) * (1.0f / DM) + EPS); float* orow = dst + (size_t)(row0 + r2 + rr) * DM;
#pragma unroll
                for (int j = 0; j < 4; ++j) *(f32x4*)(orow + 4 * lane + 256 * j) = v[rr][j] * (rs * tscale) * g[j]; }
        }
    }
}
constexpr int RT_T0H = 0, RT_T0L = 32768, RT_T1H = 65536, RT_T1L = 73728, RT_CA = 81920, RT_CB = 86016, RT_IMG = 90112, RT_PART = 90112, RT_STRIDE = 102400, RT_BIAS = 90112, RT_WCNT = 90240;
DI void router_tables(const Args& a, int lane) {
    const float* mod = (const float*)(a.ws + WS_MOD);
    for (int tk = blockIdx.x; tk < 512; tk += gridDim.x) {
        const int b = tk >> 7, kg = tk & 127, col = lane;
        if (col < 20) {
            unsigned char* img = a.ws + WS_RTAB + (size_t)b * RT_STRIDE;
            float part = 0.f; u32x4 hi, lo; f32x4 cav[2], cbv[2];
#pragma unroll
            for (int e = 0; e < 8; e += 2) { float wp[2];
#pragma unroll
                for (int h = 0; h < 2; ++h) { const int k = kg * 8 + e + h; const float w = col < 4 ? a.w_rg[k * 4 + col] : a.w_re[k * 16 + (col - 4)];
                    const float ca = a.g_ffn[k] * (mod[b * 6144 + 4096 + k] + 1.0f), cb = mod[b * 6144 + 3072 + k]; wp[h] = ca * w; part += cb * w; cav[(e + h) >> 2][(e + h) & 3] = ca; cbv[(e + h) >> 2][(e + h) & 3] = cb; }
                const unsigned hw = pk2(wp[0], wp[1]); hi[e >> 1] = hw; lo[e >> 1] = pk2(wp[0] - bflo(hw), wp[1] - bfhi(hw)); }
            if (col < 16) { *(u32x4*)(img + RT_T0H + (kg * 16 + col) * 16) = hi; *(u32x4*)(img + RT_T0L + (kg * 16 + col) * 16) = lo; }
            else { *(u32x4*)(img + RT_T1H + (kg * 4 + col - 16) * 16) = hi; *(u32x4*)(img + RT_T1L + (kg * 4 + col - 16) * 16) = lo; }
            *(float*)(img + RT_PART + (kg * 20 + col) * 4) = part;
            if (col == 0) { *(f32x4*)(img + RT_CA + kg * 32) = cav[0]; *(f32x4*)(img + RT_CA + kg * 32 + 16) = cav[1]; *(f32x4*)(img + RT_CB + kg * 32) = cbv[0]; *(f32x4*)(img + RT_CB + kg * 32 + 16) = cbv[1]; }
        }
    }
}
DI float rows4_sum(float v) { unsigned x = __builtin_bit_cast(unsigned, v), y = x; swap16(x, y); v = __builtin_bit_cast(float, x) + __builtin_bit_cast(float, y);
    x = __builtin_bit_cast(unsigned, v); y = x; swap32(x, y); return __builtin_bit_cast(float, x) + __builtin_bit_cast(float, y); }
typedef __bf16 bf16x2n_t __attribute__((ext_vector_type(2)));
DI float dot2sq(unsigned w, float c) { const bf16x2n_t v = __builtin_bit_cast(bf16x2n_t, w); return __builtin_amdgcn_fdot2_f32_bf16(v, v, c, false); }
DI void p5_router(const Args& a, LAS unsigned char* lds, int tid_, int lane_, int wave, int rep = 0) {
    int tid = threadIdx.x; asm volatile("" : "+v"(tid)); const int lane = tid & 63;
    const float* mod = (const float*)(a.ws + WS_MOD); bf16_t* H = (bf16_t*)(a.ws + WS_H);
    unsigned* cnt = (unsigned*)(a.ws + WS_CTL) + CW_CNT + 2048 * rep; int* list = (int*)(a.ws + WS_LIST); f32x2* wts = (f32x2*)(a.ws + WS_WTS);
    int* tpos = (int*)(a.ws + WS_TPOS); const bf16_t* X1 = (const bf16_t*)(a.ws + WS_X1);
    const int fr = lane & 15, fq = lane >> 4;
    LAS int* wcnt = (LAS int*)(lds + RT_WCNT);
    LAS float* bias = (LAS float*)(lds + RT_BIAS);
    int bprev = -1;
    for (int it = blockIdx.x; it < T / 128; it += gridDim.x) {
        const int row0 = it * 128 + wave * 16, b = row0 / SEQ; const bool newtab = b != bprev; bprev = b;
        const unsigned char* img = a.ws + WS_RTAB + (size_t)b * RT_STRIDE;
        float bp[8];
        if (newtab) {
#pragma unroll
            for (int i = 0; i < 11; ++i) __builtin_amdgcn_global_load_lds((const unsigned*)(img + ((i * 8 + wave) * 64 + lane) * 16), (LAS unsigned*)(lds + (i * 8 + wave) * 1024), 16, 0, 0);
#pragma unroll
            for (int q = 0; q < 8; ++q) bp[q] = tid < 320 ? *(const float*)(img + RT_PART + (((tid & 15) * 8 + q) * 20 + (tid >> 4)) * 4) : 0.f;
        }
        asm volatile("" ::: "memory");
        u32x4 xr[32];
        const bf16_t* xrow = X1 + (size_t)(row0 + fr) * DM + 8 * fq;
#pragma unroll
        for (int s_ = 0; s_ < 32; ++s_) xr[s_] = *(const u32x4*)(xrow + 32 * s_);
        asm volatile("s_waitcnt vmcnt(32)" ::: "memory");
        if (newtab) {
            float ps = ((bp[0] + bp[1]) + (bp[2] + bp[3])) + ((bp[4] + bp[5]) + (bp[6] + bp[7]));
            ps = DPP_ADD(ps, 0xB1); ps = DPP_ADD(ps, 0x4E); ps = DPP_ADD(ps, 0x141); ps = DPP_ADD(ps, 0x140);
            if (tid < 320 && (tid & 15) == 0) bias[tid >> 4] = ps;
            __syncthreads();
        }
        f32x4 acc0 = (f32x4){0.f, 0.f, 0.f, 0.f}, acc1 = acc0; float ssq = 0.f;
        {   const LAS unsigned char* t0 = lds + (fq * 16 + fr) * 16; const LAS unsigned char* t1 = lds + RT_T1H + (fq * 4 + (fr & 3)) * 16;
#pragma unroll
            for (int s_ = 0; s_ < 32; ++s_) { const bf16x8 xb = __builtin_bit_cast(bf16x8, xr[s_]);
                const bf16x8 w0h = *(const LAS bf16x8*)(t0 + s_ * 1024), w0l = *(const LAS bf16x8*)(t0 + RT_T0L + s_ * 1024), w1h = *(const LAS bf16x8*)(t1 + s_ * 256), w1l = *(const LAS bf16x8*)(t1 + (RT_T1L - RT_T1H) + s_ * 256);
                acc0 = __builtin_amdgcn_mfma_f32_16x16x32_bf16(w0h, xb, acc0, 0, 0, 0); acc1 = __builtin_amdgcn_mfma_f32_16x16x32_bf16(w1h, xb, acc1, 0, 0, 0);
                acc0 = __builtin_amdgcn_mfma_f32_16x16x32_bf16(w0l, xb, acc0, 0, 0, 0); acc1 = __builtin_amdgcn_mfma_f32_16x16x32_bf16(w1l, xb, acc1, 0, 0, 0);
                ssq = dot2sq(xr[s_].x, ssq); ssq = dot2sq(xr[s_].y, ssq); ssq = dot2sq(xr[s_].z, ssq); ssq = dot2sq(xr[s_].w, ssq); __builtin_amdgcn_sched_barrier(0); } }
        const float rs = 1.0f / sqrtf(rows4_sum(ssq) * (1.0f / DM) + EPS);
        float lg[4], l1[4];
#pragma unroll
        for (int i = 0; i < 4; ++i) { lg[i] = rs * acc0[i] + bias[4 * fq + i]; l1[i] = rs * acc1[i] + bias[16 + i]; }
        int g = 0; float gm = lg[0];
#pragma unroll
        for (int i = 1; i < 4; ++i) if (lg[i] > gm) { gm = lg[i]; g = i; }
        float gs = 0.f;
#pragma unroll
        for (int i = 0; i < 4; ++i) gs += expf(lg[i] - gm);
        const float gprob = 1.0f / gs;
        float el[4];
#pragma unroll
        for (int i = 0; i < 4; ++i) { const float o = __shfl(lg[i], (g < 3 ? fr + 16 * (g + 1) : lane)); el[i] = g < 3 ? o : l1[i]; }
        int i0 = 0; float m0 = el[0];
#pragma unroll
        for (int i = 1; i < 4; ++i) if (el[i] > m0) { m0 = el[i]; i0 = i; }
        int i1 = -1; float m1 = 0.f;
#pragma unroll
        for (int i = 0; i < 4; ++i) if (i != i0 && (i1 < 0 || el[i] > m1)) { m1 = el[i]; i1 = i; }
        const float ex = expf(m1 - m0), w0 = 1.0f / (1.0f + ex), w1 = ex * w0;
        const int ea = i0 < i1 ? i0 : i1, eb = i0 < i1 ? i1 : i0; const float mywa = (i0 < i1 ? w0 : w1) * gprob, mywb = (i0 < i1 ? w1 : w0) * gprob;
        int mybucket = g * 6 + (ea * (7 - ea)) / 2 + (eb - ea - 1);
        {   bf16_t* hrow = H + (size_t)(row0 + fr) * DM + 8 * fq; const LAS unsigned char* cp = lds + RT_CA + fq * 32;
#pragma unroll
            for (int s_ = 0; s_ < 32; ++s_) { const f32x4 ca0 = *(const LAS f32x4*)(cp + s_ * 128), ca1 = *(const LAS f32x4*)(cp + s_ * 128 + 16), cb0 = *(const LAS f32x4*)(cp + (RT_CB - RT_CA) + s_ * 128), cb1 = *(const LAS f32x4*)(cp + (RT_CB - RT_CA) + s_ * 128 + 16);
                const u32x4 xw = xr[s_]; const f32x4 v0 = (f32x4){bflo(xw.x), bfhi(xw.x), bflo(xw.y), bfhi(xw.y)}, v1 = (f32x4){bflo(xw.z), bfhi(xw.z), bflo(xw.w), bfhi(xw.w)};
                *(u32x4*)(hrow + 32 * s_) = pack8(v0 * rs * ca0 + cb0, v1 * rs * ca1 + cb1); __builtin_amdgcn_sched_barrier(0); } }
        if (lane >= 16) mybucket = -1;
        int myrank = 0;
        for (int q = 0; q < NBUCKET; ++q) { const unsigned long long mk = __ballot(mybucket == q); if (mybucket == q) myrank = __popcll(mk & ((1ull << lane) - 1ull)); if (lane == 0) wcnt[wave * NBUCKET + q] = __popcll(mk); }
        __syncthreads();
        if (tid < NBUCKET) { int tot = 0, pre[NWAVES];
#pragma unroll
            for (int w = 0; w < NWAVES; ++w) { pre[w] = tot; tot += wcnt[w * NBUCKET + tid]; }
            const unsigned base = tot ? atomicAdd(cnt + CNT_STRIDE * tid, (unsigned)tot) : 0u;
#pragma unroll
            for (int w = 0; w < NWAVES; ++w) wcnt[w * NBUCKET + tid] = (int)base + pre[w]; }
        __syncthreads();
        if (lane < 16) { const int p = wcnt[wave * NBUCKET + mybucket] + myrank; list[mybucket * T + p] = row0 + lane; wts[mybucket * T + p] = (f32x2){mywa, mywb}; tpos[row0 + lane] = (mybucket << 16) | p; }
        __syncthreads();
    }
}

struct GUnit { const bf16_t* A; const int* aidx; int nvalid; const bf16_t* B0; const bf16_t* B1; int pm, pn, lbase; };
namespace pg8 {
constexpr int BM = 256, BK = 64, HALF = 128, HTB = HALF * BK * 2, STAGE_BYTES = 8 * HTB;
DI int lds_byte(int r, int c) { const int st = (r >> 4) * 2 + (c >> 5), rr = r & 15, cc = c & 31, ob = rr * 64 + cc * 2; return st * 1024 + (ob ^ (((ob >> 9) & 1) << 5)); }
DI void stage_rc(int b, int& R, int& C) { const int st = b / 1024, sb = b % 1024, swz = sb ^ (((sb >> 9) & 1) << 5); R = (st >> 1) * 16 + swz / 64; C = (st & 1) * 32 + (swz % 64) / 2; }
DI int perm32(int rho) { const int n = rho >> 4, i = rho & 15; return 8 * (i >> 2) + 4 * n + (i & 3); }
DI void a_offsets(const GUnit& u, int K, int tid_, unsigned (&vo)[2][2]) {
    asm volatile("" : "+v"(tid_));
#pragma unroll
    for (int i = 0; i < 2; ++i) { int R, C; stage_rc(tid_ * 16 + i * 8192, R, C);
#pragma unroll
        for (int h = 0; h < 2; ++h) { const int r = h * HALF + R; const int gr = u.aidx ? u.aidx[r < u.nvalid ? r : 0] : r; vo[h][i] = ((unsigned)gr * (unsigned)K + (unsigned)C) * 2u; } }
}
template <class Sched, class Epi, bool ALIGN_EPI, int K, int ldb, int nsplit>
DI void gemm_phase(LAS unsigned char* lds, const Sched& S, const Epi& E) {
    int tid = threadIdx.x; asm volatile("" : "+v"(tid));
    const int wid = __builtin_amdgcn_readfirstlane(tid >> 6), lane = tid & 63, wr = wid >> 2, wc = wid & 3, fr = lane & 15, fq = lane >> 4;
    const int nt = K / BK;
    unsigned voffB[2];
#pragma unroll
    for (int i = 0; i < 2; ++i) { int R, C; stage_rc(tid * 16 + i * 8192, R, C); const int Rb = (R & ~31) + perm32(R & 31); voffB[i] = ((unsigned)Rb * (unsigned)ldb + (unsigned)C) * 2u; }
    const size_t hB = (size_t)HALF * ldb * 2;
    const unsigned ldsw = (unsigned)wid * 1024u;
    const int aoff = lds_byte(wr * 64 + fr, fq * 8), boff = lds_byte(wc * 32 + fr, fq * 8);
#define PG8_SA(b, h) (((b) * 2 + (h)) * HTB)
#define PG8_SB(b, h) ((4 + (b) * 2 + (h)) * HTB)
#define PG8_STAGE(bufoff, gbase, voff) do { _Pragma("unroll") for (int _i = 0; _i < 2; ++_i) \
        __builtin_amdgcn_global_load_lds((const unsigned*)((const char*)(gbase) + (voff)[_i]), (LAS unsigned*)(lds + (bufoff) + ldsw + _i * 8192), 16, 0, 0); } while (0)
#define PG8_LDA(dst, b, h) do { _Pragma("unroll") for (int m = 0; m < 4; ++m) _Pragma("unroll") for (int k = 0; k < 2; ++k) dst[m][k] = *(const LAS bf16x8*)(lds + PG8_SA(b, h) + aoff + m * 2048 + k * 1024); } while (0)
#define PG8_LDB(dst, b, h) do { _Pragma("unroll") for (int n = 0; n < 2; ++n) _Pragma("unroll") for (int k = 0; k < 2; ++k) dst[n][k] = *(const LAS bf16x8*)(lds + PG8_SB(b, h) + boff + n * 2048 + k * 1024); } while (0)
#define PG8_MMA(ai, bj, At, Bt) do { __builtin_amdgcn_s_setprio(1); _Pragma("unroll") for (int m = 0; m < 4; ++m) _Pragma("unroll") for (int n = 0; n < 2; ++n) _Pragma("unroll") for (int k = 0; k < 2; ++k) \
        acc[ai][bj][m][n] = __builtin_amdgcn_mfma_f32_16x16x32_bf16(Bt[n][k], At[m][k], acc[ai][bj][m][n], 0, 0, 0); __builtin_amdgcn_s_setprio(0); } while (0)
#define PG8_WAIT_V(n) asm volatile("s_waitcnt vmcnt(" #n ")" ::: "memory")
#define PG8_WAIT_L(n) asm volatile("s_waitcnt lgkmcnt(" #n ")" ::: "memory")
#define PG8_BAR __builtin_amdgcn_s_barrier()
#define PG8_SCHED __builtin_amdgcn_sched_barrier(0)
#define PG8_AK(u, kt) ((const char*)(u).A + (size_t)(kt) * (BK * 2))
#define PG8_BK(u, kt) ((kt) < nsplit ? (const char*)(u).B0 + (size_t)(kt) * (BK * 2) : (const char*)(u).B1 + (size_t)((kt) - nsplit) * (BK * 2))
    GUnit cur, nxt; int ui = 0;
    if (!S.next(0, cur)) return;
    f32x4 acc[2][2][4][2];
#pragma unroll
    for (int a = 0; a < 2; ++a)
#pragma unroll
        for (int b = 0; b < 2; ++b)
#pragma unroll
            for (int m = 0; m < 4; ++m)
#pragma unroll
                for (int n = 0; n < 2; ++n) acc[a][b][m][n] = (f32x4){0.f, 0.f, 0.f, 0.f};
    bf16x8 At[4][2], B0[2][2], B1[2][2];
    unsigned voffA[2][2];
    a_offsets(cur, K, tid, voffA);
    if constexpr (Epi::MIDK) E.prep(cur, 0, tid);
    {
        const char* a0 = PG8_AK(cur, 0); const char* b0 = PG8_BK(cur, 0); const char* a1 = PG8_AK(cur, 1); const char* b1 = PG8_BK(cur, 1);
        PG8_STAGE(PG8_SB(0, 0), b0, voffB); PG8_STAGE(PG8_SB(0, 1), b0 + hB, voffB); PG8_STAGE(PG8_SA(0, 0), a0, voffA[0]); PG8_STAGE(PG8_SA(0, 1), a0, voffA[1]);
        if (wr == 1) PG8_BAR;
        PG8_WAIT_V(2); PG8_BAR;
        PG8_STAGE(PG8_SB(1, 0), b1, voffB); PG8_STAGE(PG8_SA(1, 0), a1, voffA[0]); PG8_STAGE(PG8_SB(1, 1), b1 + hB, voffB);
        PG8_WAIT_V(6); PG8_BAR;
    }
    for (;;) {
        const bool has_next = S.next(ui + 1, nxt);
        if (!has_next) nxt = cur;
        for (int t = 0; t < nt; t += 2) {
            if constexpr (Epi::MIDK) { if (t == nt / 2) E.midk(acc, cur, wr, wc, fr, fq, ui & 1); }
            const bool last = (t == nt - 2);
            const char* a1 = PG8_AK(cur, t + 1);
            const char* a2 = last ? PG8_AK(nxt, 0) : PG8_AK(cur, t + 2); const char* b2 = last ? PG8_BK(nxt, 0) : PG8_BK(cur, t + 2);
            const char* a3 = last ? PG8_AK(nxt, 1) : PG8_AK(cur, t + 3); const char* b3 = last ? PG8_BK(nxt, 1) : PG8_BK(cur, t + 3);
            PG8_LDB(B0, 0, 0); PG8_LDB(B1, 0, 1); PG8_SCHED; PG8_LDA(At, 0, 0); PG8_STAGE(PG8_SA(1, 1), a1, voffA[1]);
            if (last) a_offsets(nxt, K, tid, voffA);
            PG8_WAIT_V(8); PG8_WAIT_L(0); PG8_BAR; PG8_MMA(0, 0, At, B0); PG8_MMA(0, 1, At, B1); PG8_BAR; PG8_SCHED;
            PG8_LDA(At, 0, 1); PG8_STAGE(PG8_SB(0, 0), b2, voffB); PG8_STAGE(PG8_SB(0, 1), b2 + hB, voffB); PG8_STAGE(PG8_SA(0, 0), a2, voffA[0]);
            PG8_WAIT_V(8); PG8_WAIT_L(0); PG8_BAR; PG8_MMA(1, 0, At, B0); PG8_MMA(1, 1, At, B1); PG8_BAR; PG8_SCHED;
            PG8_LDB(B0, 1, 0); PG8_LDB(B1, 1, 1); PG8_SCHED; PG8_LDA(At, 1, 0); PG8_STAGE(PG8_SA(0, 1), a2, voffA[1]);
            PG8_WAIT_V(8); PG8_WAIT_L(0); PG8_BAR; PG8_MMA(0, 0, At, B0); PG8_MMA(0, 1, At, B1); PG8_BAR; PG8_SCHED;
            PG8_LDA(At, 1, 1); PG8_STAGE(PG8_SB(1, 0), b3, voffB); PG8_STAGE(PG8_SB(1, 1), b3 + hB, voffB); PG8_STAGE(PG8_SA(1, 0), a3, voffA[0]);
            PG8_WAIT_V(8); PG8_WAIT_L(0); PG8_BAR; PG8_MMA(1, 0, At, B0); PG8_MMA(1, 1, At, B1); PG8_BAR; PG8_SCHED;
        }
        if constexpr (ALIGN_EPI) { if (wr == 0) PG8_BAR; }
        E(acc, cur, wr, wc, fr, fq, ui & 1);
        if (!has_next) break;
        if constexpr (Epi::MIDK) E.prep(nxt, (ui + 1) & 1, tid);
#pragma unroll
        for (int a = 0; a < 2; ++a)
#pragma unroll
            for (int b = 0; b < 2; ++b)
#pragma unroll
                for (int m = 0; m < 4; ++m)
#pragma unroll
                    for (int n = 0; n < 2; ++n) acc[a][b][m][n] = (f32x4){0.f, 0.f, 0.f, 0.f};
        cur = nxt; ++ui;
        if constexpr (ALIGN_EPI) { if (wr == 1) PG8_BAR; }
    }
    PG8_WAIT_V(0);
    if constexpr (!ALIGN_EPI) { if (wr == 0) PG8_BAR; }
    PG8_BAR;
#undef PG8_SA
#undef PG8_SB
#undef PG8_STAGE
#undef PG8_LDA
#undef PG8_LDB
#undef PG8_MMA
#undef PG8_WAIT_V
#undef PG8_WAIT_L
#undef PG8_BAR
#undef PG8_SCHED
#undef PG8_AK
#undef PG8_BK
}
}
struct DenseSched {
    const bf16_t* A; const bf16_t* Bt; int K, nM, nN;
    DI bool next(int i, GUnit& u) const {
        const int nwg = nM * nN; const long L = (long)i * (int)gridDim.x + (int)blockIdx.x; if (L >= nwg) return false;
        int wgid = (int)L; { const int q = nwg / 8, r = nwg % 8, xcd = wgid % 8, off = wgid / 8; wgid = (xcd < r ? xcd * (q + 1) : r * (q + 1) + (xcd - r) * q) + off; }
        const int nig = 8 * nN, gid = wgid / nig, fm = gid * 8, gsz = (nM - fm) < 8 ? (nM - fm) : 8;
        u.pm = fm + ((wgid % nig) % gsz); u.pn = (wgid % nig) / gsz;
        u.A = A + (size_t)u.pm * 256 * K; u.aidx = nullptr; u.nvalid = 256; u.B0 = Bt + (size_t)u.pn * 256 * K; u.B1 = u.B0; u.lbase = 0; return true; }
};
template <bool up> DI void moe_fill_unit(GUnit& u, int ti, int pn, const LAS int* tstart, const unsigned* cnt, const int* list, const bf16_t* A, const bf16_t* W) {
    int b = 0;
    for (int q = 1; q < NBUCKET; ++q) if (__builtin_amdgcn_readfirstlane(tstart[q]) <= ti) b = q;
    const int rt = ti - __builtin_amdgcn_readfirstlane(tstart[b]); const int g = b / 6, p = b % 6; const int ea = 4 * g + (p < 3 ? 0 : (p < 5 ? 1 : 2)), eb = 4 * g + (p < 3 ? p + 1 : (p < 5 ? p - 1 : 3));
    u.pm = ti; u.pn = pn; u.lbase = b * T + rt * 256; const int nv = __builtin_amdgcn_readfirstlane((int)cnt[CNT_STRIDE * b]) - rt * 256; u.nvalid = nv < 256 ? nv : 256;
    if (up) { u.A = A; u.aidx = list + u.lbase; const int e = pn < 4 ? ea : eb; u.B0 = W + (size_t)e * 1024 * 1024 + (size_t)(pn & 3) * 256 * 1024; u.B1 = u.B0; }
    else { u.A = A + (size_t)ti * 256 * 1024; u.aidx = nullptr; u.B0 = W + (size_t)ea * 1024 * 512 + (size_t)pn * 256 * 512; u.B1 = W + (size_t)eb * 1024 * 512 + (size_t)pn * 256 * 512; }
}
template <int NT, bool up> struct MoeSched {
    const LAS int* tstart; const unsigned* cnt; const int* list; const bf16_t* A; const bf16_t* W;
    DI bool next(int i, GUnit& u) const {
        const int ntile = __builtin_amdgcn_readfirstlane(tstart[NBUCKET]), nwg = ntile * NT; const int L0 = i * (int)gridDim.x + (int)blockIdx.x; if (L0 >= nwg) return false;
        int L = L0; { const int q = nwg / 8, r = nwg % 8, xcd = L0 % 8, off = L0 / 8; L = (xcd < r ? xcd * (q + 1) : r * (q + 1) + (xcd - r) * q) + off; }
        moe_fill_unit<up>(u, L / NT, L % NT, tstart, cnt, list, A, W); return true;
    }
};
struct MoeCut { int x, tiles_x, cstart, left, nY; };
DI MoeCut moe_cut(int ntile) { MoeCut c; c.x = (int)blockIdx.x & 7; const int q = ntile / 8, r = ntile % 8; c.tiles_x = q + (c.x < r ? 1 : 0); c.cstart = c.x * q + (c.x < r ? c.x : r); c.left = 8 * (c.tiles_x - 16); c.nY = 32 - c.left; return c; }
template <bool up, int MODE> struct MoeSplitSched {
    const LAS int* tstart; const unsigned* cnt; const int* list; const bf16_t* A; const bf16_t* W; MoeCut c;
    DI bool next(int i, GUnit& u) const {
        const int w = (int)blockIdx.x >> 3; int ti, pn;
        if (MODE == 1) { if (i >= 4) return false; const int off = i * 32 + w; ti = c.cstart + (off >> 3); pn = off & 7; }
        else if (MODE == 2 && up) { if (i > 0) return false; const int off = 128 + w; ti = c.cstart + (off >> 3); pn = off & 7; }
        else if (MODE == 2) { if (i > 0) return false; const int d = w - c.left; ti = c.cstart + (d >> 2); pn = d & 3; }
        else { const int e = i * 32 + w, rem = 4 * c.tiles_x - c.nY; if (e >= rem) return false;
            if (e < 64 - c.nY) { const int d = c.nY + e; ti = c.cstart + (d >> 2); pn = d & 3; } else { const int l = e - (64 - c.nY); ti = c.cstart + 16 + (l >> 2); pn = l & 3; } }
        moe_fill_unit<up>(u, ti, pn, tstart, cnt, list, A, W); return true;
    }
};

struct EpiProj { static constexpr bool MIDK = false;
    bf16_t *qsb, *vtsb, *qsw, *ksw, *vtsw; const float *cosT, *sinT;
    DI void operator()(const f32x4 (&acc)[2][2][4][2], const GUnit& u, int wr, int wc, int fr, int fq, int) const {
        const int pn = u.pn, rowb = u.pm * 256 + wr * 64 + fr;
        if (pn < 4) {
            bf16_t* base = qsb + (size_t)(pn >> 1) * ((WS_KSB - WS_QSB) / 2); const float sc = pn < 2 ? QSCALE : 1.0f; const int colt = (pn & 1) * 256 + wc * 32 + 8 * fq;
#pragma unroll
            for (int ai = 0; ai < 2; ++ai)
#pragma unroll
                for (int m = 0; m < 4; ++m) { const size_t row = rowb + ai * 128 + m * 16;
#pragma unroll
                    for (int bj = 0; bj < 2; ++bj) *(u32x4*)(base + row * 512 + colt + bj * 128) = pack8(acc[ai][bj][m][0] * sc, acc[ai][bj][m][1] * sc); }
        } else if (pn < 6 || (pn == 8 && wc >= 2)) {
            bf16_t* base = pn < 6 ? vtsb : vtsw; const int NF = pn < 6 ? 512 : 128, c0 = pn < 6 ? (pn - 4) * 256 + wc * 32 + 8 * fq : (wc * 32 - 64) + 8 * fq, bjs = pn < 6 ? 128 : 64;
#pragma unroll
            for (int ai = 0; ai < 2; ++ai)
#pragma unroll
                for (int m = 0; m < 4; ++m) { const int row = rowb + ai * 128 + m * 16; bf16_t* bp = base + ((size_t)(row >> 5) * NF + c0) * 32 + (row & 31);
#pragma unroll
                    for (int bj = 0; bj < 2; ++bj)
#pragma unroll
                        for (int n = 0; n < 2; ++n)
#pragma unroll
                            for (int j = 0; j < 4; ++j) bp[(bj * bjs + 4 * n + j) * 32] = (bf16_t)f2bf(acc[ai][bj][m][n][j]); }
        } else {
            const bool isq = pn < 8; bf16_t* base = isq ? qsw : ksw; const int pitch = isq ? 512 : 128; const int head = isq ? (pn - 6) * 4 + wc : wc; const float sc = isq ? QSCALE : 1.0f;
#pragma unroll
            for (int ai = 0; ai < 2; ++ai)
#pragma unroll
                for (int m = 0; m < 4; ++m) { const size_t row = rowb + ai * 128 + m * 16;
                    const f32x4 c0 = *(const f32x4*)(cosT + row * 32 + 8 * fq), c1 = *(const f32x4*)(cosT + row * 32 + 8 * fq + 4);
                    const f32x4 s0 = *(const f32x4*)(sinT + row * 32 + 8 * fq), s1 = *(const f32x4*)(sinT + row * 32 + 8 * fq + 4);
                    const f32x4 x10 = acc[ai][0][m][0], x11 = acc[ai][0][m][1], x20 = acc[ai][1][m][0], x21 = acc[ai][1][m][1];
                    const f32x4 o10 = (x10 * c0 - x20 * s0) * sc, o11 = (x11 * c1 - x21 * s1) * sc, o20 = (x20 * c0 + x10 * s0) * sc, o21 = (x21 * c1 + x11 * s1) * sc;
                    *(u32x4*)(base + row * pitch + head * 64 + 8 * fq) = pack8(o10, o11); *(u32x4*)(base + row * pitch + head * 64 + 32 + 8 * fq) = pack8(o20, o21); }
        }
    }
};
struct EpiWout {
    static constexpr bool MIDK = true;
    const float* mod; bf16_t* x1; const float* x; const float* ssq; LAS float* tab;
    DI void prep(const GUnit& u, int par, int tid) const {
        if (tid < 256) { const size_t row = (size_t)u.pm * 256 + tid; const f32x4 a0 = *(const f32x4*)(ssq + row * 16), a1 = *(const f32x4*)(ssq + row * 16 + 4), b0 = *(const f32x4*)(ssq + row * 16 + 8), b1 = *(const f32x4*)(ssq + row * 16 + 12);
            const float sa = ((a0.x + a0.y) + (a0.z + a0.w)) + ((a1.x + a1.y) + (a1.z + a1.w)), sb = ((b0.x + b0.y) + (b0.z + b0.w)) + ((b1.x + b1.y) + (b1.z + b1.w));
            const float rsb = 1.0f / sqrtf(sa * (1.0f / 512.0f) + EPS), rsw = 1.0f / sqrtf(sb * (1.0f / 512.0f) + EPS);
            *(LAS f32x2*)(tab + (par * 256 + tid) * 2) = (f32x2){rsb / rsw, rsw}; }
        else tab[1024 + par * 256 + (tid - 256)] = mod[((u.pm * 256) / SEQ) * 6144 + 2048 + u.pn * 256 + (tid - 256)];
    }
    DI void midk(f32x4 (&acc)[2][2][4][2], const GUnit& u, int wr, int wc, int fr, int fq, int par) const {
#pragma unroll
        for (int ai = 0; ai < 2; ++ai)
#pragma unroll
            for (int m = 0; m < 4; ++m) { const float ratio = tab[(par * 256 + ai * 128 + wr * 64 + m * 16 + fr) * 2];
#pragma unroll
                for (int bj = 0; bj < 2; ++bj)
#pragma unroll
                    for (int n = 0; n < 2; ++n) acc[ai][bj][m][n] = acc[ai][bj][m][n] * ratio; }
    }
    DI void operator()(f32x4 (&acc)[2][2][4][2], const GUnit& u, int wr, int wc, int fr, int fq, int par) const {
        const int rowb = u.pm * 256 + wr * 64 + fr, colb = u.pn * 256 + wc * 32 + 8 * fq; const int b = (u.pm * 256) / SEQ;
        f32x4 gt[2][2];
#pragma unroll
        for (int bj = 0; bj < 2; ++bj)
#pragma unroll
            for (int n = 0; n < 2; ++n) gt[bj][n] = *(const LAS f32x4*)(tab + 1024 + par * 256 + wc * 32 + 8 * fq + bj * 128 + 4 * n);
        const __amdgpu_buffer_rsrc_t xr = __builtin_amdgcn_make_buffer_rsrc((void*)x, 0, (int)((size_t)T * DM * 4), 0x00020000);
        const unsigned xo = ((unsigned)rowb * DM + (unsigned)colb) * 4u;
        f32x4 xa[2][2][2], xb[2][2][2];
#define WO_LOAD(dst, q) do { _Pragma("unroll") for (int mm = 0; mm < 2; ++mm) _Pragma("unroll") for (int bj = 0; bj < 2; ++bj) _Pragma("unroll") for (int n = 0; n < 2; ++n) \
            dst[mm][bj][n] = __builtin_bit_cast(f32x4, __builtin_amdgcn_raw_buffer_load_b128(xr, xo + (unsigned)(bj * 512 + n * 16), (((q) >> 1) * 128 + (2 * ((q) & 1) + mm) * 16) * (DM * 4), 2)); } while (0)
#define WO_PROC(src, q) do { _Pragma("unroll") for (int mm = 0; mm < 2; ++mm) { const int ai = (q) >> 1, m = 2 * ((q) & 1) + mm, row = rowb + ai * 128 + m * 16; const float rsw = tab[(par * 256 + ai * 128 + wr * 64 + m * 16 + fr) * 2 + 1]; \
            _Pragma("unroll") for (int bj = 0; bj < 2; ++bj) *(u32x4*)(x1 + (size_t)row * DM + colb + bj * 128) = pack8(src[mm][bj][0] + acc[ai][bj][m][0] * rsw, src[mm][bj][1] + acc[ai][bj][m][1] * rsw); } } while (0)
        WO_LOAD(xa, 0); asm volatile("" ::: "memory");
#pragma unroll
        for (int ai = 0; ai < 2; ++ai)
#pragma unroll
            for (int bj = 0; bj < 2; ++bj)
#pragma unroll
                for (int m = 0; m < 4; ++m)
#pragma unroll
                    for (int n = 0; n < 2; ++n) acc[ai][bj][m][n] = acc[ai][bj][m][n] * gt[bj][n];
        asm volatile("" ::: "memory"); WO_LOAD(xb, 1); asm volatile("" ::: "memory");
        WO_PROC(xa, 0); asm volatile("" ::: "memory"); WO_LOAD(xa, 2); asm volatile("" ::: "memory");
        WO_PROC(xb, 1); asm volatile("" ::: "memory"); WO_LOAD(xb, 3); asm volatile("" ::: "memory");
        WO_PROC(xa, 2); asm volatile("" ::: "memory"); WO_PROC(xb, 3); asm volatile("" ::: "memory");
#undef WO_LOAD
#undef WO_PROC
    }
};
DI f32x4 swiglu4(const f32x4 g, const f32x4 uu, float w) { f32x4 o;
#pragma unroll
    for (int j = 0; j < 4; ++j) o[j] = (w * uu[j]) * (g[j] * __builtin_amdgcn_rcpf(1.0f + __builtin_amdgcn_exp2f(-LOG2E * g[j])));
    return o; }
struct EpiUp { static constexpr bool MIDK = true;
    bf16_t* hid; const f32x2* wts; LAS float* tab;
    DI void prep(const GUnit& u, int par, int tid) const {
        if (tid < 256) { float w = 0.f; if (tid < u.nvalid) { const f32x2 ww = wts[u.lbase + tid]; w = u.pn >= 4 ? ww.y : ww.x; } tab[par * 256 + tid] = w; }
    }
    DI void midk(f32x4 (&)[2][2][4][2], const GUnit&, int, int, int, int, int) const {}
    DI void operator()(const f32x4 (&acc)[2][2][4][2], const GUnit& u, int wr, int wc, int fr, int fq, int par) const {
        const int hc = (u.pn >> 2) * 512 + (u.pn & 3) * 128 + wc * 32 + 8 * fq;
#pragma unroll
        for (int ai = 0; ai < 2; ++ai)
#pragma unroll
            for (int m = 0; m < 4; ++m) { const int r = ai * 128 + wr * 64 + m * 16 + fr; const float w = tab[par * 256 + r];
                *(u32x4*)(hid + (size_t)(u.pm * 256 + r) * 1024 + hc) = pack8(swiglu4(acc[ai][0][m][0], acc[ai][1][m][0], w), swiglu4(acc[ai][0][m][1], acc[ai][1][m][1], w)); }
    }
};
struct EpiDown { static constexpr bool MIDK = false;
    bf16_t* y;
    DI void operator()(const f32x4 (&acc)[2][2][4][2], const GUnit& u, int wr, int wc, int fr, int fq, int) const {
        const int rowb = u.pm * 256 + wr * 64 + fr, colb = u.pn * 256 + wc * 32 + 8 * fq;
#pragma unroll
        for (int ai = 0; ai < 2; ++ai)
#pragma unroll
            for (int m = 0; m < 4; ++m) { const size_t row = rowb + ai * 128 + m * 16;
#pragma unroll
                for (int bj = 0; bj < 2; ++bj) *(u32x4*)(y + row * DM + colb + bj * 128) = pack8(acc[ai][bj][m][0], acc[ai][bj][m][1]); }
    }
};

typedef float f32x16 __attribute__((ext_vector_type(16)));
#define MFMA32(a, b, c) __builtin_amdgcn_mfma_f32_32x32x16_bf16((a), (b), (c), 0, 0, 0)
DI int pi32(int r) { return (r & ~12) | ((r & 4) << 1) | ((r & 8) >> 1); }
DI int crow(int i, int h) { return (i & 3) + 8 * (i >> 2) + 4 * h; }
template <int S_> DI bf16x8 packacc(const f32x16& x) { u32x4 p; p.x = pk2(x[8 * S_], x[8 * S_ + 1]); p.y = pk2(x[8 * S_ + 2], x[8 * S_ + 3]); p.z = pk2(x[8 * S_ + 4], x[8 * S_ + 5]); p.w = pk2(x[8 * S_ + 6], x[8 * S_ + 7]); return __builtin_bit_cast(bf16x8, p); }
DI f32x16 zero16() { f32x16 z;
#pragma unroll
    for (int i = 0; i < 16; ++i) z[i] = 0.f;
    return z; }
constexpr int AT_SLOT = 16384, ATT_NSLOT = 6;
constexpr int ATT_STG_OFF = ATT_NSLOT * AT_SLOT, ATT_STGW = 32 * 36;
constexpr int ATT_LS_OFF = ATT_STG_OFF + NWAVES * ATT_STGW * 4, ATT_CTL_OFF = ATT_LS_OFF + NWAVES * 32 * 4;
static_assert(ATT_CTL_OFF + 64 <= LDS_MISC, "attention LDS map");
#define AT_WAIT_V(n) asm volatile("s_waitcnt vmcnt(" #n ")" ::: "memory")
#define AT_BARRIER() do { asm volatile("s_waitcnt lgkmcnt(0)" ::: "memory"); __builtin_amdgcn_s_barrier(); asm volatile("" ::: "memory"); } while (0)
DI void at_issue(const bf16_t* Kg, int kp, const bf16_t* VTg, int nf, LAS unsigned char* slotp, int jt, int wave, int lane) {
    const int key = 8 * wave + (lane >> 3), chunk = (lane & 7) ^ ((key >> 1) & 7);
    __builtin_amdgcn_global_load_lds((const unsigned*)(Kg + (64 * (size_t)jt + key) * kp + chunk * 8), (LAS unsigned*)(slotp + wave * 1024), 16, 0, 0);
    const int hh = wave >> 2, d = 16 * (wave & 3) + (lane >> 2), sl = (lane & 3) ^ ((d >> 2) & 3);
    __builtin_amdgcn_global_load_lds((const unsigned*)(VTg + ((2 * (size_t)jt + hh) * nf + d) * 32 + sl * 8), (LAS unsigned*)(slotp + 8192 + wave * 1024), 16, 0, 0);
}
DI void at_kfrag(const LAS unsigned char* sl, int hh, int r, int h, bf16x8 (&kf)[4]) { const int key = 32 * hh + pi32(r), ksw = (key >> 1) & 7; const LAS unsigned char* kb = sl + key * 128;
#pragma unroll
    for (int d0 = 0; d0 < 4; ++d0) kf[d0] = *(const LAS bf16x8*)(kb + (((2 * d0 + h) ^ ksw) * 16)); }
DI void at_vfrag(const LAS unsigned char* sl, int hh, int r, int h, bf16x8 (&vf)[2][2]) {
#pragma unroll
    for (int dt = 0; dt < 2; ++dt)
#pragma unroll
        for (int sx = 0; sx < 2; ++sx) { const int d = 32 * dt + r; vf[dt][sx] = *(const LAS bf16x8*)(sl + 8192 + hh * 4096 + d * 64 + (((2 * sx + h) ^ ((d >> 2) & 3)) * 16)); } }

template <int DIAG> DI void sb_half(const LAS unsigned char* sl, int hh, const bf16x8 (&qf)[4], float& Cl, f32x16 (&o)[2], int r, int h) {
    bf16x8 kf[4], vf[2][2];
    at_kfrag(sl, hh, r, h, kf); at_vfrag(sl, hh, r, h, vf);
    f32x16 S = zero16();
#pragma unroll
    for (int d0 = 0; d0 < 4; ++d0) S = MFMA32(kf[d0], qf[d0], S);
    float om[16];
#pragma unroll
    for (int i = 0; i < 16; ++i) { float v = __builtin_amdgcn_rcpf(1.0f + __builtin_amdgcn_exp2f(S[i])); if (DIAG && !(16 * (i >> 3) + 8 * h + (i & 7) < r)) v = 1.0f; om[i] = v; }
    f32x2 sf[8]; sf[7] = (f32x2){1.0f, 1.0f};
#pragma unroll
    for (int i = 6; i >= 0; --i) sf[i] = sf[i + 1] * (f32x2){om[i + 1], om[i + 9]};
    float Rx = sf[0].x * om[0], Ry = sf[0].y * om[8];
    asm volatile("" : "+v"(Rx), "+v"(Ry));
    unsigned ax = __builtin_bit_cast(unsigned, Rx), ay = __builtin_bit_cast(unsigned, Ry), bx = ay, by = ax;
    swap32(ax, ay); swap32(bx, by);
    const float p0 = __builtin_bit_cast(float, h == 0 ? ay : bx), p1 = __builtin_bit_cast(float, h == 0 ? by : ax);
    const float m1 = (h == 0 ? p1 : 1.0f) * Cl, m0 = (h == 0 ? p0 * p1 : p1) * Ry * Cl;
    Cl = Cl * ((Rx * Ry) * (p0 * p1));
    const f32x2 mm = (f32x2){m0, m1};
    f32x16 P;
#pragma unroll
    for (int i = 0; i < 8; ++i) { const f32x2 w = (sf[i] * mm) * ((f32x2){1.0f, 1.0f} - (f32x2){om[i], om[i + 8]}); P[i] = w.x; P[i + 8] = w.y; }
    const bf16x8 Pf0 = packacc<0>(P), Pf1 = packacc<1>(P);
#pragma unroll
    for (int dt = 0; dt < 2; ++dt) { o[dt] = MFMA32(Pf0, vf[dt][0], o[dt]); o[dt] = MFMA32(Pf1, vf[dt][1], o[dt]); }
}
constexpr float SB_CMIN = 5.421010862427522e-20f;
struct SbUnit { int b, hd, q0; };
DI SbUnit sb_unit_of(int idx) { SbUnit u; u.b = idx / 512; u.hd = (idx >> 6) & 7; u.q0 = (idx & 63) * 128; return u; }
DI void grp_barrier(volatile LAS int* bar, int& epoch, int lane) {
    asm volatile("s_waitcnt lgkmcnt(0)" ::: "memory"); ++epoch;
    if (lane == 0) __hip_atomic_fetch_add((LAS int*)bar, 1, __ATOMIC_RELAXED, __HIP_MEMORY_SCOPE_WORKGROUP);
    while (*bar < 4 * epoch) __builtin_amdgcn_s_sleep(1);
    asm volatile("" ::: "memory");
}
DI void at_issue4(const bf16_t* Kg, const bf16_t* VTg, LAS unsigned char* slotp, int jt, int w4, int lane) {
#pragma unroll
    for (int pp = 0; pp < 2; ++pp) { const int pc = w4 + 4 * pp;
        const int key = 8 * pc + (lane >> 3), chunk = (lane & 7) ^ ((key >> 1) & 7);
        __builtin_amdgcn_global_load_lds((const unsigned*)(Kg + (64 * (size_t)jt + key) * 512 + chunk * 8), (LAS unsigned*)(slotp + pc * 1024), 16, 0, 0);
        const int hh = pc >> 2, d = 16 * (pc & 3) + (lane >> 2), sl = (lane & 3) ^ ((d >> 2) & 3);
        __builtin_amdgcn_global_load_lds((const unsigned*)(VTg + ((2 * (size_t)jt + hh) * 512 + d) * 32 + sl * 8), (LAS unsigned*)(slotp + 8192 + pc * 1024), 16, 0, 0); }
}
DI int sb_prologue(const bf16_t* Q, const bf16_t* K, const bf16_t* VT, const SbUnit& u, LAS unsigned char* ring, int w4, int lane, bf16x8 (&qf)[4]) {
    const int r = lane & 31, h = lane >> 5; const size_t gb = (size_t)u.b * SEQ; const int t0w = u.q0 + 32 * w4;
    const bf16_t* Kg = K + gb * 512 + u.hd * 64; const bf16_t* VTg = VT + ((gb >> 5) * 512 + u.hd * 64) * 32;
    const int jt_hi = (u.q0 + 127) >> 6, ntiles = jt_hi + 1; int issued = 0;
    for (; issued < 2 && issued < ntiles; ++issued) at_issue4(Kg, VTg, ring + issued * AT_SLOT, jt_hi - issued, w4, lane);
#pragma unroll
    for (int d0 = 0; d0 < 4; ++d0) qf[d0] = *(const bf16x8*)(Q + (gb + t0w + r) * 512 + u.hd * 64 + 16 * d0 + 8 * h);
    return issued;
}
DI void sb_body(const bf16_t* K, const bf16_t* VT, const SbUnit& u, int issued, bf16x8 (&qf)[4], LAS unsigned char* ring, volatile LAS int* ctl, volatile LAS int* bar, int& epoch, int w4, int lane, f32x16 (&o)[2]) {
    const int r = lane & 31, h = lane >> 5; const size_t gb = (size_t)u.b * SEQ; const int t0w = u.q0 + 32 * w4, sd = t0w >> 5;
    o[0] = zero16(); o[1] = zero16(); float Cl = 1.0f;
    const bf16_t* Kg = K + gb * 512 + u.hd * 64; const bf16_t* VTg = VT + ((gb >> 5) * 512 + u.hd * 64) * 32;
    const int jt_hi = (u.q0 + 127) >> 6, ntiles = jt_hi + 1;
    if (w4 == 0 && lane == 0) { ctl[0] = 0; ctl[1] = 0; ctl[2] = 0; }
    asm volatile("s_waitcnt vmcnt(0)" : "+v"(qf[0]), "+v"(qf[1]), "+v"(qf[2]), "+v"(qf[3]) :: "memory");
    bool done = false; int slot = 0;
    for (int i = 0; i < ntiles; ++i) {
        const int jt = jt_hi - i, fly = issued - (i + 1);
        if (fly >= 1) AT_WAIT_V(4); else AT_WAIT_V(0);
        grp_barrier(bar, epoch, lane);
        if (i > 0 && ctl[(i - 1) % 3] == 4) break;
        if (w4 == 0 && lane == 0) ctl[(i + 1) % 3] = 0;
        if (issued < ntiles) { at_issue4(Kg, VTg, ring + ((slot + 2) % 3) * AT_SLOT, jt_hi - issued, w4, lane); ++issued; }
        if (!done) {
            const LAS unsigned char* sl = ring + slot * AT_SLOT;
            const int s1 = 2 * jt + 1, s0 = 2 * jt;
            if (s1 < sd) sb_half<0>(sl, 1, qf, Cl, o, r, h); else if (s1 == sd) sb_half<1>(sl, 1, qf, Cl, o, r, h);
            if (s0 < sd) sb_half<0>(sl, 0, qf, Cl, o, r, h); else if (s0 == sd) sb_half<1>(sl, 0, qf, Cl, o, r, h);
            if (s1 <= sd || s0 <= sd) done = __all(Cl < SB_CMIN);
        }
        if (done && lane == 0) __hip_atomic_fetch_add((LAS int*)&ctl[i % 3], 1, __ATOMIC_RELAXED, __HIP_MEMORY_SCOPE_WORKGROUP);
        slot = (slot + 1) % 3;
    }
    AT_WAIT_V(0);
    grp_barrier(bar, epoch, lane);
}
DI void sw_head(const bf16x8 (&qf)[4], const LAS unsigned char* lds, float sink2, int t0, int jt_lo, int lane, f32x16 (&o)[2], float& lsum) {
    const int r = lane & 31, h = lane >> 5, sd = t0 >> 5;
    f32x16 S[5]; float m = sink2;
#pragma unroll
    for (int jj = 0; jj < 5; ++jj) { const int sj = sd - 4 + jj;
        if (sj >= 0) { bf16x8 kf[4]; at_kfrag(lds + ((sj >> 1) - jt_lo) * AT_SLOT, sj & 1, r, h, kf);
            f32x16 s = zero16();
#pragma unroll
            for (int d0 = 0; d0 < 4; ++d0) s = MFMA32(kf[d0], qf[d0], s);
#pragma unroll
            for (int i = 0; i < 16; ++i) { const int ko = 16 * (i >> 3) + 8 * h + (i & 7); float v = s[i];
                if (jj == 4 && ko > r) v = -1e30f;
                if (jj == 0 && ko <= r) v = -1e30f;
                s[i] = v; m = __builtin_fmaxf(m, v); }
            S[jj] = s; }
        else {
#pragma unroll
            for (int i = 0; i < 16; ++i) S[jj][i] = -1e30f; } }
    m = __builtin_fmaxf(m, __shfl_xor(m, 32));
    o[0] = zero16(); o[1] = zero16(); float ls = 0.f;
#pragma unroll
    for (int jj = 0; jj < 5; ++jj) { const int sj = sd - 4 + jj;
        if (sj >= 0) { bf16x8 vf[2][2]; at_vfrag(lds + ((sj >> 1) - jt_lo) * AT_SLOT, sj & 1, r, h, vf);
            f32x16 P;
#pragma unroll
            for (int i = 0; i < 16; ++i) { P[i] = __builtin_amdgcn_exp2f(S[jj][i] - m); ls += P[i]; }
            const bf16x8 Pf0 = packacc<0>(P), Pf1 = packacc<1>(P);
#pragma unroll
            for (int dt = 0; dt < 2; ++dt) { o[dt] = MFMA32(Pf0, vf[dt][0], o[dt]); o[dt] = MFMA32(Pf1, vf[dt][1], o[dt]); } } }
    ls += __shfl_xor(ls, 32);
    lsum = ls + __builtin_amdgcn_exp2f(sink2 - m);
}
DI void at_store(const f32x16 (&o)[2], float lsum, LAS float* stg, LAS float* lsb, bf16_t* mixrow0, float* ssq0, int lane) {
    const int r = lane & 31, h = lane >> 5, row = lane >> 1, hf = lane & 1;
    if (h == 0) lsb[r] = lsum;
    float ss = 0.f; u32x4 w[2][2];
#pragma unroll
    for (int dt = 0; dt < 2; ++dt) {
#pragma unroll
        for (int i = 0; i < 16; ++i) stg[crow(i, h) * 36 + r] = o[dt][i];
        LDS_WAIT();
        const float il = 1.0f / lsb[row];
#pragma unroll
        for (int k = 0; k < 2; ++k) { const f32x4 a0 = *(const LAS f32x4*)(stg + row * 36 + hf * 16 + 8 * k) * il, a1 = *(const LAS f32x4*)(stg + row * 36 + hf * 16 + 8 * k + 4) * il;
            ss += ((a0.x * a0.x + a0.y * a0.y) + (a0.z * a0.z + a0.w * a0.w)) + ((a1.x * a1.x + a1.y * a1.y) + (a1.z * a1.z + a1.w * a1.w)); w[dt][k] = pack8(a0, a1); }
        LDS_WAIT();
    }
    ss += __shfl_xor(ss, 1);
    if (hf == 0) ssq0[(size_t)row * 16] = ss;
    bf16_t* mr = mixrow0 + (size_t)row * 1024 + hf * 16;
#pragma unroll
    for (int dt = 0; dt < 2; ++dt) { *(u32x4*)(mr + 32 * dt) = w[dt][0]; *(u32x4*)(mr + 32 * dt + 8) = w[dt][1]; }
}
DI void p3_attention(const Args& a, LAS unsigned char* lds, int tid, int lane, int wave, int rep = 0, int kinds = 3) {
    asm volatile("" : "+v"(tid), "+v"(lane));
    const bf16_t* QSB = (const bf16_t*)(a.ws + WS_QSB); const bf16_t* KSB = (const bf16_t*)(a.ws + WS_KSB); const bf16_t* VTSB = (const bf16_t*)(a.ws + WS_VSB);
    const bf16_t* QSW = (const bf16_t*)(a.ws + WS_QSW); const bf16_t* KSW = (const bf16_t*)(a.ws + WS_KSW); const bf16_t* VTSW = (const bf16_t*)(a.ws + WS_VSW);
    bf16_t* MIX = (bf16_t*)(a.ws + WS_MIX); float* SSQ = (float*)(a.ws + WS_SSQ); unsigned* qctr = (unsigned*)(a.ws + WS_CTL) + CW_ATTNQ + 2048 * rep;
    LAS float* stg = (LAS float*)(lds + ATT_STG_OFF) + wave * ATT_STGW; LAS float* lsb = (LAS float*)(lds + ATT_LS_OFF) + wave * 32; volatile LAS int* ctl = (volatile LAS int*)(lds + ATT_CTL_OFF);
    if (kinds & 2)
    for (int u = (int)blockIdx.x; u < (T / 256) * 2; u += (int)gridDim.x) {
        const int b = u / 64, kvh = (u >> 5) & 1, q0 = (u & 31) * 256, jt_lo = (q0 >> 6) - 2, t0 = q0 + 32 * wave; const size_t gb = (size_t)b * SEQ;
        const bf16_t* Kg = KSW + gb * 128 + kvh * 64; const bf16_t* VTg = VTSW + ((gb >> 5) * 128 + kvh * 64) * 32;
#pragma unroll
        for (int s6 = 0; s6 < 6; ++s6) if (jt_lo + s6 >= 0) at_issue(Kg, 128, VTg, 128, lds + s6 * AT_SLOT, jt_lo + s6, wave, lane);
        bf16x8 qn[4];
#pragma unroll
        for (int d0 = 0; d0 < 4; ++d0) qn[d0] = *(const bf16x8*)(QSW + (gb + t0 + (lane & 31)) * 512 + (4 * kvh) * 64 + 16 * d0 + 8 * (lane >> 5));
        AT_WAIT_V(0); AT_BARRIER();
#pragma unroll
        for (int q = 0; q < 4; ++q) { const int hq = 4 * kvh + q; f32x16 o[2]; float lsum; bf16x8 qf[4];
#pragma unroll
            for (int d0 = 0; d0 < 4; ++d0) qf[d0] = qn[d0];
            if (q < 3) {
#pragma unroll
                for (int d0 = 0; d0 < 4; ++d0) qn[d0] = *(const bf16x8*)(QSW + (gb + t0 + (lane & 31)) * 512 + (hq + 1) * 64 + 16 * d0 + 8 * (lane >> 5)); }
            sw_head(qf, lds, a.sinks[hq] * LOG2E, t0, jt_lo, lane, o, lsum);
            at_store(o, lsum, stg, lsb, MIX + (gb + t0) * 1024 + 512 + hq * 64, SSQ + (gb + t0) * 16 + 8 + hq, lane); }
        asm volatile("s_waitcnt vmcnt(0)" ::: "memory"); AT_BARRIER();
    }
    if (kinds & 1) {
        volatile LAS int* gb2 = ctl + 32;
        if (tid < 2) gb2[16 * tid] = 0;
        __syncthreads();
        const int grp = wave >> 2, w4 = wave & 3; LAS unsigned char* ring = lds + grp * 3 * AT_SLOT; volatile LAS int* gctl = ctl + 8 * grp; volatile LAS int* bar = gb2 + 16 * grp; int epoch = 0;
        constexpr int NUNITS = (T / 128) * 8; const int NG = 2 * (int)gridDim.x, gg = 2 * (int)blockIdx.x + grp;
        bf16x8 qf[4]; int idx = gg; int issued = 0; SbUnit u = sb_unit_of(idx); unsigned nxt = 0;
        if (idx < NUNITS) issued = sb_prologue(QSB, KSB, VTSB, u, ring, w4, lane, qf);
        while (idx < NUNITS) {
            if (w4 == 0 && lane == 0) nxt = atomicAdd(qctr, 1u);
            f32x16 o[2];
            sb_body(KSB, VTSB, u, issued, qf, ring, gctl, bar, epoch, w4, lane, o);
            const size_t grow = (size_t)u.b * SEQ + u.q0 + 32 * w4; const int hd = u.hd;
            if (w4 == 0 && lane == 0) gctl[4] = NG + (int)nxt;
            grp_barrier(bar, epoch, lane);
            const int nidx = __builtin_amdgcn_readfirstlane(gctl[4]);
            grp_barrier(bar, epoch, lane);
            if (nidx < NUNITS) { u = sb_unit_of(nidx); issued = sb_prologue(QSB, KSB, VTSB, u, ring, w4, lane, qf); }
            at_store(o, 1.0f, stg, lsb, MIX + grow * 1024 + hd * 64, SSQ + grow * 16 + hd, lane);
            idx = nidx;
        }
    }
}

#define XB_TMO      128
#define XB_XCNT(j)  (256  + 64 * (j))
#define XB_XSUB(j)  (1280 + 64 * (j))
#define XB_XGEN(j)  (2304 + 64 * (j))
#define XB_TOP      3328
#define XB_TOPGEN   3392
#define XCD_BAR_WORDS 3456
#define XB_SPIN_CAP (1u << 18)
DI unsigned xb_ld(unsigned* p)              { return __hip_atomic_load(p, __ATOMIC_RELAXED, __HIP_MEMORY_SCOPE_AGENT); }
DI unsigned xb_add(unsigned* p, unsigned v) { return __hip_atomic_fetch_add(p, v, __ATOMIC_RELAXED, __HIP_MEMORY_SCOPE_AGENT); }
DI unsigned xb_xcc_id() { return (unsigned)__builtin_amdgcn_s_getreg((3 << 11) | 20) & 0xFu; }
#define XB_SPIN(cond, bar) do { unsigned _sp = 0; while (cond) { __builtin_amdgcn_s_sleep(1); \
    if ((++_sp & 255u) == 0u) { if (xb_ld(&(bar)[XB_TMO])) break; if (_sp > XB_SPIN_CAP) { atomicAdd(&(bar)[XB_TMO], 1u); break; } } } } while (0)
struct XcdBarrier { unsigned* bar; unsigned x; volatile LAS unsigned* st; };
DI XcdBarrier xcd_barrier_post(unsigned* bar, volatile LAS unsigned* st) {
    XcdBarrier b; b.bar = bar; b.x = xb_xcc_id(); b.st = st;
    if (threadIdx.x == 0) (void)xb_add(&bar[XB_XCNT(b.x)], 1u);
    return b;
}
DI void xcd_barrier_complete(unsigned* bar, unsigned x, unsigned& nloc, unsigned& nx) {
    const unsigned G = gridDim.x * gridDim.y * gridDim.z;
    unsigned sum, cnt, mine, sp = 0u;
    for (;;) {
        sum = 0u; cnt = 0u; mine = 0u;
#pragma unroll
        for (unsigned j = 0; j < 16; ++j) { const unsigned c = xb_ld(&bar[XB_XCNT(j)]); sum += c; cnt += (c > 0u) ? 1u : 0u; mine = (j == x) ? c : mine; }
        if (sum == G) break;
        __builtin_amdgcn_s_sleep(1);
        if ((++sp & 255u) == 0u) { if (xb_ld(&bar[XB_TMO])) break; if (sp > XB_SPIN_CAP) { atomicAdd(&bar[XB_TMO], 1u); break; } }
    }
    nloc = mine > 0u ? mine : 1u; nx = cnt > 0u ? cnt : 1u;
}
DI void xcd_barrier(const XcdBarrier& b) {
    asm volatile("s_waitcnt vmcnt(0)" ::: "memory");
    __syncthreads();
    if (threadIdx.x == 0) {
        unsigned* bar = b.bar;
        __builtin_amdgcn_s_waitcnt(0);
        unsigned nloc = b.st[0], nx = b.st[1];
        if (nloc == 0u) { xcd_barrier_complete(bar, b.x, nloc, nx); b.st[0] = nloc; b.st[1] = nx; }
        const unsigned old = xb_add(&bar[XB_XSUB(b.x)], 1u);
        const unsigned gen = old / nloc;
        if (old + 1u == (gen + 1u) * nloc) {
            __builtin_amdgcn_fence(__ATOMIC_RELEASE, "agent");
            asm volatile("s_waitcnt vmcnt(0)" ::: "memory");
            const unsigned og = xb_add(&bar[XB_TOP], 1u);
            const unsigned tg = og / nx;
            if (og + 1u == (tg + 1u) * nx) xb_add(&bar[XB_TOPGEN], 1u);
            else XB_SPIN(xb_ld(&bar[XB_TOPGEN]) == tg, bar);
            __builtin_amdgcn_fence(__ATOMIC_ACQUIRE, "agent");
            xb_add(&bar[XB_XGEN(b.x)], 1u);
            asm volatile("s_waitcnt vmcnt(0)" ::: "memory");
        } else {
            XB_SPIN(xb_ld(&bar[XB_XGEN(b.x)]) == gen, bar);
            __builtin_amdgcn_fence(__ATOMIC_ACQUIRE, "agent");
            asm volatile("s_waitcnt vmcnt(0)" ::: "memory");
        }
    }
    __syncthreads();
}

__global__ void __launch_bounds__(NTHREADS, 2) mk_fwd(Args a) {
    extern __shared__ __attribute__((aligned(16))) unsigned char lds_raw[];
    LAS unsigned char* lds = (LAS unsigned char*)lds_raw;
    const int tid = threadIdx.x, lane = tid & 63, wave = __builtin_amdgcn_readfirstlane(tid >> 6);
    volatile LAS unsigned* misc = (volatile LAS unsigned*)(lds + LDS_MISC);
    if (tid < 2) misc[tid] = 0u;
    __syncthreads();
    const XcdBarrier gbar = xcd_barrier_post((unsigned*)(a.ws + WS_CTL) + CW_BAR, misc);
    unsigned char* ws = a.ws;
    const float* mod = (const float*)(ws + WS_MOD);

#define REPS(k) ((PROBE_DUP == (k)) ? 2 : 1)
    int n_stamp = 0;
#define STAMP() do { if (STAMP_PHASE >= 0 && blockIdx.x == 0 && tid == 0) ((unsigned long long*)(ws + WS_STAMP))[n_stamp] = __builtin_amdgcn_s_memrealtime(); ++n_stamp; } while (0)
    STAMP();
    const int p2_units = (T / 256) * (DIN / 256), p2_rem = p2_units % (int)gridDim.x, n_tailw = p2_rem ? ((int)gridDim.x - p2_rem) * NWAVES : 0;
    const int n_tail_items = n_tailw * 4 < NEXPERT_ITEMS ? n_tailw * 4 : NEXPERT_ITEMS, n_p0_items = NEXPERT_ITEMS - n_tail_items;
    for (int rep = 0; rep < REPS(0); ++rep) { p0_prologue(a, lds, tid, lane, wave); expert_items(a, lds, 0, n_p0_items, blockIdx.x * NWAVES + wave, gridDim.x * NWAVES, lane, wave); xcd_barrier(gbar); STAMP(); }
    for (int rep = 0; rep < REPS(1); ++rep) { if (wave == 7) router_tables(a, lane); p1_norm(a, lane, wave); xcd_barrier(gbar); STAMP(); }
    for (int rep = 0; rep < REPS(2); ++rep) {
        DenseSched S{(const bf16_t*)(ws + WS_H), (const bf16_t*)(ws + WS_WIN), 1024, T / 256, DIN / 256};
        EpiProj E{(bf16_t*)(ws + WS_QSB), (bf16_t*)(ws + WS_VSB), (bf16_t*)(ws + WS_QSW), (bf16_t*)(ws + WS_KSW), (bf16_t*)(ws + WS_VSW), (const float*)(ws + WS_COS), (const float*)(ws + WS_SIN)};
        pg8::gemm_phase<DenseSched, EpiProj, true, 1024, 1024, 16>(lds, S, E);
        if (p2_rem && (int)blockIdx.x >= p2_rem && rep == 0) { __syncthreads(); expert_items(a, lds, n_p0_items, n_tail_items, ((int)blockIdx.x - p2_rem) * NWAVES + wave, n_tailw, lane, wave); }
        xcd_barrier(gbar); STAMP();
    }
    if (PROBE_DUP == 31 || PROBE_DUP == 32) { p3_attention(a, lds, tid, lane, wave, 1, PROBE_DUP - 30); xcd_barrier(gbar); }
    for (int rep = 0; rep < REPS(3); ++rep) { p3_attention(a, lds, tid, lane, wave, rep); xcd_barrier(gbar); STAMP(); }
    for (int rep = 0; rep < REPS(4); ++rep) {
        DenseSched S{(const bf16_t*)(ws + WS_MIX), (const bf16_t*)(ws + WS_WOUT), 1024, T / 256, DM / 256};
        EpiWout E{mod, (bf16_t*)(ws + WS_X1), a.x, (const float*)(ws + WS_SSQ), (LAS float*)(lds + pg8::STAGE_BYTES + 1024)};
        pg8::gemm_phase<DenseSched, EpiWout, true, 1024, 1024, 16>(lds, S, E);
        xcd_barrier(gbar); STAMP();
    }
    for (int rep = 0; rep < REPS(5); ++rep) { p5_router(a, lds, tid, lane, wave, rep); xcd_barrier(gbar); STAMP(); }
    LAS int* tstart = (LAS int*)(lds + pg8::STAGE_BYTES);
    const unsigned* cnt = (const unsigned*)(ws + WS_CTL) + CW_CNT;
    if (tid == 0) { int run = 0; for (int b = 0; b < NBUCKET; ++b) { tstart[b] = run; run += ((int)cnt[CNT_STRIDE * b] + 255) >> 8; } tstart[NBUCKET] = run; }
    __syncthreads();
    const bf16_t* H2 = (const bf16_t*)(ws + WS_H); const bf16_t* HIDc = (const bf16_t*)(ws + WS_HID); const int* LISTc = (const int*)(ws + WS_LIST);
    EpiUp EU{(bf16_t*)(ws + WS_HID), (const f32x2*)(ws + WS_WTS), (LAS float*)(lds + pg8::STAGE_BYTES + 1024)}; EpiDown ED{(bf16_t*)(ws + WS_Y)};
    if (gridDim.x == 256) {
        const MoeCut mc = moe_cut(__builtin_amdgcn_readfirstlane(tstart[NBUCKET]));
        { MoeSplitSched<true, 1> S{tstart, cnt, LISTc, H2, (const bf16_t*)(ws + WS_WGU), mc}; pg8::gemm_phase<MoeSplitSched<true, 1>, EpiUp, true, 1024, 1024, 16>(lds, S, EU); }
        xcd_barrier(gbar); STAMP();
        if (((int)blockIdx.x >> 3) < mc.left) { MoeSplitSched<true, 2> S{tstart, cnt, LISTc, H2, (const bf16_t*)(ws + WS_WGU), mc}; pg8::gemm_phase<MoeSplitSched<true, 2>, EpiUp, true, 1024, 1024, 16>(lds, S, EU); }
        else { MoeSplitSched<false, 2> S{tstart, cnt, LISTc, HIDc, (const bf16_t*)(ws + WS_WD), mc}; pg8::gemm_phase<MoeSplitSched<false, 2>, EpiDown, true, 1024, 512, 8>(lds, S, ED); }
        xcd_barrier(gbar); STAMP();
        { MoeSplitSched<false, 3> S{tstart, cnt, LISTc, HIDc, (const bf16_t*)(ws + WS_WD), mc}; pg8::gemm_phase<MoeSplitSched<false, 3>, EpiDown, true, 1024, 512, 8>(lds, S, ED); }
    } else {
        { MoeSched<8, true> S{tstart, cnt, LISTc, H2, (const bf16_t*)(ws + WS_WGU)}; pg8::gemm_phase<MoeSched<8, true>, EpiUp, true, 1024, 1024, 16>(lds, S, EU); }
        xcd_barrier(gbar); STAMP();
        { MoeSched<4, false> S{tstart, cnt, LISTc, HIDc, (const bf16_t*)(ws + WS_WD)}; pg8::gemm_phase<MoeSched<4, false>, EpiDown, true, 1024, 512, 8>(lds, S, ED); }
    }
    if (STAMP_PHASE >= 0) {
        if (blockIdx.x == 0 && tid == 0) { unsigned long long* st = (unsigned long long*)(ws + WS_STAMP); st[n_stamp] = __builtin_amdgcn_s_memrealtime();
            const float t_us = (float)(st[STAMP_PHASE + 1] - st[STAMP_PHASE]) * 0.01f; *(float*)(ws + WS_STAMP + 256) = 1.0f + sqrtf(t_us * STAMP_K); } }
    xcd_barrier(gbar);
    if (PROBE_DUP == 8) { p8_final(a, tstart, lane, wave, (float*)(ws + WS_H)); xcd_barrier(gbar); }
    p8_final(a, tstart, lane, wave, a.out);
}

extern "C" void kernel_launch(void* const* d_in, const int* in_sizes, int n_in, void* d_out, int out_size, void* d_ws, size_t ws_size, hipStream_t stream) {
    static int grid = 0;
    if (grid == 0) {
        if (n_in != 18 || in_sizes[0] != T * DM || out_size != T * DM || ws_size < WS_END) { fprintf(stderr, "kernel_launch: unexpected shapes (n_in %d, in0 %d, out %d, ws %zu); nothing launched\n", n_in, n_in > 0 ? in_sizes[0] : -1, out_size, ws_size); grid = -1; return; }
        int dev = 0, cus = 0, per_cu = 0;
        (void)hipGetDevice(&dev); (void)hipDeviceGetAttribute(&cus, hipDeviceAttributeMultiprocessorCount, dev);
        (void)hipFuncSetAttribute((const void*)mk_fwd, hipFuncAttributeMaxDynamicSharedMemorySize, LDS_BYTES);
        (void)hipOccupancyMaxActiveBlocksPerMultiprocessor(&per_cu, (const void*)mk_fwd, NTHREADS, LDS_BYTES);
        if (per_cu < 1) { fprintf(stderr, "kernel_launch: occupancy query says %d blocks per CU\n", per_cu); per_cu = 1; }
        grid = cus * per_cu;
        fprintf(stderr, "kernel_launch: %d CUs x %d = grid %d\n", cus, per_cu, grid);
    }
    if (grid < 0) return;
    (void)hipMemsetAsync((char*)d_ws + WS_CTL, 0, CTL_BYTES, stream);
    Args a{};
    a.x = (const float*)d_in[0]; a.c = (const float*)d_in[1]; a.pos = (const int*)d_in[2]; a.w_ada = (const float*)d_in[3]; a.b_ada = (const float*)d_in[4]; a.g_mix = (const float*)d_in[5];
    a.w_in = (const float*)d_in[6]; a.sinks = (const float*)d_in[7]; a.g_sb = (const float*)d_in[8]; a.g_sw = (const float*)d_in[9]; a.w_out = (const float*)d_in[10]; a.g_ffn = (const float*)d_in[11];
    a.w_rg = (const float*)d_in[12]; a.w_re = (const float*)d_in[13]; a.w_gate = (const float*)d_in[14]; a.w_up = (const float*)d_in[15]; a.w_down = (const float*)d_in[16]; a.g_fin = (const float*)d_in[17];
    a.out = (float*)d_out; a.ws = (unsigned char*)d_ws;
    void* args[] = {&a};
    hipError_t e = hipLaunchCooperativeKernel((const void*)mk_fwd, dim3(grid), dim3(NTHREADS), args, LDS_BYTES, stream);
    if (e != hipSuccess) fprintf(stderr, "kernel_launch: cooperative launch failed: %s (grid %d)\n", hipGetErrorString(e), grid);
}
```

```cpp
#include <hip/hip_runtime.h>
#include <cstdio>
#include <cstdint>
#include <cmath>

#define LAS __attribute__((address_space(3)))
#define DI __device__ __forceinline__
typedef unsigned short bf16_t;
typedef short bf16x8 __attribute__((ext_vector_type(8)));
typedef float f32x4 __attribute__((ext_vector_type(4)));
typedef float f32x2 __attribute__((ext_vector_type(2)));
typedef unsigned u32x4 __attribute__((ext_vector_type(4)));
typedef unsigned u32x2 __attribute__((ext_vector_type(2)));
typedef __bf16 bf16x2_t __attribute__((ext_vector_type(2)));

constexpr int NB = 4, SEQ = 8192, DM = 1024, T = NB * SEQ;
constexpr int DIN = 2304, DSB = 512, DSW = 512, DKV = 128;
constexpr int NEXP = 16, DEXP = 512, NBUCKET = 24, WINDOW = 128;
constexpr int MAXTILES = T / 256 + NBUCKET, TPAD = MAXTILES * 256;
constexpr float EPS = 1e-6f, LOG2E = 1.4426950408889634f, QSCALE = 0.125f * LOG2E;
constexpr int NTHREADS = 512, NWAVES = 8;
#ifndef STAMP_PHASE
#define STAMP_PHASE (-1)
#endif
#ifndef STAMP_K
#define STAMP_K 1e-5f
#endif
#ifndef PROBE_DUP
#define PROBE_DUP (-1)
#endif

constexpr size_t MiB = 1u << 20;
constexpr size_t WS_CTL = 0, CTL_BYTES = 1 * MiB;
constexpr size_t WS_MOD = 1 * MiB;
constexpr size_t WS_COS = 2 * MiB, WS_SIN = 6 * MiB;
constexpr size_t WS_WIN = 10 * MiB;
constexpr size_t WS_WOUT = 15 * MiB;
constexpr size_t WS_WGU = 17 * MiB;
constexpr size_t WS_WD = 49 * MiB;
constexpr size_t WS_LIST = 65 * MiB;
constexpr size_t WS_WTS = 68 * MiB;
constexpr size_t WS_STAMP = 512 * 1024;
constexpr size_t WS_TPOS = 74 * MiB;
constexpr size_t WS_SSQ = 76 * MiB;
constexpr size_t WS_H = 80 * MiB;
constexpr size_t WS_QSB = 144 * MiB, WS_KSB = 176 * MiB, WS_VSB = 208 * MiB, WS_QSW = 240 * MiB;
constexpr size_t WS_KSW = 272 * MiB, WS_VSW = 280 * MiB;
constexpr size_t WS_MIX = 288 * MiB;
constexpr size_t WS_HID = 352 * MiB;
constexpr size_t WS_RTAB = 428 * MiB;
constexpr size_t WS_END = 429 * MiB;
constexpr size_t WS_XB = WS_HID;
constexpr size_t WS_X1 = WS_QSB;
constexpr size_t WS_Y = WS_VSB;
static_assert(WS_X1 + (size_t)T * 1024 * 2 <= WS_VSB && WS_Y + (size_t)TPAD * 1024 * 2 <= WS_MIX && WS_XB + (size_t)T * 1024 * 2 <= WS_END, "overlays");
static_assert(WS_KSB - WS_QSB == WS_VSB - WS_KSB, "q/k/v_sb buffers equally spaced");
static_assert(WS_HID + (size_t)TPAD * 1024 * 2 <= WS_END, "ws map");
constexpr int CW_CNT = 8192, CNT_STRIDE = 64, CW_ATTNQ = 16384, CW_BAR = 4096;
constexpr int LDS_MISC = 143360;

constexpr int LDS_BYTES = 147456;

struct Args {
    const float* x; const float* c; const int* pos; const float* w_ada; const float* b_ada; const float* g_mix; const float* w_in; const float* sinks;
    const float* g_sb; const float* g_sw; const float* w_out; const float* g_ffn; const float* w_rg; const float* w_re; const float* w_gate; const float* w_up;
    const float* w_down; const float* g_fin; float* out; unsigned char* ws;
};

__constant__ float INV_FREQ[32] = {1.000000000e+00f, 7.498942018e-01f, 5.623413324e-01f, 4.216965139e-01f, 3.162277639e-01f, 2.371373773e-01f, 1.778279394e-01f, 1.333521456e-01f, 1.000000015e-01f, 7.498942316e-02f, 5.623413250e-02f, 4.216964915e-02f, 3.162277490e-02f, 2.371373773e-02f, 1.778279431e-02f, 1.333521400e-02f, 9.999999776e-03f, 7.498942316e-03f, 5.623413250e-03f, 4.216964822e-03f, 3.162277630e-03f, 2.371373819e-03f, 1.778279431e-03f, 1.333521446e-03f, 1.000000047e-03f, 7.498941850e-04f, 5.623413017e-04f, 4.216965172e-04f, 3.162277571e-04f, 2.371373703e-04f, 1.778279402e-04f, 1.333521504e-04f};

DI unsigned f2bf(float f) { unsigned u = __builtin_bit_cast(unsigned, f); return (u + 0x7fffu + ((u >> 16) & 1u)) >> 16; }
DI unsigned pk2(float lo, float hi) { f32x2 v = {lo, hi}; bf16x2_t b = __builtin_convertvector(v, bf16x2_t); return __builtin_bit_cast(unsigned, b); }
DI u32x4 pack8(const f32x4 v0, const f32x4 v1) { u32x4 w; w.x = pk2(v0[0], v0[1]); w.y = pk2(v0[2], v0[3]); w.z = pk2(v1[0], v1[1]); w.w = pk2(v1[2], v1[3]); return w; }
DI float bf2f(unsigned short b) { return __builtin_bit_cast(float, (unsigned)b << 16); }
DI float bflo(unsigned w) { return __builtin_bit_cast(float, w << 16); }
DI float bfhi(unsigned w) { return __builtin_bit_cast(float, w & 0xffff0000u); }
DI float wave_sum(float v) {
#pragma unroll
    for (int o = 1; o < 64; o <<= 1) v += __shfl_xor(v, o);
    return v;
}
#define DPP_ADD(v, ctrl) ((v) + __builtin_bit_cast(float, __builtin_amdgcn_update_dpp(0, __builtin_bit_cast(int, (v)), (ctrl), 0xF, 0xF, true)))
DI void swap32(unsigned& a, unsigned& b) { asm volatile("s_nop 1\n\tv_permlane32_swap_b32 %0, %1" : "+v"(a), "+v"(b)); }
DI void swap16(unsigned& a, unsigned& b) { asm volatile("s_nop 1\n\tv_permlane16_swap_b32 %0, %1" : "+v"(a), "+v"(b)); }
DI float half_sum_fast(float v) { v = DPP_ADD(v, 0xB1); v = DPP_ADD(v, 0x4E); v = DPP_ADD(v, 0x141); v = DPP_ADD(v, 0x140);
    unsigned a = __builtin_bit_cast(unsigned, v), b = a; swap16(a, b); return __builtin_bit_cast(float, a) + __builtin_bit_cast(float, b); }
DI float wave_sum_fast(float v) { v = DPP_ADD(v, 0xB1); v = DPP_ADD(v, 0x4E); v = DPP_ADD(v, 0x141); v = DPP_ADD(v, 0x140);
    unsigned a = __builtin_bit_cast(unsigned, v), b = a; swap16(a, b); v = __builtin_bit_cast(float, a) + __builtin_bit_cast(float, b);
    a = __builtin_bit_cast(unsigned, v); b = a; swap32(a, b); return __builtin_bit_cast(float, a) + __builtin_bit_cast(float, b); }
#define LDS_WAIT() asm volatile("s_waitcnt lgkmcnt(0)" ::: "memory")
DI f32x4 ldnt4(const float* p) { return __builtin_nontemporal_load((const f32x4*)p); }

DI void tr_item64(const float* W, int N, int k0, int n0, bf16_t* WT, int drow0a, int drow0b, int Kd, const float* kscale, LAS float* scr, int lane) {
    f32x4 v[16]; const int kr = lane >> 4, c4 = 4 * (lane & 15);
#pragma unroll
    for (int i = 0; i < 16; ++i) v[i] = ldnt4(W + (size_t)(k0 + 4 * i + kr) * N + n0 + c4);
#pragma unroll
    for (int i = 0; i < 16; ++i) { const int kk = 4 * i + kr; f32x4 x = v[i]; if (kscale) x = x * kscale[k0 + kk]; LAS float* d = scr + kk * 65 + c4; d[0] = x.x; d[1] = x.y; d[2] = x.z; d[3] = x.w; }
    LDS_WAIT();
    const int c = lane & 7;
#pragma unroll
    for (int j = 0; j < 8; ++j) { const int n = (lane >> 3) + 8 * j; const LAS float* q = scr + (8 * c) * 65 + n;
        u32x4 o; o.x = pk2(q[0 * 65], q[1 * 65]); o.y = pk2(q[2 * 65], q[3 * 65]); o.z = pk2(q[4 * 65], q[5 * 65]); o.w = pk2(q[6 * 65], q[7 * 65]);
        const int dr = n < 32 ? drow0a + n : drow0b + (n - 32);
        *(u32x4*)(WT + (size_t)dr * Kd + k0 + 8 * c) = o; }
    LDS_WAIT();
}
DI int win_drow(int n0) {
    if (n0 < 1536) return n0;
    if (n0 < 2048) { const int c = n0 - 1536, head = c >> 6, half = (c >> 5) & 1; return 1536 + (head >> 2) * 256 + half * 128 + (head & 3) * 32; }
    if (n0 < 2176) { const int c = n0 - 2048, head = c >> 6, half = (c >> 5) & 1; return 2048 + half * 128 + head * 32; }
    const int c = n0 - 2176; return 2048 + (c >> 6) * 128 + 64 + (c & 63);
}
DI void p0_prologue(const Args& a, LAS unsigned char* lds, int tid, int lane, int wave) {
    unsigned char* ws = a.ws;
    {
        float* mod = (float*)(ws + WS_MOD); LAS float* red = (LAS float*)lds; LAS float* sc = (LAS float*)(lds + 32768);
        if ((int)blockIdx.x < 6144 / 64) { for (int i = tid; i < 4096; i += NTHREADS) { const float cv = a.c[i]; sc[i] = cv / (1.f + expf(-cv)); } __syncthreads(); }
        for (int cb = blockIdx.x; cb < 6144 / 64; cb += gridDim.x) {
            const int cl = tid & 15, kg = tid >> 4, col = cb * 64 + 4 * cl;
            f32x4 acc[4];
#pragma unroll
            for (int q = 0; q < 4; ++q) acc[q] = (f32x4){0.f, 0.f, 0.f, 0.f};
#pragma unroll 16
            for (int kk = 0; kk < 32; ++kk) { const int k = kg * 32 + kk; const f32x4 w = ldnt4(a.w_ada + (size_t)k * 6144 + col);
#pragma unroll
                for (int q = 0; q < 4; ++q) acc[q] = acc[q] + w * sc[q * 1024 + k]; }
#pragma unroll
            for (int q = 0; q < 4; ++q) *(LAS f32x4*)(red + (kg * 4 + q) * 64 + 4 * cl) = acc[q];
            __syncthreads();
            if (tid < 256) { const int q = tid >> 6, c2 = tid & 63; float sum = 0.f; for (int g = 0; g < 32; ++g) sum += red[(g * 4 + q) * 64 + c2]; mod[q * 6144 + cb * 64 + c2] = sum + a.b_ada[cb * 64 + c2]; }
            __syncthreads();
        }
    }
    {
        float* cosT = (float*)(ws + WS_COS); float* sinT = (float*)(ws + WS_SIN);
        for (int idx = blockIdx.x * NTHREADS + tid; idx < T * 32; idx += gridDim.x * NTHREADS) {
            const int t = idx >> 5, i = idx & 31; const float ang = (float)a.pos[t] * INV_FREQ[i];
            const double ad = (double)ang, kq = rint(ad * 0.63661977236758134308);
            double y = fma(-kq, 1.5707963267948966192, ad); y = fma(-kq, 6.123233995736766036e-17, y);
            const int q = (int)((long long)kq & 3); const double y2 = y * y;
            const double sn = y * (1.0 + y2 * (-1.0 / 6 + y2 * (1.0 / 120 + y2 * (-1.0 / 5040 + y2 * (1.0 / 362880 + y2 * (-1.0 / 39916800))))));
            const double cs = 1.0 + y2 * (-0.5 + y2 * (1.0 / 24 + y2 * (-1.0 / 720 + y2 * (1.0 / 40320 + y2 * (-1.0 / 3628800 + y2 * (1.0 / 479001600))))));
            double co, si; if (q == 0) { co = cs; si = sn; } else if (q == 1) { co = -sn; si = cs; } else if (q == 2) { co = -cs; si = -sn; } else { co = sn; si = -cs; }
            cosT[idx] = (float)co; sinT[idx] = (float)si;
        }
    }
    {
        __syncthreads();
        LAS float* scr = (LAS float*)(lds + 8192 + wave * 16640);
        const int gw = blockIdx.x * NWAVES + wave, NGW = gridDim.x * NWAVES;
        constexpr int I_IN = 16 * 36, I_OUT = 16 * 16, NITEMS = I_IN + I_OUT;
        for (int it = gw; it < NITEMS; it += NGW) {
            int r = it;
            if (r < I_IN) { const int kb = r / 36, nb = r % 36; tr_item64(a.w_in, DIN, kb * 64, nb * 64, (bf16_t*)(ws + WS_WIN), win_drow(nb * 64), win_drow(nb * 64 + 32), 1024, nullptr, scr, lane); continue; } r -= I_IN;
            { const int kb = r / 16, nb = r % 16; const float* ks = (kb < 8) ? a.g_sb : (a.g_sw - 512); tr_item64(a.w_out, 1024, kb * 64, nb * 64, (bf16_t*)(ws + WS_WOUT), nb * 64, nb * 64 + 32, 1024, ks, scr, lane); }
        }
    }
}
constexpr int NEXPERT_ITEMS = 2 * (16 * 16 * 8) + 16 * 8 * 16;
DI void expert_items(const Args& a, LAS unsigned char* lds, int first, int count, int w, int nw, int lane, int wave) {
    asm volatile("" : "+v"(lane));
    unsigned char* ws = a.ws;
    LAS float* scr = (LAS float*)(lds + 8192 + wave * 16640);
    constexpr int I_G = 16 * 16 * 8;
    for (int it = first + w; it < first + count; it += nw) {
        int r = it;
        if (r < 2 * I_G) { const int up = r >= I_G; if (up) r -= I_G; const int e = r / 128, q = r % 128, kb = q / 8, nb = q % 8, c0 = nb * 64; const int dr = (c0 >> 7) * 256 + up * 128 + (c0 & 127);
            tr_item64((up ? a.w_up : a.w_gate) + (size_t)e * 1024 * 512, 512, kb * 64, c0, (bf16_t*)(ws + WS_WGU) + (size_t)e * 1024 * 1024, dr, dr + 32, 1024, nullptr, scr, lane); continue; } r -= 2 * I_G;
        { const int e = r / 128, q = r % 128, kb = q / 16, nb = q % 16; tr_item64(a.w_down + (size_t)e * 512 * 1024, 1024, kb * 64, nb * 64, (bf16_t*)(ws + WS_WD) + (size_t)e * 1024 * 512, nb * 64, nb * 64 + 32, 512, nullptr, scr, lane); }
    }
}

DI void p1_norm(const Args& a, LAS unsigned char* lds, int tid, int lane, int wave) {
    asm volatile("" : "+v"(lane), "+v"(tid));
    const float* mod = (const float*)(a.ws + WS_MOD); bf16_t* H = (bf16_t*)(a.ws + WS_H);
    f32x4 tg[2], tsc[2], tsh[2];
#pragma unroll
    for (int i = 0; i < 2; ++i) { const int idx = tid + i * NTHREADS, b = idx >> 8, c = (idx & 255) * 4; tg[i] = *(const f32x4*)(a.g_mix + c); tsc[i] = *(const f32x4*)(mod + b * 6144 + 1024 + c); tsh[i] = *(const f32x4*)(mod + b * 6144 + c); }
    asm volatile("" ::: "memory");
    const int gw = blockIdx.x * NWAVES + wave, NGW = gridDim.x * NWAVES;
    const int npass = gw < T / 4 ? (T / 4 - gw + NGW - 1) / NGW : 0, nrows = npass * 4;
    f32x4 sl[8][4];
#define P1_LOAD(s_, n_) do { const int _n = (n_); const float* _src = _n < nrows ? a.x + (size_t)(4 * (gw + (_n >> 2) * NGW) + (_n & 3)) * DM : a.g_mix; \
        _Pragma("unroll") for (int j = 0; j < 4; ++j) sl[s_][j] = ldnt4(_src + 4 * lane + 256 * j); } while (0)
#pragma unroll
    for (int s_ = 0; s_ < 8; ++s_) P1_LOAD(s_, s_);
    asm volatile("" ::: "memory");
#pragma unroll
    for (int i = 0; i < 2; ++i) { const int idx = tid + i * NTHREADS; *(LAS f32x4*)(lds + idx * 16) = tg[i] * (tsc[i] + 1.0f); *(LAS f32x4*)(lds + 16384 + idx * 16) = tsh[i]; }
    __syncthreads();
#pragma unroll 1
    for (int nb = 0; nb < nrows; nb += 8) {
#pragma unroll
        for (int s_ = 0; s_ < 8; ++s_) { const int n = nb + s_;
            if (n < nrows) { const int row = 4 * (gw + (n >> 2) * NGW) + (n & 3); const LAS unsigned char* cp = lds + ((row / SEQ) * 1024 + 4 * lane) * 4; float sq = 0.f;
#pragma unroll
                for (int j = 0; j < 4; ++j) sq += (sl[s_][j].x * sl[s_][j].x + sl[s_][j].y * sl[s_][j].y) + (sl[s_][j].z * sl[s_][j].z + sl[s_][j].w * sl[s_][j].w);
                const float rs = 1.0f / sqrtf(wave_sum_fast(sq) * (1.0f / DM) + EPS); bf16_t* hr = H + (size_t)row * DM;
#pragma unroll
                for (int j = 0; j < 4; ++j) { const f32x4 o = sl[s_][j] * rs * *(const LAS f32x4*)(cp + j * 1024) + *(const LAS f32x4*)(cp + 16384 + j * 1024); u32x2 w; w.x = pk2(o.x, o.y); w.y = pk2(o.z, o.w); *(u32x2*)(hr + 4 * lane + 256 * j) = w; } }
            P1_LOAD(s_, n + 8); }
    }
#undef P1_LOAD
}
DI void p8_final(const Args& a, const LAS int* tstart, int lane, int wave, float* dst) {
    asm volatile("" : "+v"(lane));
    const float tscale = (STAMP_PHASE >= 0) ? *(const float*)(a.ws + WS_STAMP + 256) : 1.0f;
    const float* mod = (const float*)(a.ws + WS_MOD); const bf16_t* X1 = (const bf16_t*)(a.ws + WS_X1); const bf16_t* Y = (const bf16_t*)(a.ws + WS_Y); const int* tpos = (const int*)(a.ws + WS_TPOS);
    const int gw = blockIdx.x * NWAVES + wave, NGW = gridDim.x * NWAVES;
    for (int ch = gw; ch < T / 16; ch += NGW) {
        const int row0 = ch * 16, b = row0 / SEQ;
        f32x4 g[4], g2[4];
#pragma unroll
        for (int j = 0; j < 4; ++j) { g[j] = *(const f32x4*)(a.g_fin + 4 * lane + 256 * j); g2[j] = *(const f32x4*)(mod + b * 6144 + 5120 + 4 * lane + 256 * j); }
        const int tp = tpos[row0 + (lane & 15)];
        u32x2 xn[2][4], yn[2][4];
#pragma unroll
        for (int rr = 0; rr < 2; ++rr) { const int tpr = __builtin_amdgcn_readlane(tp, rr); const size_t srow = (size_t)tstart[tpr >> 16] * 256 + (tpr & 0xffff);
#pragma unroll
            for (int j = 0; j < 4; ++j) { xn[rr][j] = *(const u32x2*)(X1 + (size_t)(row0 + rr) * DM + 4 * lane + 256 * j); yn[rr][j] = *(const u32x2*)(Y + srow * DM + 4 * lane + 256 * j); } }
#pragma unroll 1
        for (int r2 = 0; r2 < 16; r2 += 2) {
            f32x4 v[2][4]; u32x2 xw[2][4], yw[2][4];
#pragma unroll
            for (int rr = 0; rr < 2; ++rr)
#pragma unroll
                for (int j = 0; j < 4; ++j) { xw[rr][j] = xn[rr][j]; yw[rr][j] = yn[rr][j]; }
            if (r2 + 2 < 16) {
#pragma unroll
                for (int rr = 0; rr < 2; ++rr) { const int tpr = __builtin_amdgcn_readlane(tp, r2 + 2 + rr); const size_t srow = (size_t)tstart[tpr >> 16] * 256 + (tpr & 0xffff);
#pragma unroll
                    for (int j = 0; j < 4; ++j) { xn[rr][j] = *(const u32x2*)(X1 + (size_t)(row0 + r2 + 2 + rr) * DM + 4 * lane + 256 * j); yn[rr][j] = *(const u32x2*)(Y + srow * DM + 4 * lane + 256 * j); } } }
#pragma unroll
            for (int rr = 0; rr < 2; ++rr) { float s = 0.f;
#pragma unroll
                for (int j = 0; j < 4; ++j) { v[rr][j] = (f32x4){bflo(xw[rr][j].x), bfhi(xw[rr][j].x), bflo(xw[rr][j].y), bfhi(xw[rr][j].y)} + g2[j] * (f32x4){bflo(yw[rr][j].x), bfhi(yw[rr][j].x), bflo(yw[rr][j].y), bfhi(yw[rr][j].y)};
                    s += (v[rr][j].x * v[rr][j].x + v[rr][j].y * v[rr][j].y) + (v[rr][j].z * v[rr][j].z + v[rr][j].w * v[rr][j].w); }
                const float rs = 1.0f / sqrtf(wave_sum_fast(s) * (1.0f / DM) + EPS); float* orow = dst + (size_t)(row0 + r2 + rr) * DM;
#pragma unroll
                for (int j = 0; j < 4; ++j) *(f32x4*)(orow + 4 * lane + 256 * j) = v[rr][j] * (rs * tscale) * g[j]; }
        }
    }
}
constexpr int RT_T0H = 0, RT_T0L = 32768, RT_T1H = 65536, RT_T1L = 73728, RT_CA = 81920, RT_CB = 86016, RT_IMG = 90112, RT_PART = 90112, RT_STRIDE = 102400, RT_BIAS = 90112, RT_WCNT = 90240;
DI void router_tables(const Args& a, int lane) {
    const float* mod = (const float*)(a.ws + WS_MOD);
    for (int tk = blockIdx.x; tk < 512; tk += gridDim.x) {
        const int b = tk >> 7, kg = tk & 127, col = lane;
        if (col < 20) {
            unsigned char* img = a.ws + WS_RTAB + (size_t)b * RT_STRIDE;
            float part = 0.f; u32x4 hi, lo; f32x4 cav[2], cbv[2];
#pragma unroll
            for (int e = 0; e < 8; e += 2) { float wp[2];
#pragma unroll
                for (int h = 0; h < 2; ++h) { const int k = kg * 8 + e + h; const float w = col < 4 ? a.w_rg[k * 4 + col] : a.w_re[k * 16 + (col - 4)];
                    const float ca = a.g_ffn[k] * (mod[b * 6144 + 4096 + k] + 1.0f), cb = mod[b * 6144 + 3072 + k]; wp[h] = ca * w; part += cb * w; cav[(e + h) >> 2][(e + h) & 3] = ca; cbv[(e + h) >> 2][(e + h) & 3] = cb; }
                const unsigned hw = pk2(wp[0], wp[1]); hi[e >> 1] = hw; lo[e >> 1] = pk2(wp[0] - bflo(hw), wp[1] - bfhi(hw)); }
            if (col < 16) { *(u32x4*)(img + RT_T0H + (kg * 16 + col) * 16) = hi; *(u32x4*)(img + RT_T0L + (kg * 16 + col) * 16) = lo; }
            else { *(u32x4*)(img + RT_T1H + (kg * 4 + col - 16) * 16) = hi; *(u32x4*)(img + RT_T1L + (kg * 4 + col - 16) * 16) = lo; }
            *(float*)(img + RT_PART + (kg * 20 + col) * 4) = part;
            if (col == 0) { *(f32x4*)(img + RT_CA + kg * 32) = cav[0]; *(f32x4*)(img + RT_CA + kg * 32 + 16) = cav[1]; *(f32x4*)(img + RT_CB + kg * 32) = cbv[0]; *(f32x4*)(img + RT_CB + kg * 32 + 16) = cbv[1]; }
        }
    }
}
DI float rows4_sum(float v) { unsigned x = __builtin_bit_cast(unsigned, v), y = x; swap16(x, y); v = __builtin_bit_cast(float, x) + __builtin_bit_cast(float, y);
    x = __builtin_bit_cast(unsigned, v); y = x; swap32(x, y); return __builtin_bit_cast(float, x) + __builtin_bit_cast(float, y); }
typedef __bf16 bf16x2n_t __attribute__((ext_vector_type(2)));
DI float dot2sq(unsigned w, float c) { const bf16x2n_t v = __builtin_bit_cast(bf16x2n_t, w); return __builtin_amdgcn_fdot2_f32_bf16(v, v, c, false); }
DI void p5_router(const Args& a, LAS unsigned char* lds, int tid_, int lane_, int wave, int rep = 0) {
    int tid = threadIdx.x; asm volatile("" : "+v"(tid)); const int lane = tid & 63;
    const float* mod = (const float*)(a.ws + WS_MOD); bf16_t* H = (bf16_t*)(a.ws + WS_H);
    unsigned* cnt = (unsigned*)(a.ws + WS_CTL) + CW_CNT + 2048 * rep; int* list = (int*)(a.ws + WS_LIST); f32x2* wts = (f32x2*)(a.ws + WS_WTS);
    int* tpos = (int*)(a.ws + WS_TPOS); const bf16_t* X1 = (const bf16_t*)(a.ws + WS_X1);
    const int fr = lane & 15, fq = lane >> 4;
    LAS int* wcnt = (LAS int*)(lds + RT_WCNT);
    LAS float* bias = (LAS float*)(lds + RT_BIAS);
    int bprev = -1;
    for (int it = blockIdx.x; it < T / 128; it += gridDim.x) {
        const int row0 = it * 128 + wave * 16, b = row0 / SEQ; const bool newtab = b != bprev; bprev = b;
        const unsigned char* img = a.ws + WS_RTAB + (size_t)b * RT_STRIDE;
        float bp[8];
        if (newtab) {
#pragma unroll
            for (int i = 0; i < 11; ++i) __builtin_amdgcn_global_load_lds((const unsigned*)(img + ((i * 8 + wave) * 64 + lane) * 16), (LAS unsigned*)(lds + (i * 8 + wave) * 1024), 16, 0, 0);
#pragma unroll
            for (int q = 0; q < 8; ++q) bp[q] = tid < 320 ? *(const float*)(img + RT_PART + (((tid & 15) * 8 + q) * 20 + (tid >> 4)) * 4) : 0.f;
        }
        asm volatile("" ::: "memory");
        u32x4 xr[32];
        const bf16_t* xrow = X1 + (size_t)(row0 + fr) * DM + 8 * fq;
#pragma unroll
        for (int s_ = 0; s_ < 32; ++s_) xr[s_] = *(const u32x4*)(xrow + 32 * s_);
        asm volatile("s_waitcnt vmcnt(32)" ::: "memory");
        if (newtab) {
            float ps = ((bp[0] + bp[1]) + (bp[2] + bp[3])) + ((bp[4] + bp[5]) + (bp[6] + bp[7]));
            ps = DPP_ADD(ps, 0xB1); ps = DPP_ADD(ps, 0x4E); ps = DPP_ADD(ps, 0x141); ps = DPP_ADD(ps, 0x140);
            if (tid < 320 && (tid & 15) == 0) bias[tid >> 4] = ps;
            __syncthreads();
        }
        f32x4 acc0 = (f32x4){0.f, 0.f, 0.f, 0.f}, acc1 = acc0; float ssq = 0.f;
        {   const LAS unsigned char* t0 = lds + (fq * 16 + fr) * 16; const LAS unsigned char* t1 = lds + RT_T1H + (fq * 4 + (fr & 3)) * 16;
#pragma unroll
            for (int s_ = 0; s_ < 32; ++s_) { const bf16x8 xb = __builtin_bit_cast(bf16x8, xr[s_]);
                const bf16x8 w0h = *(const LAS bf16x8*)(t0 + s_ * 1024), w0l = *(const LAS bf16x8*)(t0 + RT_T0L + s_ * 1024), w1h = *(const LAS bf16x8*)(t1 + s_ * 256), w1l = *(const LAS bf16x8*)(t1 + (RT_T1L - RT_T1H) + s_ * 256);
                acc0 = __builtin_amdgcn_mfma_f32_16x16x32_bf16(w0h, xb, acc0, 0, 0, 0); acc1 = __builtin_amdgcn_mfma_f32_16x16x32_bf16(w1h, xb, acc1, 0, 0, 0);
                acc0 = __builtin_amdgcn_mfma_f32_16x16x32_bf16(w0l, xb, acc0, 0, 0, 0); acc1 = __builtin_amdgcn_mfma_f32_16x16x32_bf16(w1l, xb, acc1, 0, 0, 0);
                ssq = dot2sq(xr[s_].x, ssq); ssq = dot2sq(xr[s_].y, ssq); ssq = dot2sq(xr[s_].z, ssq); ssq = dot2sq(xr[s_].w, ssq); __builtin_amdgcn_sched_barrier(0); } }
        const float rs = 1.0f / sqrtf(rows4_sum(ssq) * (1.0f / DM) + EPS);
        float lg[4], l1[4];
#pragma unroll
        for (int i = 0; i < 4; ++i) { lg[i] = rs * acc0[i] + bias[4 * fq + i]; l1[i] = rs * acc1[i] + bias[16 + i]; }
        int g = 0; float gm = lg[0];
#pragma unroll
        for (int i = 1; i < 4; ++i) if (lg[i] > gm) { gm = lg[i]; g = i; }
        float gs = 0.f;
#pragma unroll
        for (int i = 0; i < 4; ++i) gs += expf(lg[i] - gm);
        const float gprob = 1.0f / gs;
        float el[4];
#pragma unroll
        for (int i = 0; i < 4; ++i) { const float o = __shfl(lg[i], (g < 3 ? fr + 16 * (g + 1) : lane)); el[i] = g < 3 ? o : l1[i]; }
        int i0 = 0; float m0 = el[0];
#pragma unroll
        for (int i = 1; i < 4; ++i) if (el[i] > m0) { m0 = el[i]; i0 = i; }
        int i1 = -1; float m1 = 0.f;
#pragma unroll
        for (int i = 0; i < 4; ++i) if (i != i0 && (i1 < 0 || el[i] > m1)) { m1 = el[i]; i1 = i; }
        const float ex = expf(m1 - m0), w0 = 1.0f / (1.0f + ex), w1 = ex * w0;
        const int ea = i0 < i1 ? i0 : i1, eb = i0 < i1 ? i1 : i0; const float mywa = (i0 < i1 ? w0 : w1) * gprob, mywb = (i0 < i1 ? w1 : w0) * gprob;
        int mybucket = g * 6 + (ea * (7 - ea)) / 2 + (eb - ea - 1);
        {   bf16_t* hrow = H + (size_t)(row0 + fr) * DM + 8 * fq; const LAS unsigned char* cp = lds + RT_CA + fq * 32;
#pragma unroll
            for (int s_ = 0; s_ < 32; ++s_) { const f32x4 ca0 = *(const LAS f32x4*)(cp + s_ * 128), ca1 = *(const LAS f32x4*)(cp + s_ * 128 + 16), cb0 = *(const LAS f32x4*)(cp + (RT_CB - RT_CA) + s_ * 128), cb1 = *(const LAS f32x4*)(cp + (RT_CB - RT_CA) + s_ * 128 + 16);
                const u32x4 xw = xr[s_]; const f32x4 v0 = (f32x4){bflo(xw.x), bfhi(xw.x), bflo(xw.y), bfhi(xw.y)}, v1 = (f32x4){bflo(xw.z), bfhi(xw.z), bflo(xw.w), bfhi(xw.w)};
                *(u32x4*)(hrow + 32 * s_) = pack8(v0 * rs * ca0 + cb0, v1 * rs * ca1 + cb1); __builtin_amdgcn_sched_barrier(0); } }
        if (lane >= 16) mybucket = -1;
        int myrank = 0;
        for (int q = 0; q < NBUCKET; ++q) { const unsigned long long mk = __ballot(mybucket == q); if (mybucket == q) myrank = __popcll(mk & ((1ull << lane) - 1ull)); if (lane == 0) wcnt[wave * NBUCKET + q] = __popcll(mk); }
        __syncthreads();
        if (tid < NBUCKET) { int tot = 0, pre[NWAVES];
#pragma unroll
            for (int w = 0; w < NWAVES; ++w) { pre[w] = tot; tot += wcnt[w * NBUCKET + tid]; }
            const unsigned base = tot ? atomicAdd(cnt + CNT_STRIDE * tid, (unsigned)tot) : 0u;
#pragma unroll
            for (int w = 0; w < NWAVES; ++w) wcnt[w * NBUCKET + tid] = (int)base + pre[w]; }
        __syncthreads();
        if (lane < 16) { const int p = wcnt[wave * NBUCKET + mybucket] + myrank; list[mybucket * T + p] = row0 + lane; wts[mybucket * T + p] = (f32x2){mywa, mywb}; tpos[row0 + lane] = (mybucket << 16) | p; }
        __syncthreads();
    }
}

struct GUnit { const bf16_t* A; const int* aidx; int nvalid; const bf16_t* B0; const bf16_t* B1; int pm, pn, lbase; };
namespace pg8 {
constexpr int BM = 256, BK = 64, HALF = 128, HTB = HALF * BK * 2, STAGE_BYTES = 8 * HTB;
DI int lds_byte(int r, int c) { const int st = (r >> 4) * 2 + (c >> 5), rr = r & 15, cc = c & 31, ob = rr * 64 + cc * 2; return st * 1024 + (ob ^ (((ob >> 9) & 1) << 5)); }
DI void stage_rc(int b, int& R, int& C) { const int st = b / 1024, sb = b % 1024, swz = sb ^ (((sb >> 9) & 1) << 5); R = (st >> 1) * 16 + swz / 64; C = (st & 1) * 32 + (swz % 64) / 2; }
DI int perm32(int rho) { const int n = rho >> 4, i = rho & 15; return 8 * (i >> 2) + 4 * n + (i & 3); }
DI void a_offsets(const GUnit& u, int K, int tid_, unsigned (&vo)[2][2]) {
    asm volatile("" : "+v"(tid_));
#pragma unroll
    for (int i = 0; i < 2; ++i) { int R, C; stage_rc(tid_ * 16 + i * 8192, R, C);
#pragma unroll
        for (int h = 0; h < 2; ++h) { const int r = h * HALF + R; const int gr = u.aidx ? u.aidx[r < u.nvalid ? r : 0] : r; vo[h][i] = ((unsigned)gr * (unsigned)K + (unsigned)C) * 2u; } }
}
template <class Sched, class Epi, bool ALIGN_EPI, int K, int ldb, int nsplit>
DI void gemm_phase(LAS unsigned char* lds, const Sched& S, const Epi& E) {
    int tid = threadIdx.x; asm volatile("" : "+v"(tid));
    const int wid = __builtin_amdgcn_readfirstlane(tid >> 6), lane = tid & 63, wr = wid >> 2, wc = wid & 3, fr = lane & 15, fq = lane >> 4;
    const int nt = K / BK;
    unsigned voffB[2];
#pragma unroll
    for (int i = 0; i < 2; ++i) { int R, C; stage_rc(tid * 16 + i * 8192, R, C); const int Rb = (R & ~31) + perm32(R & 31); voffB[i] = ((unsigned)Rb * (unsigned)ldb + (unsigned)C) * 2u; }
    const size_t hB = (size_t)HALF * ldb * 2;
    const unsigned ldsw = (unsigned)wid * 1024u;
    const int aoff = lds_byte(wr * 64 + fr, fq * 8), boff = lds_byte(wc * 32 + fr, fq * 8);
#define PG8_SA(b, h) (((b) * 2 + (h)) * HTB)
#define PG8_SB(b, h) ((4 + (b) * 2 + (h)) * HTB)
#define PG8_STAGE(bufoff, gbase, voff) do { _Pragma("unroll") for (int _i = 0; _i < 2; ++_i) \
        __builtin_amdgcn_global_load_lds((const unsigned*)((const char*)(gbase) + (voff)[_i]), (LAS unsigned*)(lds + (bufoff) + ldsw + _i * 8192), 16, 0, 0); } while (0)
#define PG8_LDA(dst, b, h) do { _Pragma("unroll") for (int m = 0; m < 4; ++m) _Pragma("unroll") for (int k = 0; k < 2; ++k) dst[m][k] = *(const LAS bf16x8*)(lds + PG8_SA(b, h) + aoff + m * 2048 + k * 1024); } while (0)
#define PG8_LDB(dst, b, h) do { _Pragma("unroll") for (int n = 0; n < 2; ++n) _Pragma("unroll") for (int k = 0; k < 2; ++k) dst[n][k] = *(const LAS bf16x8*)(lds + PG8_SB(b, h) + boff + n * 2048 + k * 1024); } while (0)
#define PG8_MMA(ai, bj, At, Bt) do { __builtin_amdgcn_s_setprio(1); _Pragma("unroll") for (int m = 0; m < 4; ++m) _Pragma("unroll") for (int n = 0; n < 2; ++n) _Pragma("unroll") for (int k = 0; k < 2; ++k) \
        acc[ai][bj][m][n] = __builtin_amdgcn_mfma_f32_16x16x32_bf16(Bt[n][k], At[m][k], acc[ai][bj][m][n], 0, 0, 0); __builtin_amdgcn_s_setprio(0); } while (0)
#define PG8_WAIT_V(n) asm volatile("s_waitcnt vmcnt(" #n ")" ::: "memory")
#define PG8_WAIT_L(n) asm volatile("s_waitcnt lgkmcnt(" #n ")" ::: "memory")
#define PG8_BAR __builtin_amdgcn_s_barrier()
#define PG8_SCHED __builtin_amdgcn_sched_barrier(0)
#define PG8_AK(u, kt) ((const char*)(u).A + (size_t)(kt) * (BK * 2))
#define PG8_BK(u, kt) ((kt) < nsplit ? (const char*)(u).B0 + (size_t)(kt) * (BK * 2) : (const char*)(u).B1 + (size_t)((kt) - nsplit) * (BK * 2))
    GUnit cur, nxt; int ui = 0;
    if (!S.next(0, cur)) return;
    f32x4 acc[2][2][4][2];
#pragma unroll
    for (int a = 0; a < 2; ++a)
#pragma unroll
        for (int b = 0; b < 2; ++b)
#pragma unroll
            for (int m = 0; m < 4; ++m)
#pragma unroll
                for (int n = 0; n < 2; ++n) acc[a][b][m][n] = (f32x4){0.f, 0.f, 0.f, 0.f};
    bf16x8 At[4][2], B0[2][2], B1[2][2];
    unsigned voffA[2][2];
    a_offsets(cur, K, tid, voffA);
    if constexpr (Epi::MIDK) E.prep(cur, 0, tid);
    {
        const char* a0 = PG8_AK(cur, 0); const char* b0 = PG8_BK(cur, 0); const char* a1 = PG8_AK(cur, 1); const char* b1 = PG8_BK(cur, 1);
        PG8_STAGE(PG8_SB(0, 0), b0, voffB); PG8_STAGE(PG8_SB(0, 1), b0 + hB, voffB); PG8_STAGE(PG8_SA(0, 0), a0, voffA[0]); PG8_STAGE(PG8_SA(0, 1), a0, voffA[1]);
        if (wr == 1) PG8_BAR;
        PG8_WAIT_V(2); PG8_BAR;
        PG8_STAGE(PG8_SB(1, 0), b1, voffB); PG8_STAGE(PG8_SA(1, 0), a1, voffA[0]); PG8_STAGE(PG8_SB(1, 1), b1 + hB, voffB);
        PG8_WAIT_V(6); PG8_BAR;
    }
    for (;;) {
        const bool has_next = S.next(ui + 1, nxt);
        if (!has_next) nxt = cur;
        for (int t = 0; t < nt; t += 2) {
            if constexpr (Epi::MIDK) { if (t == nt / 2) E.midk(acc, cur, wr, wc, fr, fq, ui & 1); }
            const bool last = (t == nt - 2);
            const char* a1 = PG8_AK(cur, t + 1);
            const char* a2 = last ? PG8_AK(nxt, 0) : PG8_AK(cur, t + 2); const char* b2 = last ? PG8_BK(nxt, 0) : PG8_BK(cur, t + 2);
            const char* a3 = last ? PG8_AK(nxt, 1) : PG8_AK(cur, t + 3); const char* b3 = last ? PG8_BK(nxt, 1) : PG8_BK(cur, t + 3);
            PG8_LDB(B0, 0, 0); PG8_LDB(B1, 0, 1); PG8_SCHED; PG8_LDA(At, 0, 0); PG8_STAGE(PG8_SA(1, 1), a1, voffA[1]);
            if (last) a_offsets(nxt, K, tid, voffA);
            PG8_WAIT_V(8); PG8_WAIT_L(0); PG8_BAR; PG8_MMA(0, 0, At, B0); PG8_MMA(0, 1, At, B1); PG8_BAR; PG8_SCHED;
            PG8_LDA(At, 0, 1); PG8_STAGE(PG8_SB(0, 0), b2, voffB); PG8_STAGE(PG8_SB(0, 1), b2 + hB, voffB); PG8_STAGE(PG8_SA(0, 0), a2, voffA[0]);
            PG8_WAIT_V(8); PG8_WAIT_L(0); PG8_BAR; PG8_MMA(1, 0, At, B0); PG8_MMA(1, 1, At, B1); PG8_BAR; PG8_SCHED;
            PG8_LDB(B0, 1, 0); PG8_LDB(B1, 1, 1); PG8_SCHED; PG8_LDA(At, 1, 0); PG8_STAGE(PG8_SA(0, 1), a2, voffA[1]);
            PG8_WAIT_V(8); PG8_WAIT_L(0); PG8_BAR; PG8_MMA(0, 0, At, B0); PG8_MMA(0, 1, At, B1); PG8_BAR; PG8_SCHED;
            PG8_LDA(At, 1, 1); PG8_STAGE(PG8_SB(1, 0), b3, voffB); PG8_STAGE(PG8_SB(1, 1), b3 + hB, voffB); PG8_STAGE(PG8_SA(1, 0), a3, voffA[0]);
            PG8_WAIT_V(8); PG8_WAIT_L(0); PG8_BAR; PG8_MMA(1, 0, At, B0); PG8_MMA(1, 1, At, B1); PG8_BAR; PG8_SCHED;
        }
        if constexpr (ALIGN_EPI) { if (wr == 0) PG8_BAR; }
        E(acc, cur, wr, wc, fr, fq, ui & 1);
        if (!has_next) break;
        if constexpr (Epi::MIDK) E.prep(nxt, (ui + 1) & 1, tid);
#pragma unroll
        for (int a = 0; a < 2; ++a)
#pragma unroll
            for (int b = 0; b < 2; ++b)
#pragma unroll
                for (int m = 0; m < 4; ++m)
#pragma unroll
                    for (int n = 0; n < 2; ++n) acc[a][b][m][n] = (f32x4){0.f, 0.f, 0.f, 0.f};
        cur = nxt; ++ui;
        if constexpr (ALIGN_EPI) { if (wr == 1) PG8_BAR; }
    }
    PG8_WAIT_V(0);
    if constexpr (!ALIGN_EPI) { if (wr == 0) PG8_BAR; }
    PG8_BAR;
#undef PG8_SA
#undef PG8_SB
#undef PG8_STAGE
#undef PG8_LDA
#undef PG8_LDB
#undef PG8_MMA
#undef PG8_WAIT_V
#undef PG8_WAIT_L
#undef PG8_BAR
#undef PG8_SCHED
#undef PG8_AK
#undef PG8_BK
}
}
struct DenseSched {
    const bf16_t* A; const bf16_t* Bt; int K, nM, nN;
    DI bool next(int i, GUnit& u) const {
        const int nwg = nM * nN; const long L = (long)i * (int)gridDim.x + (int)blockIdx.x; if (L >= nwg) return false;
        int wgid = (int)L; { const int q = nwg / 8, r = nwg % 8, xcd = wgid % 8, off = wgid / 8; wgid = (xcd < r ? xcd * (q + 1) : r * (q + 1) + (xcd - r) * q) + off; }
        const int nig = 8 * nN, gid = wgid / nig, fm = gid * 8, gsz = (nM - fm) < 8 ? (nM - fm) : 8;
        u.pm = fm + ((wgid % nig) % gsz); u.pn = (wgid % nig) / gsz;
        u.A = A + (size_t)u.pm * 256 * K; u.aidx = nullptr; u.nvalid = 256; u.B0 = Bt + (size_t)u.pn * 256 * K; u.B1 = u.B0; u.lbase = 0; return true; }
};
template <bool up> DI void moe_fill_unit(GUnit& u, int ti, int pn, const LAS int* tstart, const unsigned* cnt, const int* list, const bf16_t* A, const bf16_t* W) {
    int b = 0;
    for (int q = 1; q < NBUCKET; ++q) if (__builtin_amdgcn_readfirstlane(tstart[q]) <= ti) b = q;
    const int rt = ti - __builtin_amdgcn_readfirstlane(tstart[b]); const int g = b / 6, p = b % 6; const int ea = 4 * g + (p < 3 ? 0 : (p < 5 ? 1 : 2)), eb = 4 * g + (p < 3 ? p + 1 : (p < 5 ? p - 1 : 3));
    u.pm = ti; u.pn = pn; u.lbase = b * T + rt * 256; const int nv = __builtin_amdgcn_readfirstlane((int)cnt[CNT_STRIDE * b]) - rt * 256; u.nvalid = nv < 256 ? nv : 256;
    if (up) { u.A = A; u.aidx = list + u.lbase; const int e = pn < 4 ? ea : eb; u.B0 = W + (size_t)e * 1024 * 1024 + (size_t)(pn & 3) * 256 * 1024; u.B1 = u.B0; }
    else { u.A = A + (size_t)ti * 256 * 1024; u.aidx = nullptr; u.B0 = W + (size_t)ea * 1024 * 512 + (size_t)pn * 256 * 512; u.B1 = W + (size_t)eb * 1024 * 512 + (size_t)pn * 256 * 512; }
}
template <int NT, bool up> struct MoeSched {
    const LAS int* tstart; const unsigned* cnt; const int* list; const bf16_t* A; const bf16_t* W;
    DI bool next(int i, GUnit& u) const {
        const int ntile = __builtin_amdgcn_readfirstlane(tstart[NBUCKET]), nwg = ntile * NT; const int L0 = i * (int)gridDim.x + (int)blockIdx.x; if (L0 >= nwg) return false;
        int L = L0; { const int q = nwg / 8, r = nwg % 8, xcd = L0 % 8, off = L0 / 8; L = (xcd < r ? xcd * (q + 1) : r * (q + 1) + (xcd - r) * q) + off; }
        moe_fill_unit<up>(u, L / NT, L % NT, tstart, cnt, list, A, W); return true;
    }
};
struct MoeCut { int x, tiles_x, cstart, left, nY; };
DI MoeCut moe_cut(int ntile) { MoeCut c; c.x = (int)blockIdx.x & 7; const int q = ntile / 8, r = ntile % 8; c.tiles_x = q + (c.x < r ? 1 : 0); c.cstart = c.x * q + (c.x < r ? c.x : r); c.left = 8 * (c.tiles_x - 16); c.nY = 32 - c.left; return c; }
template <bool up, int MODE> struct MoeSplitSched {
    const LAS int* tstart; const unsigned* cnt; const int* list; const bf16_t* A; const bf16_t* W; MoeCut c;
    DI bool next(int i, GUnit& u) const {
        const int w = (int)blockIdx.x >> 3; int ti, pn;
        if (MODE == 1) { if (i >= 4) return false; const int off = i * 32 + w; ti = c.cstart + (off >> 3); pn = off & 7; }
        else if (MODE == 2 && up) { if (i > 0) return false; const int off = 128 + w; ti = c.cstart + (off >> 3); pn = off & 7; }
        else if (MODE == 2) { if (i > 0) return false; const int d = w - c.left; ti = c.cstart + (d >> 2); pn = d & 3; }
        else { const int e = i * 32 + w, rem = 4 * c.tiles_x - c.nY; if (e >= rem) return false;
            if (e < 64 - c.nY) { const int d = c.nY + e; ti = c.cstart + (d >> 2); pn = d & 3; } else { const int l = e - (64 - c.nY); ti = c.cstart + 16 + (l >> 2); pn = l & 3; } }
        moe_fill_unit<up>(u, ti, pn, tstart, cnt, list, A, W); return true;
    }
};

struct EpiProj { static constexpr bool MIDK = false;
    bf16_t *qsb, *vtsb, *qsw, *ksw, *vtsw; const float *cosT, *sinT;
    DI void operator()(const f32x4 (&acc)[2][2][4][2], const GUnit& u, int wr, int wc, int fr, int fq, int) const {
        const int pn = u.pn, rowb = u.pm * 256 + wr * 64 + fr;
        if (pn < 4) {
            bf16_t* base = qsb + (size_t)(pn >> 1) * ((WS_KSB - WS_QSB) / 2); const float sc = pn < 2 ? QSCALE : 1.0f; const int colt = (pn & 1) * 256 + wc * 32 + 8 * fq;
#pragma unroll
            for (int ai = 0; ai < 2; ++ai)
#pragma unroll
                for (int m = 0; m < 4; ++m) { const size_t row = rowb + ai * 128 + m * 16;
#pragma unroll
                    for (int bj = 0; bj < 2; ++bj) *(u32x4*)(base + row * 512 + colt + bj * 128) = pack8(acc[ai][bj][m][0] * sc, acc[ai][bj][m][1] * sc); }
        } else if (pn < 6 || (pn == 8 && wc >= 2)) {
            bf16_t* base = pn < 6 ? vtsb : vtsw; const int NF = pn < 6 ? 512 : 128, c0 = pn < 6 ? (pn - 4) * 256 + wc * 32 + 8 * fq : (wc * 32 - 64) + 8 * fq, bjs = pn < 6 ? 128 : 64;
#pragma unroll
            for (int ai = 0; ai < 2; ++ai)
#pragma unroll
                for (int m = 0; m < 4; ++m) { const int row = rowb + ai * 128 + m * 16; bf16_t* bp = base + ((size_t)(row >> 5) * NF + c0) * 32 + (row & 31);
#pragma unroll
                    for (int bj = 0; bj < 2; ++bj)
#pragma unroll
                        for (int n = 0; n < 2; ++n)
#pragma unroll
                            for (int j = 0; j < 4; ++j) bp[(bj * bjs + 4 * n + j) * 32] = (bf16_t)f2bf(acc[ai][bj][m][n][j]); }
        } else {
            const bool isq = pn < 8; bf16_t* base = isq ? qsw : ksw; const int pitch = isq ? 512 : 128; const int head = isq ? (pn - 6) * 4 + wc : wc; const float sc = isq ? QSCALE : 1.0f;
#pragma unroll
            for (int ai = 0; ai < 2; ++ai)
#pragma unroll
                for (int m = 0; m < 4; ++m) { const size_t row = rowb + ai * 128 + m * 16;
                    const f32x4 c0 = *(const f32x4*)(cosT + row * 32 + 8 * fq), c1 = *(const f32x4*)(cosT + row * 32 + 8 * fq + 4);
                    const f32x4 s0 = *(const f32x4*)(sinT + row * 32 + 8 * fq), s1 = *(const f32x4*)(sinT + row * 32 + 8 * fq + 4);
                    const f32x4 x10 = acc[ai][0][m][0], x11 = acc[ai][0][m][1], x20 = acc[ai][1][m][0], x21 = acc[ai][1][m][1];
                    const f32x4 o10 = (x10 * c0 - x20 * s0) * sc, o11 = (x11 * c1 - x21 * s1) * sc, o20 = (x20 * c0 + x10 * s0) * sc, o21 = (x21 * c1 + x11 * s1) * sc;
                    *(u32x4*)(base + row * pitch + head * 64 + 8 * fq) = pack8(o10, o11); *(u32x4*)(base + row * pitch + head * 64 + 32 + 8 * fq) = pack8(o20, o21); }
        }
    }
};
struct EpiWout {
    static constexpr bool MIDK = true;
    const float* mod; bf16_t* x1; const float* x; const float* ssq; LAS float* tab;
    DI void prep(const GUnit& u, int par, int tid) const {
        if (tid < 256) { const size_t row = (size_t)u.pm * 256 + tid; const f32x4 a0 = *(const f32x4*)(ssq + row * 16), a1 = *(const f32x4*)(ssq + row * 16 + 4), b0 = *(const f32x4*)(ssq + row * 16 + 8), b1 = *(const f32x4*)(ssq + row * 16 + 12);
            const float sa = ((a0.x + a0.y) + (a0.z + a0.w)) + ((a1.x + a1.y) + (a1.z + a1.w)), sb = ((b0.x + b0.y) + (b0.z + b0.w)) + ((b1.x + b1.y) + (b1.z + b1.w));
            const float rsb = 1.0f / sqrtf(sa * (1.0f / 512.0f) + EPS), rsw = 1.0f / sqrtf(sb * (1.0f / 512.0f) + EPS);
            *(LAS f32x2*)(tab + (par * 256 + tid) * 2) = (f32x2){rsb / rsw, rsw}; }
        else tab[1024 + par * 256 + (tid - 256)] = mod[((u.pm * 256) / SEQ) * 6144 + 2048 + u.pn * 256 + (tid - 256)];
    }
    DI void midk(f32x4 (&acc)[2][2][4][2], const GUnit& u, int wr, int wc, int fr, int fq, int par) const {
#pragma unroll
        for (int ai = 0; ai < 2; ++ai)
#pragma unroll
            for (int m = 0; m < 4; ++m) { const float ratio = tab[(par * 256 + ai * 128 + wr * 64 + m * 16 + fr) * 2];
#pragma unroll
                for (int bj = 0; bj < 2; ++bj)
#pragma unroll
                    for (int n = 0; n < 2; ++n) acc[ai][bj][m][n] = acc[ai][bj][m][n] * ratio; }
    }
    DI void operator()(f32x4 (&acc)[2][2][4][2], const GUnit& u, int wr, int wc, int fr, int fq, int par) const {
        const int rowb = u.pm * 256 + wr * 64 + fr, colb = u.pn * 256 + wc * 32 + 8 * fq; const int b = (u.pm * 256) / SEQ;
        f32x4 gt[2][2];
#pragma unroll
        for (int bj = 0; bj < 2; ++bj)
#pragma unroll
            for (int n = 0; n < 2; ++n) gt[bj][n] = *(const LAS f32x4*)(tab + 1024 + par * 256 + wc * 32 + 8 * fq + bj * 128 + 4 * n);
        const __amdgpu_buffer_rsrc_t xr = __builtin_amdgcn_make_buffer_rsrc((void*)x, 0, (int)((size_t)T * DM * 4), 0x00020000);
        const unsigned xo = ((unsigned)rowb * DM + (unsigned)colb) * 4u;
        f32x4 xa[2][2][2], xb[2][2][2];
#define WO_LOAD(dst, q) do { _Pragma("unroll") for (int mm = 0; mm < 2; ++mm) _Pragma("unroll") for (int bj = 0; bj < 2; ++bj) _Pragma("unroll") for (int n = 0; n < 2; ++n) \
            dst[mm][bj][n] = __builtin_bit_cast(f32x4, __builtin_amdgcn_raw_buffer_load_b128(xr, xo + (unsigned)(bj * 512 + n * 16), (((q) >> 1) * 128 + (2 * ((q) & 1) + mm) * 16) * (DM * 4), 2)); } while (0)
#define WO_PROC(src, q) do { _Pragma("unroll") for (int mm = 0; mm < 2; ++mm) { const int ai = (q) >> 1, m = 2 * ((q) & 1) + mm, row = rowb + ai * 128 + m * 16; const float rsw = tab[(par * 256 + ai * 128 + wr * 64 + m * 16 + fr) * 2 + 1]; \
            _Pragma("unroll") for (int bj = 0; bj < 2; ++bj) *(u32x4*)(x1 + (size_t)row * DM + colb + bj * 128) = pack8(src[mm][bj][0] + acc[ai][bj][m][0] * rsw, src[mm][bj][1] + acc[ai][bj][m][1] * rsw); } } while (0)
        WO_LOAD(xa, 0); asm volatile("" ::: "memory");
#pragma unroll
        for (int ai = 0; ai < 2; ++ai)
#pragma unroll
            for (int bj = 0; bj < 2; ++bj)
#pragma unroll
                for (int m = 0; m < 4; ++m)
#pragma unroll
                    for (int n = 0; n < 2; ++n) acc[ai][bj][m][n] = acc[ai][bj][m][n] * gt[bj][n];
        asm volatile("" ::: "memory"); WO_LOAD(xb, 1); asm volatile("" ::: "memory");
        WO_PROC(xa, 0); asm volatile("" ::: "memory"); WO_LOAD(xa, 2); asm volatile("" ::: "memory");
        WO_PROC(xb, 1); asm volatile("" ::: "memory"); WO_LOAD(xb, 3); asm volatile("" ::: "memory");
        WO_PROC(xa, 2); asm volatile("" ::: "memory"); WO_PROC(xb, 3); asm volatile("" ::: "memory");
#undef WO_LOAD
#undef WO_PROC
    }
};
DI f32x4 swiglu4(const f32x4 g, const f32x4 uu, float w) { f32x4 o;
#pragma unroll
    for (int j = 0; j < 4; ++j) o[j] = (w * uu[j]) * (g[j] * __builtin_amdgcn_rcpf(1.0f + __builtin_amdgcn_exp2f(-LOG2E * g[j])));
    return o; }
struct EpiUp { static constexpr bool MIDK = true;
    bf16_t* hid; const f32x2* wts; LAS float* tab;
    DI void prep(const GUnit& u, int par, int tid) const {
        if (tid < 256) { float w = 0.f; if (tid < u.nvalid) { const f32x2 ww = wts[u.lbase + tid]; w = u.pn >= 4 ? ww.y : ww.x; } tab[par * 256 + tid] = w; }
    }
    DI void midk(f32x4 (&)[2][2][4][2], const GUnit&, int, int, int, int, int) const {}
    DI void operator()(const f32x4 (&acc)[2][2][4][2], const GUnit& u, int wr, int wc, int fr, int fq, int par) const {
        const int hc = (u.pn >> 2) * 512 + (u.pn & 3) * 128 + wc * 32 + 8 * fq;
#pragma unroll
        for (int ai = 0; ai < 2; ++ai)
#pragma unroll
            for (int m = 0; m < 4; ++m) { const int r = ai * 128 + wr * 64 + m * 16 + fr; const float w = tab[par * 256 + r];
                *(u32x4*)(hid + (size_t)(u.pm * 256 + r) * 1024 + hc) = pack8(swiglu4(acc[ai][0][m][0], acc[ai][1][m][0], w), swiglu4(acc[ai][0][m][1], acc[ai][1][m][1], w)); }
    }
};
struct EpiDown { static constexpr bool MIDK = false;
    bf16_t* y;
    DI void operator()(const f32x4 (&acc)[2][2][4][2], const GUnit& u, int wr, int wc, int fr, int fq, int) const {
        const int rowb = u.pm * 256 + wr * 64 + fr, colb = u.pn * 256 + wc * 32 + 8 * fq;
#pragma unroll
        for (int ai = 0; ai < 2; ++ai)
#pragma unroll
            for (int m = 0; m < 4; ++m) { const size_t row = rowb + ai * 128 + m * 16;
#pragma unroll
                for (int bj = 0; bj < 2; ++bj) *(u32x4*)(y + row * DM + colb + bj * 128) = pack8(acc[ai][bj][m][0], acc[ai][bj][m][1]); }
    }
};

typedef float f32x16 __attribute__((ext_vector_type(16)));
#define MFMA32(a, b, c) __builtin_amdgcn_mfma_f32_32x32x16_bf16((a), (b), (c), 0, 0, 0)
DI int pi32(int r) { return (r & ~12) | ((r & 4) << 1) | ((r & 8) >> 1); }
DI int crow(int i, int h) { return (i & 3) + 8 * (i >> 2) + 4 * h; }
template <int S_> DI bf16x8 packacc(const f32x16& x) { u32x4 p; p.x = pk2(x[8 * S_], x[8 * S_ + 1]); p.y = pk2(x[8 * S_ + 2], x[8 * S_ + 3]); p.z = pk2(x[8 * S_ + 4], x[8 * S_ + 5]); p.w = pk2(x[8 * S_ + 6], x[8 * S_ + 7]); return __builtin_bit_cast(bf16x8, p); }
DI f32x16 zero16() { f32x16 z;
#pragma unroll
    for (int i = 0; i < 16; ++i) z[i] = 0.f;
    return z; }
constexpr int AT_SLOT = 16384, ATT_NSLOT = 6;
constexpr int ATT_STG_OFF = ATT_NSLOT * AT_SLOT, ATT_STGW = 32 * 36;
constexpr int ATT_LS_OFF = ATT_STG_OFF + NWAVES * ATT_STGW * 4, ATT_CTL_OFF = ATT_LS_OFF + NWAVES * 32 * 4;
static_assert(ATT_CTL_OFF + 64 <= LDS_MISC, "attention LDS map");
#define AT_WAIT_V(n) asm volatile("s_waitcnt vmcnt(" #n ")" ::: "memory")
#define AT_BARRIER() do { asm volatile("s_waitcnt lgkmcnt(0)" ::: "memory"); __builtin_amdgcn_s_barrier(); asm volatile("" ::: "memory"); } while (0)
DI void at_issue(const bf16_t* Kg, int kp, const bf16_t* VTg, int nf, LAS unsigned char* slotp, int jt, int wave, int lane) {
    const int key = 8 * wave + (lane >> 3), chunk = (lane & 7) ^ ((key >> 1) & 7);
    __builtin_amdgcn_global_load_lds((const unsigned*)(Kg + (64 * (size_t)jt + key) * kp + chunk * 8), (LAS unsigned*)(slotp + wave * 1024), 16, 0, 0);
    const int hh = wave >> 2, d = 16 * (wave & 3) + (lane >> 2), sl = (lane & 3) ^ ((d >> 2) & 3);
    __builtin_amdgcn_global_load_lds((const unsigned*)(VTg + ((2 * (size_t)jt + hh) * nf + d) * 32 + sl * 8), (LAS unsigned*)(slotp + 8192 + wave * 1024), 16, 0, 0);
}
DI void at_kfrag(const LAS unsigned char* sl, int hh, int r, int h, bf16x8 (&kf)[4]) { const int key = 32 * hh + pi32(r), ksw = (key >> 1) & 7; const LAS unsigned char* kb = sl + key * 128;
#pragma unroll
    for (int d0 = 0; d0 < 4; ++d0) kf[d0] = *(const LAS bf16x8*)(kb + (((2 * d0 + h) ^ ksw) * 16)); }
DI void at_vfrag(const LAS unsigned char* sl, int hh, int r, int h, bf16x8 (&vf)[2][2]) {
#pragma unroll
    for (int dt = 0; dt < 2; ++dt)
#pragma unroll
        for (int sx = 0; sx < 2; ++sx) { const int d = 32 * dt + r; vf[dt][sx] = *(const LAS bf16x8*)(sl + 8192 + hh * 4096 + d * 64 + (((2 * sx + h) ^ ((d >> 2) & 3)) * 16)); } }

template <int DIAG> DI void sb_half(const LAS unsigned char* sl, int hh, const bf16x8 (&qf)[4], float& Cl, f32x16 (&o)[2], int r, int h) {
    bf16x8 kf[4], vf[2][2];
    at_kfrag(sl, hh, r, h, kf); at_vfrag(sl, hh, r, h, vf);
    f32x16 S = zero16();
#pragma unroll
    for (int d0 = 0; d0 < 4; ++d0) S = MFMA32(kf[d0], qf[d0], S);
    float om[16];
#pragma unroll
    for (int i = 0; i < 16; ++i) { float v = __builtin_amdgcn_rcpf(1.0f + __builtin_amdgcn_exp2f(S[i])); if (DIAG && !(16 * (i >> 3) + 8 * h + (i & 7) < r)) v = 1.0f; om[i] = v; }
    f32x2 sf[8]; sf[7] = (f32x2){1.0f, 1.0f};
#pragma unroll
    for (int i = 6; i >= 0; --i) sf[i] = sf[i + 1] * (f32x2){om[i + 1], om[i + 9]};
    float Rx = sf[0].x * om[0], Ry = sf[0].y * om[8];
    asm volatile("" : "+v"(Rx), "+v"(Ry));
    unsigned ax = __builtin_bit_cast(unsigned, Rx), ay = __builtin_bit_cast(unsigned, Ry), bx = ay, by = ax;
    swap32(ax, ay); swap32(bx, by);
    const float p0 = __builtin_bit_cast(float, h == 0 ? ay : bx), p1 = __builtin_bit_cast(float, h == 0 ? by : ax);
    const float m1 = (h == 0 ? p1 : 1.0f) * Cl, m0 = (h == 0 ? p0 * p1 : p1) * Ry * Cl;
    Cl = Cl * ((Rx * Ry) * (p0 * p1));
    const f32x2 mm = (f32x2){m0, m1};
    f32x16 P;
#pragma unroll
    for (int i = 0; i < 8; ++i) { const f32x2 w = (sf[i] * mm) * ((f32x2){1.0f, 1.0f} - (f32x2){om[i], om[i + 8]}); P[i] = w.x; P[i + 8] = w.y; }
    const bf16x8 Pf0 = packacc<0>(P), Pf1 = packacc<1>(P);
#pragma unroll
    for (int dt = 0; dt < 2; ++dt) { o[dt] = MFMA32(Pf0, vf[dt][0], o[dt]); o[dt] = MFMA32(Pf1, vf[dt][1], o[dt]); }
}
constexpr float SB_CMIN = 5.421010862427522e-20f;
struct SbUnit { int b, hd, q0; };
DI SbUnit sb_unit_of(int idx) { SbUnit u; u.b = idx / 512; u.hd = (idx >> 6) & 7; u.q0 = (idx & 63) * 128; return u; }
DI void grp_barrier(volatile LAS int* bar, int& epoch, int lane) {
    asm volatile("s_waitcnt lgkmcnt(0)" ::: "memory"); ++epoch;
    if (lane == 0) __hip_atomic_fetch_add((LAS int*)bar, 1, __ATOMIC_RELAXED, __HIP_MEMORY_SCOPE_WORKGROUP);
    while (*bar < 4 * epoch) __builtin_amdgcn_s_sleep(1);
    asm volatile("" ::: "memory");
}
DI void at_issue4(const bf16_t* Kg, const bf16_t* VTg, LAS unsigned char* slotp, int jt, int w4, int lane) {
#pragma unroll
    for (int pp = 0; pp < 2; ++pp) { const int pc = w4 + 4 * pp;
        const int key = 8 * pc + (lane >> 3), chunk = (lane & 7) ^ ((key >> 1) & 7);
        __builtin_amdgcn_global_load_lds((const unsigned*)(Kg + (64 * (size_t)jt + key) * 512 + chunk * 8), (LAS unsigned*)(slotp + pc * 1024), 16, 0, 0);
        const int hh = pc >> 2, d = 16 * (pc & 3) + (lane >> 2), sl = (lane & 3) ^ ((d >> 2) & 3);
        __builtin_amdgcn_global_load_lds((const unsigned*)(VTg + ((2 * (size_t)jt + hh) * 512 + d) * 32 + sl * 8), (LAS unsigned*)(slotp + 8192 + pc * 1024), 16, 0, 0); }
}
DI int sb_prologue(const bf16_t* Q, const bf16_t* K, const bf16_t* VT, const SbUnit& u, LAS unsigned char* ring, int w4, int lane, bf16x8 (&qf)[4]) {
    const int r = lane & 31, h = lane >> 5; const size_t gb = (size_t)u.b * SEQ; const int t0w = u.q0 + 32 * w4;
    const bf16_t* Kg = K + gb * 512 + u.hd * 64; const bf16_t* VTg = VT + ((gb >> 5) * 512 + u.hd * 64) * 32;
    const int jt_hi = (u.q0 + 127) >> 6, ntiles = jt_hi + 1; int issued = 0;
    for (; issued < 2 && issued < ntiles; ++issued) at_issue4(Kg, VTg, ring + issued * AT_SLOT, jt_hi - issued, w4, lane);
#pragma unroll
    for (int d0 = 0; d0 < 4; ++d0) qf[d0] = *(const bf16x8*)(Q + (gb + t0w + r) * 512 + u.hd * 64 + 16 * d0 + 8 * h);
    return issued;
}
DI void sb_body(const bf16_t* K, const bf16_t* VT, const SbUnit& u, int issued, bf16x8 (&qf)[4], LAS unsigned char* ring, volatile LAS int* ctl, volatile LAS int* bar, int& epoch, int w4, int lane, f32x16 (&o)[2]) {
    const int r = lane & 31, h = lane >> 5; const size_t gb = (size_t)u.b * SEQ; const int t0w = u.q0 + 32 * w4, sd = t0w >> 5;
    o[0] = zero16(); o[1] = zero16(); float Cl = 1.0f;
    const bf16_t* Kg = K + gb * 512 + u.hd * 64; const bf16_t* VTg = VT + ((gb >> 5) * 512 + u.hd * 64) * 32;
    const int jt_hi = (u.q0 + 127) >> 6, ntiles = jt_hi + 1;
    if (w4 == 0 && lane == 0) { ctl[0] = 0; ctl[1] = 0; ctl[2] = 0; }
    asm volatile("s_waitcnt vmcnt(0)" : "+v"(qf[0]), "+v"(qf[1]), "+v"(qf[2]), "+v"(qf[3]) :: "memory");
    bool done = false; int slot = 0;
    for (int i = 0; i < ntiles; ++i) {
        const int jt = jt_hi - i, fly = issued - (i + 1);
        if (fly >= 1) AT_WAIT_V(4); else AT_WAIT_V(0);
        grp_barrier(bar, epoch, lane);
        if (i > 0 && ctl[(i - 1) % 3] == 4) break;
        if (w4 == 0 && lane == 0) ctl[(i + 1) % 3] = 0;
        if (issued < ntiles) { at_issue4(Kg, VTg, ring + ((slot + 2) % 3) * AT_SLOT, jt_hi - issued, w4, lane); ++issued; }
        if (!done) {
            const LAS unsigned char* sl = ring + slot * AT_SLOT;
            const int s1 = 2 * jt + 1, s0 = 2 * jt;
            if (s1 < sd) sb_half<0>(sl, 1, qf, Cl, o, r, h); else if (s1 == sd) sb_half<1>(sl, 1, qf, Cl, o, r, h);
            if (s0 < sd) sb_half<0>(sl, 0, qf, Cl, o, r, h); else if (s0 == sd) sb_half<1>(sl, 0, qf, Cl, o, r, h);
            if (s1 <= sd || s0 <= sd) done = __all(Cl < SB_CMIN);
        }
        if (done && lane == 0) __hip_atomic_fetch_add((LAS int*)&ctl[i % 3], 1, __ATOMIC_RELAXED, __HIP_MEMORY_SCOPE_WORKGROUP);
        slot = (slot + 1) % 3;
    }
    AT_WAIT_V(0);
    grp_barrier(bar, epoch, lane);
}
DI void sw_head(const bf16x8 (&qf)[4], const LAS unsigned char* lds, float sink2, int t0, int jt_lo, int lane, f32x16 (&o)[2], float& lsum) {
    const int r = lane & 31, h = lane >> 5, sd = t0 >> 5;
    f32x16 S[5]; float m = sink2;
#pragma unroll
    for (int jj = 0; jj < 5; ++jj) { const int sj = sd - 4 + jj;
        if (sj >= 0) { bf16x8 kf[4]; at_kfrag(lds + ((sj >> 1) - jt_lo) * AT_SLOT, sj & 1, r, h, kf);
            f32x16 s = zero16();
#pragma unroll
            for (int d0 = 0; d0 < 4; ++d0) s = MFMA32(kf[d0], qf[d0], s);
#pragma unroll
            for (int i = 0; i < 16; ++i) { const int ko = 16 * (i >> 3) + 8 * h + (i & 7); float v = s[i];
                if (jj == 4 && ko > r) v = -1e30f;
                if (jj == 0 && ko <= r) v = -1e30f;
                s[i] = v; m = __builtin_fmaxf(m, v); }
            S[jj] = s; }
        else {
#pragma unroll
            for (int i = 0; i < 16; ++i) S[jj][i] = -1e30f; } }
    m = __builtin_fmaxf(m, __shfl_xor(m, 32));
    o[0] = zero16(); o[1] = zero16(); float ls = 0.f;
#pragma unroll
    for (int jj = 0; jj < 5; ++jj) { const int sj = sd - 4 + jj;
        if (sj >= 0) { bf16x8 vf[2][2]; at_vfrag(lds + ((sj >> 1) - jt_lo) * AT_SLOT, sj & 1, r, h, vf);
            f32x16 P;
#pragma unroll
            for (int i = 0; i < 16; ++i) { P[i] = __builtin_amdgcn_exp2f(S[jj][i] - m); ls += P[i]; }
            const bf16x8 Pf0 = packacc<0>(P), Pf1 = packacc<1>(P);
#pragma unroll
            for (int dt = 0; dt < 2; ++dt) { o[dt] = MFMA32(Pf0, vf[dt][0], o[dt]); o[dt] = MFMA32(Pf1, vf[dt][1], o[dt]); } } }
    ls += __shfl_xor(ls, 32);
    lsum = ls + __builtin_amdgcn_exp2f(sink2 - m);
}
DI void at_store(const f32x16 (&o)[2], float lsum, LAS float* stg, LAS float* lsb, bf16_t* mixrow0, float* ssq0, int lane) {
    const int r = lane & 31, h = lane >> 5, row = lane >> 1, hf = lane & 1;
    if (h == 0) lsb[r] = lsum;
    float ss = 0.f; u32x4 w[2][2];
#pragma unroll
    for (int dt = 0; dt < 2; ++dt) {
#pragma unroll
        for (int i = 0; i < 16; ++i) stg[crow(i, h) * 36 + r] = o[dt][i];
        LDS_WAIT();
        const float il = 1.0f / lsb[row];
#pragma unroll
        for (int k = 0; k < 2; ++k) { const f32x4 a0 = *(const LAS f32x4*)(stg + row * 36 + hf * 16 + 8 * k) * il, a1 = *(const LAS f32x4*)(stg + row * 36 + hf * 16 + 8 * k + 4) * il;
            ss += ((a0.x * a0.x + a0.y * a0.y) + (a0.z * a0.z + a0.w * a0.w)) + ((a1.x * a1.x + a1.y * a1.y) + (a1.z * a1.z + a1.w * a1.w)); w[dt][k] = pack8(a0, a1); }
        LDS_WAIT();
    }
    ss += __shfl_xor(ss, 1);
    if (hf == 0) ssq0[(size_t)row * 16] = ss;
    bf16_t* mr = mixrow0 + (size_t)row * 1024 + hf * 16;
#pragma unroll
    for (int dt = 0; dt < 2; ++dt) { *(u32x4*)(mr + 32 * dt) = w[dt][0]; *(u32x4*)(mr + 32 * dt + 8) = w[dt][1]; }
}
DI void p3_attention(const Args& a, LAS unsigned char* lds, int tid, int lane, int wave, int rep = 0, int kinds = 3) {
    asm volatile("" : "+v"(tid), "+v"(lane));
    const bf16_t* QSB = (const bf16_t*)(a.ws + WS_QSB); const bf16_t* KSB = (const bf16_t*)(a.ws + WS_KSB); const bf16_t* VTSB = (const bf16_t*)(a.ws + WS_VSB);
    const bf16_t* QSW = (const bf16_t*)(a.ws + WS_QSW); const bf16_t* KSW = (const bf16_t*)(a.ws + WS_KSW); const bf16_t* VTSW = (const bf16_t*)(a.ws + WS_VSW);
    bf16_t* MIX = (bf16_t*)(a.ws + WS_MIX); float* SSQ = (float*)(a.ws + WS_SSQ); unsigned* qctr = (unsigned*)(a.ws + WS_CTL) + CW_ATTNQ + 2048 * rep;
    LAS float* stg = (LAS float*)(lds + ATT_STG_OFF) + wave * ATT_STGW; LAS float* lsb = (LAS float*)(lds + ATT_LS_OFF) + wave * 32; volatile LAS int* ctl = (volatile LAS int*)(lds + ATT_CTL_OFF);
    if (kinds & 2)
    for (int u = (int)blockIdx.x; u < (T / 256) * 2; u += (int)gridDim.x) {
        const int b = u / 64, kvh = (u >> 5) & 1, q0 = (u & 31) * 256, jt_lo = (q0 >> 6) - 2, t0 = q0 + 32 * wave; const size_t gb = (size_t)b * SEQ;
        const bf16_t* Kg = KSW + gb * 128 + kvh * 64; const bf16_t* VTg = VTSW + ((gb >> 5) * 128 + kvh * 64) * 32;
#pragma unroll
        for (int s6 = 0; s6 < 6; ++s6) if (jt_lo + s6 >= 0) at_issue(Kg, 128, VTg, 128, lds + s6 * AT_SLOT, jt_lo + s6, wave, lane);
        bf16x8 qn[4];
#pragma unroll
        for (int d0 = 0; d0 < 4; ++d0) qn[d0] = *(const bf16x8*)(QSW + (gb + t0 + (lane & 31)) * 512 + (4 * kvh) * 64 + 16 * d0 + 8 * (lane >> 5));
        AT_WAIT_V(0); AT_BARRIER();
#pragma unroll
        for (int q = 0; q < 4; ++q) { const int hq = 4 * kvh + q; f32x16 o[2]; float lsum; bf16x8 qf[4];
#pragma unroll
            for (int d0 = 0; d0 < 4; ++d0) qf[d0] = qn[d0];
            if (q < 3) {
#pragma unroll
                for (int d0 = 0; d0 < 4; ++d0) qn[d0] = *(const bf16x8*)(QSW + (gb + t0 + (lane & 31)) * 512 + (hq + 1) * 64 + 16 * d0 + 8 * (lane >> 5)); }
            sw_head(qf, lds, a.sinks[hq] * LOG2E, t0, jt_lo, lane, o, lsum);
            at_store(o, lsum, stg, lsb, MIX + (gb + t0) * 1024 + 512 + hq * 64, SSQ + (gb + t0) * 16 + 8 + hq, lane); }
        asm volatile("s_waitcnt vmcnt(0)" ::: "memory"); AT_BARRIER();
    }
    if (kinds & 1) {
        volatile LAS int* gb2 = ctl + 32;
        if (tid < 2) gb2[16 * tid] = 0;
        __syncthreads();
        const int grp = wave >> 2, w4 = wave & 3; LAS unsigned char* ring = lds + grp * 3 * AT_SLOT; volatile LAS int* gctl = ctl + 8 * grp; volatile LAS int* bar = gb2 + 16 * grp; int epoch = 0;
        constexpr int NUNITS = (T / 128) * 8; const int NG = 2 * (int)gridDim.x, gg = 2 * (int)blockIdx.x + grp;
        bf16x8 qf[4]; int idx = gg; int issued = 0; SbUnit u = sb_unit_of(idx); unsigned nxt = 0;
        if (idx < NUNITS) issued = sb_prologue(QSB, KSB, VTSB, u, ring, w4, lane, qf);
        while (idx < NUNITS) {
            if (w4 == 0 && lane == 0) nxt = atomicAdd(qctr, 1u);
            f32x16 o[2];
            sb_body(KSB, VTSB, u, issued, qf, ring, gctl, bar, epoch, w4, lane, o);
            const size_t grow = (size_t)u.b * SEQ + u.q0 + 32 * w4; const int hd = u.hd;
            if (w4 == 0 && lane == 0) gctl[4] = NG + (int)nxt;
            grp_barrier(bar, epoch, lane);
            const int nidx = __builtin_amdgcn_readfirstlane(gctl[4]);
            grp_barrier(bar, epoch, lane);
            if (nidx < NUNITS) { u = sb_unit_of(nidx); issued = sb_prologue(QSB, KSB, VTSB, u, ring, w4, lane, qf); }
            at_store(o, 1.0f, stg, lsb, MIX + grow * 1024 + hd * 64, SSQ + grow * 16 + hd, lane);
            idx = nidx;
        }
    }
}

#define XB_TMO      128
#define XB_XCNT(j)  (256  + 64 * (j))
#define XB_XSUB(j)  (1280 + 64 * (j))
#define XB_XGEN(j)  (2304 + 64 * (j))
#define XB_TOP      3328
#define XB_TOPGEN   3392
#define XCD_BAR_WORDS 3456
#define XB_SPIN_CAP (1u << 18)
DI unsigned xb_ld(unsigned* p)              { return __hip_atomic_load(p, __ATOMIC_RELAXED, __HIP_MEMORY_SCOPE_AGENT); }
DI unsigned xb_add(unsigned* p, unsigned v) { return __hip_atomic_fetch_add(p, v, __ATOMIC_RELAXED, __HIP_MEMORY_SCOPE_AGENT); }
DI unsigned xb_xcc_id() { return (unsigned)__builtin_amdgcn_s_getreg((3 << 11) | 20) & 0xFu; }
#define XB_SPIN(cond, bar) do { unsigned _sp = 0; while (cond) { __builtin_amdgcn_s_sleep(1); \
    if ((++_sp & 255u) == 0u) { if (xb_ld(&(bar)[XB_TMO])) break; if (_sp > XB_SPIN_CAP) { atomicAdd(&(bar)[XB_TMO], 1u); break; } } } } while (0)
struct XcdBarrier { unsigned* bar; unsigned x; volatile LAS unsigned* st; };
DI XcdBarrier xcd_barrier_post(unsigned* bar, volatile LAS unsigned* st) {
    XcdBarrier b; b.bar = bar; b.x = xb_xcc_id(); b.st = st;
    if (threadIdx.x == 0) (void)xb_add(&bar[XB_XCNT(b.x)], 1u);
    return b;
}
DI void xcd_barrier_complete(unsigned* bar, unsigned x, unsigned& nloc, unsigned& nx) {
    const unsigned G = gridDim.x * gridDim.y * gridDim.z;
    unsigned sum, cnt, mine, sp = 0u;
    for (;;) {
        sum = 0u; cnt = 0u; mine = 0u;
#pragma unroll
        for (unsigned j = 0; j < 16; ++j) { const unsigned c = xb_ld(&bar[XB_XCNT(j)]); sum += c; cnt += (c > 0u) ? 1u : 0u; mine = (j == x) ? c : mine; }
        if (sum == G) break;
        __builtin_amdgcn_s_sleep(1);
        if ((++sp & 255u) == 0u) { if (xb_ld(&bar[XB_TMO])) break; if (sp > XB_SPIN_CAP) { atomicAdd(&bar[XB_TMO], 1u); break; } }
    }
    nloc = mine > 0u ? mine : 1u; nx = cnt > 0u ? cnt : 1u;
}
DI void xcd_barrier(const XcdBarrier& b) {
    asm volatile("s_waitcnt vmcnt(0)" ::: "memory");
    __syncthreads();
    if (threadIdx.x == 0) {
        unsigned* bar = b.bar;
        __builtin_amdgcn_s_waitcnt(0);
        unsigned nloc = b.st[0], nx = b.st[1];
        if (nloc == 0u) { xcd_barrier_complete(bar, b.x, nloc, nx); b.st[0] = nloc; b.st[1] = nx; }
        const unsigned old = xb_add(&bar[XB_XSUB(b.x)], 1u);
        const unsigned gen = old / nloc;
        if (old + 1u == (gen + 1u) * nloc) {
            __builtin_amdgcn_fence(__ATOMIC_RELEASE, "agent");
            asm volatile("s_waitcnt vmcnt(0)" ::: "memory");
            const unsigned og = xb_add(&bar[XB_TOP], 1u);
            const unsigned tg = og / nx;
            if (og + 1u == (tg + 1u) * nx) xb_add(&bar[XB_TOPGEN], 1u);
            else XB_SPIN(xb_ld(&bar[XB_TOPGEN]) == tg, bar);
            __builtin_amdgcn_fence(__ATOMIC_ACQUIRE, "agent");
            xb_add(&bar[XB_XGEN(b.x)], 1u);
            asm volatile("s_waitcnt vmcnt(0)" ::: "memory");
        } else {
            XB_SPIN(xb_ld(&bar[XB_XGEN(b.x)]) == gen, bar);
            __builtin_amdgcn_fence(__ATOMIC_ACQUIRE, "agent");
            asm volatile("s_waitcnt vmcnt(0)" ::: "memory");
        }
    }
    __syncthreads();
}

__global__ void __launch_bounds__(NTHREADS, 2) mk_fwd(Args a) {
    extern __shared__ __attribute__((aligned(16))) unsigned char lds_raw[];
    LAS unsigned char* lds = (LAS unsigned char*)lds_raw;
    const int tid = threadIdx.x, lane = tid & 63, wave = __builtin_amdgcn_readfirstlane(tid >> 6);
    volatile LAS unsigned* misc = (volatile LAS unsigned*)(lds + LDS_MISC);
    if (tid < 2) misc[tid] = 0u;
    __syncthreads();
    const XcdBarrier gbar = xcd_barrier_post((unsigned*)(a.ws + WS_CTL) + CW_BAR, misc);
    unsigned char* ws = a.ws;
    const float* mod = (const float*)(ws + WS_MOD);

#define REPS(k) ((PROBE_DUP == (k)) ? 2 : 1)
    int n_stamp = 0;
#define STAMP() do { if (STAMP_PHASE >= 0 && blockIdx.x == 0 && tid == 0) ((unsigned long long*)(ws + WS_STAMP))[n_stamp] = __builtin_amdgcn_s_memrealtime(); ++n_stamp; } while (0)
    STAMP();
    const int p2_units = (T / 256) * (DIN / 256), p2_rem = p2_units % (int)gridDim.x, n_tailw = p2_rem ? ((int)gridDim.x - p2_rem) * NWAVES : 0;
    const int n_tail_items = n_tailw * 4 < NEXPERT_ITEMS ? n_tailw * 4 : NEXPERT_ITEMS, n_p0_items = NEXPERT_ITEMS - n_tail_items;
    for (int rep = 0; rep < REPS(0); ++rep) { p0_prologue(a, lds, tid, lane, wave); expert_items(a, lds, 0, n_p0_items, blockIdx.x * NWAVES + wave, gridDim.x * NWAVES, lane, wave); xcd_barrier(gbar); STAMP(); }
    for (int rep = 0; rep < REPS(1); ++rep) { p1_norm(a, lds, tid, lane, wave); if (wave == 7) router_tables(a, lane); xcd_barrier(gbar); STAMP(); }
    for (int rep = 0; rep < REPS(2); ++rep) {
        DenseSched S{(const bf16_t*)(ws + WS_H), (const bf16_t*)(ws + WS_WIN), 1024, T / 256, DIN / 256};
        EpiProj E{(bf16_t*)(ws + WS_QSB), (bf16_t*)(ws + WS_VSB), (bf16_t*)(ws + WS_QSW), (bf16_t*)(ws + WS_KSW), (bf16_t*)(ws + WS_VSW), (const float*)(ws + WS_COS), (const float*)(ws + WS_SIN)};
        pg8::gemm_phase<DenseSched, EpiProj, true, 1024, 1024, 16>(lds, S, E);
        if (p2_rem && (int)blockIdx.x >= p2_rem && rep == 0) { __syncthreads(); expert_items(a, lds, n_p0_items, n_tail_items, ((int)blockIdx.x - p2_rem) * NWAVES + wave, n_tailw, lane, wave); }
        xcd_barrier(gbar); STAMP();
    }
    if (PROBE_DUP == 31 || PROBE_DUP == 32) { p3_attention(a, lds, tid, lane, wave, 1, PROBE_DUP - 30); xcd_barrier(gbar); }
    for (int rep = 0; rep < REPS(3); ++rep) { p3_attention(a, lds, tid, lane, wave, rep); xcd_barrier(gbar); STAMP(); }
    for (int rep = 0; rep < REPS(4); ++rep) {
        DenseSched S{(const bf16_t*)(ws + WS_MIX), (const bf16_t*)(ws + WS_WOUT), 1024, T / 256, DM / 256};
        EpiWout E{mod, (bf16_t*)(ws + WS_X1), a.x, (const float*)(ws + WS_SSQ), (LAS float*)(lds + pg8::STAGE_BYTES + 1024)};
        pg8::gemm_phase<DenseSched, EpiWout, true, 1024, 1024, 16>(lds, S, E);
        xcd_barrier(gbar); STAMP();
    }
    for (int rep = 0; rep < REPS(5); ++rep) { p5_router(a, lds, tid, lane, wave, rep); xcd_barrier(gbar); STAMP(); }
    LAS int* tstart = (LAS int*)(lds + pg8::STAGE_BYTES);
    const unsigned* cnt = (const unsigned*)(ws + WS_CTL) + CW_CNT;
    if (tid == 0) { int run = 0; for (int b = 0; b < NBUCKET; ++b) { tstart[b] = run; run += ((int)cnt[CNT_STRIDE * b] + 255) >> 8; } tstart[NBUCKET] = run; }
    __syncthreads();
    const bf16_t* H2 = (const bf16_t*)(ws + WS_H); const bf16_t* HIDc = (const bf16_t*)(ws + WS_HID); const int* LISTc = (const int*)(ws + WS_LIST);
    EpiUp EU{(bf16_t*)(ws + WS_HID), (const f32x2*)(ws + WS_WTS), (LAS float*)(lds + pg8::STAGE_BYTES + 1024)}; EpiDown ED{(bf16_t*)(ws + WS_Y)};
    if (gridDim.x == 256) {
        const MoeCut mc = moe_cut(__builtin_amdgcn_readfirstlane(tstart[NBUCKET]));
        { MoeSplitSched<true, 1> S{tstart, cnt, LISTc, H2, (const bf16_t*)(ws + WS_WGU), mc}; pg8::gemm_phase<MoeSplitSched<true, 1>, EpiUp, true, 1024, 1024, 16>(lds, S, EU); }
        xcd_barrier(gbar); STAMP();
        if (((int)blockIdx.x >> 3) < mc.left) { MoeSplitSched<true, 2> S{tstart, cnt, LISTc, H2, (const bf16_t*)(ws + WS_WGU), mc}; pg8::gemm_phase<MoeSplitSched<true, 2>, EpiUp, true, 1024, 1024, 16>(lds, S, EU); }
        else { MoeSplitSched<false, 2> S{tstart, cnt, LISTc, HIDc, (const bf16_t*)(ws + WS_WD), mc}; pg8::gemm_phase<MoeSplitSched<false, 2>, EpiDown, true, 1024, 512, 8>(lds, S, ED); }
        xcd_barrier(gbar); STAMP();
        { MoeSplitSched<false, 3> S{tstart, cnt, LISTc, HIDc, (const bf16_t*)(ws + WS_WD), mc}; pg8::gemm_phase<MoeSplitSched<false, 3>, EpiDown, true, 1024, 512, 8>(lds, S, ED); }
    } else {
        { MoeSched<8, true> S{tstart, cnt, LISTc, H2, (const bf16_t*)(ws + WS_WGU)}; pg8::gemm_phase<MoeSched<8, true>, EpiUp, true, 1024, 1024, 16>(lds, S, EU); }
        xcd_barrier(gbar); STAMP();
        { MoeSched<4, false> S{tstart, cnt, LISTc, HIDc, (const bf16_t*)(ws + WS_WD)}; pg8::gemm_phase<MoeSched<4, false>, EpiDown, true, 1024, 512, 8>(lds, S, ED); }
    }
    if (STAMP_PHASE >= 0) {
        if (blockIdx.x == 0 && tid == 0) { unsigned long long* st = (unsigned long long*)(ws + WS_STAMP); st[n_stamp] = __builtin_amdgcn_s_memrealtime();
            const float t_us = (float)(st[STAMP_PHASE + 1] - st[STAMP_PHASE]) * 0.01f; *(float*)(ws + WS_STAMP + 256) = 1.0f + sqrtf(t_us * STAMP_K); } }
    xcd_barrier(gbar);
    if (PROBE_DUP == 8) { p8_final(a, tstart, lane, wave, (float*)(ws + WS_H)); xcd_barrier(gbar); }
    p8_final(a, tstart, lane, wave, a.out);
}

extern "C" void kernel_launch(void* const* d_in, const int* in_sizes, int n_in, void* d_out, int out_size, void* d_ws, size_t ws_size, hipStream_t stream) {
    static int grid = 0;
    if (grid == 0) {
        if (n_in != 18 || in_sizes[0] != T * DM || out_size != T * DM || ws_size < WS_END) { fprintf(stderr, "kernel_launch: unexpected shapes (n_in %d, in0 %d, out %d, ws %zu); nothing launched\n", n_in, n_in > 0 ? in_sizes[0] : -1, out_size, ws_size); grid = -1; return; }
        int dev = 0, cus = 0, per_cu = 0;
        (void)hipGetDevice(&dev); (void)hipDeviceGetAttribute(&cus, hipDeviceAttributeMultiprocessorCount, dev);
        (void)hipFuncSetAttribute((const void*)mk_fwd, hipFuncAttributeMaxDynamicSharedMemorySize, LDS_BYTES);
        (void)hipOccupancyMaxActiveBlocksPerMultiprocessor(&per_cu, (const void*)mk_fwd, NTHREADS, LDS_BYTES);
        if (per_cu < 1) { fprintf(stderr, "kernel_launch: occupancy query says %d blocks per CU\n", per_cu); per_cu = 1; }
        grid = cus * per_cu;
        fprintf(stderr, "kernel_launch: %d CUs x %d = grid %d\n", cus, per_cu, grid);
    }
    if (grid < 0) return;
    (void)hipMemsetAsync((char*)d_ws + WS_CTL, 0, CTL_BYTES, stream);
    Args a{};
    a.x = (const float*)d_in[0]; a.c = (const float*)d_in[1]; a.pos = (const int*)d_in[2]; a.w_ada = (const float*)d_in[3]; a.b_ada = (const float*)d_in[4]; a.g_mix = (const float*)d_in[5];
    a.w_in = (const float*)d_in[6]; a.sinks = (const float*)d_in[7]; a.g_sb = (const float*)d_in[8]; a.g_sw = (const float*)d_in[9]; a.w_out = (const float*)d_in[10]; a.g_ffn = (const float*)d_in[11];
    a.w_rg = (const float*)d_in[12]; a.w_re = (const float*)d_in[13]; a.w_gate = (const float*)d_in[14]; a.w_up = (const float*)d_in[15]; a.w_down = (const float*)d_in[16]; a.g_fin = (const float*)d_in[17];
    a.out = (float*)d_out; a.ws = (unsigned char*)d_ws;
    void* args[] = {&a};
    hipError_t e = hipLaunchCooperativeKernel((const void*)mk_fwd, dim3(grid), dim3(NTHREADS), args, LDS_BYTES, stream);
    if (e != hipSuccess) fprintf(stderr, "kernel_launch: cooperative launch failed: %s (grid %d)\n", hipGetErrorString(e), grid);
}
```

```cpp
#include <hip/hip_runtime.h>
#include <cstdio>
#include <cstdint>
#include <cmath>

#define LAS __attribute__((address_space(3)))
#define DI __device__ __forceinline__
typedef unsigned short bf16_t;
typedef short bf16x8 __attribute__((ext_vector_type(8)));
typedef float f32x4 __attribute__((ext_vector_type(4)));
typedef float f32x2 __attribute__((ext_vector_type(2)));
typedef unsigned u32x4 __attribute__((ext_vector_type(4)));
typedef unsigned u32x2 __attribute__((ext_vector_type(2)));
typedef __bf16 bf16x2_t __attribute__((ext_vector_type(2)));

constexpr int NB = 4, SEQ = 8192, DM = 1024, T = NB * SEQ;
constexpr int DIN = 2304, DSB = 512, DSW = 512, DKV = 128;
constexpr int NEXP = 16, DEXP = 512, NBUCKET = 24, WINDOW = 128;
constexpr int MAXTILES = T / 256 + NBUCKET, TPAD = MAXTILES * 256;
constexpr float EPS = 1e-6f, LOG2E = 1.4426950408889634f, QSCALE = 0.125f * LOG2E;
constexpr int NTHREADS = 512, NWAVES = 8;
#ifndef STAMP_PHASE
#define STAMP_PHASE (-1)
#endif
#ifndef STAMP_K
#define STAMP_K 1e-5f
#endif
#ifndef PROBE_DUP
#define PROBE_DUP (-1)
#endif

constexpr size_t MiB = 1u << 20;
constexpr size_t WS_CTL = 0, CTL_BYTES = 1 * MiB;
constexpr size_t WS_MOD = 1 * MiB;
constexpr size_t WS_COS = 2 * MiB, WS_SIN = 6 * MiB;
constexpr size_t WS_WIN = 10 * MiB;
constexpr size_t WS_WOUT = 15 * MiB;
constexpr size_t WS_WGU = 17 * MiB;
constexpr size_t WS_WD = 49 * MiB;
constexpr size_t WS_LIST = 65 * MiB;
constexpr size_t WS_WTS = 68 * MiB;
constexpr size_t WS_STAMP = 512 * 1024;
constexpr size_t WS_TPOS = 74 * MiB;
constexpr size_t WS_SSQ = 76 * MiB;
constexpr size_t WS_H = 80 * MiB;
constexpr size_t WS_QSB = 144 * MiB, WS_KSB = 176 * MiB, WS_VSB = 208 * MiB, WS_QSW = 240 * MiB;
constexpr size_t WS_KSW = 272 * MiB, WS_VSW = 280 * MiB;
constexpr size_t WS_MIX = 288 * MiB;
constexpr size_t WS_HID = 352 * MiB;
constexpr size_t WS_RTAB = 428 * MiB;
constexpr size_t WS_END = 429 * MiB;
constexpr size_t WS_XB = WS_HID;
constexpr size_t WS_X1 = WS_QSB;
constexpr size_t WS_Y = WS_VSB;
static_assert(WS_X1 + (size_t)T * 1024 * 2 <= WS_VSB && WS_Y + (size_t)TPAD * 1024 * 2 <= WS_MIX && WS_XB + (size_t)T * 1024 * 2 <= WS_END, "overlays");
static_assert(WS_KSB - WS_QSB == WS_VSB - WS_KSB, "q/k/v_sb buffers equally spaced");
static_assert(WS_HID + (size_t)TPAD * 1024 * 2 <= WS_END, "ws map");
constexpr int CW_CNT = 8192, CNT_STRIDE = 64, CW_ATTNQ = 16384, CW_BAR = 4096;
constexpr int LDS_MISC = 143360;

constexpr int LDS_BYTES = 147456;

struct Args {
    const float* x; const float* c; const int* pos; const float* w_ada; const float* b_ada; const float* g_mix; const float* w_in; const float* sinks;
    const float* g_sb; const float* g_sw; const float* w_out; const float* g_ffn; const float* w_rg; const float* w_re; const float* w_gate; const float* w_up;
    const float* w_down; const float* g_fin; float* out; unsigned char* ws;
};

__constant__ float INV_FREQ[32] = {1.000000000e+00f, 7.498942018e-01f, 5.623413324e-01f, 4.216965139e-01f, 3.162277639e-01f, 2.371373773e-01f, 1.778279394e-01f, 1.333521456e-01f, 1.000000015e-01f, 7.498942316e-02f, 5.623413250e-02f, 4.216964915e-02f, 3.162277490e-02f, 2.371373773e-02f, 1.778279431e-02f, 1.333521400e-02f, 9.999999776e-03f, 7.498942316e-03f, 5.623413250e-03f, 4.216964822e-03f, 3.162277630e-03f, 2.371373819e-03f, 1.778279431e-03f, 1.333521446e-03f, 1.000000047e-03f, 7.498941850e-04f, 5.623413017e-04f, 4.216965172e-04f, 3.162277571e-04f, 2.371373703e-04f, 1.778279402e-04f, 1.333521504e-04f};

DI unsigned f2bf(float f) { unsigned u = __builtin_bit_cast(unsigned, f); return (u + 0x7fffu + ((u >> 16) & 1u)) >> 16; }
DI unsigned pk2(float lo, float hi) { f32x2 v = {lo, hi}; bf16x2_t b = __builtin_convertvector(v, bf16x2_t); return __builtin_bit_cast(unsigned, b); }
DI u32x4 pack8(const f32x4 v0, const f32x4 v1) { u32x4 w; w.x = pk2(v0[0], v0[1]); w.y = pk2(v0[2], v0[3]); w.z = pk2(v1[0], v1[1]); w.w = pk2(v1[2], v1[3]); return w; }
DI int pi32(int r) { return (r & ~12) | ((r & 4) << 1) | ((r & 8) >> 1); }
DI float bf2f(unsigned short b) { return __builtin_bit_cast(float, (unsigned)b << 16); }
DI float bflo(unsigned w) { return __builtin_bit_cast(float, w << 16); }
DI float bfhi(unsigned w) { return __builtin_bit_cast(float, w & 0xffff0000u); }
DI float wave_sum(float v) {
#pragma unroll
    for (int o = 1; o < 64; o <<= 1) v += __shfl_xor(v, o);
    return v;
}
#define DPP_ADD(v, ctrl) ((v) + __builtin_bit_cast(float, __builtin_amdgcn_update_dpp(0, __builtin_bit_cast(int, (v)), (ctrl), 0xF, 0xF, true)))
DI void swap32(unsigned& a, unsigned& b) { asm volatile("s_nop 1\n\tv_permlane32_swap_b32 %0, %1" : "+v"(a), "+v"(b)); }
DI void swap16(unsigned& a, unsigned& b) { asm volatile("s_nop 1\n\tv_permlane16_swap_b32 %0, %1" : "+v"(a), "+v"(b)); }
DI float half_sum_fast(float v) { v = DPP_ADD(v, 0xB1); v = DPP_ADD(v, 0x4E); v = DPP_ADD(v, 0x141); v = DPP_ADD(v, 0x140);
    unsigned a = __builtin_bit_cast(unsigned, v), b = a; swap16(a, b); return __builtin_bit_cast(float, a) + __builtin_bit_cast(float, b); }
DI float wave_sum_fast(float v) { v = DPP_ADD(v, 0xB1); v = DPP_ADD(v, 0x4E); v = DPP_ADD(v, 0x141); v = DPP_ADD(v, 0x140);
    unsigned a = __builtin_bit_cast(unsigned, v), b = a; swap16(a, b); v = __builtin_bit_cast(float, a) + __builtin_bit_cast(float, b);
    a = __builtin_bit_cast(unsigned, v); b = a; swap32(a, b); return __builtin_bit_cast(float, a) + __builtin_bit_cast(float, b); }
#define LDS_WAIT() asm volatile("s_waitcnt lgkmcnt(0)" ::: "memory")
DI f32x4 ldnt4(const float* p) { return __builtin_nontemporal_load((const f32x4*)p); }

DI void tr_item64(const float* W, int N, int k0, int n0, bf16_t* WT, int drow0a, int drow0b, int Kd, const float* kscale, LAS float* scr, int lane) {
    f32x4 v[16]; const int kr = lane >> 4, c4 = 4 * (lane & 15);
#pragma unroll
    for (int i = 0; i < 16; ++i) v[i] = ldnt4(W + (size_t)(k0 + 4 * i + kr) * N + n0 + c4);
#pragma unroll
    for (int i = 0; i < 16; ++i) { const int kk = 4 * i + kr; f32x4 x = v[i]; if (kscale) x = x * kscale[k0 + kk]; LAS float* d = scr + kk * 65 + c4; d[0] = x.x; d[1] = x.y; d[2] = x.z; d[3] = x.w; }
    LDS_WAIT();
    const int c = lane & 7;
#pragma unroll
    for (int j = 0; j < 8; ++j) { const int n = (lane >> 3) + 8 * j; const LAS float* q = scr + (8 * c) * 65 + n;
        u32x4 o; o.x = pk2(q[0 * 65], q[1 * 65]); o.y = pk2(q[2 * 65], q[3 * 65]); o.z = pk2(q[4 * 65], q[5 * 65]); o.w = pk2(q[6 * 65], q[7 * 65]);
        const int dr = n < 32 ? drow0a + n : drow0b + (n - 32);
        *(u32x4*)(WT + (size_t)dr * Kd + k0 + 8 * c) = o; }
    LDS_WAIT();
}
DI int win_drow(int n0) {
    if (n0 < 1536) return n0;
    if (n0 < 2048) { const int c = n0 - 1536, head = c >> 6, half = (c >> 5) & 1; return 1536 + (head >> 2) * 256 + half * 128 + (head & 3) * 32; }
    if (n0 < 2176) { const int c = n0 - 2048, head = c >> 6, half = (c >> 5) & 1; return 2048 + half * 128 + head * 32; }
    const int c = n0 - 2176; return 2048 + (c >> 6) * 128 + 64 + (c & 63);
}
DI void p0_prologue(const Args& a, LAS unsigned char* lds, int tid, int lane, int wave) {
    unsigned char* ws = a.ws;
    {
        float* mod = (float*)(ws + WS_MOD); LAS float* red = (LAS float*)lds; LAS float* sc = (LAS float*)(lds + 32768);
        if ((int)blockIdx.x < 6144 / 64) { for (int i = tid; i < 4096; i += NTHREADS) { const float cv = a.c[i]; sc[i] = cv / (1.f + expf(-cv)); } __syncthreads(); }
        for (int cb = blockIdx.x; cb < 6144 / 64; cb += gridDim.x) {
            const int cl = tid & 15, kg = tid >> 4, col = cb * 64 + 4 * cl;
            f32x4 acc[4];
#pragma unroll
            for (int q = 0; q < 4; ++q) acc[q] = (f32x4){0.f, 0.f, 0.f, 0.f};
#pragma unroll 16
            for (int kk = 0; kk < 32; ++kk) { const int k = kg * 32 + kk; const f32x4 w = ldnt4(a.w_ada + (size_t)k * 6144 + col);
#pragma unroll
                for (int q = 0; q < 4; ++q) acc[q] = acc[q] + w * sc[q * 1024 + k]; }
#pragma unroll
            for (int q = 0; q < 4; ++q) *(LAS f32x4*)(red + (kg * 4 + q) * 64 + 4 * cl) = acc[q];
            __syncthreads();
            if (tid < 256) { const int q = tid >> 6, c2 = tid & 63; float sum = 0.f; for (int g = 0; g < 32; ++g) sum += red[(g * 4 + q) * 64 + c2]; mod[q * 6144 + cb * 64 + c2] = sum + a.b_ada[cb * 64 + c2]; }
            __syncthreads();
        }
    }
    {
        float* cosT = (float*)(ws + WS_COS); float* sinT = (float*)(ws + WS_SIN);
        for (int idx = blockIdx.x * NTHREADS + tid; idx < T * 32; idx += gridDim.x * NTHREADS) {
            const int t = idx >> 5, i = idx & 31; const float ang = (float)a.pos[t] * INV_FREQ[i];
            const double ad = (double)ang, kq = rint(ad * 0.63661977236758134308);
            double y = fma(-kq, 1.5707963267948966192, ad); y = fma(-kq, 6.123233995736766036e-17, y);
            const int q = (int)((long long)kq & 3); const double y2 = y * y;
            const double sn = y * (1.0 + y2 * (-1.0 / 6 + y2 * (1.0 / 120 + y2 * (-1.0 / 5040 + y2 * (1.0 / 362880 + y2 * (-1.0 / 39916800))))));
            const double cs = 1.0 + y2 * (-0.5 + y2 * (1.0 / 24 + y2 * (-1.0 / 720 + y2 * (1.0 / 40320 + y2 * (-1.0 / 3628800 + y2 * (1.0 / 479001600))))));
            double co, si; if (q == 0) { co = cs; si = sn; } else if (q == 1) { co = -sn; si = cs; } else if (q == 2) { co = -cs; si = -sn; } else { co = sn; si = -cs; }
            cosT[idx] = (float)co; sinT[idx] = (float)si;
        }
    }
    {
        __syncthreads();
        LAS float* scr = (LAS float*)(lds + 8192 + wave * 16640);
        const int gw = blockIdx.x * NWAVES + wave, NGW = gridDim.x * NWAVES;
        constexpr int I_IN = 16 * 36, I_OUT = 16 * 16, NITEMS = I_IN + I_OUT;
        for (int it = gw; it < NITEMS; it += NGW) {
            int r = it;
            if (r < I_IN) { const int kb = r / 36, nb = r % 36; tr_item64(a.w_in, DIN, kb * 64, nb * 64, (bf16_t*)(ws + WS_WIN), win_drow(nb * 64), win_drow(nb * 64 + 32), 1024, nullptr, scr, lane); continue; } r -= I_IN;
            { const int kb = r / 16, nb = r % 16; const float* ks = (kb < 8) ? a.g_sb : (a.g_sw - 512); tr_item64(a.w_out, 1024, kb * 64, nb * 64, (bf16_t*)(ws + WS_WOUT), nb * 64, nb * 64 + 32, 1024, ks, scr, lane); }
        }
    }
}
constexpr int NEXPERT_ITEMS = 2 * (16 * 16 * 8) + 16 * 8 * 16;
DI void expert_items(const Args& a, LAS unsigned char* lds, int first, int count, int w, int nw, int lane, int wave) {
    asm volatile("" : "+v"(lane));
    unsigned char* ws = a.ws;
    LAS float* scr = (LAS float*)(lds + 8192 + wave * 16640);
    constexpr int I_G = 16 * 16 * 8;
    for (int it = first + w; it < first + count; it += nw) {
        int r = it;
        if (r < 2 * I_G) { const int up = r >= I_G; if (up) r -= I_G; const int e = r / 128, q = r % 128, kb = q / 8, nb = q % 8, c0 = nb * 64; const int dr = (c0 >> 7) * 256 + up * 128 + (c0 & 127);
            tr_item64((up ? a.w_up : a.w_gate) + (size_t)e * 1024 * 512, 512, kb * 64, c0, (bf16_t*)(ws + WS_WGU) + (size_t)e * 1024 * 1024, dr, dr + 32, 1024, nullptr, scr, lane); continue; } r -= 2 * I_G;
        { const int e = r / 128, q = r % 128, kb = q / 16, nb = q % 16; tr_item64(a.w_down + (size_t)e * 512 * 1024, 1024, kb * 64, nb * 64, (bf16_t*)(ws + WS_WD) + (size_t)e * 1024 * 512, nb * 64, nb * 64 + 32, 512, nullptr, scr, lane); }
    }
}

DI void p1_norm(const Args& a, LAS unsigned char* lds, int tid, int lane, int wave) {
    asm volatile("" : "+v"(lane), "+v"(tid));
    const float* mod = (const float*)(a.ws + WS_MOD); bf16_t* H = (bf16_t*)(a.ws + WS_H);
    f32x4 tg[2], tsc[2], tsh[2];
#pragma unroll
    for (int i = 0; i < 2; ++i) { const int idx = tid + i * NTHREADS, b = idx >> 8, c = (idx & 255) * 4; tg[i] = *(const f32x4*)(a.g_mix + c); tsc[i] = *(const f32x4*)(mod + b * 6144 + 1024 + c); tsh[i] = *(const f32x4*)(mod + b * 6144 + c); }
    asm volatile("" ::: "memory");
    const int gw = blockIdx.x * NWAVES + wave, NGW = gridDim.x * NWAVES;
    const int npass = gw < T / 4 ? (T / 4 - gw + NGW - 1) / NGW : 0, nrows = npass * 4;
    f32x4 sl[8][4];
#define P1_LOAD(s_, n_) do { const int _n = (n_); const float* _src = _n < nrows ? a.x + (size_t)(4 * (gw + (_n >> 2) * NGW) + (_n & 3)) * DM : a.g_mix; \
        _Pragma("unroll") for (int j = 0; j < 4; ++j) sl[s_][j] = ldnt4(_src + 4 * lane + 256 * j); } while (0)
#pragma unroll
    for (int s_ = 0; s_ < 8; ++s_) P1_LOAD(s_, s_);
    asm volatile("" ::: "memory");
#pragma unroll
    for (int i = 0; i < 2; ++i) { const int idx = tid + i * NTHREADS; *(LAS f32x4*)(lds + idx * 16) = tg[i] * (tsc[i] + 1.0f); *(LAS f32x4*)(lds + 16384 + idx * 16) = tsh[i]; }
    __syncthreads();
#pragma unroll 1
    for (int nb = 0; nb < nrows; nb += 8) {
#pragma unroll
        for (int s_ = 0; s_ < 8; ++s_) { const int n = nb + s_;
            if (n < nrows) { const int row = 4 * (gw + (n >> 2) * NGW) + (n & 3); const LAS unsigned char* cp = lds + ((row / SEQ) * 1024 + 4 * lane) * 4; float sq = 0.f;
#pragma unroll
                for (int j = 0; j < 4; ++j) sq += (sl[s_][j].x * sl[s_][j].x + sl[s_][j].y * sl[s_][j].y) + (sl[s_][j].z * sl[s_][j].z + sl[s_][j].w * sl[s_][j].w);
                const float rs = 1.0f / sqrtf(wave_sum_fast(sq) * (1.0f / DM) + EPS); bf16_t* hr = H + (size_t)row * DM;
#pragma unroll
                for (int j = 0; j < 4; ++j) { const f32x4 o = sl[s_][j] * rs * *(const LAS f32x4*)(cp + j * 1024) + *(const LAS f32x4*)(cp + 16384 + j * 1024); u32x2 w; w.x = pk2(o.x, o.y); w.y = pk2(o.z, o.w); *(u32x2*)(hr + 4 * lane + 256 * j) = w; } }
            P1_LOAD(s_, n + 8); }
    }
#undef P1_LOAD
}
DI void p8_final(const Args& a, const LAS int* tstart, int lane, int wave, float* dst) {
    asm volatile("" : "+v"(lane));
    const float tscale = (STAMP_PHASE >= 0) ? *(const float*)(a.ws + WS_STAMP + 256) : 1.0f;
    const float* mod = (const float*)(a.ws + WS_MOD); const bf16_t* X1 = (const bf16_t*)(a.ws + WS_X1); const bf16_t* Y = (const bf16_t*)(a.ws + WS_Y); const int* tpos = (const int*)(a.ws + WS_TPOS);
    const int gw = blockIdx.x * NWAVES + wave, NGW = gridDim.x * NWAVES;
    for (int ch = gw; ch < T / 16; ch += NGW) {
        const int row0 = ch * 16, b = row0 / SEQ;
        f32x4 g[4], g2[4];
#pragma unroll
        for (int j = 0; j < 4; ++j) { g[j] = *(const f32x4*)(a.g_fin + 4 * lane + 256 * j); g2[j] = *(const f32x4*)(mod + b * 6144 + 5120 + 4 * lane + 256 * j); }
        const int tp = tpos[row0 + (lane & 15)];
        u32x2 xn[2][4], yn[2][4];
#pragma unroll
        for (int rr = 0; rr < 2; ++rr) { const int tpr = __builtin_amdgcn_readlane(tp, rr); const size_t srow = (size_t)tstart[tpr >> 16] * 256 + (tpr & 0xffff);
#pragma unroll
            for (int j = 0; j < 4; ++j) { xn[rr][j] = *(const u32x2*)(X1 + (size_t)(row0 + rr) * DM + 4 * lane + 256 * j); yn[rr][j] = *(const u32x2*)(Y + srow * DM + 4 * lane + 256 * j); } }
#pragma unroll 1
        for (int r2 = 0; r2 < 16; r2 += 2) {
            f32x4 v[2][4]; u32x2 xw[2][4], yw[2][4];
#pragma unroll
            for (int rr = 0; rr < 2; ++rr)
#pragma unroll
                for (int j = 0; j < 4; ++j) { xw[rr][j] = xn[rr][j]; yw[rr][j] = yn[rr][j]; }
            if (r2 + 2 < 16) {
#pragma unroll
                for (int rr = 0; rr < 2; ++rr) { const int tpr = __builtin_amdgcn_readlane(tp, r2 + 2 + rr); const size_t srow = (size_t)tstart[tpr >> 16] * 256 + (tpr & 0xffff);
#pragma unroll
                    for (int j = 0; j < 4; ++j) { xn[rr][j] = *(const u32x2*)(X1 + (size_t)(row0 + r2 + 2 + rr) * DM + 4 * lane + 256 * j); yn[rr][j] = *(const u32x2*)(Y + srow * DM + 4 * lane + 256 * j); } } }
#pragma unroll
            for (int rr = 0; rr < 2; ++rr) { float s = 0.f;
#pragma unroll
                for (int j = 0; j < 4; ++j) { v[rr][j] = (f32x4){bflo(xw[rr][j].x), bfhi(xw[rr][j].x), bflo(xw[rr][j].y), bfhi(xw[rr][j].y)} + g2[j] * (f32x4){bflo(yw[rr][j].x), bfhi(yw[rr][j].x), bflo(yw[rr][j].y), bfhi(yw[rr][j].y)};
                    s += (v[rr][j].x * v[rr][j].x + v[rr][j].y * v[rr][j].y) + (v[rr][j].z * v[rr][j].z + v[rr][j].w * v[rr][j].w); }
                const float rs = 1.0f / sqrtf(wave_sum_fast(s) * (1.0f / DM) + EPS); float* orow = dst + (size_t)(row0 + r2 + rr) * DM;
#pragma unroll
                for (int j = 0; j < 4; ++j) *(f32x4*)(orow + 4 * lane + 256 * j) = v[rr][j] * (rs * tscale) * g[j]; }
        }
    }
}
constexpr int RT_T0H = 0, RT_T0L = 32768, RT_T1H = 65536, RT_T1L = 73728, RT_CA = 81920, RT_CB = 86016, RT_IMG = 90112, RT_PART = 90112, RT_STRIDE = 102400, RT_BIAS = 90112, RT_WCNT = 90240;
DI void router_tables(const Args& a, int lane) {
    const float* mod = (const float*)(a.ws + WS_MOD);
    for (int tk = blockIdx.x; tk < 512; tk += gridDim.x) {
        const int b = tk >> 7, kg = tk & 127, col = lane;
        if (col < 20) {
            unsigned char* img = a.ws + WS_RTAB + (size_t)b * RT_STRIDE;
            float part = 0.f; u32x4 hi, lo; f32x4 cav[2], cbv[2];
#pragma unroll
            for (int e = 0; e < 8; e += 2) { float wp[2];
#pragma unroll
                for (int h = 0; h < 2; ++h) { const int k = kg * 8 + e + h; const float w = col < 4 ? a.w_rg[k * 4 + col] : a.w_re[k * 16 + (col - 4)];
                    const float ca = a.g_ffn[k] * (mod[b * 6144 + 4096 + k] + 1.0f), cb = mod[b * 6144 + 3072 + k]; wp[h] = ca * w; part += cb * w; cav[(e + h) >> 2][(e + h) & 3] = ca; cbv[(e + h) >> 2][(e + h) & 3] = cb; }
                const unsigned hw = pk2(wp[0], wp[1]); hi[e >> 1] = hw; lo[e >> 1] = pk2(wp[0] - bflo(hw), wp[1] - bfhi(hw)); }
            if (col < 16) { *(u32x4*)(img + RT_T0H + (kg * 16 + col) * 16) = hi; *(u32x4*)(img + RT_T0L + (kg * 16 + col) * 16) = lo; }
            else { *(u32x4*)(img + RT_T1H + (kg * 4 + col - 16) * 16) = hi; *(u32x4*)(img + RT_T1L + (kg * 4 + col - 16) * 16) = lo; }
            *(float*)(img + RT_PART + (kg * 20 + col) * 4) = part;
            if (col == 0) { *(f32x4*)(img + RT_CA + kg * 32) = cav[0]; *(f32x4*)(img + RT_CA + kg * 32 + 16) = cav[1]; *(f32x4*)(img + RT_CB + kg * 32) = cbv[0]; *(f32x4*)(img + RT_CB + kg * 32 + 16) = cbv[1]; }
        }
    }
}
DI float rows4_sum(float v) { unsigned x = __builtin_bit_cast(unsigned, v), y = x; swap16(x, y); v = __builtin_bit_cast(float, x) + __builtin_bit_cast(float, y);
    x = __builtin_bit_cast(unsigned, v); y = x; swap32(x, y); return __builtin_bit_cast(float, x) + __builtin_bit_cast(float, y); }
typedef __bf16 bf16x2n_t __attribute__((ext_vector_type(2)));
DI float dot2sq(unsigned w, float c) { const bf16x2n_t v = __builtin_bit_cast(bf16x2n_t, w); return __builtin_amdgcn_fdot2_f32_bf16(v, v, c, false); }
DI void p5_router(const Args& a, LAS unsigned char* lds, int tid_, int lane_, int wave, int rep = 0) {
    int tid = threadIdx.x; asm volatile("" : "+v"(tid)); const int lane = tid & 63;
    const float* mod = (const float*)(a.ws + WS_MOD); bf16_t* H = (bf16_t*)(a.ws + WS_H);
    unsigned* cnt = (unsigned*)(a.ws + WS_CTL) + CW_CNT + 2048 * rep; int* list = (int*)(a.ws + WS_LIST); f32x2* wts = (f32x2*)(a.ws + WS_WTS);
    int* tpos = (int*)(a.ws + WS_TPOS); const bf16_t* X1 = (const bf16_t*)(a.ws + WS_X1);
    const int fr = lane & 15, fq = lane >> 4;
    LAS int* wcnt = (LAS int*)(lds + RT_WCNT);
    LAS float* bias = (LAS float*)(lds + RT_BIAS);
    int bprev = -1;
    for (int it = blockIdx.x; it < T / 128; it += gridDim.x) {
        const int row0 = it * 128 + wave * 16, b = row0 / SEQ; const bool newtab = b != bprev; bprev = b;
        const unsigned char* img = a.ws + WS_RTAB + (size_t)b * RT_STRIDE;
        float bp[8];
        if (newtab) {
#pragma unroll
            for (int i = 0; i < 11; ++i) __builtin_amdgcn_global_load_lds((const unsigned*)(img + ((i * 8 + wave) * 64 + lane) * 16), (LAS unsigned*)(lds + (i * 8 + wave) * 1024), 16, 0, 0);
#pragma unroll
            for (int q = 0; q < 8; ++q) bp[q] = tid < 320 ? *(const float*)(img + RT_PART + (((tid & 15) * 8 + q) * 20 + (tid >> 4)) * 4) : 0.f;
        }
        asm volatile("" ::: "memory");
        u32x4 xr[32];
        const bf16_t* xrow = X1 + (size_t)(row0 + fr) * DM + 8 * fq;
#pragma unroll
        for (int s_ = 0; s_ < 32; ++s_) xr[s_] = *(const u32x4*)(xrow + 32 * s_);
        asm volatile("s_waitcnt vmcnt(32)" ::: "memory");
        if (newtab) {
            float ps = ((bp[0] + bp[1]) + (bp[2] + bp[3])) + ((bp[4] + bp[5]) + (bp[6] + bp[7]));
            ps = DPP_ADD(ps, 0xB1); ps = DPP_ADD(ps, 0x4E); ps = DPP_ADD(ps, 0x141); ps = DPP_ADD(ps, 0x140);
            if (tid < 320 && (tid & 15) == 0) bias[tid >> 4] = ps;
            __syncthreads();
        }
        f32x4 acc0 = (f32x4){0.f, 0.f, 0.f, 0.f}, acc1 = acc0; float ssq = 0.f;
        {   const LAS unsigned char* t0 = lds + (fq * 16 + fr) * 16; const LAS unsigned char* t1 = lds + RT_T1H + (fq * 4 + (fr & 3)) * 16;
#pragma unroll
            for (int s_ = 0; s_ < 32; ++s_) { const bf16x8 xb = __builtin_bit_cast(bf16x8, xr[s_]);
                const bf16x8 w0h = *(const LAS bf16x8*)(t0 + s_ * 1024), w0l = *(const LAS bf16x8*)(t0 + RT_T0L + s_ * 1024), w1h = *(const LAS bf16x8*)(t1 + s_ * 256), w1l = *(const LAS bf16x8*)(t1 + (RT_T1L - RT_T1H) + s_ * 256);
                acc0 = __builtin_amdgcn_mfma_f32_16x16x32_bf16(w0h, xb, acc0, 0, 0, 0); acc1 = __builtin_amdgcn_mfma_f32_16x16x32_bf16(w1h, xb, acc1, 0, 0, 0);
                acc0 = __builtin_amdgcn_mfma_f32_16x16x32_bf16(w0l, xb, acc0, 0, 0, 0); acc1 = __builtin_amdgcn_mfma_f32_16x16x32_bf16(w1l, xb, acc1, 0, 0, 0);
                ssq = dot2sq(xr[s_].x, ssq); ssq = dot2sq(xr[s_].y, ssq); ssq = dot2sq(xr[s_].z, ssq); ssq = dot2sq(xr[s_].w, ssq); __builtin_amdgcn_sched_barrier(0); } }
        const float rs = 1.0f / sqrtf(rows4_sum(ssq) * (1.0f / DM) + EPS);
        float lg[4], l1[4];
#pragma unroll
        for (int i = 0; i < 4; ++i) { lg[i] = rs * acc0[i] + bias[4 * fq + i]; l1[i] = rs * acc1[i] + bias[16 + i]; }
        int g = 0; float gm = lg[0];
#pragma unroll
        for (int i = 1; i < 4; ++i) if (lg[i] > gm) { gm = lg[i]; g = i; }
        float gs = 0.f;
#pragma unroll
        for (int i = 0; i < 4; ++i) gs += expf(lg[i] - gm);
        const float gprob = 1.0f / gs;
        float el[4];
#pragma unroll
        for (int i = 0; i < 4; ++i) { const float o = __shfl(lg[i], (g < 3 ? fr + 16 * (g + 1) : lane)); el[i] = g < 3 ? o : l1[i]; }
        int i0 = 0; float m0 = el[0];
#pragma unroll
        for (int i = 1; i < 4; ++i) if (el[i] > m0) { m0 = el[i]; i0 = i; }
        int i1 = -1; float m1 = 0.f;
#pragma unroll
        for (int i = 0; i < 4; ++i) if (i != i0 && (i1 < 0 || el[i] > m1)) { m1 = el[i]; i1 = i; }
        const float ex = expf(m1 - m0), w0 = 1.0f / (1.0f + ex), w1 = ex * w0;
        const int ea = i0 < i1 ? i0 : i1, eb = i0 < i1 ? i1 : i0; const float mywa = (i0 < i1 ? w0 : w1) * gprob, mywb = (i0 < i1 ? w1 : w0) * gprob;
        int mybucket = g * 6 + (ea * (7 - ea)) / 2 + (eb - ea - 1);
        {   bf16_t* hrow = H + (size_t)(row0 + fr) * DM + 8 * fq; const LAS unsigned char* cp = lds + RT_CA + fq * 32;
#pragma unroll
            for (int s_ = 0; s_ < 32; ++s_) { const f32x4 ca0 = *(const LAS f32x4*)(cp + s_ * 128), ca1 = *(const LAS f32x4*)(cp + s_ * 128 + 16), cb0 = *(const LAS f32x4*)(cp + (RT_CB - RT_CA) + s_ * 128), cb1 = *(const LAS f32x4*)(cp + (RT_CB - RT_CA) + s_ * 128 + 16);
                const u32x4 xw = xr[s_]; const f32x4 v0 = (f32x4){bflo(xw.x), bfhi(xw.x), bflo(xw.y), bfhi(xw.y)}, v1 = (f32x4){bflo(xw.z), bfhi(xw.z), bflo(xw.w), bfhi(xw.w)};
                *(u32x4*)(hrow + 32 * s_) = pack8(v0 * rs * ca0 + cb0, v1 * rs * ca1 + cb1); __builtin_amdgcn_sched_barrier(0); } }
        if (lane >= 16) mybucket = -1;
        int myrank = 0;
        for (int q = 0; q < NBUCKET; ++q) { const unsigned long long mk = __ballot(mybucket == q); if (mybucket == q) myrank = __popcll(mk & ((1ull << lane) - 1ull)); if (lane == 0) wcnt[wave * NBUCKET + q] = __popcll(mk); }
        __syncthreads();
        if (tid < NBUCKET) { int tot = 0, pre[NWAVES];
#pragma unroll
            for (int w = 0; w < NWAVES; ++w) { pre[w] = tot; tot += wcnt[w * NBUCKET + tid]; }
            const unsigned base = tot ? atomicAdd(cnt + CNT_STRIDE * tid, (unsigned)tot) : 0u;
#pragma unroll
            for (int w = 0; w < NWAVES; ++w) wcnt[w * NBUCKET + tid] = (int)base + pre[w]; }
        __syncthreads();
        if (lane < 16) { const int p = wcnt[wave * NBUCKET + mybucket] + myrank; list[mybucket * T + p] = row0 + lane; wts[mybucket * T + p] = (f32x2){mywa, mywb}; tpos[row0 + lane] = (mybucket << 16) | p; }
        __syncthreads();
    }
}

struct GUnit { const bf16_t* A; const int* aidx; int nvalid; const bf16_t* B0; const bf16_t* B1; int pm, pn, lbase; };
namespace pg8 {
constexpr int BM = 256, BK = 64, HALF = 128, HTB = HALF * BK * 2, STAGE_BYTES = 8 * HTB;
DI int lds_byte(int r, int c) { const int st = (r >> 4) * 2 + (c >> 5), rr = r & 15, cc = c & 31, ob = rr * 64 + cc * 2; return st * 1024 + (ob ^ (((ob >> 9) & 1) << 5)); }
DI void stage_rc(int b, int& R, int& C) { const int st = b / 1024, sb = b % 1024, swz = sb ^ (((sb >> 9) & 1) << 5); R = (st >> 1) * 16 + swz / 64; C = (st & 1) * 32 + (swz % 64) / 2; }
DI int perm32(int rho) { const int n = rho >> 4, i = rho & 15; return 8 * (i >> 2) + 4 * n + (i & 3); }
DI void a_offsets(const GUnit& u, int K, int tid_, unsigned (&vo)[2][2]) {
    asm volatile("" : "+v"(tid_));
#pragma unroll
    for (int i = 0; i < 2; ++i) { int R, C; stage_rc(tid_ * 16 + i * 8192, R, C);
#pragma unroll
        for (int h = 0; h < 2; ++h) { const int r = h * HALF + R; const int gr = u.aidx ? u.aidx[r < u.nvalid ? r : 0] : r; vo[h][i] = ((unsigned)gr * (unsigned)K + (unsigned)C) * 2u; } }
}
template <class Sched, class Epi, bool ALIGN_EPI, int K, int ldb, int nsplit>
DI void gemm_phase(LAS unsigned char* lds, const Sched& S, const Epi& E) {
    int tid = threadIdx.x; asm volatile("" : "+v"(tid));
    const int wid = __builtin_amdgcn_readfirstlane(tid >> 6), lane = tid & 63, wr = wid >> 2, wc = wid & 3, fr = lane & 15, fq = lane >> 4;
    const int nt = K / BK;
    unsigned voffB[2];
#pragma unroll
    for (int i = 0; i < 2; ++i) { int R, C; stage_rc(tid * 16 + i * 8192, R, C); const int Rb = (R & ~31) + perm32(R & 31); voffB[i] = ((unsigned)Rb * (unsigned)ldb + (unsigned)C) * 2u; }
    const size_t hB = (size_t)HALF * ldb * 2;
    const unsigned ldsw = (unsigned)wid * 1024u;
    const int aoff = lds_byte(wr * 64 + fr, fq * 8), boff = lds_byte(wc * 32 + fr, fq * 8);
#define PG8_SA(b, h) (((b) * 2 + (h)) * HTB)
#define PG8_SB(b, h) ((4 + (b) * 2 + (h)) * HTB)
#define PG8_STAGE(bufoff, gbase, voff) do { _Pragma("unroll") for (int _i = 0; _i < 2; ++_i) \
        __builtin_amdgcn_global_load_lds((const unsigned*)((const char*)(gbase) + (voff)[_i]), (LAS unsigned*)(lds + (bufoff) + ldsw + _i * 8192), 16, 0, 0); } while (0)
#define PG8_LDA(dst, b, h) do { _Pragma("unroll") for (int m = 0; m < 4; ++m) _Pragma("unroll") for (int k = 0; k < 2; ++k) dst[m][k] = *(const LAS bf16x8*)(lds + PG8_SA(b, h) + aoff + m * 2048 + k * 1024); } while (0)
#define PG8_LDB(dst, b, h) do { _Pragma("unroll") for (int n = 0; n < 2; ++n) _Pragma("unroll") for (int k = 0; k < 2; ++k) dst[n][k] = *(const LAS bf16x8*)(lds + PG8_SB(b, h) + boff + n * 2048 + k * 1024); } while (0)
#define PG8_MMA(ai, bj, At, Bt) do { __builtin_amdgcn_s_setprio(1); _Pragma("unroll") for (int m = 0; m < 4; ++m) _Pragma("unroll") for (int n = 0; n < 2; ++n) _Pragma("unroll") for (int k = 0; k < 2; ++k) \
        acc[ai][bj][m][n] = __builtin_amdgcn_mfma_f32_16x16x32_bf16(Bt[n][k], At[m][k], acc[ai][bj][m][n], 0, 0, 0); __builtin_amdgcn_s_setprio(0); } while (0)
#define PG8_WAIT_V(n) asm volatile("s_waitcnt vmcnt(" #n ")" ::: "memory")
#define PG8_WAIT_L(n) asm volatile("s_waitcnt lgkmcnt(" #n ")" ::: "memory")
#define PG8_BAR __builtin_amdgcn_s_barrier()
#define PG8_SCHED __builtin_amdgcn_sched_barrier(0)
#define PG8_AK(u, kt) ((const char*)(u).A + (size_t)(kt) * (BK * 2))
#define PG8_BK(u, kt) ((kt) < nsplit ? (const char*)(u).B0 + (size_t)(kt) * (BK * 2) : (const char*)(u).B1 + (size_t)((kt) - nsplit) * (BK * 2))
    GUnit cur, nxt; int ui = 0;
    if (!S.next(0, cur)) return;
    f32x4 acc[2][2][4][2];
#pragma unroll
    for (int a = 0; a < 2; ++a)
#pragma unroll
        for (int b = 0; b < 2; ++b)
#pragma unroll
            for (int m = 0; m < 4; ++m)
#pragma unroll
                for (int n = 0; n < 2; ++n) acc[a][b][m][n] = (f32x4){0.f, 0.f, 0.f, 0.f};
    bf16x8 At[4][2], B0[2][2], B1[2][2];
    unsigned voffA[2][2];
    a_offsets(cur, K, tid, voffA);
    if constexpr (Epi::MIDK) E.prep(cur, 0, tid);
    {
        const char* a0 = PG8_AK(cur, 0); const char* b0 = PG8_BK(cur, 0); const char* a1 = PG8_AK(cur, 1); const char* b1 = PG8_BK(cur, 1);
        PG8_STAGE(PG8_SB(0, 0), b0, voffB); PG8_STAGE(PG8_SB(0, 1), b0 + hB, voffB); PG8_STAGE(PG8_SA(0, 0), a0, voffA[0]); PG8_STAGE(PG8_SA(0, 1), a0, voffA[1]);
        if (wr == 1) PG8_BAR;
        PG8_WAIT_V(2); PG8_BAR;
        PG8_STAGE(PG8_SB(1, 0), b1, voffB); PG8_STAGE(PG8_SA(1, 0), a1, voffA[0]); PG8_STAGE(PG8_SB(1, 1), b1 + hB, voffB);
        PG8_WAIT_V(6); PG8_BAR;
    }
    for (;;) {
        const bool has_next = S.next(ui + 1, nxt);
        if (!has_next) nxt = cur;
        for (int t = 0; t < nt; t += 2) {
            if constexpr (Epi::MIDK) { if (t == nt / 2) E.midk(acc, cur, wr, wc, fr, fq, ui & 1); }
            const bool last = (t == nt - 2);
            const char* a1 = PG8_AK(cur, t + 1);
            const char* a2 = last ? PG8_AK(nxt, 0) : PG8_AK(cur, t + 2); const char* b2 = last ? PG8_BK(nxt, 0) : PG8_BK(cur, t + 2);
            const char* a3 = last ? PG8_AK(nxt, 1) : PG8_AK(cur, t + 3); const char* b3 = last ? PG8_BK(nxt, 1) : PG8_BK(cur, t + 3);
            PG8_LDB(B0, 0, 0); PG8_LDB(B1, 0, 1); PG8_SCHED; PG8_LDA(At, 0, 0); PG8_STAGE(PG8_SA(1, 1), a1, voffA[1]);
            if (last) a_offsets(nxt, K, tid, voffA);
            PG8_WAIT_V(8); PG8_WAIT_L(0); PG8_BAR; PG8_MMA(0, 0, At, B0); PG8_MMA(0, 1, At, B1); PG8_BAR; PG8_SCHED;
            PG8_LDA(At, 0, 1); PG8_STAGE(PG8_SB(0, 0), b2, voffB); PG8_STAGE(PG8_SB(0, 1), b2 + hB, voffB); PG8_STAGE(PG8_SA(0, 0), a2, voffA[0]);
            PG8_WAIT_V(8); PG8_WAIT_L(0); PG8_BAR; PG8_MMA(1, 0, At, B0); PG8_MMA(1, 1, At, B1); PG8_BAR; PG8_SCHED;
            PG8_LDB(B0, 1, 0); PG8_LDB(B1, 1, 1); PG8_SCHED; PG8_LDA(At, 1, 0); PG8_STAGE(PG8_SA(0, 1), a2, voffA[1]);
            PG8_WAIT_V(8); PG8_WAIT_L(0); PG8_BAR; PG8_MMA(0, 0, At, B0); PG8_MMA(0, 1, At, B1); PG8_BAR; PG8_SCHED;
            PG8_LDA(At, 1, 1); PG8_STAGE(PG8_SB(1, 0), b3, voffB); PG8_STAGE(PG8_SB(1, 1), b3 + hB, voffB); PG8_STAGE(PG8_SA(1, 0), a3, voffA[0]);
            PG8_WAIT_V(8); PG8_WAIT_L(0); PG8_BAR; PG8_MMA(1, 0, At, B0); PG8_MMA(1, 1, At, B1); PG8_BAR; PG8_SCHED;
        }
        if constexpr (ALIGN_EPI) { if (wr == 0) PG8_BAR; }
        E(acc, cur, wr, wc, fr, fq, ui & 1);
        if (!has_next) break;
        if constexpr (Epi::MIDK) E.prep(nxt, (ui + 1) & 1, tid);
#pragma unroll
        for (int a = 0; a < 2; ++a)
#pragma unroll
            for (int b = 0; b < 2; ++b)
#pragma unroll
                for (int m = 0; m < 4; ++m)
#pragma unroll
                    for (int n = 0; n < 2; ++n) acc[a][b][m][n] = (f32x4){0.f, 0.f, 0.f, 0.f};
        cur = nxt; ++ui;
        if constexpr (ALIGN_EPI) { if (wr == 1) PG8_BAR; }
    }
    PG8_WAIT_V(0);
    if constexpr (!ALIGN_EPI) { if (wr == 0) PG8_BAR; }
    PG8_BAR;
#undef PG8_SA
#undef PG8_SB
#undef PG8_STAGE
#undef PG8_LDA
#undef PG8_LDB
#undef PG8_MMA
#undef PG8_WAIT_V
#undef PG8_WAIT_L
#undef PG8_BAR
#undef PG8_SCHED
#undef PG8_AK
#undef PG8_BK
}
}
struct DenseSched {
    const bf16_t* A; const bf16_t* Bt; int K, nM, nN;
    DI bool next(int i, GUnit& u) const {
        const int nwg = nM * nN; const long L = (long)i * (int)gridDim.x + (int)blockIdx.x; if (L >= nwg) return false;
        int wgid = (int)L; { const int q = nwg / 8, r = nwg % 8, xcd = wgid % 8, off = wgid / 8; wgid = (xcd < r ? xcd * (q + 1) : r * (q + 1) + (xcd - r) * q) + off; }
        const int nig = 8 * nN, gid = wgid / nig, fm = gid * 8, gsz = (nM - fm) < 8 ? (nM - fm) : 8;
        u.pm = fm + ((wgid % nig) % gsz); u.pn = (wgid % nig) / gsz;
        u.A = A + (size_t)u.pm * 256 * K; u.aidx = nullptr; u.nvalid = 256; u.B0 = Bt + (size_t)u.pn * 256 * K; u.B1 = u.B0; u.lbase = 0; return true; }
};
template <bool up> DI void moe_fill_unit(GUnit& u, int ti, int pn, const LAS int* tstart, const unsigned* cnt, const int* list, const bf16_t* A, const bf16_t* W) {
    int b = 0;
    for (int q = 1; q < NBUCKET; ++q) if (__builtin_amdgcn_readfirstlane(tstart[q]) <= ti) b = q;
    const int rt = ti - __builtin_amdgcn_readfirstlane(tstart[b]); const int g = b / 6, p = b % 6; const int ea = 4 * g + (p < 3 ? 0 : (p < 5 ? 1 : 2)), eb = 4 * g + (p < 3 ? p + 1 : (p < 5 ? p - 1 : 3));
    u.pm = ti; u.pn = pn; u.lbase = b * T + rt * 256; const int nv = __builtin_amdgcn_readfirstlane((int)cnt[CNT_STRIDE * b]) - rt * 256; u.nvalid = nv < 256 ? nv : 256;
    if (up) { u.A = A; u.aidx = list + u.lbase; const int e = pn < 4 ? ea : eb; u.B0 = W + (size_t)e * 1024 * 1024 + (size_t)(pn & 3) * 256 * 1024; u.B1 = u.B0; }
    else { u.A = A + (size_t)ti * 256 * 1024; u.aidx = nullptr; u.B0 = W + (size_t)ea * 1024 * 512 + (size_t)pn * 256 * 512; u.B1 = W + (size_t)eb * 1024 * 512 + (size_t)pn * 256 * 512; }
}
template <int NT, bool up> struct MoeSched {
    const LAS int* tstart; const unsigned* cnt; const int* list; const bf16_t* A; const bf16_t* W;
    DI bool next(int i, GUnit& u) const {
        const int ntile = __builtin_amdgcn_readfirstlane(tstart[NBUCKET]), nwg = ntile * NT; const int L0 = i * (int)gridDim.x + (int)blockIdx.x; if (L0 >= nwg) return false;
        int L = L0; { const int q = nwg / 8, r = nwg % 8, xcd = L0 % 8, off = L0 / 8; L = (xcd < r ? xcd * (q + 1) : r * (q + 1) + (xcd - r) * q) + off; }
        moe_fill_unit<up>(u, L / NT, L % NT, tstart, cnt, list, A, W); return true;
    }
};
struct MoeCut { int x, tiles_x, cstart, left, nY; };
DI MoeCut moe_cut(int ntile) { MoeCut c; c.x = (int)blockIdx.x & 7; const int q = ntile / 8, r = ntile % 8; c.tiles_x = q + (c.x < r ? 1 : 0); c.cstart = c.x * q + (c.x < r ? c.x : r); c.left = 8 * (c.tiles_x - 16); c.nY = 32 - c.left; return c; }
template <bool up, int MODE> struct MoeSplitSched {
    const LAS int* tstart; const unsigned* cnt; const int* list; const bf16_t* A; const bf16_t* W; MoeCut c;
    DI bool next(int i, GUnit& u) const {
        const int w = (int)blockIdx.x >> 3; int ti, pn;
        if (MODE == 1) { if (i >= 4) return false; const int off = i * 32 + w; ti = c.cstart + (off >> 3); pn = off & 7; }
        else if (MODE == 2 && up) { if (i > 0) return false; const int off = 128 + w; ti = c.cstart + (off >> 3); pn = off & 7; }
        else if (MODE == 2) { if (i > 0) return false; const int d = w - c.left; ti = c.cstart + (d >> 2); pn = d & 3; }
        else { const int e = i * 32 + w, rem = 4 * c.tiles_x - c.nY; if (e >= rem) return false;
            if (e < 64 - c.nY) { const int d = c.nY + e; ti = c.cstart + (d >> 2); pn = d & 3; } else { const int l = e - (64 - c.nY); ti = c.cstart + 16 + (l >> 2); pn = l & 3; } }
        moe_fill_unit<up>(u, ti, pn, tstart, cnt, list, A, W); return true;
    }
};

struct EpiProj { static constexpr bool MIDK = false;
    bf16_t *qsb, *vtsb, *qsw, *ksw, *vtsw; const float *cosT, *sinT;
    DI void operator()(const f32x4 (&acc)[2][2][4][2], const GUnit& u, int wr, int wc, int fr, int fq, int) const {
        const int pn = u.pn, rowb = u.pm * 256 + wr * 64 + fr;
        if (pn < 4) {
            bf16_t* base = qsb + (size_t)(pn >> 1) * ((WS_KSB - WS_QSB) / 2); const float sc = pn < 2 ? QSCALE : 1.0f; const int colt = (pn & 1) * 256 + wc * 32 + 8 * fq;
#pragma unroll
            for (int ai = 0; ai < 2; ++ai)
#pragma unroll
                for (int m = 0; m < 4; ++m) { const size_t row = rowb + ai * 128 + m * 16;
                    const size_t kro = (row >> 5) * 16384 + (size_t)(((wc & 1) * 4 + fq) * 256 + pi32((int)row & 31) * 8);
#pragma unroll
                    for (int bj = 0; bj < 2; ++bj) { bf16_t* dstp = pn < 2 ? base + row * 512 + colt + bj * 128 : base + kro + ((pn & 1) * 4 + (wc >> 1) + 2 * bj) * 2048;
                        *(u32x4*)dstp = pack8(acc[ai][bj][m][0] * sc, acc[ai][bj][m][1] * sc); } }
        } else if (pn < 6) {
#pragma unroll
            for (int ai = 0; ai < 2; ++ai)
#pragma unroll
                for (int m = 0; m < 4; ++m) { const int row = rowb + ai * 128 + m * 16;
                    bf16_t* bp = vtsb + (size_t)(row >> 5) * 16384 + (((row >> 4) & 1) * 512 + ((row >> 3) & 1) * 256 + (row & 7)) + ((pn - 4) * 4 + (wc >> 1)) * 2048 + (wc & 1) * 1024 + 8 * fq * 8;
#pragma unroll
                    for (int bj = 0; bj < 2; ++bj)
#pragma unroll
                        for (int n = 0; n < 2; ++n)
#pragma unroll
                            for (int j = 0; j < 4; ++j) bp[bj * 4096 + (4 * n + j) * 8] = (bf16_t)f2bf(acc[ai][bj][m][n][j]); }
        } else if (pn == 8 && wc >= 2) {
            bf16_t* base = pn < 6 ? vtsb : vtsw; const int NF = pn < 6 ? 512 : 128, c0 = pn < 6 ? (pn - 4) * 256 + wc * 32 + 8 * fq : (wc * 32 - 64) + 8 * fq, bjs = pn < 6 ? 128 : 64;
#pragma unroll
            for (int ai = 0; ai < 2; ++ai)
#pragma unroll
                for (int m = 0; m < 4; ++m) { const int row = rowb + ai * 128 + m * 16; bf16_t* bp = base + ((size_t)(row >> 5) * NF + c0) * 32 + (row & 31);
#pragma unroll
                    for (int bj = 0; bj < 2; ++bj)
#pragma unroll
                        for (int n = 0; n < 2; ++n)
#pragma unroll
                            for (int j = 0; j < 4; ++j) bp[(bj * bjs + 4 * n + j) * 32] = (bf16_t)f2bf(acc[ai][bj][m][n][j]); }
        } else {
            const bool isq = pn < 8; bf16_t* base = isq ? qsw : ksw; const int pitch = isq ? 512 : 128; const int head = isq ? (pn - 6) * 4 + wc : wc; const float sc = isq ? QSCALE : 1.0f;
#pragma unroll
            for (int ai = 0; ai < 2; ++ai)
#pragma unroll
                for (int m = 0; m < 4; ++m) { const size_t row = rowb + ai * 128 + m * 16;
                    const f32x4 c0 = *(const f32x4*)(cosT + row * 32 + 8 * fq), c1 = *(const f32x4*)(cosT + row * 32 + 8 * fq + 4);
                    const f32x4 s0 = *(const f32x4*)(sinT + row * 32 + 8 * fq), s1 = *(const f32x4*)(sinT + row * 32 + 8 * fq + 4);
                    const f32x4 x10 = acc[ai][0][m][0], x11 = acc[ai][0][m][1], x20 = acc[ai][1][m][0], x21 = acc[ai][1][m][1];
                    const f32x4 o10 = (x10 * c0 - x20 * s0) * sc, o11 = (x11 * c1 - x21 * s1) * sc, o20 = (x20 * c0 + x10 * s0) * sc, o21 = (x21 * c1 + x11 * s1) * sc;
                    *(u32x4*)(base + row * pitch + head * 64 + 8 * fq) = pack8(o10, o11); *(u32x4*)(base + row * pitch + head * 64 + 32 + 8 * fq) = pack8(o20, o21); }
        }
    }
};
struct EpiWout {
    static constexpr bool MIDK = true;
    const float* mod; bf16_t* x1; const float* x; const float* ssq; LAS float* tab;
    DI void prep(const GUnit& u, int par, int tid) const {
        if (tid < 256) { const size_t row = (size_t)u.pm * 256 + tid; const f32x4 a0 = *(const f32x4*)(ssq + row * 16), a1 = *(const f32x4*)(ssq + row * 16 + 4), b0 = *(const f32x4*)(ssq + row * 16 + 8), b1 = *(const f32x4*)(ssq + row * 16 + 12);
            const float sa = ((a0.x + a0.y) + (a0.z + a0.w)) + ((a1.x + a1.y) + (a1.z + a1.w)), sb = ((b0.x + b0.y) + (b0.z + b0.w)) + ((b1.x + b1.y) + (b1.z + b1.w));
            const float rsb = 1.0f / sqrtf(sa * (1.0f / 512.0f) + EPS), rsw = 1.0f / sqrtf(sb * (1.0f / 512.0f) + EPS);
            *(LAS f32x2*)(tab + (par * 256 + tid) * 2) = (f32x2){rsb / rsw, rsw}; }
        else tab[1024 + par * 256 + (tid - 256)] = mod[((u.pm * 256) / SEQ) * 6144 + 2048 + u.pn * 256 + (tid - 256)];
    }
    DI void midk(f32x4 (&acc)[2][2][4][2], const GUnit& u, int wr, int wc, int fr, int fq, int par) const {
#pragma unroll
        for (int ai = 0; ai < 2; ++ai)
#pragma unroll
            for (int m = 0; m < 4; ++m) { const float ratio = tab[(par * 256 + ai * 128 + wr * 64 + m * 16 + fr) * 2];
#pragma unroll
                for (int bj = 0; bj < 2; ++bj)
#pragma unroll
                    for (int n = 0; n < 2; ++n) acc[ai][bj][m][n] = acc[ai][bj][m][n] * ratio; }
    }
    DI void operator()(f32x4 (&acc)[2][2][4][2], const GUnit& u, int wr, int wc, int fr, int fq, int par) const {
        const int rowb = u.pm * 256 + wr * 64 + fr, colb = u.pn * 256 + wc * 32 + 8 * fq; const int b = (u.pm * 256) / SEQ;
        f32x4 gt[2][2];
#pragma unroll
        for (int bj = 0; bj < 2; ++bj)
#pragma unroll
            for (int n = 0; n < 2; ++n) gt[bj][n] = *(const LAS f32x4*)(tab + 1024 + par * 256 + wc * 32 + 8 * fq + bj * 128 + 4 * n);
        const __amdgpu_buffer_rsrc_t xr = __builtin_amdgcn_make_buffer_rsrc((void*)x, 0, (int)((size_t)T * DM * 4), 0x00020000);
        const unsigned xo = ((unsigned)rowb * DM + (unsigned)colb) * 4u;
        f32x4 xa[2][2][2], xb[2][2][2];
#define WO_LOAD(dst, q) do { _Pragma("unroll") for (int mm = 0; mm < 2; ++mm) _Pragma("unroll") for (int bj = 0; bj < 2; ++bj) _Pragma("unroll") for (int n = 0; n < 2; ++n) \
            dst[mm][bj][n] = __builtin_bit_cast(f32x4, __builtin_amdgcn_raw_buffer_load_b128(xr, xo + (unsigned)(bj * 512 + n * 16), (((q) >> 1) * 128 + (2 * ((q) & 1) + mm) * 16) * (DM * 4), 2)); } while (0)
#define WO_PROC(src, q) do { _Pragma("unroll") for (int mm = 0; mm < 2; ++mm) { const int ai = (q) >> 1, m = 2 * ((q) & 1) + mm, row = rowb + ai * 128 + m * 16; const float rsw = tab[(par * 256 + ai * 128 + wr * 64 + m * 16 + fr) * 2 + 1]; \
            _Pragma("unroll") for (int bj = 0; bj < 2; ++bj) *(u32x4*)(x1 + (size_t)row * DM + colb + bj * 128) = pack8(src[mm][bj][0] + acc[ai][bj][m][0] * rsw, src[mm][bj][1] + acc[ai][bj][m][1] * rsw); } } while (0)
        WO_LOAD(xa, 0); asm volatile("" ::: "memory");
#pragma unroll
        for (int ai = 0; ai < 2; ++ai)
#pragma unroll
            for (int bj = 0; bj < 2; ++bj)
#pragma unroll
                for (int m = 0; m < 4; ++m)
#pragma unroll
                    for (int n = 0; n < 2; ++n) acc[ai][bj][m][n] = acc[ai][bj][m][n] * gt[bj][n];
        asm volatile("" ::: "memory"); WO_LOAD(xb, 1); asm volatile("" ::: "memory");
        WO_PROC(xa, 0); asm volatile("" ::: "memory"); WO_LOAD(xa, 2); asm volatile("" ::: "memory");
        WO_PROC(xb, 1); asm volatile("" ::: "memory"); WO_LOAD(xb, 3); asm volatile("" ::: "memory");
        WO_PROC(xa, 2); asm volatile("" ::: "memory"); WO_PROC(xb, 3); asm volatile("" ::: "memory");
#undef WO_LOAD
#undef WO_PROC
    }
};
DI f32x4 swiglu4(const f32x4 g, const f32x4 uu, float w) { f32x4 o;
#pragma unroll
    for (int j = 0; j < 4; ++j) o[j] = (w * uu[j]) * (g[j] * __builtin_amdgcn_rcpf(1.0f + __builtin_amdgcn_exp2f(-LOG2E * g[j])));
    return o; }
struct EpiUp { static constexpr bool MIDK = true;
    bf16_t* hid; const f32x2* wts; LAS float* tab;
    DI void prep(const GUnit& u, int par, int tid) const {
        if (tid < 256) { float w = 0.f; if (tid < u.nvalid) { const f32x2 ww = wts[u.lbase + tid]; w = u.pn >= 4 ? ww.y : ww.x; } tab[par * 256 + tid] = w; }
    }
    DI void midk(f32x4 (&)[2][2][4][2], const GUnit&, int, int, int, int, int) const {}
    DI void operator()(const f32x4 (&acc)[2][2][4][2], const GUnit& u, int wr, int wc, int fr, int fq, int par) const {
        const int hc = (u.pn >> 2) * 512 + (u.pn & 3) * 128 + wc * 32 + 8 * fq;
#pragma unroll
        for (int ai = 0; ai < 2; ++ai)
#pragma unroll
            for (int m = 0; m < 4; ++m) { const int r = ai * 128 + wr * 64 + m * 16 + fr; const float w = tab[par * 256 + r];
                *(u32x4*)(hid + (size_t)(u.pm * 256 + r) * 1024 + hc) = pack8(swiglu4(acc[ai][0][m][0], acc[ai][1][m][0], w), swiglu4(acc[ai][0][m][1], acc[ai][1][m][1], w)); }
    }
};
struct EpiDown { static constexpr bool MIDK = false;
    bf16_t* y;
    DI void operator()(const f32x4 (&acc)[2][2][4][2], const GUnit& u, int wr, int wc, int fr, int fq, int) const {
        const int rowb = u.pm * 256 + wr * 64 + fr, colb = u.pn * 256 + wc * 32 + 8 * fq;
#pragma unroll
        for (int ai = 0; ai < 2; ++ai)
#pragma unroll
            for (int m = 0; m < 4; ++m) { const size_t row = rowb + ai * 128 + m * 16;
#pragma unroll
                for (int bj = 0; bj < 2; ++bj) *(u32x4*)(y + row * DM + colb + bj * 128) = pack8(acc[ai][bj][m][0], acc[ai][bj][m][1]); }
    }
};

typedef float f32x16 __attribute__((ext_vector_type(16)));
#define MFMA32(a, b, c) __builtin_amdgcn_mfma_f32_32x32x16_bf16((a), (b), (c), 0, 0, 0)
DI int crow(int i, int h) { return (i & 3) + 8 * (i >> 2) + 4 * h; }
template <int S_> DI bf16x8 packacc(const f32x16& x) { u32x4 p; p.x = pk2(x[8 * S_], x[8 * S_ + 1]); p.y = pk2(x[8 * S_ + 2], x[8 * S_ + 3]); p.z = pk2(x[8 * S_ + 4], x[8 * S_ + 5]); p.w = pk2(x[8 * S_ + 6], x[8 * S_ + 7]); return __builtin_bit_cast(bf16x8, p); }
DI f32x16 zero16() { f32x16 z;
#pragma unroll
    for (int i = 0; i < 16; ++i) z[i] = 0.f;
    return z; }
constexpr int AT_SLOT = 16384, ATT_NSLOT = 6;
constexpr int ATT_STG_OFF = ATT_NSLOT * AT_SLOT, ATT_STGW = 32 * 36;
constexpr int ATT_LS_OFF = ATT_STG_OFF + NWAVES * ATT_STGW * 4, ATT_CTL_OFF = ATT_LS_OFF + NWAVES * 32 * 4;
static_assert(ATT_CTL_OFF + 64 <= LDS_MISC, "attention LDS map");
#define AT_WAIT_V(n) asm volatile("s_waitcnt vmcnt(" #n ")" ::: "memory")
#define AT_BARRIER() do { asm volatile("s_waitcnt lgkmcnt(0)" ::: "memory"); __builtin_amdgcn_s_barrier(); asm volatile("" ::: "memory"); } while (0)
DI void at_issue(const bf16_t* Kg, int kp, const bf16_t* VTg, int nf, LAS unsigned char* slotp, int jt, int wave, int lane) {
    const int key = 8 * wave + (lane >> 3), chunk = (lane & 7) ^ ((key >> 1) & 7);
    __builtin_amdgcn_global_load_lds((const unsigned*)(Kg + (64 * (size_t)jt + key) * kp + chunk * 8), (LAS unsigned*)(slotp + wave * 1024), 16, 0, 0);
    const int hh = wave >> 2, d = 16 * (wave & 3) + (lane >> 2), sl = (lane & 3) ^ ((d >> 2) & 3);
    __builtin_amdgcn_global_load_lds((const unsigned*)(VTg + ((2 * (size_t)jt + hh) * nf + d) * 32 + sl * 8), (LAS unsigned*)(slotp + 8192 + wave * 1024), 16, 0, 0);
}
DI void at_kfrag(const LAS unsigned char* sl, int hh, int r, int h, bf16x8 (&kf)[4]) { const int key = 32 * hh + pi32(r), ksw = (key >> 1) & 7; const LAS unsigned char* kb = sl + key * 128;
#pragma unroll
    for (int d0 = 0; d0 < 4; ++d0) kf[d0] = *(const LAS bf16x8*)(kb + (((2 * d0 + h) ^ ksw) * 16)); }
DI void at_vfrag(const LAS unsigned char* sl, int hh, int r, int h, bf16x8 (&vf)[2][2]) {
#pragma unroll
    for (int dt = 0; dt < 2; ++dt)
#pragma unroll
        for (int sx = 0; sx < 2; ++sx) { const int d = 32 * dt + r; vf[dt][sx] = *(const LAS bf16x8*)(sl + 8192 + hh * 4096 + d * 64 + (((2 * sx + h) ^ ((d >> 2) & 3)) * 16)); } }

template <int DIAG> DI void sb_core(const bf16x8 (&kf)[4], const bf16x8 (&vf)[2][2], const bf16x8 (&qf)[4], float& Cl, f32x16 (&o)[2], int r, int h) {
    f32x16 S = zero16();
#pragma unroll
    for (int d0 = 0; d0 < 4; ++d0) S = MFMA32(kf[d0], qf[d0], S);
    float om[16];
#pragma unroll
    for (int i = 0; i < 16; ++i) { float v = __builtin_amdgcn_rcpf(1.0f + __builtin_amdgcn_exp2f(S[i])); if (DIAG && !(16 * (i >> 3) + 8 * h + (i & 7) < r)) v = 1.0f; om[i] = v; }
    f32x2 sf[8]; sf[7] = (f32x2){1.0f, 1.0f};
#pragma unroll
    for (int i = 6; i >= 0; --i) sf[i] = sf[i + 1] * (f32x2){om[i + 1], om[i + 9]};
    float Rx = sf[0].x * om[0], Ry = sf[0].y * om[8];
    asm volatile("" : "+v"(Rx), "+v"(Ry));
    unsigned ax = __builtin_bit_cast(unsigned, Rx), ay = __builtin_bit_cast(unsigned, Ry), bx = ay, by = ax;
    swap32(ax, ay); swap32(bx, by);
    const float p0 = __builtin_bit_cast(float, h == 0 ? ay : bx), p1 = __builtin_bit_cast(float, h == 0 ? by : ax);
    const float m1 = (h == 0 ? p1 : 1.0f) * Cl, m0 = (h == 0 ? p0 * p1 : p1) * Ry * Cl;
    Cl = Cl * ((Rx * Ry) * (p0 * p1));
    const f32x2 mm = (f32x2){m0, m1};
    f32x16 P;
#pragma unroll
    for (int i = 0; i < 8; ++i) { const f32x2 w = (sf[i] * mm) * ((f32x2){1.0f, 1.0f} - (f32x2){om[i], om[i + 8]}); P[i] = w.x; P[i + 8] = w.y; }
    const bf16x8 Pf0 = packacc<0>(P), Pf1 = packacc<1>(P);
#pragma unroll
    for (int dt = 0; dt < 2; ++dt) { o[dt] = MFMA32(Pf0, vf[dt][0], o[dt]); o[dt] = MFMA32(Pf1, vf[dt][1], o[dt]); }
}
constexpr float SB_CMIN = 5.421010862427522e-20f;
struct SbUnit { int b, hd, blk; };
DI SbUnit sb_unit_of(int idx) { SbUnit u; u.b = idx >> 11; u.hd = (idx >> 8) & 7; u.blk = idx & 255; return u; }
DI void sb_load(const bf16_t* Kf, const bf16_t* Vf, int gblk, int lane, bf16x8 (&kf)[4], bf16x8 (&vf)[2][2]) {
    const size_t o = (size_t)(gblk < 0 ? 0 : gblk) * 16384 + lane * 8;
#pragma unroll
    for (int d0 = 0; d0 < 4; ++d0) kf[d0] = *(const bf16x8*)(Kf + o + d0 * 512);
#pragma unroll
    for (int dt = 0; dt < 2; ++dt)
#pragma unroll
        for (int sx = 0; sx < 2; ++sx) vf[dt][sx] = *(const bf16x8*)(Vf + o + (dt * 2 + sx) * 512);
}
DI void sb_wave_unit(const bf16_t* Q, const bf16_t* K, const bf16_t* VT, const SbUnit& u, int lane, f32x16 (&o)[2]) {
    const int r = lane & 31, h = lane >> 5; const size_t gb = (size_t)u.b * SEQ; const int sd = u.blk;
    const bf16_t* Kf = K + (gb >> 5) * 16384 + u.hd * 2048; const bf16_t* Vf = VT + (gb >> 5) * 16384 + u.hd * 2048;
    bf16x8 qf[4], kA[4], vA[2][2], kB[4], vB[2][2], kC[4], vC[2][2];
#pragma unroll
    for (int d0 = 0; d0 < 4; ++d0) qf[d0] = *(const bf16x8*)(Q + (gb + 32 * sd + r) * 512 + u.hd * 64 + 16 * d0 + 8 * h);
    sb_load(Kf, Vf, sd, lane, kA, vA); sb_load(Kf, Vf, sd - 1, lane, kB, vB); sb_load(Kf, Vf, sd - 2, lane, kC, vC);
    o[0] = zero16(); o[1] = zero16(); float Cl = 1.0f;
    sb_core<1>(kA, vA, qf, Cl, o, r, h);
    int s = sd - 1;
    for (;;) {
        if (s < 0 || __all(Cl < SB_CMIN)) break;
        sb_load(Kf, Vf, s - 2, lane, kA, vA); sb_core<0>(kB, vB, qf, Cl, o, r, h); --s;
        if (s < 0 || __all(Cl < SB_CMIN)) break;
        sb_load(Kf, Vf, s - 2, lane, kB, vB); sb_core<0>(kC, vC, qf, Cl, o, r, h); --s;
        if (s < 0 || __all(Cl < SB_CMIN)) break;
        sb_load(Kf, Vf, s - 2, lane, kC, vC); sb_core<0>(kA, vA, qf, Cl, o, r, h); --s;
    }
}
DI void sw_head(const bf16x8 (&qf)[4], const LAS unsigned char* lds, float sink2, int t0, int jt_lo, int lane, f32x16 (&o)[2], float& lsum) {
    const int r = lane & 31, h = lane >> 5, sd = t0 >> 5;
    f32x16 S[5]; float m = sink2;
#pragma unroll
    for (int jj = 0; jj < 5; ++jj) { const int sj = sd - 4 + jj;
        if (sj >= 0) { bf16x8 kf[4]; at_kfrag(lds + ((sj >> 1) - jt_lo) * AT_SLOT, sj & 1, r, h, kf);
            f32x16 s = zero16();
#pragma unroll
            for (int d0 = 0; d0 < 4; ++d0) s = MFMA32(kf[d0], qf[d0], s);
#pragma unroll
            for (int i = 0; i < 16; ++i) { const int ko = 16 * (i >> 3) + 8 * h + (i & 7); float v = s[i];
                if (jj == 4 && ko > r) v = -1e30f;
                if (jj == 0 && ko <= r) v = -1e30f;
                s[i] = v; m = __builtin_fmaxf(m, v); }
            S[jj] = s; }
        else {
#pragma unroll
            for (int i = 0; i < 16; ++i) S[jj][i] = -1e30f; } }
    m = __builtin_fmaxf(m, __shfl_xor(m, 32));
    o[0] = zero16(); o[1] = zero16(); float ls = 0.f;
#pragma unroll
    for (int jj = 0; jj < 5; ++jj) { const int sj = sd - 4 + jj;
        if (sj >= 0) { bf16x8 vf[2][2]; at_vfrag(lds + ((sj >> 1) - jt_lo) * AT_SLOT, sj & 1, r, h, vf);
            f32x16 P;
#pragma unroll
            for (int i = 0; i < 16; ++i) { P[i] = __builtin_amdgcn_exp2f(S[jj][i] - m); ls += P[i]; }
            const bf16x8 Pf0 = packacc<0>(P), Pf1 = packacc<1>(P);
#pragma unroll
            for (int dt = 0; dt < 2; ++dt) { o[dt] = MFMA32(Pf0, vf[dt][0], o[dt]); o[dt] = MFMA32(Pf1, vf[dt][1], o[dt]); } } }
    ls += __shfl_xor(ls, 32);
    lsum = ls + __builtin_amdgcn_exp2f(sink2 - m);
}
DI void at_store(const f32x16 (&o)[2], float lsum, LAS float* stg, LAS float* lsb, bf16_t* mixrow0, float* ssq0, int lane) {
    const int r = lane & 31, h = lane >> 5, row = lane >> 1, hf = lane & 1;
    if (h == 0) lsb[r] = lsum;
    float ss = 0.f; u32x4 w[2][2];
#pragma unroll
    for (int dt = 0; dt < 2; ++dt) {
#pragma unroll
        for (int i = 0; i < 16; ++i) stg[crow(i, h) * 36 + r] = o[dt][i];
        LDS_WAIT();
        const float il = 1.0f / lsb[row];
#pragma unroll
        for (int k = 0; k < 2; ++k) { const f32x4 a0 = *(const LAS f32x4*)(stg + row * 36 + hf * 16 + 8 * k) * il, a1 = *(const LAS f32x4*)(stg + row * 36 + hf * 16 + 8 * k + 4) * il;
            ss += ((a0.x * a0.x + a0.y * a0.y) + (a0.z * a0.z + a0.w * a0.w)) + ((a1.x * a1.x + a1.y * a1.y) + (a1.z * a1.z + a1.w * a1.w)); w[dt][k] = pack8(a0, a1); }
        LDS_WAIT();
    }
    ss += __shfl_xor(ss, 1);
    if (hf == 0) ssq0[(size_t)row * 16] = ss;
    bf16_t* mr = mixrow0 + (size_t)row * 1024 + hf * 16;
#pragma unroll
    for (int dt = 0; dt < 2; ++dt) { *(u32x4*)(mr + 32 * dt) = w[dt][0]; *(u32x4*)(mr + 32 * dt + 8) = w[dt][1]; }
}
DI void p3_attention(const Args& a, LAS unsigned char* lds, int tid, int lane, int wave, int rep = 0, int kinds = 3) {
    asm volatile("" : "+v"(tid), "+v"(lane));
    const bf16_t* QSB = (const bf16_t*)(a.ws + WS_QSB); const bf16_t* KSB = (const bf16_t*)(a.ws + WS_KSB); const bf16_t* VTSB = (const bf16_t*)(a.ws + WS_VSB);
    const bf16_t* QSW = (const bf16_t*)(a.ws + WS_QSW); const bf16_t* KSW = (const bf16_t*)(a.ws + WS_KSW); const bf16_t* VTSW = (const bf16_t*)(a.ws + WS_VSW);
    bf16_t* MIX = (bf16_t*)(a.ws + WS_MIX); float* SSQ = (float*)(a.ws + WS_SSQ); unsigned* qctr = (unsigned*)(a.ws + WS_CTL) + CW_ATTNQ + 2048 * rep;
    LAS float* stg = (LAS float*)(lds + ATT_STG_OFF) + wave * ATT_STGW; LAS float* lsb = (LAS float*)(lds + ATT_LS_OFF) + wave * 32; volatile LAS int* ctl = (volatile LAS int*)(lds + ATT_CTL_OFF);
    if (kinds & 2)
    for (int u = (int)blockIdx.x; u < (T / 256) * 2; u += (int)gridDim.x) {
        const int b = u / 64, kvh = (u >> 5) & 1, q0 = (u & 31) * 256, jt_lo = (q0 >> 6) - 2, t0 = q0 + 32 * wave; const size_t gb = (size_t)b * SEQ;
        const bf16_t* Kg = KSW + gb * 128 + kvh * 64; const bf16_t* VTg = VTSW + ((gb >> 5) * 128 + kvh * 64) * 32;
#pragma unroll
        for (int s6 = 0; s6 < 6; ++s6) if (jt_lo + s6 >= 0) at_issue(Kg, 128, VTg, 128, lds + s6 * AT_SLOT, jt_lo + s6, wave, lane);
        bf16x8 qn[4];
#pragma unroll
        for (int d0 = 0; d0 < 4; ++d0) qn[d0] = *(const bf16x8*)(QSW + (gb + t0 + (lane & 31)) * 512 + (4 * kvh) * 64 + 16 * d0 + 8 * (lane >> 5));
        AT_WAIT_V(0); AT_BARRIER();
#pragma unroll
        for (int q = 0; q < 4; ++q) { const int hq = 4 * kvh + q; f32x16 o[2]; float lsum; bf16x8 qf[4];
#pragma unroll
            for (int d0 = 0; d0 < 4; ++d0) qf[d0] = qn[d0];
            if (q < 3) {
#pragma unroll
                for (int d0 = 0; d0 < 4; ++d0) qn[d0] = *(const bf16x8*)(QSW + (gb + t0 + (lane & 31)) * 512 + (hq + 1) * 64 + 16 * d0 + 8 * (lane >> 5)); }
            sw_head(qf, lds, a.sinks[hq] * LOG2E, t0, jt_lo, lane, o, lsum);
            at_store(o, lsum, stg, lsb, MIX + (gb + t0) * 1024 + 512 + hq * 64, SSQ + (gb + t0) * 16 + 8 + hq, lane); }
        asm volatile("s_waitcnt vmcnt(0)" ::: "memory"); AT_BARRIER();
    }
    if (kinds & 1) {
        constexpr int NUNITS = (T / 32) * 8;
        const bool pooled = ((int)gridDim.x & 7) == 0; const int pool = pooled ? (int)blockIdx.x & 7 : 0, npool = pooled ? 8 : 1, upp = NUNITS / npool;
        const int wrank = (pooled ? ((int)blockIdx.x >> 3) : (int)blockIdx.x) * NWAVES + wave, nw = ((int)gridDim.x / npool) * NWAVES;
        unsigned* ctr = qctr + 64 * pool;
        int li = wrank;
        while (li < upp) {
            unsigned nxt = 0;
            if (lane == 0) nxt = atomicAdd(ctr, 1u);
            const SbUnit u = sb_unit_of(pool * upp + li);
            f32x16 o[2];
            sb_wave_unit(QSB, KSB, VTSB, u, lane, o);
            const size_t grow = (size_t)u.b * SEQ + 32 * u.blk;
            at_store(o, 1.0f, stg, lsb, MIX + grow * 1024 + u.hd * 64, SSQ + grow * 16 + u.hd, lane);
            li = nw + (int)__builtin_amdgcn_readfirstlane(nxt);
        }
    }
}

#define XB_TMO      128
#define XB_XCNT(j)  (256  + 64 * (j))
#define XB_XSUB(j)  (1280 + 64 * (j))
#define XB_XGEN(j)  (2304 + 64 * (j))
#define XB_TOP      3328
#define XB_TOPGEN   3392
#define XCD_BAR_WORDS 3456
#define XB_SPIN_CAP (1u << 18)
DI unsigned xb_ld(unsigned* p)              { return __hip_atomic_load(p, __ATOMIC_RELAXED, __HIP_MEMORY_SCOPE_AGENT); }
DI unsigned xb_add(unsigned* p, unsigned v) { return __hip_atomic_fetch_add(p, v, __ATOMIC_RELAXED, __HIP_MEMORY_SCOPE_AGENT); }
DI unsigned xb_xcc_id() { return (unsigned)__builtin_amdgcn_s_getreg((3 << 11) | 20) & 0xFu; }
#define XB_SPIN(cond, bar) do { unsigned _sp = 0; while (cond) { __builtin_amdgcn_s_sleep(1); \
    if ((++_sp & 255u) == 0u) { if (xb_ld(&(bar)[XB_TMO])) break; if (_sp > XB_SPIN_CAP) { atomicAdd(&(bar)[XB_TMO], 1u); break; } } } } while (0)
struct XcdBarrier { unsigned* bar; unsigned x; volatile LAS unsigned* st; };
DI XcdBarrier xcd_barrier_post(unsigned* bar, volatile LAS unsigned* st) {
    XcdBarrier b; b.bar = bar; b.x = xb_xcc_id(); b.st = st;
    if (threadIdx.x == 0) (void)xb_add(&bar[XB_XCNT(b.x)], 1u);
    return b;
}
DI void xcd_barrier_complete(unsigned* bar, unsigned x, unsigned& nloc, unsigned& nx) {
    const unsigned G = gridDim.x * gridDim.y * gridDim.z;
    unsigned sum, cnt, mine, sp = 0u;
    for (;;) {
        sum = 0u; cnt = 0u; mine = 0u;
#pragma unroll
        for (unsigned j = 0; j < 16; ++j) { const unsigned c = xb_ld(&bar[XB_XCNT(j)]); sum += c; cnt += (c > 0u) ? 1u : 0u; mine = (j == x) ? c : mine; }
        if (sum == G) break;
        __builtin_amdgcn_s_sleep(1);
        if ((++sp & 255u) == 0u) { if (xb_ld(&bar[XB_TMO])) break; if (sp > XB_SPIN_CAP) { atomicAdd(&bar[XB_TMO], 1u); break; } }
    }
    nloc = mine > 0u ? mine : 1u; nx = cnt > 0u ? cnt : 1u;
}
DI void xcd_barrier(const XcdBarrier& b) {
    asm volatile("s_waitcnt vmcnt(0)" ::: "memory");
    __syncthreads();
    if (threadIdx.x == 0) {
        unsigned* bar = b.bar;
        __builtin_amdgcn_s_waitcnt(0);
        unsigned nloc = b.st[0], nx = b.st[1];
        if (nloc == 0u) { xcd_barrier_complete(bar, b.x, nloc, nx); b.st[0] = nloc; b.st[1] = nx; }
        const unsigned old = xb_add(&bar[XB_XSUB(b.x)], 1u);
        const unsigned gen = old / nloc;
        if (old + 1u == (gen + 1u) * nloc) {
            __builtin_amdgcn_fence(__ATOMIC_RELEASE, "agent");
            asm volatile("s_waitcnt vmcnt(0)" ::: "memory");
            const unsigned og = xb_add(&bar[XB_TOP], 1u);
            const unsigned tg = og / nx;
            if (og + 1u == (tg + 1u) * nx) xb_add(&bar[XB_TOPGEN], 1u);
            else XB_SPIN(xb_ld(&bar[XB_TOPGEN]) == tg, bar);
            __builtin_amdgcn_fence(__ATOMIC_ACQUIRE, "agent");
            xb_add(&bar[XB_XGEN(b.x)], 1u);
            asm volatile("s_waitcnt vmcnt(0)" ::: "memory");
        } else {
            XB_SPIN(xb_ld(&bar[XB_XGEN(b.x)]) == gen, bar);
            __builtin_amdgcn_fence(__ATOMIC_ACQUIRE, "agent");
            asm volatile("s_waitcnt vmcnt(0)" ::: "memory");
        }
    }
    __syncthreads();
}

__global__ void __launch_bounds__(NTHREADS, 2) mk_fwd(Args a) {
    extern __shared__ __attribute__((aligned(16))) unsigned char lds_raw[];
    LAS unsigned char* lds = (LAS unsigned char*)lds_raw;
    const int tid = threadIdx.x, lane = tid & 63, wave = __builtin_amdgcn_readfirstlane(tid >> 6);
    volatile LAS unsigned* misc = (volatile LAS unsigned*)(lds + LDS_MISC);
    if (tid < 2) misc[tid] = 0u;
    __syncthreads();
    const XcdBarrier gbar = xcd_barrier_post((unsigned*)(a.ws + WS_CTL) + CW_BAR, misc);
    unsigned char* ws = a.ws;
    const float* mod = (const float*)(ws + WS_MOD);

#define REPS(k) ((PROBE_DUP == (k)) ? 2 : 1)
    int n_stamp = 0;
#define STAMP() do { if (STAMP_PHASE >= 0 && blockIdx.x == 0 && tid == 0) ((unsigned long long*)(ws + WS_STAMP))[n_stamp] = __builtin_amdgcn_s_memrealtime(); ++n_stamp; } while (0)
    STAMP();
    const int p2_units = (T / 256) * (DIN / 256), p2_rem = p2_units % (int)gridDim.x, n_tailw = p2_rem ? ((int)gridDim.x - p2_rem) * NWAVES : 0;
    const int n_tail_items = n_tailw * 4 < NEXPERT_ITEMS ? n_tailw * 4 : NEXPERT_ITEMS, n_p0_items = NEXPERT_ITEMS - n_tail_items;
    for (int rep = 0; rep < REPS(0); ++rep) { p0_prologue(a, lds, tid, lane, wave); expert_items(a, lds, 0, n_p0_items, blockIdx.x * NWAVES + wave, gridDim.x * NWAVES, lane, wave); xcd_barrier(gbar); STAMP(); }
    for (int rep = 0; rep < REPS(1); ++rep) { p1_norm(a, lds, tid, lane, wave); if (wave == 7) router_tables(a, lane); xcd_barrier(gbar); STAMP(); }
    for (int rep = 0; rep < REPS(2); ++rep) {
        DenseSched S{(const bf16_t*)(ws + WS_H), (const bf16_t*)(ws + WS_WIN), 1024, T / 256, DIN / 256};
        EpiProj E{(bf16_t*)(ws + WS_QSB), (bf16_t*)(ws + WS_VSB), (bf16_t*)(ws + WS_QSW), (bf16_t*)(ws + WS_KSW), (bf16_t*)(ws + WS_VSW), (const float*)(ws + WS_COS), (const float*)(ws + WS_SIN)};
        pg8::gemm_phase<DenseSched, EpiProj, true, 1024, 1024, 16>(lds, S, E);
        if (p2_rem && (int)blockIdx.x >= p2_rem && rep == 0) { __syncthreads(); expert_items(a, lds, n_p0_items, n_tail_items, ((int)blockIdx.x - p2_rem) * NWAVES + wave, n_tailw, lane, wave); }
        xcd_barrier(gbar); STAMP();
    }
    if (PROBE_DUP == 31 || PROBE_DUP == 32) { p3_attention(a, lds, tid, lane, wave, 1, PROBE_DUP - 30); xcd_barrier(gbar); }
    for (int rep = 0; rep < REPS(3); ++rep) { p3_attention(a, lds, tid, lane, wave, rep); xcd_barrier(gbar); STAMP(); }
    for (int rep = 0; rep < REPS(4); ++rep) {
        DenseSched S{(const bf16_t*)(ws + WS_MIX), (const bf16_t*)(ws + WS_WOUT), 1024, T / 256, DM / 256};
        EpiWout E{mod, (bf16_t*)(ws + WS_X1), a.x, (const float*)(ws + WS_SSQ), (LAS float*)(lds + pg8::STAGE_BYTES + 1024)};
        pg8::gemm_phase<DenseSched, EpiWout, true, 1024, 1024, 16>(lds, S, E);
        xcd_barrier(gbar); STAMP();
    }
    for (int rep = 0; rep < REPS(5); ++rep) { p5_router(a, lds, tid, lane, wave, rep); xcd_barrier(gbar); STAMP(); }
    LAS int* tstart = (LAS int*)(lds + pg8::STAGE_BYTES);
    const unsigned* cnt = (const unsigned*)(ws + WS_CTL) + CW_CNT;
    if (tid == 0) { int run = 0; for (int b = 0; b < NBUCKET; ++b) { tstart[b] = run; run += ((int)cnt[CNT_STRIDE * b] + 255) >> 8; } tstart[NBUCKET] = run; }
    __syncthreads();
    const bf16_t* H2 = (const bf16_t*)(ws + WS_H); const bf16_t* HIDc = (const bf16_t*)(ws + WS_HID); const int* LISTc = (const int*)(ws + WS_LIST);
    EpiUp EU{(bf16_t*)(ws + WS_HID), (const f32x2*)(ws + WS_WTS), (LAS float*)(lds + pg8::STAGE_BYTES + 1024)}; EpiDown ED{(bf16_t*)(ws + WS_Y)};
    if (gridDim.x == 256) {
        const MoeCut mc = moe_cut(__builtin_amdgcn_readfirstlane(tstart[NBUCKET]));
        { MoeSplitSched<true, 1> S{tstart, cnt, LISTc, H2, (const bf16_t*)(ws + WS_WGU), mc}; pg8::gemm_phase<MoeSplitSched<true, 1>, EpiUp, true, 1024, 1024, 16>(lds, S, EU); }
        xcd_barrier(gbar); STAMP();
        if (((int)blockIdx.x >> 3) < mc.left) { MoeSplitSched<true, 2> S{tstart, cnt, LISTc, H2, (const bf16_t*)(ws + WS_WGU), mc}; pg8::gemm_phase<MoeSplitSched<true, 2>, EpiUp, true, 1024, 1024, 16>(lds, S, EU); }
        else { MoeSplitSched<false, 2> S{tstart, cnt, LISTc, HIDc, (const bf16_t*)(ws + WS_WD), mc}; pg8::gemm_phase<MoeSplitSched<false, 2>, EpiDown, true, 1024, 512, 8>(lds, S, ED); }
        xcd_barrier(gbar); STAMP();
        { MoeSplitSched<false, 3> S{tstart, cnt, LISTc, HIDc, (const bf16_t*)(ws + WS_WD), mc}; pg8::gemm_phase<MoeSplitSched<false, 3>, EpiDown, true, 1024, 512, 8>(lds, S, ED); }
    } else {
        { MoeSched<8, true> S{tstart, cnt, LISTc, H2, (const bf16_t*)(ws + WS_WGU)}; pg8::gemm_phase<MoeSched<8, true>, EpiUp, true, 1024, 1024, 16>(lds, S, EU); }
        xcd_barrier(gbar); STAMP();
        { MoeSched<4, false> S{tstart, cnt, LISTc, HIDc, (const bf16_t*)(ws + WS_WD)}; pg8::gemm_phase<MoeSched<4, false>, EpiDown, true, 1024, 512, 8>(lds, S, ED); }
    }
    if (STAMP_PHASE >= 0) {
        if (blockIdx.x == 0 && tid == 0) { unsigned long long* st = (unsigned long long*)(ws + WS_STAMP); st[n_stamp] = __builtin_amdgcn_s_memrealtime();
            const float t_us = (float)(st[STAMP_PHASE + 1] - st[STAMP_PHASE]) * 0.01f; *(float*)(ws + WS_STAMP + 256) = 1.0f + sqrtf(t_us * STAMP_K); } }
    xcd_barrier(gbar);
    if (PROBE_DUP == 8) { p8_final(a, tstart, lane, wave, (float*)(ws + WS_H)); xcd_barrier(gbar); }
    p8_final(a, tstart, lane, wave, a.out);
}

extern "C" void kernel_launch(void* const* d_in, const int* in_sizes, int n_in, void* d_out, int out_size, void* d_ws, size_t ws_size, hipStream_t stream) {
    static int grid = 0;
    if (grid == 0) {
        if (n_in != 18 || in_sizes[0] != T * DM || out_size != T * DM || ws_size < WS_END) { fprintf(stderr, "kernel_launch: unexpected shapes (n_in %d, in0 %d, out %d, ws %zu); nothing launched\n", n_in, n_in > 0 ? in_sizes[0] : -1, out_size, ws_size); grid = -1; return; }
        int dev = 0, cus = 0, per_cu = 0;
        (void)hipGetDevice(&dev); (void)hipDeviceGetAttribute(&cus, hipDeviceAttributeMultiprocessorCount, dev);
        (void)hipFuncSetAttribute((const void*)mk_fwd, hipFuncAttributeMaxDynamicSharedMemorySize, LDS_BYTES);
        (void)hipOccupancyMaxActiveBlocksPerMultiprocessor(&per_cu, (const void*)mk_fwd, NTHREADS, LDS_BYTES);
        if (per_cu < 1) { fprintf(stderr, "kernel_launch: occupancy query says %d blocks per CU\n", per_cu); per_cu = 1; }
        grid = cus * per_cu;
        fprintf(stderr, "kernel_launch: %d CUs x %d = grid %d\n", cus, per_cu, grid);
    }
    if (grid < 0) return;
    (void)hipMemsetAsync((char*)d_ws + WS_CTL, 0, CTL_BYTES, stream);
    Args a{};
    a.x = (const float*)d_in[0]; a.c = (const float*)d_in[1]; a.pos = (const int*)d_in[2]; a.w_ada = (const float*)d_in[3]; a.b_ada = (const float*)d_in[4]; a.g_mix = (const float*)d_in[5];
    a.w_in = (const float*)d_in[6]; a.sinks = (const float*)d_in[7]; a.g_sb = (const float*)d_in[8]; a.g_sw = (const float*)d_in[9]; a.w_out = (const float*)d_in[10]; a.g_ffn = (const float*)d_in[11];
    a.w_rg = (const float*)d_in[12]; a.w_re = (const float*)d_in[13]; a.w_gate = (const float*)d_in[14]; a.w_up = (const float*)d_in[15]; a.w_down = (const float*)d_in[16]; a.g_fin = (const float*)d_in[17];
    a.out = (float*)d_out; a.ws = (unsigned char*)d_ws;
    void* args[] = {&a};
    hipError_t e = hipLaunchCooperativeKernel((const void*)mk_fwd, dim3(grid), dim3(NTHREADS), args, LDS_BYTES, stream);
    if (e != hipSuccess) fprintf(stderr, "kernel_launch: cooperative launch failed: %s (grid %d)\n", hipGetErrorString(e), grid);
}
```
